# Optimizing an MI355X kernel written in HIP

```python
import math
import jax
import jax.numpy as jnp
from jax import lax
import numpy as np


D_MODEL = 1024
BATCH = 8
SEQ = 2048
DEPTH = 2

F32 = jnp.float32
GRID_W = 64
CTX_LEN = 256
Q_BLOCK = 128
ROPE_THETA = 10000.0
LN_EPS = 1e-5
DEEPNORM_ALPHA = (2 * DEPTH) ** 0.25
DEEPNORM_BETA = (8 * DEPTH) ** -0.25
N_EVEN = (DEPTH + 1) // 2
N_ODD = DEPTH // 2
MIX_WIDTH = D_MODEL

A_HEAD_DIM = 64
A_HEADS = (MIX_WIDTH // 2) // A_HEAD_DIM
A_WIDTH = A_HEADS * A_HEAD_DIM
A_DECAY_LORA = 64
A_ICLR_LORA = 64
A_GATE_LORA = 128
A_GN_EPS = 64e-5
A_IN = 3 * A_WIDTH + 2 * A_DECAY_LORA + 2 * A_ICLR_LORA + A_GATE_LORA

B_HEAD_DIM = 64
B_V_DIM = 2 * B_HEAD_DIM
B_HEADS = (MIX_WIDTH - A_WIDTH) // B_V_DIM
B_WIDTH = B_HEADS * B_V_DIM
B_QK = B_HEADS * 2 * B_HEAD_DIM
B_IN = 2 * B_QK + B_WIDTH
B_SUBLN_EPS = 1e-5
EVEN_IN = A_IN + B_IN

C_HEAD_DIM = 128
C_HEADS = MIX_WIDTH // C_HEAD_DIM
C_KV_HEADS = 2
C_GROUP = C_HEADS // C_KV_HEADS
C_Q = C_HEADS * C_HEAD_DIM
C_KV = C_KV_HEADS * C_HEAD_DIM
ODD_IN = C_Q + 2 * C_KV
QK_NORM_EPS = 1e-6

N_EXPERTS = 16
N_GROUPS = 4
EXPERTS_PER_GROUP = N_EXPERTS // N_GROUPS
TOP_K = 2
EXPERT_FF = 512

kernel_name = 'hybrid_rwkv7_diffattn_gqa_grouped_moe'


def _layer_norm(x, g, b):
    xf = x.astype(F32)
    mu = jnp.mean(xf, -1, keepdims=True)
    var = jnp.mean(jnp.square(xf - mu), -1, keepdims=True)
    return ((xf - mu) * lax.rsqrt(var + LN_EPS) * g + b).astype(x.dtype)


def _rms_norm(x, g, eps):
    xf = x.astype(F32)
    y = xf * lax.rsqrt(jnp.mean(jnp.square(xf), -1, keepdims=True) + eps)
    return (y * g).astype(x.dtype)


def _modulate(x, shift, scale):
    return x * (1.0 + scale) + shift


def _rope_tables(row_pos, col_pos, head_dim):
    axis_dim = head_dim // 2
    inv = ROPE_THETA ** (-jnp.arange(0, axis_dim, 2, dtype=F32) / axis_dim)
    ang = jnp.concatenate([row_pos[:, None] * inv, col_pos[:, None] * inv], -1)
    return jnp.cos(ang), jnp.sin(ang)


def _apply_rope(x, cos, sin):
    half = x.shape[-1] // 2
    shape = (1, x.shape[1]) + (1,) * (x.ndim - 3) + (half,)
    cs, sn = cos.reshape(shape), sin.reshape(shape)
    xf = x.astype(F32)
    x1, x2 = xf[..., :half], xf[..., half:]
    return jnp.concatenate([x1 * cs - x2 * sn, x1 * sn + x2 * cs], -1).astype(x.dtype)


def _sweep_query_blocks(fn, q):
    bsz, s = q.shape[:2]
    nb = s // Q_BLOCK
    qb = jnp.moveaxis(q.reshape((bsz, nb, Q_BLOCK) + q.shape[2:]), 1, 0)
    out = jnp.moveaxis(lax.map(fn, qb), 0, 1)
    return out.reshape((bsz, s) + out.shape[3:])


def _centred_shift(p):
    zero = jnp.zeros_like(p[:, :1])
    prev = jnp.concatenate([zero, p[:, :-1]], axis=1)
    nxt = jnp.concatenate([p[:, 1:], zero], axis=1)
    return 0.5 * (prev + nxt)


def _heads_a(z):
    return z.reshape(z.shape[:-1] + (A_HEADS, A_HEAD_DIM))


def _rwkv_features(pa, mu, w0, w2, a0, a2, g2, k_k, k_a):
    bsz, t, _ = pa.shape
    u = pa + (_centred_shift(pa) - pa) * mu
    o1, o2, o3 = A_WIDTH, 2 * A_WIDTH, 3 * A_WIDTH
    o4 = o3 + 2 * A_DECAY_LORA
    o5 = o4 + 2 * A_ICLR_LORA
    r, k, v = u[..., :o1], u[..., o1:o2], u[..., o2:o3]
    wd = u[..., o3:o4].reshape(bsz, t, 2, A_DECAY_LORA)
    ad = u[..., o4:o5].reshape(bsz, t, 2, A_ICLR_LORA)
    gd = u[..., o5:]
    w_log = -jax.nn.softplus(-(w0 + jnp.einsum('btdl,dlc->btdc', jnp.tanh(wd), w2))) - 0.5
    decay = jnp.exp(-jnp.exp(w_log.astype(F32)))
    a = jax.nn.sigmoid(a0 + jnp.einsum('btdl,dlc->btdc', ad, a2))
    g = jax.nn.sigmoid(gd) @ g2
    kk = _heads_a(k * k_k).astype(F32)
    kk = kk / jnp.maximum(jnp.sqrt(jnp.sum(jnp.square(kk), -1, keepdims=True)), 1e-12)
    k_dir = k[:, :, None, :] * (1.0 + (a - 1.0) * k_a)
    return _heads_a(r), _heads_a(k_dir), _heads_a(v), _heads_a(decay), kk, _heads_a(a), g


def _wkv7_scan(feats, d, s0, reverse):
    r, k_dir, v, decay, kk, a, _ = feats
    tm = lambda z: jnp.moveaxis(z.astype(F32), 1, 0)
    xs = (tm(r), tm(decay[:, :, d]), tm(k_dir[:, :, d]), tm(v), tm(-kk), tm(kk * a[:, :, d]))

    def step(s, inp):
        r_t, w_t, k_t, v_t, a_t, b_t = inp
        sa = jnp.einsum('bhvk,bhk->bhv', s, a_t)
        s = s * w_t[:, :, None, :] + sa[..., :, None] * b_t[..., None, :] + v_t[..., :, None] * k_t[..., None, :]
        return s, jnp.einsum('bhvk,bhk->bhv', s, r_t)

    s_final, ys = lax.scan(step, s0, xs, reverse=reverse)
    return jnp.moveaxis(ys, 0, 1), s_final


def _rwkv_readout(y, feats, r_k, lnx_g, lnx_b):
    r, k_dir, v, _, _, _, g = feats
    bsz, t = y.shape[:2]
    mu = jnp.mean(y, -1, keepdims=True)
    var = jnp.mean(jnp.square(y - mu), -1, keepdims=True)
    yn = ((y - mu) * lax.rsqrt(var + A_GN_EPS)).reshape(bsz, t, A_WIDTH) * lnx_g + lnx_b
    bonus = jnp.sum(r * (k_dir[:, :, 0] + k_dir[:, :, 1]) * r_k, -1, keepdims=True) * v
    return ((yn + bonus.reshape(bsz, t, A_WIDTH)) * g).astype(g.dtype)


def _rwkv7_group(pa_c, pa_l, mu, w0, w2, a0, a2, g2, k_k, k_a, r_k, lnx_g, lnx_b):
    feats_c = _rwkv_features(pa_c, mu, w0, w2, a0, a2, g2, k_k, k_a)
    feats_l = _rwkv_features(pa_l, mu, w0, w2, a0, a2, g2, k_k, k_a)
    s0 = jnp.zeros((pa_l.shape[0], A_HEADS, A_HEAD_DIM, A_HEAD_DIM), F32)
    ys_c, ys_l = [], []
    for d, rev in enumerate((False, True)):
        y_c, s_ctx = _wkv7_scan(feats_c, d, s0, rev)
        y_l, _ = _wkv7_scan(feats_l, d, s_ctx, rev)
        ys_c.append(y_c)
        ys_l.append(y_l)
    out_c = _rwkv_readout(ys_c[0] + ys_c[1], feats_c, r_k, lnx_g, lnx_b)
    out_l = _rwkv_readout(ys_l[0] + ys_l[1], feats_l, r_k, lnx_g, lnx_b)
    return out_c, out_l


def _diff_core(q, k, v, lam):
    s = jnp.einsum('bqhmd,bkhmd->bhmqk', q, k).astype(F32) * (B_HEAD_DIM ** -0.5)
    p = jax.nn.softmax(s, axis=-1)
    w = p[:, :, 0] - lam * p[:, :, 1]
    return jnp.einsum('bhqk,bkhe->bqhe', w.astype(v.dtype), v)


def _diff_attn_group(pb_c, pb_l, lam_vecs, subln_g, lambda_init, cos, sin):
    def split(p):
        bsz, t, _ = p.shape
        q = p[..., :B_QK].reshape(bsz, t, B_HEADS, 2, B_HEAD_DIM)
        k = p[..., B_QK:2 * B_QK].reshape(bsz, t, B_HEADS, 2, B_HEAD_DIM)
        v = p[..., 2 * B_QK:].reshape(bsz, t, B_HEADS, B_V_DIM)
        return q, k, v

    q_c, k_c, v_c = split(pb_c)
    q_l, k_l, v_l = split(pb_l)
    q_l = _apply_rope(q_l, cos, sin)
    k_l = _apply_rope(k_l, cos, sin)
    lv = lam_vecs.astype(F32)
    lam = jnp.exp(jnp.sum(lv[0] * lv[1])) - jnp.exp(jnp.sum(lv[2] * lv[3])) + lambda_init
    k_all = jnp.concatenate([k_c, k_l], axis=1)
    v_all = jnp.concatenate([v_c, v_l], axis=1)
    o_l = _sweep_query_blocks(lambda qb: _diff_core(qb, k_all, v_all, lam), q_l)
    o_c = _diff_core(q_c, k_c, v_c, lam)

    def post(o):
        bsz, t = o.shape[:2]
        return (_rms_norm(o, subln_g, B_SUBLN_EPS) * (1.0 - lambda_init)).reshape(bsz, t, B_WIDTH)

    return post(o_c), post(o_l)


def _even_mixer(hc, hl, w_in, w_out, a_mu, a_w0, a_w2, a_a0, a_a2, a_g2, a_kk, a_ka, a_rk,
                a_lnx_g, a_lnx_b, b_lam, b_subln_g, lambda_init, cos, sin):
    pc = hc @ w_in
    pl = hl @ w_in
    ya_c, ya_l = _rwkv7_group(pc[..., :A_IN], pl[..., :A_IN], a_mu, a_w0, a_w2, a_a0, a_a2, a_g2,
                              a_kk, a_ka, a_rk, a_lnx_g, a_lnx_b)
    yb_c, yb_l = _diff_attn_group(pc[..., A_IN:], pl[..., A_IN:], b_lam, b_subln_g, lambda_init, cos, sin)
    out_c = jnp.concatenate([ya_c, yb_c], -1) @ w_out
    out_l = jnp.concatenate([ya_l, yb_l], -1) @ w_out
    return out_c, out_l


def _gqa_core(q, k, v):
    s = jnp.einsum('bqhgd,bkhd->bhgqk', q, k).astype(F32) * (C_HEAD_DIM ** -0.5)
    p = jax.nn.softmax(s, axis=-1).astype(v.dtype)
    return jnp.einsum('bhgqk,bkhd->bqhgd', p, v)


def _odd_mixer(hc, hl, w_in, w_out, qn_g, kn_g, cos, sin, need_ctx):
    def proj(h, with_q):
        bsz, t, _ = h.shape
        p = h @ (w_in if with_q else w_in[:, C_Q:])
        off = C_Q if with_q else 0
        q = None
        if with_q:
            q = _rms_norm(p[..., :C_Q].reshape(bsz, t, C_KV_HEADS, C_GROUP, C_HEAD_DIM), qn_g, QK_NORM_EPS)
        k = _rms_norm(p[..., off:off + C_KV].reshape(bsz, t, C_KV_HEADS, C_HEAD_DIM), kn_g, QK_NORM_EPS)
        v = p[..., off + C_KV:].reshape(bsz, t, C_KV_HEADS, C_HEAD_DIM)
        return q, k, v

    q_l, k_l, v_l = proj(hl, True)
    q_l = _apply_rope(q_l, cos, sin)
    k_l = _apply_rope(k_l, cos, sin)
    q_c, k_c, v_c = proj(hc, need_ctx)
    k_all = jnp.concatenate([k_c, k_l], axis=1)
    v_all = jnp.concatenate([v_c, v_l], axis=1)
    bsz, s = hl.shape[:2]
    o_l = _sweep_query_blocks(lambda qb: _gqa_core(qb, k_all, v_all), q_l)
    out_l = o_l.reshape(bsz, s, C_Q) @ w_out
    out_c = None
    if need_ctx:
        out_c = _gqa_core(q_c, k_c, v_c).reshape(hc.shape[0], hc.shape[1], C_Q) @ w_out
    return out_c, out_l


def _moe(h, router_w, router_b, w1, w3, w2):
    t = h.shape[0]
    logits = (h @ router_w).astype(F32) + router_b.astype(F32)
    probs = jax.nn.softmax(logits, axis=-1)
    gscore = jnp.sum(lax.top_k(probs.reshape(t, N_GROUPS, EXPERTS_PER_GROUP), TOP_K)[0], -1)
    best = jnp.argmax(gscore, axis=-1)
    in_grp = (jnp.arange(N_EXPERTS) // EXPERTS_PER_GROUP)[None, :] == best[:, None]
    top_p, top_i = lax.top_k(jnp.where(in_grp, probs, -jnp.inf), TOP_K)
    top_w = top_p / jnp.sum(top_p, -1, keepdims=True)
    gates = jnp.sum(jax.nn.one_hot(top_i, N_EXPERTS, dtype=F32) * top_w[..., None], axis=1).astype(h.dtype)
    out = jnp.zeros_like(h)
    for e in range(N_EXPERTS):
        hid = jax.nn.silu(h @ w1[e]) * (h @ w3[e])
        out = out + gates[:, e:e + 1] * (hid @ w2[e])
    return out


def setup_inputs(seed: int = 0) -> dict:
    key = jax.random.key(seed)
    ks = iter(jax.random.split(key, 48))

    def nrm(shape, scale):
        return jax.random.normal(next(ks), shape, F32) * scale

    def unif(shape, lo, hi):
        return jax.random.uniform(next(ks), shape, F32, lo, hi)

    d = D_MODEL
    ev_out = A_WIDTH + B_WIDTH
    return {
        'x': nrm((BATCH, SEQ, d), 1.0),
        'c': nrm((BATCH, d), 1.0),
        'ctx': nrm((BATCH, CTX_LEN, d), 1.0),
        'c_ctx': nrm((d,), 1.0),
        'router_w': nrm((d, N_EXPERTS), d ** -0.5),
        'router_b': nrm((N_EXPERTS,), 0.01),
        'ada_w': nrm((DEPTH, d, 6 * d), 0.5 * d ** -0.5),
        'ada_b': nrm((DEPTH, 6 * d), 0.01),
        'ln1_g': 1.0 + nrm((DEPTH, d), 0.02),
        'ln1_b': nrm((DEPTH, d), 0.02),
        'ln2_g': 1.0 + nrm((DEPTH, d), 0.02),
        'ln2_b': nrm((DEPTH, d), 0.02),
        'moe_w1': nrm((DEPTH, N_EXPERTS, d, EXPERT_FF), d ** -0.5),
        'moe_w3': nrm((DEPTH, N_EXPERTS, d, EXPERT_FF), d ** -0.5),
        'moe_w2': nrm((DEPTH, N_EXPERTS, EXPERT_FF, d), DEEPNORM_BETA * EXPERT_FF ** -0.5),
        'ev_w_in': nrm((N_EVEN, d, EVEN_IN), d ** -0.5),
        'ev_w_out': nrm((N_EVEN, ev_out, d), DEEPNORM_BETA * ev_out ** -0.5),
        'ev_a_mu': unif((N_EVEN, A_IN), 0.0, 1.0),
        'ev_a_w0': unif((N_EVEN, 2, A_WIDTH), -6.0, -1.0),
        'ev_a_w2': nrm((N_EVEN, 2, A_DECAY_LORA, A_WIDTH), 0.5 * A_DECAY_LORA ** -0.5),
        'ev_a_a0': nrm((N_EVEN, 2, A_WIDTH), 0.1),
        'ev_a_a2': nrm((N_EVEN, 2, A_ICLR_LORA, A_WIDTH), 0.5 * A_ICLR_LORA ** -0.5),
        'ev_a_g2': nrm((N_EVEN, A_GATE_LORA, A_WIDTH), A_GATE_LORA ** -0.5),
        'ev_a_kk': 0.85 + nrm((N_EVEN, A_WIDTH), 0.05),
        'ev_a_ka': 1.0 + nrm((N_EVEN, A_WIDTH), 0.05),
        'ev_a_rk': nrm((N_EVEN, A_HEADS, A_HEAD_DIM), 0.1),
        'ev_a_lnx_g': 1.0 + nrm((N_EVEN, A_WIDTH), 0.02),
        'ev_a_lnx_b': nrm((N_EVEN, A_WIDTH), 0.02),
        'ev_b_lam': nrm((N_EVEN, 4, B_HEAD_DIM), 0.1),
        'ev_b_subln_g': 1.0 + nrm((N_EVEN, B_V_DIM), 0.02),
        'od_w_in': nrm((N_ODD, d, ODD_IN), d ** -0.5),
        'od_w_out': nrm((N_ODD, C_Q, d), DEEPNORM_BETA * C_Q ** -0.5),
        'od_qn_g': 1.0 + nrm((N_ODD, C_HEAD_DIM), 0.02),
        'od_kn_g': 1.0 + nrm((N_ODD, C_HEAD_DIM), 0.02),
    }


def reference(x, c, ctx, c_ctx, router_w, router_b, ada_w, ada_b, ln1_g, ln1_b, ln2_g, ln2_b,
              moe_w1, moe_w3, moe_w2, ev_w_in, ev_w_out, ev_a_mu, ev_a_w0, ev_a_w2, ev_a_a0, ev_a_a2,
              ev_a_g2, ev_a_kk, ev_a_ka, ev_a_rk, ev_a_lnx_g, ev_a_lnx_b, ev_b_lam, ev_b_subln_g,
              od_w_in, od_w_out, od_qn_g, od_kn_g):
    bsz, n_lat, d = x.shape
    rows = n_lat // GRID_W
    rr, cc = jnp.meshgrid(jnp.arange(rows), jnp.arange(GRID_W), indexing='ij')
    row_pos = rr.reshape(-1).astype(F32)
    col_pos = cc.reshape(-1).astype(F32)
    cos_b, sin_b = _rope_tables(row_pos, col_pos, B_HEAD_DIM)
    cos_c, sin_c = _rope_tables(row_pos, col_pos, C_HEAD_DIM)
    s_lat = jax.nn.silu(c)
    s_ctx = jax.nn.silu(c_ctx)
    xl, xc = x, ctx
    for i in range(DEPTH):
        last = i == DEPTH - 1
        j = i // 2
        mod_l = jnp.split((s_lat @ ada_w[i] + ada_b[i])[:, None, :], 6, axis=-1)
        mod_c = jnp.split(s_ctx @ ada_w[i] + ada_b[i], 6, axis=-1)
        hl = _modulate(xl, mod_l[0], mod_l[1])
        hc = _modulate(xc, mod_c[0], mod_c[1])
        if i % 2 == 0:
            lambda_init = 0.8 - 0.6 * math.exp(-0.3 * i)
            mix_c, mix_l = _even_mixer(hc, hl, ev_w_in[j], ev_w_out[j], ev_a_mu[j], ev_a_w0[j], ev_a_w2[j],
                                       ev_a_a0[j], ev_a_a2[j], ev_a_g2[j], ev_a_kk[j], ev_a_ka[j], ev_a_rk[j],
                                       ev_a_lnx_g[j], ev_a_lnx_b[j], ev_b_lam[j], ev_b_subln_g[j],
                                       lambda_init, cos_b, sin_b)
        else:
            mix_c, mix_l = _odd_mixer(hc, hl, od_w_in[j], od_w_out[j], od_qn_g[j], od_kn_g[j],
                                      cos_c, sin_c, not last)
        xl = _layer_norm(DEEPNORM_ALPHA * xl + mod_l[2] * mix_l, ln1_g[i], ln1_b[i])
        hl = _modulate(xl, mod_l[3], mod_l[4])
        if last:
            ffn_l = _moe(hl.reshape(-1, d), router_w, router_b, moe_w1[i], moe_w3[i], moe_w2[i]).reshape(hl.shape)
        else:
            xc = _layer_norm(DEEPNORM_ALPHA * xc + mod_c[2] * mix_c, ln1_g[i], ln1_b[i])
            hc = _modulate(xc, mod_c[3], mod_c[4])
            n_c = hc.shape[0] * hc.shape[1]
            ffn = _moe(jnp.concatenate([hc.reshape(-1, d), hl.reshape(-1, d)], axis=0),
                       router_w, router_b, moe_w1[i], moe_w3[i], moe_w2[i])
            ffn_c = ffn[:n_c].reshape(hc.shape)
            ffn_l = ffn[n_c:].reshape(hl.shape)
            xc = _layer_norm(DEEPNORM_ALPHA * xc + mod_c[5] * ffn_c, ln2_g[i], ln2_b[i])
        xl = _layer_norm(DEEPNORM_ALPHA * xl + mod_l[5] * ffn_l, ln2_g[i], ln2_b[i])
    return xl
```

```cpp
#include <hip/hip_runtime.h>
#include <hip/hip_bf16.h>
#include <cstdio>
#include <cstdint>
#include <cmath>
namespace pg8 {
#define PG8_LAS __attribute__((address_space(3)))
typedef unsigned short bf16_t;
typedef short bf16x8 __attribute__((ext_vector_type(8)));
typedef float f32x4 __attribute__((ext_vector_type(4)));
typedef unsigned u32x4 __attribute__((ext_vector_type(4)));
typedef unsigned u32x2 __attribute__((ext_vector_type(2)));
constexpr int BM = 256, BK = 64, HALF = 128, HTB = HALF * BK * 2  , STAGE_BYTES = 8 * HTB, NXCD = 8, WGM = 8;

__host__ __device__ __forceinline__ int lds_byte(int r, int c) { const int st = (r >> 4) * 2 + (c >> 5), rr = r & 15, cc = c & 31, ob = rr * 64 + cc * 2; return st * 1024 + (ob ^ (((ob >> 9) & 1) << 5)); }
__host__ __device__ __forceinline__ void stage_rc(int b, int& R, int& C) { const int st = b / 1024, sb = b % 1024, swz = sb ^ (((sb >> 9) & 1) << 5); R = (st >> 1) * 16 + swz / 64; C = (st & 1) * 32 + (swz % 64) / 2; }
__host__ __device__ __forceinline__ int perm32(int rho) { const int n = rho >> 4, i = rho & 15; return 8 * (i >> 2) + 4 * n + (i & 3); }

struct Unit { int pm, pn; size_t aoff, boff; int gbase, nvalid, orow0, e; };
struct Gemm { const bf16_t* A; const bf16_t* Bt; int K; };

__device__ __forceinline__ int xcd_remap(int wgid, int nwg) { const int q = nwg / NXCD, r = nwg % NXCD, xcd = wgid % NXCD, off = wgid / NXCD; return (xcd < r ? xcd * (q + 1) : r * (q + 1) + (xcd - r) * q) + off; }

struct DenseOrder {
    int nM, nN, nwg, G, c, K;
    static constexpr bool GATHER = false;
    __device__ void init(int M, int N, int K_, int G_, int c_) { nM = M / BM; nN = N / BM; nwg = nM * nN; G = G_; c = c_; K = K_; }
    __device__ bool next(int i, Unit& u) const {
        const long L = (long)i * G + c; if (L >= nwg) return false;
        const int wgid = xcd_remap((int)L, nwg);
        const int nig = WGM * nN, gid = wgid / nig, fm = gid * WGM, gsz = (nM - fm) < WGM ? (nM - fm) : WGM;
        u.pm = fm + ((wgid % nig) % gsz); u.pn = (wgid % nig) / gsz;
        u.aoff = (size_t)u.pm * BM * K * 2; u.boff = (size_t)u.pn * BM * K * 2; u.gbase = 0; u.nvalid = BM; u.orow0 = u.pm * BM; u.e = 0; return true;
    }
    __device__ __forceinline__ int token(const Unit&, int) const { return 0; }
};

__device__ __forceinline__ unsigned cvt_pk_bf16(float lo, float hi) { unsigned r; asm volatile("v_cvt_pk_bf16_f32 %0, %1, %2" : "=v"(r) : "v"(lo), "v"(hi)); return r; }

template <class Epi, class Sched>
__device__ __forceinline__ void gemm_phase(PG8_LAS unsigned char* lds, const Gemm g, const Sched& S, const Epi& E, int wave_id) {
    int tid = (wave_id << 6) | (int)__builtin_amdgcn_mbcnt_hi(~0u, __builtin_amdgcn_mbcnt_lo(~0u, 0u)); asm volatile("" : "+v"(tid));
    const int wid = __builtin_amdgcn_readfirstlane(tid >> 6), lane = tid & 63, wr = wid >> 2, wc = wid & 3, fr = lane & 15, fq = lane >> 4;
    const int K = g.K, nt = K / BK;
    int RA[2], CA[2];
    unsigned voffB[2], voffA[2][2], voffAn[2][2];
#pragma unroll
    for (int i = 0; i < 2; ++i) { int R, C; stage_rc(tid * 16 + i * 8192, R, C); RA[i] = R; CA[i] = C; const int Rb = Epi::PERM ? ((R & ~31) + perm32(R & 31)) : R;
        voffB[i] = (unsigned)(Rb * K + C) * 2u;
        voffA[0][i] = (unsigned)(R * K + C) * 2u; voffA[1][i] = (unsigned)((R + HALF) * K + C) * 2u; voffAn[0][i] = voffA[0][i]; voffAn[1][i] = voffA[1][i]; }
    const size_t kstep = (size_t)(BK * 2);
    const size_t hstep = (size_t)HALF * K * 2;
    const unsigned ldsw = (unsigned)wid * 1024u;
    const int aoff = lds_byte(wr * 64 + fr, fq * 8), boff = lds_byte(wc * 32 + fr, fq * 8);
#define PG8_SA(b, h) (((b) * 2 + (h)) * HTB)
#define PG8_SB(b, h) ((4 + (b) * 2 + (h)) * HTB)
#define PG8_STAGE(bufoff, gbase, voff) do { _Pragma("unroll") for (int _i = 0; _i < 2; ++_i) \
        __builtin_amdgcn_global_load_lds((const unsigned*)((const char*)(gbase) + (voff)[_i]), (PG8_LAS unsigned*)(lds + (bufoff) + ldsw + _i * 8192), 16, 0, 0); } while (0)
#define PG8_LDA(dst, b, h) do { _Pragma("unroll") for (int m = 0; m < 4; ++m) _Pragma("unroll") for (int k = 0; k < 2; ++k) dst[m][k] = *(const PG8_LAS bf16x8*)(lds + PG8_SA(b, h) + aoff + m * 2048 + k * 1024); } while (0)
#define PG8_LDB(dst, b, h) do { _Pragma("unroll") for (int n = 0; n < 2; ++n) _Pragma("unroll") for (int k = 0; k < 2; ++k) dst[n][k] = *(const PG8_LAS bf16x8*)(lds + PG8_SB(b, h) + boff + n * 2048 + k * 1024); } while (0)
#define PG8_MMA(ai, bj, At, Bt) do { __builtin_amdgcn_s_setprio(1); _Pragma("unroll") for (int m = 0; m < 4; ++m) _Pragma("unroll") for (int n = 0; n < 2; ++n) _Pragma("unroll") for (int k = 0; k < 2; ++k) \
        acc[ai][bj][m][n] = __builtin_amdgcn_mfma_f32_16x16x32_bf16(Bt[n][k], At[m][k], acc[ai][bj][m][n], 0, 0, 0); __builtin_amdgcn_s_setprio(0); } while (0)
#define PG8_WAIT_V(n) asm volatile("s_waitcnt vmcnt(" #n ")" ::: "memory")
#define PG8_WAIT_L(n) asm volatile("s_waitcnt lgkmcnt(" #n ")" ::: "memory")
#define PG8_BAR __builtin_amdgcn_s_barrier()
#define PG8_SCHED __builtin_amdgcn_sched_barrier(0)
#define PG8_GOFF(dst, U) do { if constexpr (Sched::GATHER) { _Pragma("unroll") for (int _h = 0; _h < 2; ++_h) _Pragma("unroll") for (int _i = 0; _i < 2; ++_i) \
        dst[_h][_i] = (unsigned)(S.token(U, _h * HALF + RA[_i]) * K + CA[_i]) * 2u; } } while (0)
    Unit cur, nxt; int ui = 0;
    if (!S.next(0, cur)) return;
    f32x4 acc[2][2][4][2];
#pragma unroll
    for (int a = 0; a < 2; ++a)
#pragma unroll
        for (int b = 0; b < 2; ++b)
#pragma unroll
            for (int m = 0; m < 4; ++m)
#pragma unroll
                for (int n = 0; n < 2; ++n) acc[a][b][m][n] = (f32x4){0.f, 0.f, 0.f, 0.f};
    bf16x8 At[4][2], B0[2][2], B1[2][2];
    PG8_GOFF(voffA, cur);
    const char* cA = (const char*)g.A + (Sched::GATHER ? (size_t)0 : cur.aoff); const char* cB = (const char*)g.Bt + cur.boff;
    PG8_STAGE(PG8_SB(0, 0), cB, voffB); PG8_STAGE(PG8_SA(0, 0), cA, voffA[0]); PG8_STAGE(PG8_SB(0, 1), cB + hstep, voffB); PG8_STAGE(PG8_SA(0, 1), cA, voffA[1]);
    if (wr == 1) PG8_BAR;
    PG8_WAIT_V(4); PG8_BAR;
    PG8_STAGE(PG8_SB(1, 0), cB + kstep, voffB); PG8_STAGE(PG8_SA(1, 0), cA + kstep, voffA[0]); PG8_STAGE(PG8_SB(1, 1), cB + hstep + kstep, voffB);
    PG8_WAIT_V(6); PG8_BAR;
    for (;;) {
        const bool has_next = S.next(ui + 1, nxt);
        if (has_next) { PG8_GOFF(voffAn, nxt); if constexpr (Sched::GATHER) { asm volatile("" : "+v"(voffAn[0][0]), "+v"(voffAn[0][1]), "+v"(voffAn[1][0]), "+v"(voffAn[1][1])); } }
        const char* nA = has_next ? (const char*)g.A + (Sched::GATHER ? (size_t)0 : nxt.aoff) : cA; const char* nB = has_next ? (const char*)g.Bt + nxt.boff : cB;
        for (int t = 0; t < nt; t += 2) {
            const bool last = (t == nt - 2);
            const char* a1 = cA + (size_t)(t + 1) * kstep;
            const char* a2 = last ? nA : cA + (size_t)(t + 2) * kstep; const char* b2 = last ? nB : cB + (size_t)(t + 2) * kstep;
            const char* a3 = a2 + kstep; const char* b3 = b2 + kstep;
            unsigned va2[2][2];
#pragma unroll
            for (int h = 0; h < 2; ++h)
#pragma unroll
                for (int i = 0; i < 2; ++i) va2[h][i] = (Sched::GATHER && last && has_next) ? voffAn[h][i] : voffA[h][i];
            PG8_LDB(B0, 0, 0); PG8_SCHED; PG8_LDA(At, 0, 0); PG8_STAGE(PG8_SA(1, 1), a1, voffA[1]);
            PG8_WAIT_L(8); PG8_BAR; PG8_WAIT_L(0); PG8_MMA(0, 0, At, B0); PG8_BAR; PG8_SCHED;
            PG8_LDB(B1, 0, 1); PG8_STAGE(PG8_SB(0, 0), b2, voffB);
            PG8_BAR; PG8_WAIT_L(0); PG8_MMA(0, 1, At, B1); PG8_BAR;
            PG8_LDA(At, 0, 1); PG8_STAGE(PG8_SA(0, 0), a2, va2[0]);
            PG8_BAR; PG8_WAIT_L(0); PG8_MMA(1, 0, At, B0); PG8_BAR; PG8_SCHED;
            PG8_STAGE(PG8_SB(0, 1), b2 + hstep, voffB);
            PG8_WAIT_V(6); PG8_BAR; PG8_MMA(1, 1, At, B1); PG8_BAR;
            PG8_LDB(B0, 1, 0); PG8_SCHED; PG8_LDA(At, 1, 0); PG8_STAGE(PG8_SA(0, 1), a2, va2[1]);
            PG8_WAIT_L(8); PG8_BAR; PG8_WAIT_L(0); PG8_MMA(0, 0, At, B0); PG8_BAR; PG8_SCHED;
            PG8_LDB(B1, 1, 1); PG8_STAGE(PG8_SB(1, 0), b3, voffB);
            PG8_BAR; PG8_WAIT_L(0); PG8_MMA(0, 1, At, B1); PG8_BAR;
            PG8_LDA(At, 1, 1); PG8_STAGE(PG8_SA(1, 0), a3, va2[0]);
            PG8_BAR; PG8_WAIT_L(0); PG8_MMA(1, 0, At, B0); PG8_BAR; PG8_SCHED;
            PG8_STAGE(PG8_SB(1, 1), b3 + hstep, voffB);
            PG8_WAIT_V(6); PG8_BAR; PG8_MMA(1, 1, At, B1); PG8_BAR;
        }
        E(acc, cur, wr, wc, fr, fq);
        if (!has_next) break;
#pragma unroll
        for (int a = 0; a < 2; ++a)
#pragma unroll
            for (int b = 0; b < 2; ++b)
#pragma unroll
                for (int m = 0; m < 4; ++m)
#pragma unroll
                    for (int n = 0; n < 2; ++n) acc[a][b][m][n] = (f32x4){0.f, 0.f, 0.f, 0.f};
        cur = nxt; cA = nA; cB = nB; ++ui;
        if constexpr (Sched::GATHER) {
#pragma unroll
            for (int h = 0; h < 2; ++h)
#pragma unroll
                for (int i = 0; i < 2; ++i) voffA[h][i] = voffAn[h][i];
        }
    }
    PG8_WAIT_V(0);
    if (wr == 0) PG8_BAR;
    PG8_BAR;
#undef PG8_SA
#undef PG8_SB
#undef PG8_STAGE
#undef PG8_LDA
#undef PG8_LDB
#undef PG8_MMA
#undef PG8_WAIT_V
#undef PG8_WAIT_L
#undef PG8_BAR
#undef PG8_SCHED
#undef PG8_GOFF
}
}
namespace att {
using bf16x8 = __attribute__((ext_vector_type(8))) short;
using s16x4  = __attribute__((ext_vector_type(4))) short;
using f32x16 = __attribute__((ext_vector_type(16))) float;
using u32x4  = __attribute__((ext_vector_type(4))) unsigned;
typedef unsigned short bf16_t;
constexpr int NW = 8, QBLK = 32, KVBLK = 64;
constexpr float THR = 8.f;
constexpr size_t SHM_V = KVBLK * 128 * 2, SHM_K = KVBLK * 128 * 2, SHM_ATTN = 2 * SHM_V + 2 * SHM_K + NW * 64 * 4;
#define KSWZ(row, colB) ((row) * 256 + ((colB) ^ (((row) & 7) << 4)))
#define KSWZ64(row, colB) ((row) * 128 + ((colB) ^ ((((row) >> 1) & 7) << 4)))
#define SBAR() __builtin_amdgcn_sched_barrier(0)
__device__ __forceinline__ int crow(int r, int hi) { return (r & 3) + 8 * (r >> 2) + 4 * hi; }
__device__ __forceinline__ unsigned cvtpk(float lo, float hi) { unsigned r; asm volatile("v_cvt_pk_bf16_f32 %0, %1, %2" : "=v"(r) : "v"(lo), "v"(hi)); return r; }

template <int DQK> struct Sc { static constexpr float SCALE = (DQK == 64) ? 0.125f : 0.088388347648318440f; };

template <int DQK>
__device__ __forceinline__ void partialSM(f32x16& p0, f32x16& p1, float& m_reg, float& mn, float& alpha) {
  constexpr float SCALE = Sc<DQK>::SCALE;
  constexpr float C = SCALE * 1.4426950408889634f;
  float pmax = p0[0];
#pragma unroll
  for (int r = 1; r < 16; ++r) pmax = fmaxf(pmax, p0[r]);
#pragma unroll
  for (int r = 0; r < 16; ++r) pmax = fmaxf(pmax, p1[r]);
  { auto rr = __builtin_amdgcn_permlane32_swap(__float_as_uint(pmax), __float_as_uint(pmax), false, false);
    pmax = fmaxf(__uint_as_float(rr[0]), __uint_as_float(rr[1])); }
  if (__builtin_expect(__all(pmax - m_reg <= THR / SCALE), 1)) { mn = m_reg; alpha = 1.f; }
  else { mn = fmaxf(m_reg, pmax); alpha = __builtin_amdgcn_exp2f((m_reg - mn) * C); m_reg = mn; }
  float mnC = -mn * C;
#pragma unroll
  for (int r = 0; r < 16; ++r) p0[r] = fmaf(p0[r], C, mnC);
#pragma unroll
  for (int r = 0; r < 16; ++r) p1[r] = fmaf(p1[r], C, mnC);
#pragma unroll
  for (int r = 0; r < 16; ++r) p0[r] = __builtin_amdgcn_exp2f(p0[r]);
}
__device__ __forceinline__ void finishSM(f32x16& p0, f32x16& p1, float alpha, float& l_reg, bf16x8& pa0, bf16x8& pa1, bf16x8& pa2, bf16x8& pa3) {
#pragma unroll
  for (int r = 0; r < 16; ++r) p1[r] = __builtin_amdgcn_exp2f(p1[r]);
  float ps = 0;
#pragma unroll
  for (int r = 0; r < 16; ++r) ps += p0[r];
#pragma unroll
  for (int r = 0; r < 16; ++r) ps += p1[r];
  { auto rr = __builtin_amdgcn_permlane32_swap(__float_as_uint(ps), __float_as_uint(ps), false, false);
    ps = __uint_as_float(rr[0]) + __uint_as_float(rr[1]); }
  l_reg = l_reg * alpha + ps;
#define PK4(P, BASE, OUT) do { unsigned a0 = cvtpk(P[BASE + 0], P[BASE + 1]), a1 = cvtpk(P[BASE + 2], P[BASE + 3]);   \
    unsigned b0 = cvtpk(P[BASE + 4], P[BASE + 5]), b1 = cvtpk(P[BASE + 6], P[BASE + 7]);                              \
    auto r0 = __builtin_amdgcn_permlane32_swap(a0, b0, false, false); auto r1 = __builtin_amdgcn_permlane32_swap(a1, b1, false, false); \
    u32x4 w = {r0[0], r1[0], r0[1], r1[1]}; OUT = *reinterpret_cast<bf16x8*>(&w); } while (0)
  PK4(p0, 0, pa0); PK4(p0, 8, pa1); PK4(p1, 0, pa2); PK4(p1, 8, pa3);
#undef PK4
}
template <int DQK>
__device__ __forceinline__ void qkt(f32x16& p0, f32x16& p1, const char* Ks, const bf16x8* qr, int r32, int hi) {
  p0 = f32x16{}; p1 = f32x16{};
#pragma unroll
  for (int d0 = 0; d0 < DQK / 16; ++d0) { const int cb = (d0 * 16 + hi * 8) * 2;
    bf16x8 b0, b1;
    if constexpr (DQK == 128) { b0 = *reinterpret_cast<const bf16x8*>(Ks + KSWZ(r32, cb)); b1 = *reinterpret_cast<const bf16x8*>(Ks + KSWZ(32 + r32, cb)); }
    else { b0 = *reinterpret_cast<const bf16x8*>(Ks + KSWZ64(r32, cb)); b1 = *reinterpret_cast<const bf16x8*>(Ks + KSWZ64(32 + r32, cb)); }
    p0 = __builtin_amdgcn_mfma_f32_32x32x16_bf16(b0, qr[d0], p0, 0, 0, 0);
    p1 = __builtin_amdgcn_mfma_f32_32x32x16_bf16(b1, qr[d0], p1, 0, 0, 0); }
}
__device__ __forceinline__ int v_st(int k, int c) { const int kk = (k & ~0xC) | ((k & 4) << 1) | ((k & 8) >> 1); return ((kk >> 3) * 4 + (c >> 5)) * 512 + ((kk & 7) * 32 + (c & 31)) * 2; }
__device__ __forceinline__ int v_rd_base(int lane) { return ((lane & 3) << 3) | (((lane >> 2) & 3) << 6) | (((lane >> 4) & 1) << 5) | (((lane >> 5) & 1) << 8); }
constexpr int v_rd_off(int d0, int ks, int half) { return d0 * 512 + ks * 4096 + half * 2048; }
template <int OFF> __device__ __forceinline__ s16x4 tr_read(int vb) {
  s16x4 r; asm volatile("ds_read_b64_tr_b16 %0, %1 offset:%2" : "=&v"(r) : "v"(vb), "i"(OFF) : "memory"); return r;
}
template <int D0> __device__ __forceinline__ void pv_one(f32x16& od, int vb, bf16x8 pa0, bf16x8 pa1, bf16x8 pa2, bf16x8 pa3) {
  const s16x4 l0 = tr_read<v_rd_off(D0, 0, 0)>(vb), h0 = tr_read<v_rd_off(D0, 0, 1)>(vb), l1 = tr_read<v_rd_off(D0, 1, 0)>(vb), h1 = tr_read<v_rd_off(D0, 1, 1)>(vb);
  const s16x4 l2 = tr_read<v_rd_off(D0, 2, 0)>(vb), h2 = tr_read<v_rd_off(D0, 2, 1)>(vb), l3 = tr_read<v_rd_off(D0, 3, 0)>(vb), h3 = tr_read<v_rd_off(D0, 3, 1)>(vb);
  asm volatile("s_waitcnt lgkmcnt(0)" ::: "memory"); SBAR();
#define PK(L, H) (bf16x8){L[0], L[1], L[2], L[3], H[0], H[1], H[2], H[3]}
  od = __builtin_amdgcn_mfma_f32_32x32x16_bf16(pa0, PK(l0, h0), od, 0, 0, 0);
  od = __builtin_amdgcn_mfma_f32_32x32x16_bf16(pa1, PK(l1, h1), od, 0, 0, 0);
  od = __builtin_amdgcn_mfma_f32_32x32x16_bf16(pa2, PK(l2, h2), od, 0, 0, 0);
  od = __builtin_amdgcn_mfma_f32_32x32x16_bf16(pa3, PK(l3, h3), od, 0, 0, 0);
#undef PK
}
__device__ __forceinline__ void pv_d0(f32x16* o, int vb, bf16x8 pa0, bf16x8 pa1, bf16x8 pa2, bf16x8 pa3) {
  pv_one<0>(o[0], vb, pa0, pa1, pa2, pa3); pv_one<1>(o[1], vb, pa0, pa1, pa2, pa3); pv_one<2>(o[2], vb, pa0, pa1, pa2, pa3); pv_one<3>(o[3], vb, pa0, pa1, pa2, pa3);
}

template <int DQK, int LDQ, int LDK, int LDO>
__device__ __forceinline__ void attn_body(const bf16_t* __restrict__ Qb, const bf16_t* __restrict__ Kh, const bf16_t* __restrict__ Vh, bf16_t* __restrict__ Ob, int seq, char* lds, int wave_id) {
  int tid = (wave_id << 6) | (int)__builtin_amdgcn_mbcnt_hi(~0u, __builtin_amdgcn_mbcnt_lo(~0u, 0u)); asm volatile("" : "+v"(tid));
  const int wid = tid >> 6, lane = tid & 63, r32 = lane & 31, hi = lane >> 5;
  char* V_lds = lds; char* K_lds = lds + 2 * SHM_V;
  float* ws = (float*)(lds + 2 * SHM_V + 2 * SHM_K) + wid * 64; float* li_l = ws; float* al_l = ws + 32;
  float m_reg = -1e30f, l_reg = 0; f32x16 o[4] = {}; bf16x8 qr[DQK / 16];
  const bf16_t* Qw = Qb + (long)(wid * QBLK + r32) * LDQ + hi * 8;
#pragma unroll
  for (int d0 = 0; d0 < DQK / 16; ++d0) qr[d0] = *reinterpret_cast<const bf16x8*>(Qw + d0 * 16);
  const int sr = tid >> 4, sc = (tid & 15) * 8, vst0 = v_st(sr, sc), vst1 = v_st(32 + sr, sc);
  const int kr64 = tid >> 3, kc64 = (tid & 7) * 8;
  const int vb0 = (int)(uintptr_t)V_lds + v_rd_base(lane);
  struct { bf16x8 vs0, vs1, ks0, ks1; } sr_[2];
#define SLOAD(i, k0) do { sr_[i].vs0 = *reinterpret_cast<const bf16x8*>(&Vh[(long)((k0) + sr) * LDK + sc]); sr_[i].vs1 = *reinterpret_cast<const bf16x8*>(&Vh[(long)((k0) + 32 + sr) * LDK + sc]); \
    if constexpr (DQK == 128) { sr_[i].ks0 = *reinterpret_cast<const bf16x8*>(&Kh[(long)((k0) + sr) * LDK + sc]); sr_[i].ks1 = *reinterpret_cast<const bf16x8*>(&Kh[(long)((k0) + 32 + sr) * LDK + sc]); } \
    else { sr_[i].ks0 = *reinterpret_cast<const bf16x8*>(&Kh[(long)((k0) + kr64) * LDK + kc64]); } } while (0)
#define SWRITE(b, i) do { *(bf16x8*)(V_lds + (b) * SHM_V + vst0) = sr_[i].vs0;          \
    *(bf16x8*)(V_lds + (b) * SHM_V + vst1) = sr_[i].vs1;               \
    if constexpr (DQK == 128) { const int kc = sc * 2; *(bf16x8*)(K_lds + (b) * SHM_K + KSWZ(sr, kc)) = sr_[i].ks0; *(bf16x8*)(K_lds + (b) * SHM_K + KSWZ(32 + sr, kc)) = sr_[i].ks1; } \
    else { const int kc = kc64 * 2; *(bf16x8*)(K_lds + (b) * SHM_K + KSWZ64(kr64, kc)) = sr_[i].ks0; } } while (0)
#define SWAIT() do { if constexpr (DQK == 128) asm volatile("s_waitcnt vmcnt(4)" ::: "memory"); else asm volatile("s_waitcnt vmcnt(3)" ::: "memory"); } while (0)
#define RESC(a) do { if (__any((a) < 1.f)) { if (hi == 0) al_l[r32] = (a); asm volatile("s_waitcnt lgkmcnt(0)" ::: "memory"); \
    _Pragma("unroll") for (int d = 0; d < 4; ++d) _Pragma("unroll") for (int r = 0; r < 16; ++r) o[d][r] *= al_l[crow(r, hi)]; } } while (0)
  f32x16 pA0, pA1, pB0, pB1; float mnA, mnB, alA, alB; bf16x8 pa0, pa1, pa2, pa3; const int NT = seq / KVBLK;
  constexpr int SE = 0, SO = 1;
  SLOAD(SE, 0); asm volatile("s_waitcnt vmcnt(0)" ::: "memory"); SWRITE(0, SE); __syncthreads();
  qkt<DQK>(pA0, pA1, K_lds, qr, r32, hi); partialSM<DQK>(pA0, pA1, m_reg, mnA, alA);
  SLOAD(SO, KVBLK); if (2 < NT) SLOAD(SE, 2 * KVBLK);
  if (2 < NT) { SWAIT(); } else { asm volatile("s_waitcnt vmcnt(0)" ::: "memory"); }
  SWRITE(1, SO); __syncthreads();
  for (int j = 1; j + 1 < NT; j += 2) {
    SBAR(); qkt<DQK>(pB0, pB1, K_lds + SHM_K, qr, r32, hi);
    finishSM(pA0, pA1, alA, l_reg, pa0, pa1, pa2, pa3); SBAR();
    SLOAD(SO, (j + 2) * KVBLK); SBAR();
    pv_d0(o, vb0, pa0, pa1, pa2, pa3); partialSM<DQK>(pB0, pB1, m_reg, mnB, alB);
    __syncthreads(); SWAIT(); SWRITE(0, SE);
    RESC(alB); __syncthreads();
    SBAR(); qkt<DQK>(pA0, pA1, K_lds, qr, r32, hi);
    finishSM(pB0, pB1, alB, l_reg, pa0, pa1, pa2, pa3); SBAR();
    if (j + 3 < NT) SLOAD(SE, (j + 3) * KVBLK); SBAR();
    pv_d0(o, vb0 + (int)SHM_V, pa0, pa1, pa2, pa3); partialSM<DQK>(pA0, pA1, m_reg, mnA, alA);
    __syncthreads(); if (j + 3 < NT) { SWAIT(); } else { asm volatile("s_waitcnt vmcnt(0)" ::: "memory"); } SWRITE(1, SO);
    RESC(alA); __syncthreads();
  }
  SBAR(); qkt<DQK>(pB0, pB1, K_lds + SHM_K, qr, r32, hi);
  finishSM(pA0, pA1, alA, l_reg, pa0, pa1, pa2, pa3); SBAR();
  pv_d0(o, vb0, pa0, pa1, pa2, pa3); partialSM<DQK>(pB0, pB1, m_reg, mnB, alB);
  __syncthreads(); RESC(alB);
  finishSM(pB0, pB1, alB, l_reg, pa0, pa1, pa2, pa3); SBAR();
  pv_d0(o, vb0 + (int)SHM_V, pa0, pa1, pa2, pa3);
  if (hi == 0) li_l[r32] = l_reg; asm volatile("s_waitcnt lgkmcnt(0)" ::: "memory");
  float rli[16];
#pragma unroll
  for (int r = 0; r < 16; ++r) rli[r] = __builtin_amdgcn_rcpf(li_l[crow(r, hi)]);
  bf16_t* Ow = Ob + (long)(wid * QBLK) * LDO;
#pragma unroll
  for (int r = 0; r < 16; ++r) { const int orow = crow(r, hi);
#pragma unroll
    for (int d0 = 0; d0 < 4; ++d0) { const float v = o[d0][r] * rli[r]; Ow[(long)orow * LDO + d0 * 32 + r32] = (bf16_t)(cvtpk(v, v) & 0xffffu); } }
  __syncthreads();
#undef SLOAD
#undef SWRITE
#undef SWAIT
#undef RESC
}
#undef SBAR
}
constexpr int NWAVES = 8, NTHR = 512;
constexpr int NB = 8, SEQ = 2048, CTXL = 256, TPB = CTXL + SEQ  , MROWS = NB * TPB  , DM = 1024;
constexpr int A_W = 512, A_IN = 1920, B_IN = 1536, EVEN_IN = 3456, EVEN_PAD = 3584, ODD_IN = 1536;
constexpr int NEXP = 16, EFF = 512, CAP = MROWS, MOE_ROWS = 40960;
constexpr float LN_EPS = 1e-5f, ALPHA = 1.4142135623730951f, GN_EPS = 64e-5f, SUBLN_EPS = 1e-5f, QKN_EPS = 1e-6f, LAMBDA_INIT0 = 0.2f;

constexpr size_t MiB = 1u << 20;
constexpr size_t WS_CTL = 0, CTL_ZERO_BYTES = 1 * MiB;
constexpr size_t WS_MOD = 1 * MiB;
constexpr size_t WS_ROPE = 2 * MiB;
constexpr size_t WS_WEVIN = 4 * MiB, WS_WEVOUT = 11 * MiB, WS_WODIN = 13 * MiB, WS_WODOUT = 16 * MiB;
constexpr size_t WS_WM13 = 18 * MiB, WS_WM2 = 50 * MiB;
constexpr size_t WS_H = 66 * MiB;
constexpr size_t WS_X = 102 * MiB;
constexpr size_t WS_PA = 174 * MiB;
constexpr size_t WS_PB = 246 * MiB;
constexpr size_t WS_TAIL = 300 * MiB;
constexpr size_t WS_END = 336 * MiB;
constexpr size_t FEAT_BYTES = (size_t)MROWS * 512 * 2;
constexpr size_t WS_F0 = 18 * MiB;
constexpr size_t WS_YF = WS_TAIL, WS_YR = WS_TAIL + FEAT_BYTES;
constexpr size_t WS_OB0 = WS_PA, WS_OB1 = WS_PA + FEAT_BYTES;
constexpr size_t WS_A2 = WS_PA + 2 * FEAT_BYTES;
constexpr size_t WS_MIX = WS_TAIL;
constexpr size_t WS_HID = WS_PA;
constexpr size_t WS_Y = WS_PA + 40 * MiB;
constexpr size_t WS_QKV1 = WS_PA;
constexpr size_t WS_OATT = WS_PA + 54 * MiB;
static_assert(WS_F0 + 8 * FEAT_BYTES <= WS_PA && WS_A2 + 2 * FEAT_BYTES <= WS_PB && WS_Y + (size_t)MOE_ROWS * 1024 * 2 <= WS_TAIL && WS_OATT + 2 * FEAT_BYTES <= WS_TAIL && WS_YR + FEAT_BYTES <= WS_END, "ws map");
constexpr int CW_BAR = 4096;
constexpr int CW_CNT = 16384;
constexpr size_t WS_ROUTE = 336 * MiB;
constexpr size_t WS_PERM_ = WS_ROUTE, WS_GATE = WS_ROUTE + (size_t)NEXP * CAP * 4, WS_TOK = WS_GATE + (size_t)NEXP * CAP * 4, WS_TOTAL = WS_TOK + (size_t)MROWS * 2 * 4;
static_assert(WS_TOTAL <= 339 * MiB, "ws total");

constexpr int RING_OFF = 0, RING_BYTES = 131072;
constexpr int LDSCTL_OFF = RING_BYTES, MISC_OFF = LDSCTL_OFF + 320;
constexpr int MOETAB_OFF = LDSCTL_OFF + 1024;
constexpr int LDS_BYTES = 147456;

#define GAS __attribute__((address_space(1)))
#define LAS __attribute__((address_space(3)))
typedef unsigned short bf16;
typedef unsigned v4u __attribute__((ext_vector_type(4)));
typedef unsigned v2u __attribute__((ext_vector_type(2)));
typedef float f32x4 __attribute__((ext_vector_type(4)));
typedef short bf16x8 __attribute__((ext_vector_type(8)));
typedef GAS unsigned gu32;
#define RLX_AGENT __ATOMIC_RELAXED, __HIP_MEMORY_SCOPE_AGENT
#define LDS_WAIT() asm volatile("s_waitcnt lgkmcnt(0)" ::: "memory")
#define VM_WAIT() asm volatile("s_waitcnt vmcnt(0)" ::: "memory")
__device__ __forceinline__ unsigned f2bf(float f) { unsigned u = __builtin_bit_cast(unsigned, f); return (u + 0x7fffu + ((u >> 16) & 1u)) >> 16; }
__device__ __forceinline__ unsigned pk2(float lo, float hi) { return f2bf(lo) | (f2bf(hi) << 16); }
__device__ __forceinline__ float bf2f(unsigned short b) { return __builtin_bit_cast(float, (unsigned)b << 16); }
__device__ __forceinline__ float bflo(unsigned w) { return __builtin_bit_cast(float, w << 16); }
__device__ __forceinline__ float bfhi(unsigned w) { return __builtin_bit_cast(float, w & 0xffff0000u); }
__device__ __forceinline__ float sigmoidf_(float x) { return 1.f / (1.f + __expf(-x)); }
__device__ __forceinline__ float wave_sum(float v) {
#pragma unroll
    for (int o = 1; o < 64; o <<= 1) v += __shfl_xor(v, o);
    return v;
}

#define XB_TMO      128
#define XB_XCNT(j)  (256  + 64 * (j))
#define XB_XSUB(j)  (1280 + 64 * (j))
#define XB_XGEN(j)  (2304 + 64 * (j))
#define XB_TOP      3328
#define XB_TOPGEN   3392
#define XCD_BAR_WORDS 3456
#define XB_SPIN_CAP (1u << 22)
__device__ __forceinline__ unsigned xb_ld(unsigned* p)              { return __hip_atomic_load(p, __ATOMIC_RELAXED, __HIP_MEMORY_SCOPE_AGENT); }
__device__ __forceinline__ unsigned xb_add(unsigned* p, unsigned v) { return __hip_atomic_fetch_add(p, v, __ATOMIC_RELAXED, __HIP_MEMORY_SCOPE_AGENT); }
__device__ __forceinline__ unsigned xb_xcc_id() { return (unsigned)__builtin_amdgcn_s_getreg((3 << 11) | 20) & 0xFu; }
#define XB_SPIN(cond, bar) do { unsigned _sp = 0; while (cond) { __builtin_amdgcn_s_sleep(1); \
    if ((++_sp & 255u) == 0u) { if (xb_ld(&(bar)[XB_TMO])) break; if (_sp > XB_SPIN_CAP) { atomicAdd(&(bar)[XB_TMO], 1u); break; } } } } while (0)
struct XcdBarrier { unsigned* bar; unsigned x; volatile LAS unsigned* st; };
__device__ __forceinline__ XcdBarrier xcd_barrier_post(unsigned* bar, volatile LAS unsigned* st) {
    XcdBarrier b; b.bar = bar; b.x = xb_xcc_id(); b.st = st;
    if (threadIdx.x == 0) (void)xb_add(&bar[XB_XCNT(b.x)], 1u);
    return b;
}
__device__ __forceinline__ void xcd_barrier_complete(unsigned* bar, unsigned x, unsigned& nloc, unsigned& nx) {
    const unsigned G = gridDim.x * gridDim.y * gridDim.z;
    unsigned sum, cnt, mine, sp = 0u;
    for (;;) {
        sum = 0u; cnt = 0u; mine = 0u;
#pragma unroll
        for (unsigned j = 0; j < 16; ++j) { const unsigned c = xb_ld(&bar[XB_XCNT(j)]); sum += c; cnt += (c > 0u) ? 1u : 0u; mine = (j == x) ? c : mine; }
        if (sum == G) break;
        __builtin_amdgcn_s_sleep(1);
        if ((++sp & 255u) == 0u) { if (xb_ld(&bar[XB_TMO])) break; if (sp > XB_SPIN_CAP) { atomicAdd(&bar[XB_TMO], 1u); break; } }
    }
    nloc = mine > 0u ? mine : 1u; nx = cnt > 0u ? cnt : 1u;
}
__device__ __forceinline__ void xcd_barrier(const XcdBarrier& b) {
    asm volatile("s_waitcnt vmcnt(0)" ::: "memory");
    __syncthreads();
    if (threadIdx.x == 0) {
        unsigned* bar = b.bar;
        __builtin_amdgcn_s_waitcnt(0);
        unsigned nloc = b.st[0], nx = b.st[1];
        if (nloc == 0u) { xcd_barrier_complete(bar, b.x, nloc, nx); b.st[0] = nloc; b.st[1] = nx; }
        const unsigned old = xb_add(&bar[XB_XSUB(b.x)], 1u);
        const unsigned gen = old / nloc;
        if (old + 1u == (gen + 1u) * nloc) {
            __builtin_amdgcn_fence(__ATOMIC_RELEASE, "agent");
            asm volatile("s_waitcnt vmcnt(0)" ::: "memory");
            const unsigned og = xb_add(&bar[XB_TOP], 1u);
            const unsigned tg = og / nx;
            if (og + 1u == (tg + 1u) * nx) xb_add(&bar[XB_TOPGEN], 1u);
            else XB_SPIN(xb_ld(&bar[XB_TOPGEN]) == tg, bar);
            __builtin_amdgcn_fence(__ATOMIC_ACQUIRE, "agent");
            xb_add(&bar[XB_XGEN(b.x)], 1u);
            asm volatile("s_waitcnt vmcnt(0)" ::: "memory");
        } else {
            XB_SPIN(xb_ld(&bar[XB_XGEN(b.x)]) == gen, bar);
            __builtin_amdgcn_fence(__ATOMIC_ACQUIRE, "agent");
            asm volatile("s_waitcnt vmcnt(0)" ::: "memory");
        }
    }
    __syncthreads();
}

struct Args { const float* in[34]; float* out; unsigned char* ws; };
struct Frame {
    LAS unsigned char* lds; char* ldsg;
    int tid, lane, wave, G, bid;
    const float* const* in; float* out; unsigned char* ws;
};
enum { I_X = 0, I_C, I_CTX, I_CCTX, I_RW, I_RB, I_ADAW, I_ADAB, I_LN1G, I_LN1B, I_LN2G, I_LN2B, I_W1, I_W3, I_W2, I_EVWIN, I_EVWOUT, I_AMU, I_AW0, I_AW2, I_AA0, I_AA2,
       I_AG2, I_AKK, I_AKA, I_ARK, I_LNXG, I_LNXB, I_BLAM, I_SUBG, I_ODWIN, I_ODWOUT, I_QNG, I_KNG };

__device__ __forceinline__ const float* x0_row(const Frame& F, int row) {
    const int b = row / TPB, tt = row - b * TPB;
    return tt < CTXL ? F.in[I_CTX] + ((size_t)b * CTXL + tt) * DM : F.in[I_X] + ((size_t)b * SEQ + (tt - CTXL)) * DM;
}
__device__ __forceinline__ const float* mod_ptr(const Frame& F, int layer, int row, int idx) {
    const int b = row / TPB, tt = row - b * TPB; const int r = tt < CTXL ? 8 : b;
    return (const float*)(F.ws + WS_MOD) + ((size_t)(layer * 9 + r) * 6 + idx) * DM;
}
__device__ __forceinline__ void transpose_item(const float* W, int K, int N, bf16* WT, int mode, LAS float* scr, int item, int lane) {
    const int nblk = N / 32, kb = item / nblk, nb = item % nblk, k0 = 64 * kb, n0 = 32 * nb;
#pragma unroll 8
    for (int i = 0; i < 32; ++i) { const int kk = 2 * i + (lane >> 5); scr[kk * 33 + (lane & 31)] = W[(size_t)(k0 + kk) * N + n0 + (lane & 31)]; }
    LDS_WAIT(); asm volatile("" ::: "memory");
    const int c = lane & 7;
#pragma unroll
    for (int j = 0; j < 4; ++j) { const int n = (lane >> 3) + 8 * j; const LAS float* s = scr + (8 * c) * 33 + n;
        v4u o; o.x = pk2(s[0 * 33], s[1 * 33]); o.y = pk2(s[2 * 33], s[3 * 33]); o.z = pk2(s[4 * 33], s[5 * 33]); o.w = pk2(s[6 * 33], s[7 * 33]);
        const int ng = n0 + n; const int nd = mode == 0 ? ng : (8 * (ng >> 2) + 4 * (mode - 1) + (ng & 3));
        *(GAS v4u*)(WT + (size_t)nd * K + k0 + 8 * c) = o; }
    LDS_WAIT(); asm volatile("" ::: "memory");
}
__device__ __forceinline__ void convert_moe_weights(Frame& F, int layer) {
    LAS float* scr = (LAS float*)(F.lds + RING_OFF + F.wave * 16384);
    const int gw = F.bid * NWAVES + F.wave, NGW = F.G * NWAVES;
    constexpr int I13 = (DM / 64) * (EFF / 32)  , I2 = (EFF / 64) * (DM / 32)  ;
    bf16* W13 = (bf16*)(F.ws + WS_WM13); bf16* W2 = (bf16*)(F.ws + WS_WM2);
    for (int it = gw; it < NEXP * (2 * I13 + I2); it += NGW) {
        const int e = it / (2 * I13 + I2); int r = it % (2 * I13 + I2);
        const size_t wofs = ((size_t)layer * NEXP + e) * DM * EFF;
        if (r < I13) { transpose_item(F.in[I_W1] + wofs, DM, EFF, W13 + (size_t)e * 1024 * DM, 1, scr, r, F.lane); continue; } r -= I13;
        if (r < I13) { transpose_item(F.in[I_W3] + wofs, DM, EFF, W13 + (size_t)e * 1024 * DM, 2, scr, r, F.lane); continue; } r -= I13;
        transpose_item(F.in[I_W2] + wofs, EFF, DM, W2 + (size_t)e * DM * EFF, 0, scr, r, F.lane);
    }
}
__device__ __forceinline__ void p_prologue(Frame& F) {
    LAS float* scr = (LAS float*)(F.lds + RING_OFF + F.wave * 16384);
    const int gw = F.bid * NWAVES + F.wave, NGW = F.G * NWAVES;
    constexpr int I_A = (DM / 64) * (EVEN_IN / 32), I_B = (DM / 64) * (DM / 32), I_C_ = (DM / 64) * (ODD_IN / 32);
    for (int it = gw; it < I_A + 2 * I_B + I_C_; it += NGW) {
        int r = it;
        if (r < I_A) { transpose_item(F.in[I_EVWIN], DM, EVEN_IN, (bf16*)(F.ws + WS_WEVIN), 0, scr, r, F.lane); continue; } r -= I_A;
        if (r < I_B) { transpose_item(F.in[I_EVWOUT], DM, DM, (bf16*)(F.ws + WS_WEVOUT), 0, scr, r, F.lane); continue; } r -= I_B;
        if (r < I_C_) { transpose_item(F.in[I_ODWIN], DM, ODD_IN, (bf16*)(F.ws + WS_WODIN), 0, scr, r, F.lane); continue; } r -= I_C_;
        transpose_item(F.in[I_ODWOUT], DM, DM, (bf16*)(F.ws + WS_WODOUT), 0, scr, r, F.lane);
    }
    {
        v4u* z = (v4u*)((bf16*)(F.ws + WS_WEVIN) + (size_t)EVEN_IN * DM); const int n16 = (EVEN_PAD - EVEN_IN) * DM * 2 / 16;
        for (int i = F.bid * NTHR + F.tid; i < n16; i += F.G * NTHR) z[i] = (v4u){0u, 0u, 0u, 0u};
    }
    {
        float* cosB = (float*)(F.ws + WS_ROPE); float* sinB = cosB + SEQ * 32; float* cosC = sinB + SEQ * 32; float* sinC = cosC + SEQ * 64;
        for (int i = F.bid * NTHR + F.tid; i < SEQ * 96; i += F.G * NTHR) {
            if (i < SEQ * 32) { const int t = i >> 5, j = i & 31; const float pos = (float)(j < 16 ? (t >> 6) : (t & 63)); const int f = j & 15;
                const float inv = powf(10000.f, -(float)(2 * f) / 32.f); const float ang = pos * inv; cosB[i] = cosf(ang); sinB[i] = sinf(ang); }
            else { const int ii = i - SEQ * 32; const int t = ii >> 6, j = ii & 63; const float pos = (float)(j < 32 ? (t >> 6) : (t & 63)); const int f = j & 31;
                const float inv = powf(10000.f, -(float)(2 * f) / 64.f); const float ang = pos * inv; cosC[ii] = cosf(ang); sinC[ii] = sinf(ang); }
        }
    }
    __syncthreads();
    if (F.bid < 192) {
        LAS float* sv = (LAS float*)(F.lds + RING_OFF);
        LAS float* red = sv + 9 * 1024;
        for (int i = F.tid; i < 9 * 1024; i += NTHR) { const int r = i >> 10, k = i & 1023; const float c = r < 8 ? F.in[I_C][r * DM + k] : F.in[I_CCTX][k]; sv[i] = c * sigmoidf_(c); }
        __syncthreads();
        for (int it = F.bid; it < 192; it += F.G) {
            const int l = it / 96, cb = it % 96, col = cb * 64 + F.lane;
            const float* w = F.in[I_ADAW] + (size_t)l * DM * 6144 + col;
            float acc[9];
#pragma unroll
            for (int r = 0; r < 9; ++r) acc[r] = 0.f;
            for (int k = F.wave * 128; k < F.wave * 128 + 128; ++k) { const float wv = w[(size_t)k * 6144];
#pragma unroll
                for (int r = 0; r < 9; ++r) acc[r] += sv[r * 1024 + k] * wv; }
#pragma unroll
            for (int r = 0; r < 9; ++r) red[(F.wave * 9 + r) * 64 + F.lane] = acc[r];
            __syncthreads();
            for (int i = F.tid; i < 9 * 64; i += NTHR) { const int r = i >> 6, c = i & 63; float s = 0.f;
#pragma unroll
                for (int w8 = 0; w8 < 8; ++w8) s += red[(w8 * 9 + r) * 64 + c];
                const int cc = cb * 64 + c;
                ((float*)(F.ws + WS_MOD))[(size_t)(l * 9 + r) * 6144 + cc] = s + F.in[I_ADAB][l * 6144 + cc]; }
            __syncthreads();
        }
    }
}

struct Row16 { f32x4 v[4]; };
__device__ __forceinline__ Row16 ld_row_f32(const float* p, int lane) { Row16 r; const f32x4* q = (const f32x4*)p + lane;
#pragma unroll
    for (int j = 0; j < 4; ++j) r.v[j] = q[64 * j]; return r; }
__device__ __forceinline__ Row16 ld_row_bf16(const bf16* p, int lane) { Row16 r; const v2u* q = (const v2u*)p + lane;
#pragma unroll
    for (int j = 0; j < 4; ++j) { const v2u w = q[64 * j]; r.v[j] = (f32x4){bflo(w.x), bfhi(w.x), bflo(w.y), bfhi(w.y)}; } return r; }
__device__ __forceinline__ void st_row_f32(float* p, int lane, const Row16& r) { f32x4* q = (f32x4*)p + lane;
#pragma unroll
    for (int j = 0; j < 4; ++j) q[64 * j] = r.v[j]; }
__device__ __forceinline__ void st_row_bf16(bf16* p, int lane, const Row16& r) { v2u* q = (v2u*)p + lane;
#pragma unroll
    for (int j = 0; j < 4; ++j) q[64 * j] = (v2u){pk2(r.v[j].x, r.v[j].y), pk2(r.v[j].z, r.v[j].w)}; }
__device__ __forceinline__ Row16 layer_norm(const Row16& x, const float* g, const float* b, int lane) {
    float s = 0.f;
#pragma unroll
    for (int j = 0; j < 4; ++j) s += (x.v[j].x + x.v[j].y) + (x.v[j].z + x.v[j].w);
    const float mean = wave_sum(s) * (1.f / DM); float s2 = 0.f; Row16 d;
#pragma unroll
    for (int j = 0; j < 4; ++j) { d.v[j] = x.v[j] - mean; s2 += (d.v[j].x * d.v[j].x + d.v[j].y * d.v[j].y) + (d.v[j].z * d.v[j].z + d.v[j].w * d.v[j].w); }
    const float rstd = 1.f / sqrtf(wave_sum(s2) * (1.f / DM) + LN_EPS);
    const Row16 gg = ld_row_f32(g, lane), bb = ld_row_f32(b, lane); Row16 o;
#pragma unroll
    for (int j = 0; j < 4; ++j) o.v[j] = d.v[j] * rstd * gg.v[j] + bb.v[j];
    return o;
}
__device__ __forceinline__ Row16 modulate(const Row16& x, const float* shift, const float* scale, int lane) {
    const Row16 sh = ld_row_f32(shift, lane), sc = ld_row_f32(scale, lane); Row16 o;
#pragma unroll
    for (int j = 0; j < 4; ++j) o.v[j] = x.v[j] * (1.f + sc.v[j]) + sh.v[j];
    return o;
}

__device__ __forceinline__ void p_mod0(Frame& F) {
    const int gw = F.bid * NWAVES + F.wave, NGW = F.G * NWAVES;
    for (int row = gw; row < MROWS; row += NGW) {
        const Row16 x = ld_row_f32(x0_row(F, row), F.lane);
        const Row16 h = modulate(x, mod_ptr(F, 0, row, 0), mod_ptr(F, 0, row, 1), F.lane);
        st_row_bf16((bf16*)(F.ws + WS_H) + (size_t)row * DM, F.lane, h);
    }
}

template <int LAYER>
__device__ __forceinline__ void p_ln_route(Frame& F) {
    LAS float* rwT = (LAS float*)(F.lds + RING_OFF);
    for (int i = F.tid; i < DM * NEXP; i += NTHR) { const int k = i >> 4, e = i & 15; rwT[e * DM + k] = F.in[I_RW][i]; }
    __syncthreads();
    const int gw = F.bid * NWAVES + F.wave, NGW = F.G * NWAVES;
    float* X = (float*)(F.ws + WS_X); bf16* H = (bf16*)(F.ws + WS_H); const bf16* MIX = (const bf16*)(F.ws + WS_MIX);
    unsigned* cnt = (unsigned*)(F.ws + WS_CTL) + CW_CNT + LAYER * 64;
    int* PERM = (int*)(F.ws + WS_PERM_); float* GATE = (float*)(F.ws + WS_GATE); int* TOK = (int*)(F.ws + WS_TOK);
    for (int row = gw; row < MROWS; row += NGW) {
        const int b = row / TPB, tt = row - b * TPB;
        if (LAYER == 1 && tt < CTXL) continue;
        const Row16 xin = LAYER == 0 ? ld_row_f32(x0_row(F, row), F.lane) : ld_row_f32(X + (size_t)row * DM, F.lane);
        const Row16 mix = ld_row_bf16(MIX + (size_t)row * DM, F.lane);
        const Row16 gate = ld_row_f32(mod_ptr(F, LAYER, row, 2), F.lane);
        Row16 pre;
#pragma unroll
        for (int j = 0; j < 4; ++j) pre.v[j] = ALPHA * xin.v[j] + gate.v[j] * mix.v[j];
        const Row16 x1 = layer_norm(pre, F.in[I_LN1G] + LAYER * DM, F.in[I_LN1B] + LAYER * DM, F.lane);
        st_row_f32(X + (size_t)row * DM, F.lane, x1);
        const Row16 h = modulate(x1, mod_ptr(F, LAYER, row, 3), mod_ptr(F, LAYER, row, 4), F.lane);
        st_row_bf16(H + (size_t)row * DM, F.lane, h);
        float lg[NEXP];
#pragma unroll
        for (int e = 0; e < NEXP; ++e) { float s = 0.f;
#pragma unroll
            for (int j = 0; j < 4; ++j) { const f32x4 w = *((const LAS f32x4*)(rwT + e * DM) + F.lane + 64 * j); s += (h.v[j].x * w.x + h.v[j].y * w.y) + (h.v[j].z * w.z + h.v[j].w * w.w); }
            lg[e] = wave_sum(s) + F.in[I_RB][e]; if ((e & 3) == 3) asm volatile("" ::: "memory"); }
        if (F.lane == 0) {
            float mx = lg[0];
#pragma unroll
            for (int e = 1; e < NEXP; ++e) mx = fmaxf(mx, lg[e]);
            float p[NEXP];
#pragma unroll
            for (int e = 0; e < NEXP; ++e) p[e] = expf(lg[e] - mx);
            int best = 0; float bs = -1.f;
#pragma unroll
            for (int g = 0; g < 4; ++g) { float a = p[4 * g], c2 = -1.f;
#pragma unroll
                for (int i = 1; i < 4; ++i) { const float v = p[4 * g + i]; if (v > a) { c2 = a; a = v; } else if (v > c2) c2 = v; }
                const float sc = a + c2; if (sc > bs) { bs = sc; best = g; } }
            int i0 = 0; float p0 = -1.f;
#pragma unroll
            for (int i = 0; i < 4; ++i) { float v = 0.f;
#pragma unroll
                for (int g = 0; g < 4; ++g) v = (g == best) ? p[4 * g + i] : v;
                if (v > p0) { p0 = v; i0 = i; } }
            int i1 = 0; float p1 = -1.f;
#pragma unroll
            for (int i = 0; i < 4; ++i) { float v = 0.f;
#pragma unroll
                for (int g = 0; g < 4; ++g) v = (g == best) ? p[4 * g + i] : v;
                if (i != i0 && v > p1) { p1 = v; i1 = i; } }
            const int e0 = best * 4 + i0, e1 = best * 4 + i1; const float w0 = p0 / (p0 + p1), w1 = p1 / (p0 + p1);
            const unsigned r0 = atomicAdd(cnt + e0, 1u), r1 = atomicAdd(cnt + e1, 1u);
            PERM[(size_t)e0 * CAP + r0] = row; GATE[(size_t)e0 * CAP + r0] = w0; PERM[(size_t)e1 * CAP + r1] = row; GATE[(size_t)e1 * CAP + r1] = w1;
            TOK[row * 2 + 0] = (e0 << 20) | (int)r0; TOK[row * 2 + 1] = (e1 << 20) | (int)r1;
        }
    }
}

__device__ __forceinline__ void expert_tile_offsets(const unsigned* cnt, int (&toff)[NEXP + 1]) {
    toff[0] = 0;
#pragma unroll
    for (int e = 0; e < NEXP; ++e) toff[e + 1] = toff[e] + (int)((__hip_atomic_load(cnt + e, __ATOMIC_RELAXED, __HIP_MEMORY_SCOPE_AGENT) + 255u) >> 8);
}

template <int LAYER>
__device__ __forceinline__ void p_ln2(Frame& F) {
    const int gw = F.bid * NWAVES + F.wave, NGW = F.G * NWAVES;
    float* X = (float*)(F.ws + WS_X); bf16* H = (bf16*)(F.ws + WS_H); const bf16* Y = (const bf16*)(F.ws + WS_Y);
    const unsigned* cnt = (const unsigned*)(F.ws + WS_CTL) + CW_CNT + LAYER * 64; const int* TOK = (const int*)(F.ws + WS_TOK);
    int toff[NEXP + 1]; expert_tile_offsets(cnt, toff);
    for (int row = gw; row < MROWS; row += NGW) {
        const int b = row / TPB, tt = row - b * TPB;
        if (LAYER == 1 && tt < CTXL) continue;
        const int t0 = __hip_atomic_load(TOK + row * 2, __ATOMIC_RELAXED, __HIP_MEMORY_SCOPE_AGENT), t1 = __hip_atomic_load(TOK + row * 2 + 1, __ATOMIC_RELAXED, __HIP_MEMORY_SCOPE_AGENT); const int e0 = t0 >> 20, e1 = t1 >> 20;
        int o0 = 0, o1 = 0;
#pragma unroll
        for (int e = 0; e < NEXP; ++e) { o0 = (e == e0) ? toff[e] : o0; o1 = (e == e1) ? toff[e] : o1; }
        const size_t y0 = (size_t)o0 * 256 + (t0 & 0xfffff), y1 = (size_t)o1 * 256 + (t1 & 0xfffff);
        const Row16 xin = ld_row_f32(X + (size_t)row * DM, F.lane);
        const Row16 ya = ld_row_bf16(Y + y0 * DM, F.lane), yb = ld_row_bf16(Y + y1 * DM, F.lane);
        const Row16 gate = ld_row_f32(mod_ptr(F, LAYER, row, 5), F.lane);
        Row16 pre;
#pragma unroll
        for (int j = 0; j < 4; ++j) pre.v[j] = ALPHA * xin.v[j] + gate.v[j] * (ya.v[j] + yb.v[j]);
        const Row16 x2 = layer_norm(pre, F.in[I_LN2G] + LAYER * DM, F.in[I_LN2B] + LAYER * DM, F.lane);
        if (LAYER == 0) {
            st_row_f32(X + (size_t)row * DM, F.lane, x2);
            const Row16 h = modulate(x2, mod_ptr(F, 1, row, 0), mod_ptr(F, 1, row, 1), F.lane);
            st_row_bf16(H + (size_t)row * DM, F.lane, h);
        } else {
            st_row_f32(F.out + ((size_t)b * SEQ + (tt - CTXL)) * DM, F.lane, x2);
        }
    }
}
__device__ __forceinline__ bf16* feat_ptr(Frame& F, int i) { return (bf16*)(F.ws + WS_F0 + (size_t)i * FEAT_BYTES); }
enum { FT_R = 0, FT_K, FT_V, FT_KK, FT_G, FT_A0, FT_A1, FT_E };

__device__ __forceinline__ void p_rope0(Frame& F) {
    const int gw = F.bid * NWAVES + F.wave, NGW = F.G * NWAVES;
    bf16* PB = (bf16*)(F.ws + WS_PB); const float* cosB = (const float*)(F.ws + WS_ROPE); const float* sinB = cosB + SEQ * 32;
    for (int row = gw; row < MROWS; row += NGW) {
        const int b = row / TPB, tt = row - b * TPB; if (tt < CTXL) continue; const int t = tt - CTXL;
        bf16* p = PB + (size_t)row * B_IN;
#pragma unroll
        for (int q = 0; q < 8; ++q) { const int pr = q * 64 + F.lane; const int vec = pr >> 5, i = pr & 31; const int c1 = vec * 64 + i, c2 = c1 + 32;
            const float x1 = bf2f(p[c1]), x2 = bf2f(p[c2]); const float cs = cosB[t * 32 + i], sn = sinB[t * 32 + i];
            p[c1] = (bf16)f2bf(x1 * cs - x2 * sn); p[c2] = (bf16)f2bf(x1 * sn + x2 * cs); }
    }
}

__device__ __forceinline__ void p_features(Frame& F, int d) {
    LAS float* lin = (LAS float*)(F.lds + RING_OFF);
    const bf16* PA = (const bf16*)(F.ws + WS_PA);
    const int c = F.tid;
    const float* mu = F.in[I_AMU];
    const float mu_r = mu[c], mu_k = mu[512 + c], mu_v = mu[1024 + c], mu_l = c < 384 ? mu[1536 + c] : 0.f;
    const float k_k = F.in[I_AKK][c];
    bf16* fr = feat_ptr(F, FT_R); bf16* fk = feat_ptr(F, FT_K); bf16* fv = feat_ptr(F, FT_V); bf16* fkk = feat_ptr(F, FT_KK); bf16* fg = feat_ptr(F, FT_G);
    bf16* fa = feat_ptr(F, d == 0 ? FT_A0 : FT_A1); bf16* fe = feat_ptr(F, FT_E);
    LAS float* gtmp = (LAS float*)(F.lds + RING_OFF + 65536);
    for (int it = F.bid; it < NB * 72; it += F.G) {
        const int b = it / 72, ci = it % 72; const bool isctx = ci < 8; const int t0 = isctx ? ci * 32 : (ci - 8) * 32, L = isctx ? CTXL : SEQ;
        const int rbase = b * TPB + (isctx ? 0 : CTXL);
        __syncthreads();
        for (int t = 0; t < 32; ++t) {
            const int tp = t0 + t; const size_t row = (size_t)(rbase + tp);
            const bf16* pc = PA + row * A_IN; const bool hp = tp > 0, hn = tp + 1 < L;
#define UMIX(col, m) ({ const float cur_ = bf2f(pc[col]); const float pv_ = hp ? bf2f(pc[(col) - A_IN]) : 0.f; const float nx_ = hn ? bf2f(pc[(col) + A_IN]) : 0.f; cur_ + (0.5f * (pv_ + nx_) - cur_) * (m); })
            if (d == 0) {
                const float ur = UMIX(c, mu_r), uk = UMIX(512 + c, mu_k), uv = UMIX(1024 + c, mu_v);
                fr[row * 512 + c] = (bf16)f2bf(ur); fk[row * 512 + c] = (bf16)f2bf(uk); fv[row * 512 + c] = (bf16)f2bf(uv);
                const float kr = uk * k_k; const float ss = wave_sum(kr * kr);
                fkk[row * 512 + c] = (bf16)f2bf(kr / fmaxf(sqrtf(ss), 1e-12f));
            }
            if (c < 384) { float ul = UMIX(1536 + c, mu_l); if (c < 128) ul = tanhf(ul); else if (c >= 256) ul = sigmoidf_(ul); lin[t * 384 + c] = ul; }
#undef UMIX
        }
        __syncthreads();
#pragma unroll 1
        for (int pass = 0; pass < (d == 0 ? 4 : 2); ++pass) {
            float wreg[64];
            const float* wsrc = pass == 0 ? F.in[I_AA2] + (size_t)d * 64 * 512 : pass == 1 ? F.in[I_AW2] + (size_t)d * 64 * 512 : F.in[I_AG2] + (size_t)(pass - 2) * 64 * 512;
#pragma unroll
            for (int l = 0; l < 64; ++l) wreg[l] = wsrc[l * 512 + c];
            const int inoff = pass == 0 ? 128 + d * 64 : pass == 1 ? d * 64 : 256 + (pass - 2) * 64;
            const float bias = pass == 0 ? F.in[I_AA0][d * 512 + c] : pass == 1 ? F.in[I_AW0][d * 512 + c] : 0.f;
#pragma unroll 1
            for (int t = 0; t < 32; ++t) {
                asm volatile("" ::: "memory");
                const size_t row = (size_t)(rbase + t0 + t);
                float acc = bias; const LAS f32x4* in4 = (const LAS f32x4*)(lin + t * 384 + inoff);
#pragma unroll
                for (int l4 = 0; l4 < 16; ++l4) { const f32x4 x = in4[l4]; acc += x.x * wreg[4 * l4] + x.y * wreg[4 * l4 + 1] + x.z * wreg[4 * l4 + 2] + x.w * wreg[4 * l4 + 3]; }
                if (pass == 0) fa[row * 512 + c] = (bf16)f2bf(sigmoidf_(acc));
                else if (pass == 1) fe[row * 512 + c] = (bf16)f2bf(sigmoidf_(acc) * 0.6065306597126334f);
                else if (pass == 2) gtmp[t * 512 + c] = acc;
                else fg[row * 512 + c] = (bf16)f2bf(acc + gtmp[t * 512 + c]);
            }
        }
    }
}

__device__ __forceinline__ void p_scan(Frame& F, int d) {
    constexpr int TS = 64;
    LAS float* stg = (LAS float*)(F.lds + RING_OFF);
    LAS float* ybuf = stg + TS * 6 * 64;
    const bf16* fr = feat_ptr(F, FT_R); const bf16* fk = feat_ptr(F, FT_K); const bf16* fv = feat_ptr(F, FT_V); const bf16* fkk = feat_ptr(F, FT_KK);
    const bf16* fa = feat_ptr(F, d == 0 ? FT_A0 : FT_A1); const bf16* fe = feat_ptr(F, FT_E);
    bf16* yout = (bf16*)(F.ws + (d == 0 ? WS_YF : WS_YR));
    for (int chain = F.bid; chain < NB * 8; chain += F.G) {
        const int b = chain >> 3, h = chain & 7;
        float S[8];
#pragma unroll
        for (int j = 0; j < 8; ++j) S[j] = 0.f;
        const int v = F.tid >> 3, ks = F.tid & 7;
        for (int blk = 0; blk < TPB / TS; ++blk) {
            __syncthreads();
            {
                const int s = F.tid >> 3, c8 = (F.tid & 7) * 8; const int i = blk * TS + s;
                const int row = d == 0 ? b * TPB + i : (i < CTXL ? b * TPB + (CTXL - 1 - i) : b * TPB + CTXL + (TPB - 1 - i));
                const size_t off = (size_t)row * 512 + h * 64 + c8;
                const v4u qr = *(const v4u*)(fr + off), qk = *(const v4u*)(fk + off), qv = *(const v4u*)(fv + off), qkk = *(const v4u*)(fkk + off), qa = *(const v4u*)(fa + off), qe = *(const v4u*)(fe + off);
                const unsigned wr_[4] = {qr.x, qr.y, qr.z, qr.w}, wk_[4] = {qk.x, qk.y, qk.z, qk.w}, wv_[4] = {qv.x, qv.y, qv.z, qv.w}, wkk_[4] = {qkk.x, qkk.y, qkk.z, qkk.w}, wa_[4] = {qa.x, qa.y, qa.z, qa.w}, we_[4] = {qe.x, qe.y, qe.z, qe.w};
                LAS float* o = stg + s * 384 + c8;
#pragma unroll
                for (int j = 0; j < 8; ++j) { const int w = j >> 1; const bool up = j & 1;
                    const float r_ = up ? bfhi(wr_[w]) : bflo(wr_[w]), k_ = up ? bfhi(wk_[w]) : bflo(wk_[w]), v_ = up ? bfhi(wv_[w]) : bflo(wv_[w]);
                    const float kk_ = up ? bfhi(wkk_[w]) : bflo(wkk_[w]), a_ = up ? bfhi(wa_[w]) : bflo(wa_[w]), e_ = up ? bfhi(we_[w]) : bflo(we_[w]);
                    const float ka = F.in[I_AKA][h * 64 + c8 + j];
                    o[0 * 64 + j] = __expf(-e_); o[1 * 64 + j] = k_ * (1.f + (a_ - 1.f) * ka); o[2 * 64 + j] = -kk_; o[3 * 64 + j] = kk_ * a_; o[4 * 64 + j] = r_; o[5 * 64 + j] = v_; }
            }
            __syncthreads();
            for (int s = 0; s < TS; ++s) {
                const LAS f32x4* p = (const LAS f32x4*)(stg + s * 384 + ks * 8);
                const f32x4 w0 = p[0], w1 = p[1], k0 = p[16], k1 = p[17], a0 = p[32], a1 = p[33], b0 = p[48], b1 = p[49], r0 = p[64], r1 = p[65];
                const float vv = stg[s * 384 + 5 * 64 + v];
                float sa = (S[0] * a0.x + S[1] * a0.y) + (S[2] * a0.z + S[3] * a0.w) + (S[4] * a1.x + S[5] * a1.y) + (S[6] * a1.z + S[7] * a1.w);
                sa += __shfl_xor(sa, 1); sa += __shfl_xor(sa, 2); sa += __shfl_xor(sa, 4);
                S[0] = S[0] * w0.x + sa * b0.x + vv * k0.x; S[1] = S[1] * w0.y + sa * b0.y + vv * k0.y; S[2] = S[2] * w0.z + sa * b0.z + vv * k0.z; S[3] = S[3] * w0.w + sa * b0.w + vv * k0.w;
                S[4] = S[4] * w1.x + sa * b1.x + vv * k1.x; S[5] = S[5] * w1.y + sa * b1.y + vv * k1.y; S[6] = S[6] * w1.z + sa * b1.z + vv * k1.z; S[7] = S[7] * w1.w + sa * b1.w + vv * k1.w;
                float y = (S[0] * r0.x + S[1] * r0.y) + (S[2] * r0.z + S[3] * r0.w) + (S[4] * r1.x + S[5] * r1.y) + (S[6] * r1.z + S[7] * r1.w);
                y += __shfl_xor(y, 1); y += __shfl_xor(y, 2); y += __shfl_xor(y, 4);
                if (ks == 0) ybuf[s * 64 + v] = y;
            }
            __syncthreads();
            for (int i2 = F.tid; i2 < TS * 64; i2 += NTHR) { const int s = i2 >> 6, vv = i2 & 63; const int i = blk * TS + s;
                const int row = d == 0 ? b * TPB + i : (i < CTXL ? b * TPB + (CTXL - 1 - i) : b * TPB + CTXL + (TPB - 1 - i));
                yout[(size_t)row * 512 + h * 64 + vv] = (bf16)f2bf(ybuf[i2]); }
        }
    }
}

__device__ __forceinline__ void p_attn0(Frame& F) {
    const bf16* PB = (const bf16*)(F.ws + WS_PB);
    for (int u = F.bid; u < 576; u += F.G) {
        int b, h, m, qt;
        if (u < 512) { qt = 1 + (u & 7); const int r = u >> 3; m = r & 1; h = (r >> 1) & 3; b = r >> 3; }
        else { const int r = u - 512; qt = 0; m = r & 1; h = (r >> 1) & 3; b = r >> 3; }
        const size_t row0 = (size_t)b * TPB;
        const bf16* Q = PB + (row0 + (size_t)qt * 256) * B_IN + h * 128 + m * 64;
        const bf16* Kp = PB + row0 * B_IN + 512 + h * 128 + m * 64;
        const bf16* Vp = PB + row0 * B_IN + 1024 + h * 128;
        bf16* O = (bf16*)(F.ws + (m == 0 ? WS_OB0 : WS_OB1)) + (row0 + (size_t)qt * 256) * 512 + h * 128;
        att::attn_body<64, B_IN, B_IN, 512>(Q, Kp, Vp, O, qt == 0 ? CTXL : TPB, F.ldsg + RING_OFF, F.wave);
    }
}

__device__ __forceinline__ void p_readout(Frame& F) {
    const int gw = F.bid * NWAVES + F.wave, NGW = F.G * NWAVES;
    const bf16* fr = feat_ptr(F, FT_R); const bf16* fk = feat_ptr(F, FT_K); const bf16* fv = feat_ptr(F, FT_V); const bf16* fg = feat_ptr(F, FT_G);
    const bf16* yf = (const bf16*)(F.ws + WS_YF); const bf16* yr = (const bf16*)(F.ws + WS_YR);
    const bf16* ob0 = (const bf16*)(F.ws + WS_OB0); const bf16* ob1 = (const bf16*)(F.ws + WS_OB1);
    bf16* A2 = (bf16*)(F.ws + WS_A2);
    float lam;
    { const float* lv = F.in[I_BLAM]; const float s1 = wave_sum(lv[F.lane] * lv[64 + F.lane]), s2 = wave_sum(lv[128 + F.lane] * lv[192 + F.lane]); lam = expf(s1) - expf(s2) + LAMBDA_INIT0; }
    const int c8 = F.lane * 8;
    for (int row = gw; row < MROWS; row += NGW) {
        const size_t off = (size_t)row * 512 + c8;
        const v4u qr = *(const v4u*)(fr + off), qk = *(const v4u*)(fk + off), qv = *(const v4u*)(fv + off), qg = *(const v4u*)(fg + off), q1 = *(const v4u*)(yf + off), q2 = *(const v4u*)(yr + off);
        const v4u qa0 = *(const v4u*)(feat_ptr(F, FT_A0) + off), qa1 = *(const v4u*)(feat_ptr(F, FT_A1) + off);
        const unsigned wr_[4] = {qr.x, qr.y, qr.z, qr.w}, wk_[4] = {qk.x, qk.y, qk.z, qk.w}, wv_[4] = {qv.x, qv.y, qv.z, qv.w}, wg_[4] = {qg.x, qg.y, qg.z, qg.w}, w1_[4] = {q1.x, q1.y, q1.z, q1.w}, w2_[4] = {q2.x, q2.y, q2.z, q2.w}, wa0_[4] = {qa0.x, qa0.y, qa0.z, qa0.w}, wa1_[4] = {qa1.x, qa1.y, qa1.z, qa1.w};
        float y[8], bon = 0.f, s = 0.f;
#pragma unroll
        for (int j = 0; j < 8; ++j) { const int w = j >> 1; const bool up = j & 1;
            y[j] = (up ? bfhi(w1_[w]) : bflo(w1_[w])) + (up ? bfhi(w2_[w]) : bflo(w2_[w])); s += y[j];
            const float r_ = up ? bfhi(wr_[w]) : bflo(wr_[w]), k_ = up ? bfhi(wk_[w]) : bflo(wk_[w]), as_ = (up ? bfhi(wa0_[w]) : bflo(wa0_[w])) + (up ? bfhi(wa1_[w]) : bflo(wa1_[w]));
            bon += r_ * (k_ * (2.f + (as_ - 2.f) * F.in[I_AKA][c8 + j])) * F.in[I_ARK][c8 + j]; }
        s += __shfl_xor(s, 1); s += __shfl_xor(s, 2); s += __shfl_xor(s, 4); bon += __shfl_xor(bon, 1); bon += __shfl_xor(bon, 2); bon += __shfl_xor(bon, 4);
        const float mean = s * (1.f / 64.f); float q = 0.f;
#pragma unroll
        for (int j = 0; j < 8; ++j) { y[j] -= mean; q += y[j] * y[j]; }
        q += __shfl_xor(q, 1); q += __shfl_xor(q, 2); q += __shfl_xor(q, 4);
        const float rstd = 1.f / sqrtf(q * (1.f / 64.f) + GN_EPS);
        float o[8];
#pragma unroll
        for (int j = 0; j < 8; ++j) { const int w = j >> 1; const bool up = j & 1; const float v_ = up ? bfhi(wv_[w]) : bflo(wv_[w]), g_ = up ? bfhi(wg_[w]) : bflo(wg_[w]);
            o[j] = (y[j] * rstd * F.in[I_LNXG][c8 + j] + F.in[I_LNXB][c8 + j] + bon * v_) * g_; }
        *(v4u*)(A2 + (size_t)row * DM + c8) = (v4u){pk2(o[0], o[1]), pk2(o[2], o[3]), pk2(o[4], o[5]), pk2(o[6], o[7])};
        const v4u p0 = *(const v4u*)(ob0 + off), p1 = *(const v4u*)(ob1 + off);
        const unsigned u0[4] = {p0.x, p0.y, p0.z, p0.w}, u1[4] = {p1.x, p1.y, p1.z, p1.w};
        float z[8], ss = 0.f;
#pragma unroll
        for (int j = 0; j < 8; ++j) { const int w = j >> 1; const bool up = j & 1; z[j] = (up ? bfhi(u0[w]) : bflo(u0[w])) - lam * (up ? bfhi(u1[w]) : bflo(u1[w])); ss += z[j] * z[j]; }
        ss += __shfl_xor(ss, 1); ss += __shfl_xor(ss, 2); ss += __shfl_xor(ss, 4); ss += __shfl_xor(ss, 8);
        const float rr = 1.f / sqrtf(ss * (1.f / 128.f) + SUBLN_EPS) * (1.f - LAMBDA_INIT0);
#pragma unroll
        for (int j = 0; j < 8; ++j) z[j] = z[j] * rr * F.in[I_SUBG][(c8 + j) & 127];
        *(v4u*)(A2 + (size_t)row * DM + 512 + c8) = (v4u){pk2(z[0], z[1]), pk2(z[2], z[3]), pk2(z[4], z[5]), pk2(z[6], z[7])};
    }
}

__device__ __forceinline__ void p_qknorm1(Frame& F) {
    const int gw = F.bid * NWAVES + F.wave, NGW = F.G * NWAVES;
    bf16* QKV = (bf16*)(F.ws + WS_QKV1); const float* cosC = (const float*)(F.ws + WS_ROPE) + SEQ * 64; const float* sinC = cosC + SEQ * 64;
    const float qg1 = F.in[I_QNG][F.lane], qg2 = F.in[I_QNG][64 + F.lane], kg1 = F.in[I_KNG][F.lane], kg2 = F.in[I_KNG][64 + F.lane];
    for (int row = gw; row < MROWS; row += NGW) {
        const int b = row / TPB, tt = row - b * TPB; const bool lat = tt >= CTXL; const int t = tt - CTXL;
        float cs = 1.f, sn = 0.f; if (lat) { cs = cosC[t * 64 + F.lane]; sn = sinC[t * 64 + F.lane]; }
        bf16* p = QKV + (size_t)row * ODD_IN;
        for (int hd = lat ? 0 : 8; hd < 10; ++hd) {
            bf16* ph = p + hd * 128; const float x1 = bf2f(ph[F.lane]), x2 = bf2f(ph[64 + F.lane]);
            const float ss = wave_sum(x1 * x1 + x2 * x2); const float ri = 1.f / sqrtf(ss * (1.f / 128.f) + QKN_EPS);
            const float y1 = x1 * ri * (hd < 8 ? qg1 : kg1), y2 = x2 * ri * (hd < 8 ? qg2 : kg2);
            ph[F.lane] = (bf16)f2bf(y1 * cs - y2 * sn); ph[64 + F.lane] = (bf16)f2bf(y1 * sn + y2 * cs);
        }
    }
}
__device__ __forceinline__ void p_attn1(Frame& F) {
    const bf16* QKV = (const bf16*)(F.ws + WS_QKV1); bf16* OA = (bf16*)(F.ws + WS_OATT);
    for (int u = F.bid; u < 512; u += F.G) {
        const int qt = 1 + (u & 7), h = (u >> 3) & 7, b = u >> 6; const int kvh = h >> 2;
        const size_t row0 = (size_t)b * TPB;
        const bf16* Q = QKV + (row0 + (size_t)qt * 256) * ODD_IN + h * 128;
        const bf16* Kp = QKV + row0 * ODD_IN + 1024 + kvh * 128;
        const bf16* Vp = QKV + row0 * ODD_IN + 1280 + kvh * 128;
        bf16* O = OA + (row0 + (size_t)qt * 256) * DM + h * 128;
        att::attn_body<128, ODD_IN, ODD_IN, DM>(Q, Kp, Vp, O, TPB, F.ldsg + RING_OFF, F.wave);
    }
}
namespace pg8 {
struct EpiBf16 {
    static constexpr bool PERM = true;
    bf16_t* O; int ldc;
    __device__ __forceinline__ void operator()(const f32x4 (&acc)[2][2][4][2], const Unit& u, int wr, int wc, int fr, int fq) const {
        const int row0 = u.orow0 + wr * 64 + fr, col0 = u.pn * BM + wc * 32 + 8 * fq;
#pragma unroll
        for (int ai = 0; ai < 2; ++ai)
#pragma unroll
            for (int m = 0; m < 4; ++m) { bf16_t* rowp = O + (size_t)(row0 + ai * HALF + m * 16) * ldc + col0;
#pragma unroll
                for (int bj = 0; bj < 2; ++bj) { const f32x4 v0 = acc[ai][bj][m][0], v1 = acc[ai][bj][m][1];
                    u32x4 w; w.x = cvt_pk_bf16(v0[0], v0[1]); w.y = cvt_pk_bf16(v0[2], v0[3]); w.z = cvt_pk_bf16(v1[0], v1[1]); w.w = cvt_pk_bf16(v1[2], v1[3]);
                    *(u32x4*)(rowp + bj * HALF) = w; } }
    }
};
struct EpiIn0 {
    static constexpr bool PERM = true;
    bf16_t* PA; bf16_t* PB;
    __device__ __forceinline__ void operator()(const f32x4 (&acc)[2][2][4][2], const Unit& u, int wr, int wc, int fr, int fq) const {
        const int row0 = u.orow0 + wr * 64 + fr, col0 = u.pn * BM + wc * 32 + 8 * fq;
#pragma unroll
        for (int ai = 0; ai < 2; ++ai)
#pragma unroll
            for (int m = 0; m < 4; ++m) { const size_t row = (size_t)(row0 + ai * HALF + m * 16);
#pragma unroll
                for (int bj = 0; bj < 2; ++bj) { const f32x4 v0 = acc[ai][bj][m][0], v1 = acc[ai][bj][m][1]; const int col = col0 + bj * HALF;
                    u32x4 w; w.x = cvt_pk_bf16(v0[0], v0[1]); w.y = cvt_pk_bf16(v0[2], v0[3]); w.z = cvt_pk_bf16(v1[0], v1[1]); w.w = cvt_pk_bf16(v1[2], v1[3]);
                    if (col < 1920) *(u32x4*)(PA + row * 1920 + col) = w; else if (col < 3456) *(u32x4*)(PB + row * 1536 + (col - 1920)) = w; } }
    }
};
struct EpiMoe1 {
    static constexpr bool PERM = true;
    bf16_t* HID;
    __device__ __forceinline__ void operator()(const f32x4 (&acc)[2][2][4][2], const Unit& u, int wr, int wc, int fr, int fq) const {
        const int row0 = u.orow0 + wr * 64 + fr, col0 = u.pn * 128 + wc * 16 + 4 * fq;
#pragma unroll
        for (int ai = 0; ai < 2; ++ai)
#pragma unroll
            for (int m = 0; m < 4; ++m) { bf16_t* rowp = HID + (size_t)(row0 + ai * HALF + m * 16) * 512 + col0;
#pragma unroll
                for (int bj = 0; bj < 2; ++bj) { const f32x4 a = acc[ai][bj][m][0], b = acc[ai][bj][m][1]; float h[4];
#pragma unroll
                    for (int i = 0; i < 4; ++i) h[i] = a[i] / (1.f + __expf(-a[i])) * b[i];
                    u32x2 w; w.x = cvt_pk_bf16(h[0], h[1]); w.y = cvt_pk_bf16(h[2], h[3]);
                    *(u32x2*)(rowp + bj * 64) = w; } }
    }
};
struct EpiMoe2 {
    static constexpr bool PERM = true;
    bf16_t* Y; const float* GATE;
    __device__ __forceinline__ void operator()(const f32x4 (&acc)[2][2][4][2], const Unit& u, int wr, int wc, int fr, int fq) const {
        const int r0 = wr * 64 + fr, col0 = u.pn * BM + wc * 32 + 8 * fq;
#pragma unroll
        for (int ai = 0; ai < 2; ++ai)
#pragma unroll
            for (int m = 0; m < 4; ++m) { const int r = r0 + ai * HALF + m * 16; if (r >= u.nvalid) continue;
                const float gt = GATE[u.gbase + r]; bf16_t* rowp = Y + (size_t)(u.orow0 + r) * 1024 + col0;
#pragma unroll
                for (int bj = 0; bj < 2; ++bj) { const f32x4 v0 = acc[ai][bj][m][0] * gt, v1 = acc[ai][bj][m][1] * gt;
                    u32x4 w; w.x = cvt_pk_bf16(v0[0], v0[1]); w.y = cvt_pk_bf16(v0[2], v0[3]); w.z = cvt_pk_bf16(v1[0], v1[1]); w.w = cvt_pk_bf16(v1[2], v1[3]);
                    *(u32x4*)(rowp + bj * HALF) = w; } }
    }
};
__device__ __forceinline__ void moe_build_table(const unsigned* cnt, PG8_LAS int* tab, int tid) {
    unsigned cn[16]; int total = 0;
#pragma unroll
    for (int e = 0; e < 16; ++e) { cn[e] = __hip_atomic_load(cnt + e, __ATOMIC_RELAXED, __HIP_MEMORY_SCOPE_AGENT); total += (int)((cn[e] + 255u) >> 8); }
    total *= 4;
    if (tid == 0) tab[0] = total;
    for (int L = tid; L < total; L += 512) {
        int base = 0, toff = 0, e = 0; bool found = false; unsigned ce = cn[0];
#pragma unroll
        for (int q = 0; q < 16; ++q) { const int nt = (int)((cn[q] + 255u) >> 8); if (!found) { if (L >= base + 4 * nt) { base += 4 * nt; toff += nt; e = q + 1; } else { found = true; ce = cn[q]; } } }
        const int nt_e = (int)((ce + 255u) >> 8); const int within = L - base, pn = within / nt_e, rt = within % nt_e;
        const int rem = (int)ce - rt * 256; const int nvalid = rem < 256 ? rem : 256;
        tab[4 + 2 * L] = e | (rt << 4) | (pn << 12) | (nvalid << 16); tab[4 + 2 * L + 1] = toff + rt;
    }
    __syncthreads();
}
template <bool GATHER_>
struct MoeOrder {
    static constexpr bool GATHER = GATHER_;
    const PG8_LAS int* tab; const int* perm; int G, c, K;
    __device__ __forceinline__ bool next(int i, Unit& u) const {
        const int total = __builtin_amdgcn_readfirstlane(tab[0]);
        const int L0 = i * G + c; if (L0 >= total) return false;
        const int L = xcd_remap(L0, total);
        const int w0 = __builtin_amdgcn_readfirstlane(tab[4 + 2 * L]), w1 = __builtin_amdgcn_readfirstlane(tab[4 + 2 * L + 1]);
        const int e = w0 & 15, rt = (w0 >> 4) & 255, pn = (w0 >> 12) & 3;
        u.pm = rt; u.pn = pn; u.e = e; u.gbase = e * 18432 + rt * 256; u.nvalid = (w0 >> 16) & 511; u.orow0 = w1 * 256;
        u.boff = ((size_t)e * 1024 + (size_t)pn * 256) * K * 2; u.aoff = (size_t)u.orow0 * K * 2; return true;
    }
    __device__ __forceinline__ int token(const Unit& u, int r) const { return perm[u.gbase + (r < u.nvalid ? r : 0)]; }
};
}

enum { PH_PROLOGUE = 0, PH_MOD0, PH_GEMM_IN0, PH_FEAT0, PH_SCAN0, PH_FEAT1, PH_SCAN1, PH_ATTN0, PH_READOUT, PH_GEMM_OUT0, PH_LNR0, PH_MOE1_0, PH_MOE2_0, PH_LN2_0,
       PH_GEMM_IN1, PH_QKN1, PH_ATTN1, PH_GEMM_OUT1, PH_LNR1, PH_MOE1_1, PH_MOE2_1, PH_FINAL, N_PHASES };

template <int LAYER> __device__ __forceinline__ void p_moe1(Frame& F) {
    pg8::Gemm g{(const pg8::bf16_t*)(F.ws + WS_H), (const pg8::bf16_t*)(F.ws + WS_WM13), DM};
    pg8::moe_build_table((const unsigned*)(F.ws + WS_CTL) + CW_CNT + LAYER * 64, (LAS int*)(F.lds + MOETAB_OFF), F.tid);
    pg8::MoeOrder<true> S{(const LAS int*)(F.lds + MOETAB_OFF), (const int*)(F.ws + WS_PERM_), F.G, F.bid, DM};
    pg8::EpiMoe1 E{(pg8::bf16_t*)(F.ws + WS_HID)};
    pg8::gemm_phase<pg8::EpiMoe1, pg8::MoeOrder<true>>(F.lds + RING_OFF, g, S, E, F.wave);
}
template <int LAYER> __device__ __forceinline__ void p_moe2(Frame& F) {
    pg8::Gemm g{(const pg8::bf16_t*)(F.ws + WS_HID), (const pg8::bf16_t*)(F.ws + WS_WM2), EFF};
    pg8::moe_build_table((const unsigned*)(F.ws + WS_CTL) + CW_CNT + LAYER * 64, (LAS int*)(F.lds + MOETAB_OFF), F.tid);
    pg8::MoeOrder<false> S{(const LAS int*)(F.lds + MOETAB_OFF), (const int*)(F.ws + WS_PERM_), F.G, F.bid, EFF};
    pg8::EpiMoe2 E{(pg8::bf16_t*)(F.ws + WS_Y), (const float*)(F.ws + WS_GATE)};
    pg8::gemm_phase<pg8::EpiMoe2, pg8::MoeOrder<false>>(F.lds + RING_OFF, g, S, E, F.wave);
}
__device__ __forceinline__ void p_gemm_dense(Frame& F, size_t a_off, size_t w_off, int N, size_t o_off, int ldc) {
    pg8::Gemm g{(const pg8::bf16_t*)(F.ws + a_off), (const pg8::bf16_t*)(F.ws + w_off), DM};
    pg8::DenseOrder S; S.init(MROWS, N, DM, F.G, F.bid);
    pg8::EpiBf16 E{(pg8::bf16_t*)(F.ws + o_off), ldc};
    pg8::gemm_phase<pg8::EpiBf16, pg8::DenseOrder>(F.lds + RING_OFF, g, S, E, F.wave);
}

template <int PH> __device__ __forceinline__ void run_phase(Frame& F) {
    if constexpr (PH == PH_PROLOGUE) p_prologue(F);
    else if constexpr (PH == PH_MOD0) p_mod0(F);
    else if constexpr (PH == PH_GEMM_IN0) {
        pg8::Gemm g{(const pg8::bf16_t*)(F.ws + WS_H), (const pg8::bf16_t*)(F.ws + WS_WEVIN), DM};
        pg8::DenseOrder S; S.init(MROWS, EVEN_PAD, DM, F.G, F.bid);
        pg8::EpiIn0 E{(pg8::bf16_t*)(F.ws + WS_PA), (pg8::bf16_t*)(F.ws + WS_PB)};
        pg8::gemm_phase<pg8::EpiIn0, pg8::DenseOrder>(F.lds + RING_OFF, g, S, E, F.wave); }
    else if constexpr (PH == PH_FEAT0) { p_rope0(F); p_features(F, 0); }
    else if constexpr (PH == PH_SCAN0) p_scan(F, 0);
    else if constexpr (PH == PH_FEAT1) p_features(F, 1);
    else if constexpr (PH == PH_SCAN1) p_scan(F, 1);
    else if constexpr (PH == PH_ATTN0) p_attn0(F);
    else if constexpr (PH == PH_READOUT) p_readout(F);
    else if constexpr (PH == PH_GEMM_OUT0) p_gemm_dense(F, WS_A2, WS_WEVOUT, DM, WS_MIX, DM);
    else if constexpr (PH == PH_LNR0) { convert_moe_weights(F, 0); __syncthreads(); p_ln_route<0>(F); }
    else if constexpr (PH == PH_MOE1_0) p_moe1<0>(F);
    else if constexpr (PH == PH_MOE2_0) p_moe2<0>(F);
    else if constexpr (PH == PH_LN2_0) { p_ln2<0>(F); convert_moe_weights(F, 1); }
    else if constexpr (PH == PH_GEMM_IN1) p_gemm_dense(F, WS_H, WS_WODIN, ODD_IN, WS_QKV1, ODD_IN);
    else if constexpr (PH == PH_QKN1) p_qknorm1(F);
    else if constexpr (PH == PH_ATTN1) p_attn1(F);
    else if constexpr (PH == PH_GEMM_OUT1) p_gemm_dense(F, WS_OATT, WS_WODOUT, DM, WS_MIX, DM);
    else if constexpr (PH == PH_LNR1) p_ln_route<1>(F);
    else if constexpr (PH == PH_MOE1_1) p_moe1<1>(F);
    else if constexpr (PH == PH_MOE2_1) p_moe2<1>(F);
    else if constexpr (PH == PH_FINAL) p_ln2<1>(F);
}
template <int PH, int HI> __device__ __forceinline__ void run_phases(Frame& F, const XcdBarrier& bar) {
    if constexpr (PH < HI) {
        {
            const float* const* inp = (const float* const*)__builtin_amdgcn_kernarg_segment_ptr(); asm volatile("" : "+s"(inp)); F.in = inp;
            asm volatile("" : "+s"(F.ws), "+s"(F.out), "+s"(F.G), "+s"(F.bid), "+s"(F.wave));
            int l_ = (int)__builtin_amdgcn_mbcnt_hi(~0u, __builtin_amdgcn_mbcnt_lo(~0u, 0u)); asm volatile("" : "+v"(l_)); F.lane = l_; F.tid = (F.wave << 6) | l_; }
        asm volatile("; PHASE_MARK %0" :: "i"(PH));
        run_phase<PH>(F);
        if constexpr (PH + 1 < HI) { xcd_barrier(bar); run_phases<PH + 1, HI>(F, bar); }
    }
}

template <int LO, int HI>
__global__ void __launch_bounds__(NTHR, 2) fwd_kernel(Args args) {
    extern __shared__ __attribute__((aligned(16))) unsigned char lds[];
    Frame F;
    F.lds = (LAS unsigned char*)lds; F.ldsg = (char*)lds;
    F.tid = threadIdx.x; F.lane = F.tid & 63; F.wave = __builtin_amdgcn_readfirstlane(F.tid >> 6);
    F.G = gridDim.x; F.bid = blockIdx.x; F.in = args.in; F.out = args.out; F.ws = args.ws;
    volatile LAS unsigned* MISC = (volatile LAS unsigned*)(F.lds + MISC_OFF);
    for (int u = F.tid; u < (LDS_BYTES - LDSCTL_OFF) / 4; u += NTHR) ((LAS unsigned*)(F.lds + LDSCTL_OFF))[u] = 0u;
    __syncthreads();
    XcdBarrier bar; bar.bar = (unsigned*)(F.ws + WS_CTL) + CW_BAR; bar.x = 0; bar.st = nullptr;
    if constexpr (HI - LO > 1) bar = xcd_barrier_post((unsigned*)(F.ws + WS_CTL) + CW_BAR, MISC + 8);
    run_phases<LO, HI>(F, bar);
}

#ifndef N_LAUNCH_MODE
#define N_LAUNCH_MODE 0
#endif
template <int PH> static void launch_from(int grid, hipStream_t stream, const Args& a) {
    if constexpr (PH < N_PHASES) {
        (void)hipFuncSetAttribute((const void*)fwd_kernel<PH, PH + 1>, hipFuncAttributeMaxDynamicSharedMemorySize, LDS_BYTES);
        hipLaunchKernelGGL((fwd_kernel<PH, PH + 1>), dim3(grid), dim3(NTHR), LDS_BYTES, stream, a);
        launch_from<PH + 1>(grid, stream, a);
    }
}
extern "C" void kernel_launch(void* const* d_in, const int* in_sizes, int n_in, void* d_out, int out_size, void* d_ws, size_t ws_size, hipStream_t stream) {
    static int grid = 0;
    if (grid == 0) {
        if (n_in != 34 || in_sizes[0] != NB * SEQ * DM || out_size != NB * SEQ * DM || ws_size < WS_TOTAL) {
            fprintf(stderr, "kernel_launch: unexpected shapes: n_in %d in0 %d out %d ws %zu (need %zu)\n", n_in, n_in > 0 ? in_sizes[0] : -1, out_size, ws_size, (size_t)WS_TOTAL); grid = -1; return; }
        int dev = 0, cus = 0;
        if (hipGetDevice(&dev) != hipSuccess || hipDeviceGetAttribute(&cus, hipDeviceAttributeMultiprocessorCount, dev) != hipSuccess) { grid = -1; return; }
#if N_LAUNCH_MODE == 0
        if (hipFuncSetAttribute((const void*)fwd_kernel<0, N_PHASES>, hipFuncAttributeMaxDynamicSharedMemorySize, LDS_BYTES) != hipSuccess) { fprintf(stderr, "kernel_launch: hipFuncSetAttribute failed\n"); grid = -1; return; }
#endif
        (void)hipGetLastError();
        grid = cus;
    }
    if (grid < 0) return;
    if (hipMemsetAsync((char*)d_ws + WS_CTL, 0, CTL_ZERO_BYTES, stream) != hipSuccess) return;
    Args a{};
    for (int i = 0; i < 34; ++i) a.in[i] = (const float*)d_in[i];
    a.out = (float*)d_out; a.ws = (unsigned char*)d_ws;
#if N_LAUNCH_MODE == 1
    launch_from<0>(grid, stream, a);
#else
    hipLaunchKernelGGL((fwd_kernel<0, N_PHASES>), dim3(grid), dim3(NTHR), LDS_BYTES, stream, a);
#endif
    const hipError_t le = hipPeekAtLastError();
    if (le != hipSuccess) fprintf(stderr, "kernel_launch: launch failed: %s\n", hipGetErrorName(le));
}
```

```cpp
#include <hip/hip_runtime.h>
#include <hip/hip_bf16.h>
#include <cstdio>
#include <cstdint>
#include <cmath>
namespace pg8 {
#define PG8_LAS __attribute__((address_space(3)))
typedef unsigned short bf16_t;
typedef short bf16x8 __attribute__((ext_vector_type(8)));
typedef float f32x4 __attribute__((ext_vector_type(4)));
typedef unsigned u32x4 __attribute__((ext_vector_type(4)));
typedef unsigned u32x2 __attribute__((ext_vector_type(2)));
constexpr int BM = 256, BK = 64, HALF = 128, HTB = HALF * BK * 2  , STAGE_BYTES = 8 * HTB, NXCD = 8, WGM = 8;

__host__ __device__ __forceinline__ int lds_byte(int r, int c) { const int st = (r >> 4) * 2 + (c >> 5), rr = r & 15, cc = c & 31, ob = rr * 64 + cc * 2; return st * 1024 + (ob ^ (((ob >> 9) & 1) << 5)); }
__host__ __device__ __forceinline__ void stage_rc(int b, int& R, int& C) { const int st = b / 1024, sb = b % 1024, swz = sb ^ (((sb >> 9) & 1) << 5); R = (st >> 1) * 16 + swz / 64; C = (st & 1) * 32 + (swz % 64) / 2; }
__host__ __device__ __forceinline__ int perm32(int rho) { const int n = rho >> 4, i = rho & 15; return 8 * (i >> 2) + 4 * n + (i & 3); }

struct Unit { int pm, pn; size_t aoff, boff; int gbase, nvalid, orow0, e; };
struct Gemm { const bf16_t* A; const bf16_t* Bt; int K; };

__device__ __forceinline__ int xcd_remap(int wgid, int nwg) { const int q = nwg / NXCD, r = nwg % NXCD, xcd = wgid % NXCD, off = wgid / NXCD; return (xcd < r ? xcd * (q + 1) : r * (q + 1) + (xcd - r) * q) + off; }

struct DenseOrder {
    int nM, nN, nwg, G, c, K;
    static constexpr bool GATHER = false;
    __device__ void init(int M, int N, int K_, int G_, int c_) { nM = M / BM; nN = N / BM; nwg = nM * nN; G = G_; c = c_; K = K_; }
    __device__ bool next(int i, Unit& u) const {
        const long L = (long)i * G + c; if (L >= nwg) return false;
        const int wgid = xcd_remap((int)L, nwg);
        const int nig = WGM * nN, gid = wgid / nig, fm = gid * WGM, gsz = (nM - fm) < WGM ? (nM - fm) : WGM;
        u.pm = fm + ((wgid % nig) % gsz); u.pn = (wgid % nig) / gsz;
        u.aoff = (size_t)u.pm * BM * K * 2; u.boff = (size_t)u.pn * BM * K * 2; u.gbase = 0; u.nvalid = BM; u.orow0 = u.pm * BM; u.e = 0; return true;
    }
    __device__ __forceinline__ int token(const Unit&, int) const { return 0; }
};

__device__ __forceinline__ unsigned cvt_pk_bf16(float lo, float hi) { unsigned r; asm volatile("v_cvt_pk_bf16_f32 %0, %1, %2" : "=v"(r) : "v"(lo), "v"(hi)); return r; }

template <class Epi, class Sched>
__device__ __forceinline__ void gemm_phase(PG8_LAS unsigned char* lds, const Gemm g, const Sched& S, const Epi& E, int wave_id) {
    int tid = (wave_id << 6) | (int)__builtin_amdgcn_mbcnt_hi(~0u, __builtin_amdgcn_mbcnt_lo(~0u, 0u)); asm volatile("" : "+v"(tid));
    const int wid = __builtin_amdgcn_readfirstlane(tid >> 6), lane = tid & 63, wr = wid >> 2, wc = wid & 3, fr = lane & 15, fq = lane >> 4;
    const int K = g.K, nt = K / BK;
    int RA[2], CA[2];
    unsigned voffB[2], voffA[2][2], voffAn[2][2];
#pragma unroll
    for (int i = 0; i < 2; ++i) { int R, C; stage_rc(tid * 16 + i * 8192, R, C); RA[i] = R; CA[i] = C; const int Rb = Epi::PERM ? ((R & ~31) + perm32(R & 31)) : R;
        voffB[i] = (unsigned)(Rb * K + C) * 2u;
        voffA[0][i] = (unsigned)(R * K + C) * 2u; voffA[1][i] = (unsigned)((R + HALF) * K + C) * 2u; voffAn[0][i] = voffA[0][i]; voffAn[1][i] = voffA[1][i]; }
    const size_t kstep = (size_t)(BK * 2);
    const size_t hstep = (size_t)HALF * K * 2;
    const unsigned ldsw = (unsigned)wid * 1024u;
    const int aoff = lds_byte(wr * 64 + fr, fq * 8), boff = lds_byte(wc * 32 + fr, fq * 8);
#define PG8_SA(b, h) (((b) * 2 + (h)) * HTB)
#define PG8_SB(b, h) ((4 + (b) * 2 + (h)) * HTB)
#define PG8_STAGE(bufoff, gbase, voff) do { _Pragma("unroll") for (int _i = 0; _i < 2; ++_i) \
        __builtin_amdgcn_global_load_lds((const unsigned*)((const char*)(gbase) + (voff)[_i]), (PG8_LAS unsigned*)(lds + (bufoff) + ldsw + _i * 8192), 16, 0, 0); } while (0)
#define PG8_LDA(dst, b, h) do { _Pragma("unroll") for (int m = 0; m < 4; ++m) _Pragma("unroll") for (int k = 0; k < 2; ++k) dst[m][k] = *(const PG8_LAS bf16x8*)(lds + PG8_SA(b, h) + aoff + m * 2048 + k * 1024); } while (0)
#define PG8_LDB(dst, b, h) do { _Pragma("unroll") for (int n = 0; n < 2; ++n) _Pragma("unroll") for (int k = 0; k < 2; ++k) dst[n][k] = *(const PG8_LAS bf16x8*)(lds + PG8_SB(b, h) + boff + n * 2048 + k * 1024); } while (0)
#define PG8_MMA(ai, bj, At, Bt) do { __builtin_amdgcn_s_setprio(1); _Pragma("unroll") for (int m = 0; m < 4; ++m) _Pragma("unroll") for (int n = 0; n < 2; ++n) _Pragma("unroll") for (int k = 0; k < 2; ++k) \
        acc[ai][bj][m][n] = __builtin_amdgcn_mfma_f32_16x16x32_bf16(Bt[n][k], At[m][k], acc[ai][bj][m][n], 0, 0, 0); __builtin_amdgcn_s_setprio(0); } while (0)
#define PG8_WAIT_V(n) asm volatile("s_waitcnt vmcnt(" #n ")" ::: "memory")
#define PG8_WAIT_L(n) asm volatile("s_waitcnt lgkmcnt(" #n ")" ::: "memory")
#define PG8_BAR __builtin_amdgcn_s_barrier()
#define PG8_SCHED __builtin_amdgcn_sched_barrier(0)
#define PG8_GOFF(dst, U) do { if constexpr (Sched::GATHER) { _Pragma("unroll") for (int _h = 0; _h < 2; ++_h) _Pragma("unroll") for (int _i = 0; _i < 2; ++_i) \
        dst[_h][_i] = (unsigned)(S.token(U, _h * HALF + RA[_i]) * K + CA[_i]) * 2u; } } while (0)
    Unit cur, nxt; int ui = 0;
    if (!S.next(0, cur)) return;
    f32x4 acc[2][2][4][2];
#pragma unroll
    for (int a = 0; a < 2; ++a)
#pragma unroll
        for (int b = 0; b < 2; ++b)
#pragma unroll
            for (int m = 0; m < 4; ++m)
#pragma unroll
                for (int n = 0; n < 2; ++n) acc[a][b][m][n] = (f32x4){0.f, 0.f, 0.f, 0.f};
    bf16x8 At[4][2], B0[2][2], B1[2][2];
    PG8_GOFF(voffA, cur);
    const char* cA = (const char*)g.A + (Sched::GATHER ? (size_t)0 : cur.aoff); const char* cB = (const char*)g.Bt + cur.boff;
    PG8_STAGE(PG8_SB(0, 0), cB, voffB); PG8_STAGE(PG8_SA(0, 0), cA, voffA[0]); PG8_STAGE(PG8_SB(0, 1), cB + hstep, voffB); PG8_STAGE(PG8_SA(0, 1), cA, voffA[1]);
    if (wr == 1) PG8_BAR;
    PG8_WAIT_V(4); PG8_BAR;
    PG8_STAGE(PG8_SB(1, 0), cB + kstep, voffB); PG8_STAGE(PG8_SA(1, 0), cA + kstep, voffA[0]); PG8_STAGE(PG8_SB(1, 1), cB + hstep + kstep, voffB);
    PG8_WAIT_V(6); PG8_BAR;
    for (;;) {
        const bool has_next = S.next(ui + 1, nxt);
        if (has_next) { PG8_GOFF(voffAn, nxt); if constexpr (Sched::GATHER) { asm volatile("" : "+v"(voffAn[0][0]), "+v"(voffAn[0][1]), "+v"(voffAn[1][0]), "+v"(voffAn[1][1])); } }
        const char* nA = has_next ? (const char*)g.A + (Sched::GATHER ? (size_t)0 : nxt.aoff) : cA; const char* nB = has_next ? (const char*)g.Bt + nxt.boff : cB;
        for (int t = 0; t < nt; t += 2) {
            const bool last = (t == nt - 2);
            const char* a1 = cA + (size_t)(t + 1) * kstep;
            const char* a2 = last ? nA : cA + (size_t)(t + 2) * kstep; const char* b2 = last ? nB : cB + (size_t)(t + 2) * kstep;
            const char* a3 = a2 + kstep; const char* b3 = b2 + kstep;
            unsigned va2[2][2];
#pragma unroll
            for (int h = 0; h < 2; ++h)
#pragma unroll
                for (int i = 0; i < 2; ++i) va2[h][i] = (Sched::GATHER && last && has_next) ? voffAn[h][i] : voffA[h][i];
            PG8_LDB(B0, 0, 0); PG8_SCHED; PG8_LDA(At, 0, 0); PG8_STAGE(PG8_SA(1, 1), a1, voffA[1]);
            PG8_WAIT_L(8); PG8_BAR; PG8_WAIT_L(0); PG8_MMA(0, 0, At, B0); PG8_BAR; PG8_SCHED;
            PG8_LDB(B1, 0, 1); PG8_STAGE(PG8_SB(0, 0), b2, voffB);
            PG8_BAR; PG8_WAIT_L(0); PG8_MMA(0, 1, At, B1); PG8_BAR;
            PG8_LDA(At, 0, 1); PG8_STAGE(PG8_SA(0, 0), a2, va2[0]);
            PG8_BAR; PG8_WAIT_L(0); PG8_MMA(1, 0, At, B0); PG8_BAR; PG8_SCHED;
            PG8_STAGE(PG8_SB(0, 1), b2 + hstep, voffB);
            PG8_WAIT_V(6); PG8_BAR; PG8_MMA(1, 1, At, B1); PG8_BAR;
            PG8_LDB(B0, 1, 0); PG8_SCHED; PG8_LDA(At, 1, 0); PG8_STAGE(PG8_SA(0, 1), a2, va2[1]);
            PG8_WAIT_L(8); PG8_BAR; PG8_WAIT_L(0); PG8_MMA(0, 0, At, B0); PG8_BAR; PG8_SCHED;
            PG8_LDB(B1, 1, 1); PG8_STAGE(PG8_SB(1, 0), b3, voffB);
            PG8_BAR; PG8_WAIT_L(0); PG8_MMA(0, 1, At, B1); PG8_BAR;
            PG8_LDA(At, 1, 1); PG8_STAGE(PG8_SA(1, 0), a3, va2[0]);
            PG8_BAR; PG8_WAIT_L(0); PG8_MMA(1, 0, At, B0); PG8_BAR; PG8_SCHED;
            PG8_STAGE(PG8_SB(1, 1), b3 + hstep, voffB);
            PG8_WAIT_V(6); PG8_BAR; PG8_MMA(1, 1, At, B1); PG8_BAR;
        }
        E(acc, cur, wr, wc, fr, fq);
        if (!has_next) break;
#pragma unroll
        for (int a = 0; a < 2; ++a)
#pragma unroll
            for (int b = 0; b < 2; ++b)
#pragma unroll
                for (int m = 0; m < 4; ++m)
#pragma unroll
                    for (int n = 0; n < 2; ++n) acc[a][b][m][n] = (f32x4){0.f, 0.f, 0.f, 0.f};
        cur = nxt; cA = nA; cB = nB; ++ui;
        if constexpr (Sched::GATHER) {
#pragma unroll
            for (int h = 0; h < 2; ++h)
#pragma unroll
                for (int i = 0; i < 2; ++i) voffA[h][i] = voffAn[h][i];
        }
    }
    PG8_WAIT_V(0);
    if (wr == 0) PG8_BAR;
    PG8_BAR;
#undef PG8_SA
#undef PG8_SB
#undef PG8_STAGE
#undef PG8_LDA
#undef PG8_LDB
#undef PG8_MMA
#undef PG8_WAIT_V
#undef PG8_WAIT_L
#undef PG8_BAR
#undef PG8_SCHED
#undef PG8_GOFF
}
}
namespace att {
using bf16x8 = __attribute__((ext_vector_type(8))) short;
using s16x4  = __attribute__((ext_vector_type(4))) short;
using f32x16 = __attribute__((ext_vector_type(16))) float;
using u32x4  = __attribute__((ext_vector_type(4))) unsigned;
typedef unsigned short bf16_t;
constexpr int NW = 8, QBLK = 32, KVBLK = 64;
constexpr float THR = 8.f;
constexpr size_t SHM_V = KVBLK * 128 * 2, SHM_K = KVBLK * 128 * 2, SHM_ATTN = 2 * SHM_V + 2 * SHM_K + NW * 64 * 4;
#define KSWZ(row, colB) ((row) * 256 + ((colB) ^ (((row) & 7) << 4)))
#define KSWZ64(row, colB) ((row) * 128 + ((colB) ^ ((((row) >> 1) & 7) << 4)))
#define SBAR() __builtin_amdgcn_sched_barrier(0)
__device__ __forceinline__ int crow(int r, int hi) { return (r & 3) + 8 * (r >> 2) + 4 * hi; }
__device__ __forceinline__ unsigned cvtpk(float lo, float hi) { unsigned r; asm volatile("v_cvt_pk_bf16_f32 %0, %1, %2" : "=v"(r) : "v"(lo), "v"(hi)); return r; }

template <int DQK> struct Sc { static constexpr float SCALE = (DQK == 64) ? 0.125f : 0.088388347648318440f; };

template <int DQK>
__device__ __forceinline__ void partialSM(f32x16& p0, f32x16& p1, float& m_reg, float& mn, float& alpha) {
  constexpr float SCALE = Sc<DQK>::SCALE;
  constexpr float C = SCALE * 1.4426950408889634f;
  float pmax = p0[0];
#pragma unroll
  for (int r = 1; r < 16; ++r) pmax = fmaxf(pmax, p0[r]);
#pragma unroll
  for (int r = 0; r < 16; ++r) pmax = fmaxf(pmax, p1[r]);
  { auto rr = __builtin_amdgcn_permlane32_swap(__float_as_uint(pmax), __float_as_uint(pmax), false, false);
    pmax = fmaxf(__uint_as_float(rr[0]), __uint_as_float(rr[1])); }
  if (__builtin_expect(__all(pmax - m_reg <= THR / SCALE), 1)) { mn = m_reg; alpha = 1.f; }
  else { mn = fmaxf(m_reg, pmax); alpha = __builtin_amdgcn_exp2f((m_reg - mn) * C); m_reg = mn; }
  float mnC = -mn * C;
#pragma unroll
  for (int r = 0; r < 16; ++r) p0[r] = fmaf(p0[r], C, mnC);
#pragma unroll
  for (int r = 0; r < 16; ++r) p1[r] = fmaf(p1[r], C, mnC);
#pragma unroll
  for (int r = 0; r < 16; ++r) p0[r] = __builtin_amdgcn_exp2f(p0[r]);
}
__device__ __forceinline__ void finishSM(f32x16& p0, f32x16& p1, float alpha, float& l_reg, bf16x8& pa0, bf16x8& pa1, bf16x8& pa2, bf16x8& pa3) {
#pragma unroll
  for (int r = 0; r < 16; ++r) p1[r] = __builtin_amdgcn_exp2f(p1[r]);
  float ps = 0;
#pragma unroll
  for (int r = 0; r < 16; ++r) ps += p0[r];
#pragma unroll
  for (int r = 0; r < 16; ++r) ps += p1[r];
  { auto rr = __builtin_amdgcn_permlane32_swap(__float_as_uint(ps), __float_as_uint(ps), false, false);
    ps = __uint_as_float(rr[0]) + __uint_as_float(rr[1]); }
  l_reg = l_reg * alpha + ps;
#define PK4(P, BASE, OUT) do { unsigned a0 = cvtpk(P[BASE + 0], P[BASE + 1]), a1 = cvtpk(P[BASE + 2], P[BASE + 3]);   \
    unsigned b0 = cvtpk(P[BASE + 4], P[BASE + 5]), b1 = cvtpk(P[BASE + 6], P[BASE + 7]);                              \
    auto r0 = __builtin_amdgcn_permlane32_swap(a0, b0, false, false); auto r1 = __builtin_amdgcn_permlane32_swap(a1, b1, false, false); \
    u32x4 w = {r0[0], r1[0], r0[1], r1[1]}; OUT = *reinterpret_cast<bf16x8*>(&w); } while (0)
  PK4(p0, 0, pa0); PK4(p0, 8, pa1); PK4(p1, 0, pa2); PK4(p1, 8, pa3);
#undef PK4
}
template <int DQK>
__device__ __forceinline__ void qkt(f32x16& p0, f32x16& p1, const char* Ks, const bf16x8* qr, int r32, int hi) {
  p0 = f32x16{}; p1 = f32x16{};
#pragma unroll
  for (int d0 = 0; d0 < DQK / 16; ++d0) { const int cb = (d0 * 16 + hi * 8) * 2;
    bf16x8 b0, b1;
    if constexpr (DQK == 128) { b0 = *reinterpret_cast<const bf16x8*>(Ks + KSWZ(r32, cb)); b1 = *reinterpret_cast<const bf16x8*>(Ks + KSWZ(32 + r32, cb)); }
    else { b0 = *reinterpret_cast<const bf16x8*>(Ks + KSWZ64(r32, cb)); b1 = *reinterpret_cast<const bf16x8*>(Ks + KSWZ64(32 + r32, cb)); }
    p0 = __builtin_amdgcn_mfma_f32_32x32x16_bf16(b0, qr[d0], p0, 0, 0, 0);
    p1 = __builtin_amdgcn_mfma_f32_32x32x16_bf16(b1, qr[d0], p1, 0, 0, 0); }
}
__device__ __forceinline__ int v_st(int k, int c) { const int kk = (k & ~0xC) | ((k & 4) << 1) | ((k & 8) >> 1); return ((kk >> 3) * 4 + (c >> 5)) * 512 + ((kk & 7) * 32 + (c & 31)) * 2; }
__device__ __forceinline__ int v_rd_base(int lane) { return ((lane & 3) << 3) | (((lane >> 2) & 3) << 6) | (((lane >> 4) & 1) << 5) | (((lane >> 5) & 1) << 8); }
constexpr int v_rd_off(int d0, int ks, int half) { return d0 * 512 + ks * 4096 + half * 2048; }
template <int OFF> __device__ __forceinline__ s16x4 tr_read(int vb) {
  s16x4 r; asm volatile("ds_read_b64_tr_b16 %0, %1 offset:%2" : "=&v"(r) : "v"(vb), "i"(OFF) : "memory"); return r;
}
template <int D0> __device__ __forceinline__ void pv_one(f32x16& od, int vb, bf16x8 pa0, bf16x8 pa1, bf16x8 pa2, bf16x8 pa3) {
  const s16x4 l0 = tr_read<v_rd_off(D0, 0, 0)>(vb), h0 = tr_read<v_rd_off(D0, 0, 1)>(vb), l1 = tr_read<v_rd_off(D0, 1, 0)>(vb), h1 = tr_read<v_rd_off(D0, 1, 1)>(vb);
  const s16x4 l2 = tr_read<v_rd_off(D0, 2, 0)>(vb), h2 = tr_read<v_rd_off(D0, 2, 1)>(vb), l3 = tr_read<v_rd_off(D0, 3, 0)>(vb), h3 = tr_read<v_rd_off(D0, 3, 1)>(vb);
  asm volatile("s_waitcnt lgkmcnt(0)" ::: "memory"); SBAR();
#define PK(L, H) (bf16x8){L[0], L[1], L[2], L[3], H[0], H[1], H[2], H[3]}
  od = __builtin_amdgcn_mfma_f32_32x32x16_bf16(pa0, PK(l0, h0), od, 0, 0, 0);
  od = __builtin_amdgcn_mfma_f32_32x32x16_bf16(pa1, PK(l1, h1), od, 0, 0, 0);
  od = __builtin_amdgcn_mfma_f32_32x32x16_bf16(pa2, PK(l2, h2), od, 0, 0, 0);
  od = __builtin_amdgcn_mfma_f32_32x32x16_bf16(pa3, PK(l3, h3), od, 0, 0, 0);
#undef PK
}
__device__ __forceinline__ void pv_d0(f32x16* o, int vb, bf16x8 pa0, bf16x8 pa1, bf16x8 pa2, bf16x8 pa3) {
  pv_one<0>(o[0], vb, pa0, pa1, pa2, pa3); pv_one<1>(o[1], vb, pa0, pa1, pa2, pa3); pv_one<2>(o[2], vb, pa0, pa1, pa2, pa3); pv_one<3>(o[3], vb, pa0, pa1, pa2, pa3);
}

template <int DQK, int LDQ, int LDK, int LDO>
__device__ __forceinline__ void attn_body(const bf16_t* __restrict__ Qb, const bf16_t* __restrict__ Kh, const bf16_t* __restrict__ Vh, bf16_t* __restrict__ Ob, int seq, char* lds, int wave_id) {
  int tid = (wave_id << 6) | (int)__builtin_amdgcn_mbcnt_hi(~0u, __builtin_amdgcn_mbcnt_lo(~0u, 0u)); asm volatile("" : "+v"(tid));
  const int wid = tid >> 6, lane = tid & 63, r32 = lane & 31, hi = lane >> 5;
  char* V_lds = lds; char* K_lds = lds + 2 * SHM_V;
  float* ws = (float*)(lds + 2 * SHM_V + 2 * SHM_K) + wid * 64; float* li_l = ws; float* al_l = ws + 32;
  float m_reg = -1e30f, l_reg = 0; f32x16 o[4] = {}; bf16x8 qr[DQK / 16];
  const bf16_t* Qw = Qb + (long)(wid * QBLK + r32) * LDQ + hi * 8;
#pragma unroll
  for (int d0 = 0; d0 < DQK / 16; ++d0) qr[d0] = *reinterpret_cast<const bf16x8*>(Qw + d0 * 16);
  const int sr = tid >> 4, sc = (tid & 15) * 8, vst0 = v_st(sr, sc), vst1 = v_st(32 + sr, sc);
  const int kr64 = tid >> 3, kc64 = (tid & 7) * 8;
  const int vb0 = (int)(uintptr_t)V_lds + v_rd_base(lane);
  struct { bf16x8 vs0, vs1, ks0, ks1; } sr_[2];
#define SLOAD(i, k0) do { sr_[i].vs0 = *reinterpret_cast<const bf16x8*>(&Vh[(long)((k0) + sr) * LDK + sc]); sr_[i].vs1 = *reinterpret_cast<const bf16x8*>(&Vh[(long)((k0) + 32 + sr) * LDK + sc]); \
    if constexpr (DQK == 128) { sr_[i].ks0 = *reinterpret_cast<const bf16x8*>(&Kh[(long)((k0) + sr) * LDK + sc]); sr_[i].ks1 = *reinterpret_cast<const bf16x8*>(&Kh[(long)((k0) + 32 + sr) * LDK + sc]); } \
    else { sr_[i].ks0 = *reinterpret_cast<const bf16x8*>(&Kh[(long)((k0) + kr64) * LDK + kc64]); } } while (0)
#define SWRITE(b, i) do { *(bf16x8*)(V_lds + (b) * SHM_V + vst0) = sr_[i].vs0;          \
    *(bf16x8*)(V_lds + (b) * SHM_V + vst1) = sr_[i].vs1;               \
    if constexpr (DQK == 128) { const int kc = sc * 2; *(bf16x8*)(K_lds + (b) * SHM_K + KSWZ(sr, kc)) = sr_[i].ks0; *(bf16x8*)(K_lds + (b) * SHM_K + KSWZ(32 + sr, kc)) = sr_[i].ks1; } \
    else { const int kc = kc64 * 2; *(bf16x8*)(K_lds + (b) * SHM_K + KSWZ64(kr64, kc)) = sr_[i].ks0; } } while (0)
#define SWAIT() do { if constexpr (DQK == 128) asm volatile("s_waitcnt vmcnt(4)" ::: "memory"); else asm volatile("s_waitcnt vmcnt(3)" ::: "memory"); } while (0)
#define RESC(a) do { if (__any((a) < 1.f)) { if (hi == 0) al_l[r32] = (a); asm volatile("s_waitcnt lgkmcnt(0)" ::: "memory"); \
    _Pragma("unroll") for (int d = 0; d < 4; ++d) _Pragma("unroll") for (int r = 0; r < 16; ++r) o[d][r] *= al_l[crow(r, hi)]; } } while (0)
  f32x16 pA0, pA1, pB0, pB1; float mnA, mnB, alA, alB; bf16x8 pa0, pa1, pa2, pa3; const int NT = seq / KVBLK;
  constexpr int SE = 0, SO = 1;
  SLOAD(SE, 0); asm volatile("s_waitcnt vmcnt(0)" ::: "memory"); SWRITE(0, SE); __syncthreads();
  qkt<DQK>(pA0, pA1, K_lds, qr, r32, hi); partialSM<DQK>(pA0, pA1, m_reg, mnA, alA);
  SLOAD(SO, KVBLK); if (2 < NT) SLOAD(SE, 2 * KVBLK);
  if (2 < NT) { SWAIT(); } else { asm volatile("s_waitcnt vmcnt(0)" ::: "memory"); }
  SWRITE(1, SO); __syncthreads();
  for (int j = 1; j + 1 < NT; j += 2) {
    SBAR(); qkt<DQK>(pB0, pB1, K_lds + SHM_K, qr, r32, hi);
    finishSM(pA0, pA1, alA, l_reg, pa0, pa1, pa2, pa3); SBAR();
    SLOAD(SO, (j + 2) * KVBLK); SBAR();
    pv_d0(o, vb0, pa0, pa1, pa2, pa3); partialSM<DQK>(pB0, pB1, m_reg, mnB, alB);
    __syncthreads(); SWAIT(); SWRITE(0, SE);
    RESC(alB); __syncthreads();
    SBAR(); qkt<DQK>(pA0, pA1, K_lds, qr, r32, hi);
    finishSM(pB0, pB1, alB, l_reg, pa0, pa1, pa2, pa3); SBAR();
    if (j + 3 < NT) SLOAD(SE, (j + 3) * KVBLK); SBAR();
    pv_d0(o, vb0 + (int)SHM_V, pa0, pa1, pa2, pa3); partialSM<DQK>(pA0, pA1, m_reg, mnA, alA);
    __syncthreads(); if (j + 3 < NT) { SWAIT(); } else { asm volatile("s_waitcnt vmcnt(0)" ::: "memory"); } SWRITE(1, SO);
    RESC(alA); __syncthreads();
  }
  SBAR(); qkt<DQK>(pB0, pB1, K_lds + SHM_K, qr, r32, hi);
  finishSM(pA0, pA1, alA, l_reg, pa0, pa1, pa2, pa3); SBAR();
  pv_d0(o, vb0, pa0, pa1, pa2, pa3); partialSM<DQK>(pB0, pB1, m_reg, mnB, alB);
  __syncthreads(); RESC(alB);
  finishSM(pB0, pB1, alB, l_reg, pa0, pa1, pa2, pa3); SBAR();
  pv_d0(o, vb0 + (int)SHM_V, pa0, pa1, pa2, pa3);
  if (hi == 0) li_l[r32] = l_reg; asm volatile("s_waitcnt lgkmcnt(0)" ::: "memory");
  float rli[16];
#pragma unroll
  for (int r = 0; r < 16; ++r) rli[r] = __builtin_amdgcn_rcpf(li_l[crow(r, hi)]);
  bf16_t* Ow = Ob + (long)(wid * QBLK) * LDO;
#pragma unroll
  for (int r = 0; r < 16; ++r) { const int orow = crow(r, hi);
#pragma unroll
    for (int d0 = 0; d0 < 4; ++d0) { const float v = o[d0][r] * rli[r]; Ow[(long)orow * LDO + d0 * 32 + r32] = (bf16_t)(cvtpk(v, v) & 0xffffu); } }
  __syncthreads();
#undef SLOAD
#undef SWRITE
#undef SWAIT
#undef RESC
}
#undef SBAR
}
constexpr int NWAVES = 8, NTHR = 512;
constexpr int NB = 8, SEQ = 2048, CTXL = 256, TPB = CTXL + SEQ  , MROWS = NB * TPB  , DM = 1024;
constexpr int A_W = 512, A_IN = 1920, B_IN = 1536, EVEN_IN = 3456, EVEN_PAD = 3584, ODD_IN = 1536;
constexpr int NEXP = 16, EFF = 512, CAP = MROWS, MOE_ROWS = 40960;
constexpr float LN_EPS = 1e-5f, ALPHA = 1.4142135623730951f, GN_EPS = 64e-5f, SUBLN_EPS = 1e-5f, QKN_EPS = 1e-6f, LAMBDA_INIT0 = 0.2f;

constexpr size_t MiB = 1u << 20;
constexpr size_t WS_CTL = 0, CTL_ZERO_BYTES = 1 * MiB;
constexpr size_t WS_MOD = 1 * MiB;
constexpr size_t WS_ROPE = 2 * MiB;
constexpr size_t WS_WEVIN = 4 * MiB, WS_WEVOUT = 11 * MiB, WS_WODIN = 13 * MiB, WS_WODOUT = 16 * MiB;
constexpr size_t WS_WM13 = 18 * MiB, WS_WM2 = 50 * MiB;
constexpr size_t WS_H = 66 * MiB;
constexpr size_t WS_X = 102 * MiB;
constexpr size_t CH_BYTES = (size_t)4608 * 64 * 64 * 2;
constexpr size_t WS_CHG = 18 * MiB, WS_CHH = 54 * MiB, WS_CHRQ = 90 * MiB, WS_CHY = 126 * MiB;
constexpr size_t FEAT_BYTES = (size_t)MROWS * 512 * 2;
constexpr size_t WS_VOUT = 162 * MiB, WS_GOUT = 180 * MiB;
constexpr size_t WS_PA = 198 * MiB;
constexpr size_t WS_PB = 270 * MiB;
constexpr size_t WS_GL = 324 * MiB;
constexpr size_t WS_BON = WS_GL + (size_t)4608 * 64 * 4;
constexpr size_t WS_LORA = WS_BON + (size_t)2 * MROWS * 8 * 4;
constexpr size_t WS_OB0 = WS_PA, WS_OB1 = WS_PA + FEAT_BYTES;
constexpr size_t WS_A2 = WS_PA + 2 * FEAT_BYTES;
constexpr size_t WS_TAIL = 300 * MiB;
constexpr size_t WS_MIX = WS_TAIL;
constexpr size_t WS_HID = 174 * MiB;
constexpr size_t WS_Y = 214 * MiB;
constexpr size_t WS_QKV1 = 174 * MiB;
constexpr size_t WS_OATT = 228 * MiB;
static_assert(WS_CHY + CH_BYTES <= WS_VOUT && WS_GOUT + FEAT_BYTES <= WS_PA && WS_A2 + 2 * FEAT_BYTES <= WS_PB && WS_PB + (size_t)MROWS * 1536 * 2 <= WS_GL && WS_LORA + 393216 <= 328 * MiB
              && WS_Y + (size_t)MOE_ROWS * 1024 * 2 <= WS_TAIL && WS_OATT + 2 * FEAT_BYTES <= WS_TAIL && WS_MIX + 2 * FEAT_BYTES <= 336 * MiB && WS_A2 >= WS_HID + 40 * MiB - 40 * MiB, "ws map");
constexpr int CW_BAR = 4096;
constexpr int CW_CNT = 16384;
constexpr size_t WS_ROUTE = 336 * MiB;
constexpr size_t WS_PERM_ = WS_ROUTE, WS_GATE = WS_ROUTE + (size_t)NEXP * CAP * 4, WS_TOK = WS_GATE + (size_t)NEXP * CAP * 4, WS_TOTAL = WS_TOK + (size_t)MROWS * 2 * 4;
static_assert(WS_TOTAL <= 339 * MiB, "ws total");

constexpr int RING_OFF = 0, RING_BYTES = 131072;
constexpr int LDSCTL_OFF = RING_BYTES, MISC_OFF = LDSCTL_OFF + 320;
constexpr int MOETAB_OFF = LDSCTL_OFF + 1024;
constexpr int LDS_BYTES = 147456;

#define GAS __attribute__((address_space(1)))
#define LAS __attribute__((address_space(3)))
typedef unsigned short bf16;
typedef unsigned v4u __attribute__((ext_vector_type(4)));
typedef unsigned v2u __attribute__((ext_vector_type(2)));
typedef float f32x4 __attribute__((ext_vector_type(4)));
typedef short bf16x8 __attribute__((ext_vector_type(8)));
typedef GAS unsigned gu32;
#define RLX_AGENT __ATOMIC_RELAXED, __HIP_MEMORY_SCOPE_AGENT
#define LDS_WAIT() asm volatile("s_waitcnt lgkmcnt(0)" ::: "memory")
#define VM_WAIT() asm volatile("s_waitcnt vmcnt(0)" ::: "memory")
__device__ __forceinline__ unsigned f2bf(float f) { unsigned u = __builtin_bit_cast(unsigned, f); return (u + 0x7fffu + ((u >> 16) & 1u)) >> 16; }
__device__ __forceinline__ unsigned pk2(float lo, float hi) { return f2bf(lo) | (f2bf(hi) << 16); }
__device__ __forceinline__ float bf2f(unsigned short b) { return __builtin_bit_cast(float, (unsigned)b << 16); }
__device__ __forceinline__ float bflo(unsigned w) { return __builtin_bit_cast(float, w << 16); }
__device__ __forceinline__ float bfhi(unsigned w) { return __builtin_bit_cast(float, w & 0xffff0000u); }
__device__ __forceinline__ float sigmoidf_(float x) { return 1.f / (1.f + __expf(-x)); }
__device__ __forceinline__ float wave_sum(float v) {
#pragma unroll
    for (int o = 1; o < 64; o <<= 1) v += __shfl_xor(v, o);
    return v;
}

#define XB_TMO      128
#define XB_XCNT(j)  (256  + 64 * (j))
#define XB_XSUB(j)  (1280 + 64 * (j))
#define XB_XGEN(j)  (2304 + 64 * (j))
#define XB_TOP      3328
#define XB_TOPGEN   3392
#define XCD_BAR_WORDS 3456
#define XB_SPIN_CAP (1u << 22)
__device__ __forceinline__ unsigned xb_ld(unsigned* p)              { return __hip_atomic_load(p, __ATOMIC_RELAXED, __HIP_MEMORY_SCOPE_AGENT); }
__device__ __forceinline__ unsigned xb_add(unsigned* p, unsigned v) { return __hip_atomic_fetch_add(p, v, __ATOMIC_RELAXED, __HIP_MEMORY_SCOPE_AGENT); }
__device__ __forceinline__ unsigned xb_xcc_id() { return (unsigned)__builtin_amdgcn_s_getreg((3 << 11) | 20) & 0xFu; }
#define XB_SPIN(cond, bar) do { unsigned _sp = 0; while (cond) { __builtin_amdgcn_s_sleep(1); \
    if ((++_sp & 255u) == 0u) { if (xb_ld(&(bar)[XB_TMO])) break; if (_sp > XB_SPIN_CAP) { atomicAdd(&(bar)[XB_TMO], 1u); break; } } } } while (0)
struct XcdBarrier { unsigned* bar; unsigned x; volatile LAS unsigned* st; };
__device__ __forceinline__ XcdBarrier xcd_barrier_post(unsigned* bar, volatile LAS unsigned* st) {
    XcdBarrier b; b.bar = bar; b.x = xb_xcc_id(); b.st = st;
    if (threadIdx.x == 0) (void)xb_add(&bar[XB_XCNT(b.x)], 1u);
    return b;
}
__device__ __forceinline__ void xcd_barrier_complete(unsigned* bar, unsigned x, unsigned& nloc, unsigned& nx) {
    const unsigned G = gridDim.x * gridDim.y * gridDim.z;
    unsigned sum, cnt, mine, sp = 0u;
    for (;;) {
        sum = 0u; cnt = 0u; mine = 0u;
#pragma unroll
        for (unsigned j = 0; j < 16; ++j) { const unsigned c = xb_ld(&bar[XB_XCNT(j)]); sum += c; cnt += (c > 0u) ? 1u : 0u; mine = (j == x) ? c : mine; }
        if (sum == G) break;
        __builtin_amdgcn_s_sleep(1);
        if ((++sp & 255u) == 0u) { if (xb_ld(&bar[XB_TMO])) break; if (sp > XB_SPIN_CAP) { atomicAdd(&bar[XB_TMO], 1u); break; } }
    }
    nloc = mine > 0u ? mine : 1u; nx = cnt > 0u ? cnt : 1u;
}
__device__ __forceinline__ void xcd_barrier(const XcdBarrier& b) {
    asm volatile("s_waitcnt vmcnt(0)" ::: "memory");
    __syncthreads();
    if (threadIdx.x == 0) {
        unsigned* bar = b.bar;
        __builtin_amdgcn_s_waitcnt(0);
        unsigned nloc = b.st[0], nx = b.st[1];
        if (nloc == 0u) { xcd_barrier_complete(bar, b.x, nloc, nx); b.st[0] = nloc; b.st[1] = nx; }
        const unsigned old = xb_add(&bar[XB_XSUB(b.x)], 1u);
        const unsigned gen = old / nloc;
        if (old + 1u == (gen + 1u) * nloc) {
            __builtin_amdgcn_fence(__ATOMIC_RELEASE, "agent");
            asm volatile("s_waitcnt vmcnt(0)" ::: "memory");
            const unsigned og = xb_add(&bar[XB_TOP], 1u);
            const unsigned tg = og / nx;
            if (og + 1u == (tg + 1u) * nx) xb_add(&bar[XB_TOPGEN], 1u);
            else XB_SPIN(xb_ld(&bar[XB_TOPGEN]) == tg, bar);
            __builtin_amdgcn_fence(__ATOMIC_ACQUIRE, "agent");
            xb_add(&bar[XB_XGEN(b.x)], 1u);
            asm volatile("s_waitcnt vmcnt(0)" ::: "memory");
        } else {
            XB_SPIN(xb_ld(&bar[XB_XGEN(b.x)]) == gen, bar);
            __builtin_amdgcn_fence(__ATOMIC_ACQUIRE, "agent");
            asm volatile("s_waitcnt vmcnt(0)" ::: "memory");
        }
    }
    __syncthreads();
}

struct Args { const float* in[34]; float* out; unsigned char* ws; };
struct Frame {
    LAS unsigned char* lds; char* ldsg;
    int tid, lane, wave, G, bid;
    const float* const* in; float* out; unsigned char* ws;
};
enum { I_X = 0, I_C, I_CTX, I_CCTX, I_RW, I_RB, I_ADAW, I_ADAB, I_LN1G, I_LN1B, I_LN2G, I_LN2B, I_W1, I_W3, I_W2, I_EVWIN, I_EVWOUT, I_AMU, I_AW0, I_AW2, I_AA0, I_AA2,
       I_AG2, I_AKK, I_AKA, I_ARK, I_LNXG, I_LNXB, I_BLAM, I_SUBG, I_ODWIN, I_ODWOUT, I_QNG, I_KNG };

__device__ __forceinline__ const float* x0_row(const Frame& F, int row) {
    const int b = row / TPB, tt = row - b * TPB;
    return tt < CTXL ? F.in[I_CTX] + ((size_t)b * CTXL + tt) * DM : F.in[I_X] + ((size_t)b * SEQ + (tt - CTXL)) * DM;
}
__device__ __forceinline__ const float* mod_ptr(const Frame& F, int layer, int row, int idx) {
    const int b = row / TPB, tt = row - b * TPB; const int r = tt < CTXL ? 8 : b;
    return (const float*)(F.ws + WS_MOD) + ((size_t)(layer * 9 + r) * 6 + idx) * DM;
}
__device__ __forceinline__ void transpose_item(const float* W, int K, int N, bf16* WT, int mode, LAS float* scr, int item, int lane) {
    const int nblk = N / 32, kb = item / nblk, nb = item % nblk, k0 = 64 * kb, n0 = 32 * nb;
#pragma unroll 8
    for (int i = 0; i < 32; ++i) { const int kk = 2 * i + (lane >> 5); scr[kk * 33 + (lane & 31)] = W[(size_t)(k0 + kk) * N + n0 + (lane & 31)]; }
    LDS_WAIT(); asm volatile("" ::: "memory");
    const int c = lane & 7;
#pragma unroll
    for (int j = 0; j < 4; ++j) { const int n = (lane >> 3) + 8 * j; const LAS float* s = scr + (8 * c) * 33 + n;
        v4u o; o.x = pk2(s[0 * 33], s[1 * 33]); o.y = pk2(s[2 * 33], s[3 * 33]); o.z = pk2(s[4 * 33], s[5 * 33]); o.w = pk2(s[6 * 33], s[7 * 33]);
        const int ng = n0 + n; const int nd = mode == 0 ? ng : (8 * (ng >> 2) + 4 * (mode - 1) + (ng & 3));
        *(GAS v4u*)(WT + (size_t)nd * K + k0 + 8 * c) = o; }
    LDS_WAIT(); asm volatile("" ::: "memory");
}
__device__ __forceinline__ void convert_moe_weights(Frame& F, int layer) {
    LAS float* scr = (LAS float*)(F.lds + RING_OFF + F.wave * 16384);
    const int gw = F.bid * NWAVES + F.wave, NGW = F.G * NWAVES;
    constexpr int I13 = (DM / 64) * (EFF / 32)  , I2 = (EFF / 64) * (DM / 32)  ;
    bf16* W13 = (bf16*)(F.ws + WS_WM13); bf16* W2 = (bf16*)(F.ws + WS_WM2);
    for (int it = gw; it < NEXP * (2 * I13 + I2); it += NGW) {
        const int e = it / (2 * I13 + I2); int r = it % (2 * I13 + I2);
        const size_t wofs = ((size_t)layer * NEXP + e) * DM * EFF;
        if (r < I13) { transpose_item(F.in[I_W1] + wofs, DM, EFF, W13 + (size_t)e * 1024 * DM, 1, scr, r, F.lane); continue; } r -= I13;
        if (r < I13) { transpose_item(F.in[I_W3] + wofs, DM, EFF, W13 + (size_t)e * 1024 * DM, 2, scr, r, F.lane); continue; } r -= I13;
        transpose_item(F.in[I_W2] + wofs, EFF, DM, W2 + (size_t)e * DM * EFF, 0, scr, r, F.lane);
    }
}
__device__ __forceinline__ void p_prologue(Frame& F) {
    LAS float* scr = (LAS float*)(F.lds + RING_OFF + F.wave * 16384);
    const int gw = F.bid * NWAVES + F.wave, NGW = F.G * NWAVES;
    constexpr int I_A = (DM / 64) * (EVEN_IN / 32), I_B = (DM / 64) * (DM / 32), I_C_ = (DM / 64) * (ODD_IN / 32);
    for (int it = gw; it < I_A + 2 * I_B + I_C_; it += NGW) {
        int r = it;
        if (r < I_A) { transpose_item(F.in[I_EVWIN], DM, EVEN_IN, (bf16*)(F.ws + WS_WEVIN), 0, scr, r, F.lane); continue; } r -= I_A;
        if (r < I_B) { transpose_item(F.in[I_EVWOUT], DM, DM, (bf16*)(F.ws + WS_WEVOUT), 0, scr, r, F.lane); continue; } r -= I_B;
        if (r < I_C_) { transpose_item(F.in[I_ODWIN], DM, ODD_IN, (bf16*)(F.ws + WS_WODIN), 0, scr, r, F.lane); continue; } r -= I_C_;
        transpose_item(F.in[I_ODWOUT], DM, DM, (bf16*)(F.ws + WS_WODOUT), 0, scr, r, F.lane);
    }
    {
        v4u* z = (v4u*)((bf16*)(F.ws + WS_WEVIN) + (size_t)EVEN_IN * DM); const int n16 = (EVEN_PAD - EVEN_IN) * DM * 2 / 16;
        for (int i = F.bid * NTHR + F.tid; i < n16; i += F.G * NTHR) z[i] = (v4u){0u, 0u, 0u, 0u};
    }
    {
        bf16* W2T = (bf16*)(F.ws + WS_LORA); bf16* A2T = W2T + 2 * 512 * 64; bf16* G2T = A2T + 2 * 512 * 64;
        for (int i = F.bid * NTHR + F.tid; i < 3 * 65536; i += F.G * NTHR) {
            const int which = i >> 16, r = i & 65535;
            if (which < 2) { const int d = r >> 15, c = (r >> 6) & 511, l = r & 63; const float v = (which == 0 ? F.in[I_AW2] : F.in[I_AA2])[((size_t)d * 64 + l) * 512 + c]; (which == 0 ? W2T : A2T)[r] = (bf16)f2bf(v); }
            else { const int c = r >> 7, j = r & 127; G2T[r] = (bf16)f2bf(F.in[I_AG2][(size_t)j * 512 + c]); }
        }
    }
    {
        float* cosB = (float*)(F.ws + WS_ROPE); float* sinB = cosB + SEQ * 32; float* cosC = sinB + SEQ * 32; float* sinC = cosC + SEQ * 64;
        for (int i = F.bid * NTHR + F.tid; i < SEQ * 96; i += F.G * NTHR) {
            if (i < SEQ * 32) { const int t = i >> 5, j = i & 31; const float pos = (float)(j < 16 ? (t >> 6) : (t & 63)); const int f = j & 15;
                const float inv = powf(10000.f, -(float)(2 * f) / 32.f); const float ang = pos * inv; cosB[i] = cosf(ang); sinB[i] = sinf(ang); }
            else { const int ii = i - SEQ * 32; const int t = ii >> 6, j = ii & 63; const float pos = (float)(j < 32 ? (t >> 6) : (t & 63)); const int f = j & 31;
                const float inv = powf(10000.f, -(float)(2 * f) / 64.f); const float ang = pos * inv; cosC[ii] = cosf(ang); sinC[ii] = sinf(ang); }
        }
    }
    __syncthreads();
    if (F.bid < 192) {
        LAS float* sv = (LAS float*)(F.lds + RING_OFF);
        LAS float* red = sv + 9 * 1024;
        for (int i = F.tid; i < 9 * 1024; i += NTHR) { const int r = i >> 10, k = i & 1023; const float c = r < 8 ? F.in[I_C][r * DM + k] : F.in[I_CCTX][k]; sv[i] = c * sigmoidf_(c); }
        __syncthreads();
        for (int it = F.bid; it < 192; it += F.G) {
            const int l = it / 96, cb = it % 96, col = cb * 64 + F.lane;
            const float* w = F.in[I_ADAW] + (size_t)l * DM * 6144 + col;
            float acc[9];
#pragma unroll
            for (int r = 0; r < 9; ++r) acc[r] = 0.f;
            for (int k = F.wave * 128; k < F.wave * 128 + 128; ++k) { const float wv = w[(size_t)k * 6144];
#pragma unroll
                for (int r = 0; r < 9; ++r) acc[r] += sv[r * 1024 + k] * wv; }
#pragma unroll
            for (int r = 0; r < 9; ++r) red[(F.wave * 9 + r) * 64 + F.lane] = acc[r];
            __syncthreads();
            for (int i = F.tid; i < 9 * 64; i += NTHR) { const int r = i >> 6, c = i & 63; float s = 0.f;
#pragma unroll
                for (int w8 = 0; w8 < 8; ++w8) s += red[(w8 * 9 + r) * 64 + c];
                const int cc = cb * 64 + c;
                ((float*)(F.ws + WS_MOD))[(size_t)(l * 9 + r) * 6144 + cc] = s + F.in[I_ADAB][l * 6144 + cc]; }
            __syncthreads();
        }
    }
}

struct Row16 { f32x4 v[4]; };
__device__ __forceinline__ Row16 ld_row_f32(const float* p, int lane) { Row16 r; const f32x4* q = (const f32x4*)p + lane;
#pragma unroll
    for (int j = 0; j < 4; ++j) r.v[j] = q[64 * j]; return r; }
__device__ __forceinline__ Row16 ld_row_bf16(const bf16* p, int lane) { Row16 r; const v2u* q = (const v2u*)p + lane;
#pragma unroll
    for (int j = 0; j < 4; ++j) { const v2u w = q[64 * j]; r.v[j] = (f32x4){bflo(w.x), bfhi(w.x), bflo(w.y), bfhi(w.y)}; } return r; }
__device__ __forceinline__ void st_row_f32(float* p, int lane, const Row16& r) { f32x4* q = (f32x4*)p + lane;
#pragma unroll
    for (int j = 0; j < 4; ++j) q[64 * j] = r.v[j]; }
__device__ __forceinline__ void st_row_bf16(bf16* p, int lane, const Row16& r) { v2u* q = (v2u*)p + lane;
#pragma unroll
    for (int j = 0; j < 4; ++j) q[64 * j] = (v2u){pk2(r.v[j].x, r.v[j].y), pk2(r.v[j].z, r.v[j].w)}; }
__device__ __forceinline__ Row16 layer_norm(const Row16& x, const float* g, const float* b, int lane) {
    float s = 0.f;
#pragma unroll
    for (int j = 0; j < 4; ++j) s += (x.v[j].x + x.v[j].y) + (x.v[j].z + x.v[j].w);
    const float mean = wave_sum(s) * (1.f / DM); float s2 = 0.f; Row16 d;
#pragma unroll
    for (int j = 0; j < 4; ++j) { d.v[j] = x.v[j] - mean; s2 += (d.v[j].x * d.v[j].x + d.v[j].y * d.v[j].y) + (d.v[j].z * d.v[j].z + d.v[j].w * d.v[j].w); }
    const float rstd = 1.f / sqrtf(wave_sum(s2) * (1.f / DM) + LN_EPS);
    const Row16 gg = ld_row_f32(g, lane), bb = ld_row_f32(b, lane); Row16 o;
#pragma unroll
    for (int j = 0; j < 4; ++j) o.v[j] = d.v[j] * rstd * gg.v[j] + bb.v[j];
    return o;
}
__device__ __forceinline__ Row16 modulate(const Row16& x, const float* shift, const float* scale, int lane) {
    const Row16 sh = ld_row_f32(shift, lane), sc = ld_row_f32(scale, lane); Row16 o;
#pragma unroll
    for (int j = 0; j < 4; ++j) o.v[j] = x.v[j] * (1.f + sc.v[j]) + sh.v[j];
    return o;
}

__device__ __forceinline__ void p_mod0(Frame& F) {
    const int gw = F.bid * NWAVES + F.wave, NGW = F.G * NWAVES;
    for (int row = gw; row < MROWS; row += NGW) {
        const Row16 x = ld_row_f32(x0_row(F, row), F.lane);
        const Row16 h = modulate(x, mod_ptr(F, 0, row, 0), mod_ptr(F, 0, row, 1), F.lane);
        st_row_bf16((bf16*)(F.ws + WS_H) + (size_t)row * DM, F.lane, h);
    }
}

template <int LAYER>
__device__ __forceinline__ void p_ln_route(Frame& F) {
    LAS float* rwT = (LAS float*)(F.lds + RING_OFF);
    for (int i = F.tid; i < DM * NEXP; i += NTHR) { const int k = i >> 4, e = i & 15; rwT[e * DM + k] = F.in[I_RW][i]; }
    __syncthreads();
    const int gw = F.bid * NWAVES + F.wave, NGW = F.G * NWAVES;
    float* X = (float*)(F.ws + WS_X); bf16* H = (bf16*)(F.ws + WS_H); const bf16* MIX = (const bf16*)(F.ws + WS_MIX);
    unsigned* cnt = (unsigned*)(F.ws + WS_CTL) + CW_CNT + LAYER * 64;
    int* PERM = (int*)(F.ws + WS_PERM_); float* GATE = (float*)(F.ws + WS_GATE); int* TOK = (int*)(F.ws + WS_TOK);
    for (int row = gw; row < MROWS; row += NGW) {
        const int b = row / TPB, tt = row - b * TPB;
        if (LAYER == 1 && tt < CTXL) continue;
        const Row16 xin = LAYER == 0 ? ld_row_f32(x0_row(F, row), F.lane) : ld_row_f32(X + (size_t)row * DM, F.lane);
        const Row16 mix = ld_row_bf16(MIX + (size_t)row * DM, F.lane);
        const Row16 gate = ld_row_f32(mod_ptr(F, LAYER, row, 2), F.lane);
        Row16 pre;
#pragma unroll
        for (int j = 0; j < 4; ++j) pre.v[j] = ALPHA * xin.v[j] + gate.v[j] * mix.v[j];
        const Row16 x1 = layer_norm(pre, F.in[I_LN1G] + LAYER * DM, F.in[I_LN1B] + LAYER * DM, F.lane);
        st_row_f32(X + (size_t)row * DM, F.lane, x1);
        const Row16 h = modulate(x1, mod_ptr(F, LAYER, row, 3), mod_ptr(F, LAYER, row, 4), F.lane);
        st_row_bf16(H + (size_t)row * DM, F.lane, h);
        float lg[NEXP];
#pragma unroll
        for (int e = 0; e < NEXP; ++e) { float s = 0.f;
#pragma unroll
            for (int j = 0; j < 4; ++j) { const f32x4 w = *((const LAS f32x4*)(rwT + e * DM) + F.lane + 64 * j); s += (h.v[j].x * w.x + h.v[j].y * w.y) + (h.v[j].z * w.z + h.v[j].w * w.w); }
            lg[e] = wave_sum(s) + F.in[I_RB][e]; if ((e & 3) == 3) asm volatile("" ::: "memory"); }
        if (F.lane == 0) {
            float mx = lg[0];
#pragma unroll
            for (int e = 1; e < NEXP; ++e) mx = fmaxf(mx, lg[e]);
            float p[NEXP];
#pragma unroll
            for (int e = 0; e < NEXP; ++e) p[e] = expf(lg[e] - mx);
            int best = 0; float bs = -1.f;
#pragma unroll
            for (int g = 0; g < 4; ++g) { float a = p[4 * g], c2 = -1.f;
#pragma unroll
                for (int i = 1; i < 4; ++i) { const float v = p[4 * g + i]; if (v > a) { c2 = a; a = v; } else if (v > c2) c2 = v; }
                const float sc = a + c2; if (sc > bs) { bs = sc; best = g; } }
            int i0 = 0; float p0 = -1.f;
#pragma unroll
            for (int i = 0; i < 4; ++i) { float v = 0.f;
#pragma unroll
                for (int g = 0; g < 4; ++g) v = (g == best) ? p[4 * g + i] : v;
                if (v > p0) { p0 = v; i0 = i; } }
            int i1 = 0; float p1 = -1.f;
#pragma unroll
            for (int i = 0; i < 4; ++i) { float v = 0.f;
#pragma unroll
                for (int g = 0; g < 4; ++g) v = (g == best) ? p[4 * g + i] : v;
                if (i != i0 && v > p1) { p1 = v; i1 = i; } }
            const int e0 = best * 4 + i0, e1 = best * 4 + i1; const float w0 = p0 / (p0 + p1), w1 = p1 / (p0 + p1);
            const unsigned r0 = atomicAdd(cnt + e0, 1u), r1 = atomicAdd(cnt + e1, 1u);
            PERM[(size_t)e0 * CAP + r0] = row; GATE[(size_t)e0 * CAP + r0] = w0; PERM[(size_t)e1 * CAP + r1] = row; GATE[(size_t)e1 * CAP + r1] = w1;
            TOK[row * 2 + 0] = (e0 << 20) | (int)r0; TOK[row * 2 + 1] = (e1 << 20) | (int)r1;
        }
    }
}

__device__ __forceinline__ void expert_tile_offsets(const unsigned* cnt, int (&toff)[NEXP + 1]) {
    toff[0] = 0;
#pragma unroll
    for (int e = 0; e < NEXP; ++e) toff[e + 1] = toff[e] + (int)((__hip_atomic_load(cnt + e, __ATOMIC_RELAXED, __HIP_MEMORY_SCOPE_AGENT) + 255u) >> 8);
}

template <int LAYER>
__device__ __forceinline__ void p_ln2(Frame& F) {
    const int gw = F.bid * NWAVES + F.wave, NGW = F.G * NWAVES;
    float* X = (float*)(F.ws + WS_X); bf16* H = (bf16*)(F.ws + WS_H); const bf16* Y = (const bf16*)(F.ws + WS_Y);
    const unsigned* cnt = (const unsigned*)(F.ws + WS_CTL) + CW_CNT + LAYER * 64; const int* TOK = (const int*)(F.ws + WS_TOK);
    int toff[NEXP + 1]; expert_tile_offsets(cnt, toff);
    for (int row = gw; row < MROWS; row += NGW) {
        const int b = row / TPB, tt = row - b * TPB;
        if (LAYER == 1 && tt < CTXL) continue;
        const int t0 = __hip_atomic_load(TOK + row * 2, __ATOMIC_RELAXED, __HIP_MEMORY_SCOPE_AGENT), t1 = __hip_atomic_load(TOK + row * 2 + 1, __ATOMIC_RELAXED, __HIP_MEMORY_SCOPE_AGENT); const int e0 = t0 >> 20, e1 = t1 >> 20;
        int o0 = 0, o1 = 0;
#pragma unroll
        for (int e = 0; e < NEXP; ++e) { o0 = (e == e0) ? toff[e] : o0; o1 = (e == e1) ? toff[e] : o1; }
        const size_t y0 = (size_t)o0 * 256 + (t0 & 0xfffff), y1 = (size_t)o1 * 256 + (t1 & 0xfffff);
        const Row16 xin = ld_row_f32(X + (size_t)row * DM, F.lane);
        const Row16 ya = ld_row_bf16(Y + y0 * DM, F.lane), yb = ld_row_bf16(Y + y1 * DM, F.lane);
        const Row16 gate = ld_row_f32(mod_ptr(F, LAYER, row, 5), F.lane);
        Row16 pre;
#pragma unroll
        for (int j = 0; j < 4; ++j) pre.v[j] = ALPHA * xin.v[j] + gate.v[j] * (ya.v[j] + yb.v[j]);
        const Row16 x2 = layer_norm(pre, F.in[I_LN2G] + LAYER * DM, F.in[I_LN2B] + LAYER * DM, F.lane);
        if (LAYER == 0) {
            st_row_f32(X + (size_t)row * DM, F.lane, x2);
            const Row16 h = modulate(x2, mod_ptr(F, 1, row, 0), mod_ptr(F, 1, row, 1), F.lane);
            st_row_bf16(H + (size_t)row * DM, F.lane, h);
        } else {
            st_row_f32(F.out + ((size_t)b * SEQ + (tt - CTXL)) * DM, F.lane, x2);
        }
    }
}
namespace ck {
typedef short bf16x8 __attribute__((ext_vector_type(8)));
typedef float f32x16 __attribute__((ext_vector_type(16)));
typedef float f32x4 __attribute__((ext_vector_type(4)));
constexpr int NCH = 36;
__device__ __forceinline__ int crow(int r, int hi) { return (r & 3) + 8 * (r >> 2) + 4 * hi; }
__device__ __forceinline__ int swz(int row, int c16) { return row * 128 + ((c16 ^ ((row >> 1) & 7)) << 4); }
__device__ __forceinline__ int swz_el(int row, int col) { return swz(row, col >> 3) + (col & 7) * 2; }
__device__ __forceinline__ void mm_tile(f32x16& acc, const LAS unsigned char* A, int arow0, const LAS unsigned char* B, int brow0, int ks0, int nks, int r32, int hh) {
#pragma unroll
    for (int ks = 0; ks < 4; ++ks) if (ks >= ks0 && ks < ks0 + nks) {
        const bf16x8 a = *(const LAS bf16x8*)(A + swz(arow0 + r32, 2 * ks + hh));
        const bf16x8 b = *(const LAS bf16x8*)(B + swz(brow0 + r32, 2 * ks + hh));
        acc = __builtin_amdgcn_mfma_f32_32x32x16_bf16(a, b, acc, 0, 0, 0); }
}
__device__ __forceinline__ f32x16 zero16() { f32x16 z;
#pragma unroll
    for (int i = 0; i < 16; ++i) z[i] = 0.f; return z; }
__device__ __forceinline__ int chunk_index(int b, int h, int d, int c) { return ((b * 8 + h) * 2 + d) * NCH + c; }
}

constexpr int CK_LIN = 0;
constexpr int CK_E = 32768;
constexpr int CK_OPS = 65536;
constexpr int CK_WSUM = 65536 + 57344;
static_assert(CK_WSUM + 2048 <= RING_BYTES, "chunk LDS map");

__device__ __forceinline__ void p_chunk_pre(Frame& F) {
    using namespace ck;
    const LAS unsigned char* L0 = F.lds + RING_OFF;
    LAS unsigned char* lds = F.lds + RING_OFF;
    const bf16* PA = (const bf16*)(F.ws + WS_PA);
    const int wave = F.wave;
    bf16* CHG = (bf16*)(F.ws + WS_CHG); bf16* CHH = (bf16*)(F.ws + WS_CHH); bf16* CHRQ = (bf16*)(F.ws + WS_CHRQ); bf16* CHY = (bf16*)(F.ws + WS_CHY);
    float* GLp = (float*)(F.ws + WS_GL); float* BON = (float*)(F.ws + WS_BON);
    bf16* VOUT = (bf16*)(F.ws + WS_VOUT); bf16* GOUT = (bf16*)(F.ws + WS_GOUT);
    const bf16* W2T = (const bf16*)(F.ws + WS_LORA); const bf16* A2T = W2T + 2 * 512 * 64; const bf16* G2T = A2T + 2 * 512 * 64;
    const float* mu = F.in[I_AMU];
    for (int it = F.bid; it < NB * 8 * 36 * 2; it += F.G) {
        const int d = it & 1, tb = (it >> 1) % 36, bh = (it >> 1) / 36, h = bh & 7, b = bh >> 3;
        const bool isctx = tb < 4; const int t0 = isctx ? tb * 64 : (tb - 4) * 64, Ls = isctx ? CTXL : SEQ;
        const int rbase = b * TPB + (isctx ? 0 : CTXL);
        const int c = d == 0 ? tb : (isctx ? 3 - tb : 4 + (31 - (tb - 4)));
        const int ci = chunk_index(b, h, d, c);
        __syncthreads();
        int lane = F.lane; asm volatile("" : "+v"(lane));
        const int tid = (wave << 6) | lane, r32 = lane & 31, hh = lane >> 5, k = lane, pg = wave;
        {
            const int cc = tid & 255, tg = tid >> 8;
            if (d == 0 || cc < 128) {
                const int col = cc < 64 ? 1536 + 64 * d + cc : cc < 128 ? 1664 + 64 * d + (cc - 64) : 1792 + (cc - 128);
                const float m = mu[col]; const int mat = cc >> 6, l = cc & 63;
                const bf16* pc = PA + (size_t)(rbase + t0 + 32 * tg) * A_IN + col;
                float prev = (t0 + 32 * tg > 0) ? bf2f(pc[-A_IN]) : 0.f, cur = bf2f(pc[0]);
#pragma unroll 4
                for (int j = 0; j < 32; ++j) {
                    const int tl = 32 * tg + j; const float nxt = (t0 + tl + 1 < Ls) ? bf2f(pc[(size_t)(j + 1) * A_IN]) : 0.f;
                    float u = cur + (0.5f * (prev + nxt) - cur) * m;
                    if (mat == 0) u = tanhf(u); else if (mat >= 2) u = sigmoidf_(u);
                    *(LAS bf16*)(lds + CK_LIN + mat * 8192 + swz_el(tl, l)) = (bf16)f2bf(u);
                    prev = cur; cur = nxt; }
            }
        }
        float rr[8], kx[8], vv[8];
        {
            const int tlo = d == 0 ? 8 * pg : 63 - (8 * pg + 7);
            const bf16* pr = PA + (size_t)(rbase + t0 + tlo) * A_IN + 64 * h + k;
            const float mr = mu[64 * h + k], mk = mu[512 + 64 * h + k], mv = mu[1024 + 64 * h + k];
            float win[3][10];
#pragma unroll
            for (int j = 0; j < 10; ++j) { const int tg2 = t0 + tlo + j - 1; const bool ok = tg2 >= 0 && tg2 < Ls;
#pragma unroll
                for (int s = 0; s < 3; ++s) win[s][j] = ok ? bf2f(pr[(ptrdiff_t)(j - 1) * A_IN + 512 * s]) : 0.f; }
#pragma unroll
            for (int i = 0; i < 8; ++i) { const int j = d == 0 ? i + 1 : 8 - i;
                rr[i] = win[0][j] + (0.5f * (win[0][j - 1] + win[0][j + 1]) - win[0][j]) * mr;
                kx[i] = win[1][j] + (0.5f * (win[1][j - 1] + win[1][j + 1]) - win[1][j]) * mk;
                vv[i] = win[2][j] + (0.5f * (win[2][j - 1] + win[2][j + 1]) - win[2][j]) * mv; }
        }
        __syncthreads();
        {
            const int tq = wave & 3, ti = tq >> 1, tj = tq & 1; const bool isW = wave < 4;
            f32x16 acc = zero16();
            const bf16* WT = (isW ? W2T : A2T) + ((size_t)d * 512 + 64 * h + 32 * tj + r32) * 64;
#pragma unroll
            for (int ks = 0; ks < 4; ++ks) {
                const bf16x8 a = *(const LAS bf16x8*)(L0 + CK_LIN + (isW ? 0 : 8192) + swz(32 * ti + r32, 2 * ks + hh));
                const bf16x8 bq = *(const bf16x8*)(WT + 16 * ks + 8 * hh);
                acc = __builtin_amdgcn_mfma_f32_32x32x16_bf16(a, bq, acc, 0, 0, 0); }
            const int ch = 32 * tj + r32; const float bias = isW ? F.in[I_AW0][d * 512 + 64 * h + ch] : F.in[I_AA0][d * 512 + 64 * h + ch];
#pragma unroll
            for (int r = 0; r < 16; ++r) { const int tl = 32 * ti + crow(r, hh); const int p = d == 0 ? tl : 63 - tl;
                const float sg = sigmoidf_(acc[r] + bias);
                *(LAS float*)(lds + CK_E + (isW ? 0 : 16384) + (p * 64 + ch) * 4) = isW ? sg * 0.6065306597126334f : sg; }
            if (d == 0 && isW) {
                f32x16 g = zero16();
                const bf16* GT = G2T + (size_t)(64 * h + 32 * tj + r32) * 128;
#pragma unroll
                for (int ks = 0; ks < 8; ++ks) {
                    const bf16x8 a = *(const LAS bf16x8*)(L0 + CK_LIN + 16384 + (ks >> 2) * 8192 + swz(32 * ti + r32, 2 * (ks & 3) + hh));
                    const bf16x8 bq = *(const bf16x8*)(GT + 16 * ks + 8 * hh);
                    g = __builtin_amdgcn_mfma_f32_32x32x16_bf16(a, bq, g, 0, 0, 0); }
#pragma unroll
                for (int r = 0; r < 16; ++r) { const int tl = 32 * ti + crow(r, hh);
                    GOUT[(size_t)(rbase + t0 + tl) * 512 + 64 * h + ch] = (bf16)f2bf(g[r]); }
            }
        }
        __syncthreads();
        {
            float e[8], ai[8], cl[8];
#pragma unroll
            for (int i = 0; i < 8; ++i) { e[i] = *(const LAS float*)(L0 + CK_E + ((8 * pg + i) * 64 + k) * 4); ai[i] = *(const LAS float*)(L0 + CK_E + 16384 + ((8 * pg + i) * 64 + k) * 4); }
            float run = 0.f;
#pragma unroll
            for (int i = 0; i < 8; ++i) { run -= e[i]; cl[i] = run; }
            *(LAS float*)(lds + CK_WSUM + (pg * 64 + k) * 4) = run;
            __syncthreads();
            float off = 0.f, tot = 0.f;
#pragma unroll
            for (int q = 0; q < 8; ++q) { const float s = *(const LAS float*)(L0 + CK_WSUM + (q * 64 + k) * 4); tot += s; off += (q < pg) ? s : 0.f; }
            const float kkc = F.in[I_AKK][64 * h + k], kac = F.in[I_AKA][64 * h + k], rkc = F.in[I_ARK][64 * h + k];
            unsigned bh_w[4], kh_w[4], vt_w[4]; float bhv[8], khv[8];
#pragma unroll
            for (int i = 0; i < 8; ++i) {
                const int p = 8 * pg + i; const float c_ = cl[i] + off;
                const float kr = kx[i] * kkc; const float ss = wave_sum(kr * kr); const float kk = kr / fmaxf(sqrtf(ss), 1e-12f);
                const float kd = kx[i] * (1.f + (ai[i] - 1.f) * kac), bb = kk * ai[i];
                const float bon = wave_sum(rr[i] * kd * rkc);
                const float em = __expf(-c_), ep = __expf(c_), el = __expf(tot - c_);
                *(LAS bf16*)(lds + CK_OPS + 0 * 8192 + swz_el(p, k)) = (bf16)f2bf(-kk * __expf(c_ + e[i]));
                *(LAS bf16*)(lds + CK_OPS + 1 * 8192 + swz_el(p, k)) = (bf16)f2bf(bb * em);
                *(LAS bf16*)(lds + CK_OPS + 2 * 8192 + swz_el(p, k)) = (bf16)f2bf(kd * em);
                *(LAS bf16*)(lds + CK_OPS + 3 * 8192 + swz_el(p, k)) = (bf16)f2bf(rr[i] * ep);
                bhv[i] = bb * el; khv[i] = kd * el;
                const int tl = d == 0 ? p : 63 - p; const size_t row = (size_t)(rbase + t0 + tl);
                if (lane == 0) BON[((size_t)d * MROWS + row) * 8 + h] = bon;
                if (d == 0) VOUT[row * 512 + 64 * h + k] = (bf16)f2bf(vv[i]);
            }
#pragma unroll
            for (int i = 0; i < 4; ++i) { bh_w[i] = pk2(bhv[2 * i], bhv[2 * i + 1]); kh_w[i] = pk2(khv[2 * i], khv[2 * i + 1]); vt_w[i] = pk2(vv[2 * i], vv[2 * i + 1]); }
            *(LAS v4u*)(lds + CK_OPS + 4 * 8192 + swz(k, pg)) = (v4u){bh_w[0], bh_w[1], bh_w[2], bh_w[3]};
            *(LAS v4u*)(lds + CK_OPS + 5 * 8192 + swz(k, pg)) = (v4u){kh_w[0], kh_w[1], kh_w[2], kh_w[3]};
            *(LAS v4u*)(lds + CK_OPS + 6 * 8192 + swz(k, pg)) = (v4u){vt_w[0], vt_w[1], vt_w[2], vt_w[3]};
            if (pg == 0) GLp[(size_t)ci * 64 + k] = __expf(tot);
        }
        __syncthreads();
        { asm volatile("" : "+v"(lane)); }
        for (int job = wave; job < 16; job += 8) {
            const int prod = job >> 2, tq = job & 3, ti = tq >> 1, tj = tq & 1;
            f32x16 acc = zero16();
            if (!(ti == 0 && tj == 1))
                mm_tile(acc, L0 + CK_OPS + (prod < 2 ? 0 : 3) * 8192, 32 * ti, L0 + CK_OPS + ((prod & 1) ? 2 : 1) * 8192, 32 * tj, 0, 4, r32, hh);
            const int s = 32 * tj + r32;
#pragma unroll
            for (int r = 0; r < 16; ++r) { const int p = 32 * ti + crow(r, hh); const bool keep = prod < 2 ? (s < p) : (s <= p); const float v = keep ? acc[r] : 0.f;
                if (prod == 0) *(LAS float*)(lds + CK_E + (p * 64 + s) * 4) = v;
                else *(LAS bf16*)(lds + CK_LIN + (prod - 1) * 8192 + swz_el(p, s)) = (bf16)f2bf(v); }
        }
        __syncthreads();
        if (wave < 4) {
            const int ti = wave >> 1, tj = wave & 1; f32x16 acc = zero16();
            mm_tile(acc, L0 + CK_LIN + 0 * 8192, 32 * ti, L0 + CK_OPS + 6 * 8192, 32 * tj, 0, 4, r32, hh);
#pragma unroll
            for (int r = 0; r < 16; ++r) *(LAS bf16*)(lds + CK_E + 16384 + ((32 * ti + crow(r, hh)) * 64 + 32 * tj + r32) * 2) = (bf16)f2bf(acc[r]);
        }
        __syncthreads();
        { asm volatile("" : "+v"(lane)); }
        {
            const int q = lane & 3, col = wave * 16 + (lane >> 2);
            float xq[16];
#pragma unroll
            for (int j = 0; j < 16; ++j) xq[j] = 0.f;
#pragma unroll
            for (int p = 0; p < 64; ++p) {
                if ((p & 1) == 0) asm volatile("" ::: "memory");
                float part = 0.f;
#pragma unroll
                for (int j = 0; j < (p + 3) / 4; ++j) part += *(const LAS float*)(L0 + CK_E + (p * 64 + 4 * j + q) * 4) * xq[j];
                part += __shfl_xor(part, 1); part += __shfl_xor(part, 2);
                const float rhs = col < 64 ? bf2f(*(const LAS bf16*)(L0 + CK_OPS + swz_el(p, col))) : bf2f(*(const LAS bf16*)(L0 + CK_E + 16384 + (p * 64 + (col - 64)) * 2));
                const float xp = rhs + part;
                xq[p >> 2] = (q == (p & 3)) ? xp : xq[p >> 2];
            }
            LAS unsigned char* XT = col < 64 ? lds + CK_LIN + 3 * 8192 : lds + CK_E + 16384 + 8192;
            const int rw = col & 63;
#pragma unroll
            for (int j = 0; j < 16; ++j) *(LAS bf16*)(XT + swz_el(rw, 4 * j + q)) = (bf16)f2bf(xq[j]);
        }
        __syncthreads();
        { asm volatile("" : "+v"(lane)); }
        for (int job = wave; job < 16; job += 8) {
            const int prod = job >> 2, tq = job & 3, ti = tq >> 1, tj = tq & 1;
            const LAS unsigned char* WT_ = L0 + CK_LIN + 3 * 8192; const LAS unsigned char* UT_ = L0 + CK_E + 16384 + 8192;
            const LAS unsigned char* Arb = L0 + CK_LIN + 1 * 8192; const LAS unsigned char* Ark = L0 + CK_LIN + 2 * 8192;
            const LAS unsigned char* BhT = L0 + CK_OPS + 4 * 8192; const LAS unsigned char* KhT = L0 + CK_OPS + 5 * 8192; const LAS unsigned char* VT = L0 + CK_OPS + 6 * 8192;
            f32x16 acc = zero16();
            if (prod == 0) mm_tile(acc, Arb, 32 * ti, WT_, 32 * tj, 0, 4, r32, hh);
            else if (prod == 1) { mm_tile(acc, Arb, 32 * ti, UT_, 32 * tj, 0, 4, r32, hh); mm_tile(acc, Ark, 32 * ti, VT, 32 * tj, 0, 4, r32, hh); }
            else if (prod == 2) mm_tile(acc, WT_, 32 * ti, BhT, 32 * tj, 0, 4, r32, hh);
            else { mm_tile(acc, UT_, 32 * ti, BhT, 32 * tj, 0, 4, r32, hh); mm_tile(acc, VT, 32 * ti, KhT, 32 * tj, 0, 4, r32, hh); }
            const int cc = 32 * tj + r32;
            if (prod == 0) {
#pragma unroll
                for (int r = 0; r < 16; ++r) { const int p = 32 * ti + crow(r, hh); const float v = acc[r] + bf2f(*(const LAS bf16*)(L0 + CK_OPS + 3 * 8192 + swz_el(p, cc)));
                    CHRQ[(size_t)ci * 4096 + p * 64 + cc] = (bf16)f2bf(v); }
            } else if (prod == 1) {
#pragma unroll
                for (int r = 0; r < 16; ++r) { const int p = 32 * ti + crow(r, hh); CHY[(size_t)ci * 4096 + p * 64 + cc] = (bf16)f2bf(acc[r]); }
            } else if (prod == 2) {
#pragma unroll
                for (int rq = 0; rq < 4; ++rq) { const int k0 = 32 * ti + 8 * rq + 4 * hh;
                    *(v2u*)(CHG + (size_t)ci * 4096 + cc * 64 + k0) = (v2u){pk2(acc[4 * rq], acc[4 * rq + 1]), pk2(acc[4 * rq + 2], acc[4 * rq + 3])}; }
            } else {
#pragma unroll
                for (int r = 0; r < 16; ++r) { const int v_ = 32 * ti + crow(r, hh); CHH[(size_t)ci * 4096 + v_ * 64 + cc] = (bf16)f2bf(acc[r]); }
            }
        }
    }
}

__device__ __forceinline__ void p_state(Frame& F) {
    using namespace ck;
    const int lane = F.lane, wave = F.wave, r32 = lane & 31, hh = lane >> 5;
    const bf16* CHG = (const bf16*)(F.ws + WS_CHG); const bf16* CHH = (const bf16*)(F.ws + WS_CHH); const bf16* CHRQ = (const bf16*)(F.ws + WS_CHRQ); bf16* CHY = (bf16*)(F.ws + WS_CHY);
    const float* GLp = (const float*)(F.ws + WS_GL);
    LAS unsigned char* lds = F.lds + RING_OFF;
    for (int chain = F.bid; chain < NB * 8 * 2; chain += F.G) {
        const int d = chain & 1, h = (chain >> 1) & 7, b = chain >> 4;
        const int tq = wave & 3, ti = tq >> 1, tj = tq & 1;
        f32x16 S = zero16();
        __syncthreads();
        for (int i = F.tid; i < 8192 / 16; i += NTHR) *(LAS v4u*)(lds + i * 16) = (v4u){0u, 0u, 0u, 0u};
        __syncthreads();
        for (int c = 0; c < NCH; ++c) {
            const size_t cb = (size_t)chunk_index(b, h, d, c) * 4096;
            const LAS unsigned char* Sb = lds + (c & 1) * 8192; LAS unsigned char* Sn = lds + ((c + 1) & 1) * 8192;
            if (wave < 4) {
                f32x16 acc = zero16();
#pragma unroll
                for (int ks = 0; ks < 4; ++ks) {
                    const bf16x8 a = *(const LAS bf16x8*)(Sb + swz(32 * ti + r32, 2 * ks + hh));
                    const bf16x8 g = *(const bf16x8*)(CHG + cb + (size_t)(32 * tj + r32) * 64 + 16 * ks + 8 * hh);
                    acc = __builtin_amdgcn_mfma_f32_32x32x16_bf16(a, g, acc, 0, 0, 0); }
                const float gl = GLp[(size_t)chunk_index(b, h, d, c) * 64 + 32 * tj + r32];
#pragma unroll
                for (int r = 0; r < 16; ++r) { const int v_ = 32 * ti + crow(r, hh);
                    S[r] = S[r] * gl + acc[r] + bf2f(CHH[cb + v_ * 64 + 32 * tj + r32]);
                    *(LAS bf16*)(Sn + swz_el(v_, 32 * tj + r32)) = (bf16)f2bf(S[r]); }
            } else {
                f32x16 acc = zero16();
#pragma unroll
                for (int ks = 0; ks < 4; ++ks) {
                    const bf16x8 a = *(const bf16x8*)(CHRQ + cb + (size_t)(32 * ti + r32) * 64 + 16 * ks + 8 * hh);
                    const bf16x8 s = *(const LAS bf16x8*)(Sb + swz(32 * tj + r32, 2 * ks + hh));
                    acc = __builtin_amdgcn_mfma_f32_32x32x16_bf16(a, s, acc, 0, 0, 0); }
#pragma unroll
                for (int r = 0; r < 16; ++r) { const int p = 32 * ti + crow(r, hh); const size_t o = cb + p * 64 + 32 * tj + r32;
                    CHY[o] = (bf16)f2bf(acc[r] + bf2f(CHY[o])); }
            }
            __syncthreads();
        }
    }
}

__device__ __forceinline__ void p_rope0(Frame& F) {
    const int gw = F.bid * NWAVES + F.wave, NGW = F.G * NWAVES;
    bf16* PB = (bf16*)(F.ws + WS_PB); const float* cosB = (const float*)(F.ws + WS_ROPE); const float* sinB = cosB + SEQ * 32;
    for (int row = gw; row < MROWS; row += NGW) {
        const int b = row / TPB, tt = row - b * TPB; if (tt < CTXL) continue; const int t = tt - CTXL;
        bf16* p = PB + (size_t)row * B_IN;
#pragma unroll
        for (int q = 0; q < 8; ++q) { const int pr = q * 64 + F.lane; const int vec = pr >> 5, i = pr & 31; const int c1 = vec * 64 + i, c2 = c1 + 32;
            const float x1 = bf2f(p[c1]), x2 = bf2f(p[c2]); const float cs = cosB[t * 32 + i], sn = sinB[t * 32 + i];
            p[c1] = (bf16)f2bf(x1 * cs - x2 * sn); p[c2] = (bf16)f2bf(x1 * sn + x2 * cs); }
    }
}

__device__ __forceinline__ void p_attn0(Frame& F) {
    const bf16* PB = (const bf16*)(F.ws + WS_PB);
    for (int u = F.bid; u < 576; u += F.G) {
        int b, h, m, qt;
        if (u < 512) { qt = 1 + (u & 7); const int r = u >> 3; m = r & 1; h = (r >> 1) & 3; b = r >> 3; }
        else { const int r = u - 512; qt = 0; m = r & 1; h = (r >> 1) & 3; b = r >> 3; }
        const size_t row0 = (size_t)b * TPB;
        const bf16* Q = PB + (row0 + (size_t)qt * 256) * B_IN + h * 128 + m * 64;
        const bf16* Kp = PB + row0 * B_IN + 512 + h * 128 + m * 64;
        const bf16* Vp = PB + row0 * B_IN + 1024 + h * 128;
        bf16* O = (bf16*)(F.ws + (m == 0 ? WS_OB0 : WS_OB1)) + (row0 + (size_t)qt * 256) * 512 + h * 128;
        att::attn_body<64, B_IN, B_IN, 512>(Q, Kp, Vp, O, qt == 0 ? CTXL : TPB, F.ldsg + RING_OFF, F.wave);
    }
}

__device__ __forceinline__ void p_readout(Frame& F) {
    const int gw = F.bid * NWAVES + F.wave, NGW = F.G * NWAVES;
    const bf16* CHY = (const bf16*)(F.ws + WS_CHY); const bf16* fv = (const bf16*)(F.ws + WS_VOUT); const bf16* fg = (const bf16*)(F.ws + WS_GOUT); const float* BON = (const float*)(F.ws + WS_BON);
    const bf16* ob0 = (const bf16*)(F.ws + WS_OB0); const bf16* ob1 = (const bf16*)(F.ws + WS_OB1);
    bf16* A2 = (bf16*)(F.ws + WS_A2);
    float lam;
    { const float* lv = F.in[I_BLAM]; const float s1 = wave_sum(lv[F.lane] * lv[64 + F.lane]), s2 = wave_sum(lv[128 + F.lane] * lv[192 + F.lane]); lam = expf(s1) - expf(s2) + LAMBDA_INIT0; }
    const int c8 = F.lane * 8, hd = F.lane >> 3, v0 = (F.lane & 7) * 8;
    for (int row = gw; row < MROWS; row += NGW) {
        const size_t off = (size_t)row * 512 + c8;
        const int b = row / TPB, tt = row - b * TPB;
        const int ir = tt < CTXL ? (CTXL - 1 - tt) : CTXL + (TPB - 1 - tt);
        const size_t of = (size_t)ck::chunk_index(b, hd, 0, tt >> 6) * 4096 + (tt & 63) * 64 + v0, orv = (size_t)ck::chunk_index(b, hd, 1, ir >> 6) * 4096 + (ir & 63) * 64 + v0;
        const v4u qv = *(const v4u*)(fv + off), qg = *(const v4u*)(fg + off), q1 = *(const v4u*)(CHY + of), q2 = *(const v4u*)(CHY + orv);
        const unsigned wv_[4] = {qv.x, qv.y, qv.z, qv.w}, wg_[4] = {qg.x, qg.y, qg.z, qg.w}, w1_[4] = {q1.x, q1.y, q1.z, q1.w}, w2_[4] = {q2.x, q2.y, q2.z, q2.w};
        const float bon = BON[(size_t)row * 8 + hd] + BON[((size_t)MROWS + row) * 8 + hd];
        float y[8], s = 0.f;
#pragma unroll
        for (int j = 0; j < 8; ++j) { const int w = j >> 1; const bool up = j & 1; y[j] = (up ? bfhi(w1_[w]) : bflo(w1_[w])) + (up ? bfhi(w2_[w]) : bflo(w2_[w])); s += y[j]; }
        s += __shfl_xor(s, 1); s += __shfl_xor(s, 2); s += __shfl_xor(s, 4);
        const float mean = s * (1.f / 64.f); float q = 0.f;
#pragma unroll
        for (int j = 0; j < 8; ++j) { y[j] -= mean; q += y[j] * y[j]; }
        q += __shfl_xor(q, 1); q += __shfl_xor(q, 2); q += __shfl_xor(q, 4);
        const float rstd = 1.f / sqrtf(q * (1.f / 64.f) + GN_EPS);
        float o[8];
#pragma unroll
        for (int j = 0; j < 8; ++j) { const int w = j >> 1; const bool up = j & 1; const float v_ = up ? bfhi(wv_[w]) : bflo(wv_[w]), g_ = up ? bfhi(wg_[w]) : bflo(wg_[w]);
            o[j] = (y[j] * rstd * F.in[I_LNXG][c8 + j] + F.in[I_LNXB][c8 + j] + bon * v_) * g_; }
        *(v4u*)(A2 + (size_t)row * DM + c8) = (v4u){pk2(o[0], o[1]), pk2(o[2], o[3]), pk2(o[4], o[5]), pk2(o[6], o[7])};
        const v4u p0 = *(const v4u*)(ob0 + off), p1 = *(const v4u*)(ob1 + off);
        const unsigned u0[4] = {p0.x, p0.y, p0.z, p0.w}, u1[4] = {p1.x, p1.y, p1.z, p1.w};
        float z[8], ss = 0.f;
#pragma unroll
        for (int j = 0; j < 8; ++j) { const int w = j >> 1; const bool up = j & 1; z[j] = (up ? bfhi(u0[w]) : bflo(u0[w])) - lam * (up ? bfhi(u1[w]) : bflo(u1[w])); ss += z[j] * z[j]; }
        ss += __shfl_xor(ss, 1); ss += __shfl_xor(ss, 2); ss += __shfl_xor(ss, 4); ss += __shfl_xor(ss, 8);
        const float rr = 1.f / sqrtf(ss * (1.f / 128.f) + SUBLN_EPS) * (1.f - LAMBDA_INIT0);
#pragma unroll
        for (int j = 0; j < 8; ++j) z[j] = z[j] * rr * F.in[I_SUBG][(c8 + j) & 127];
        *(v4u*)(A2 + (size_t)row * DM + 512 + c8) = (v4u){pk2(z[0], z[1]), pk2(z[2], z[3]), pk2(z[4], z[5]), pk2(z[6], z[7])};
    }
}

__device__ __forceinline__ void p_qknorm1(Frame& F) {
    const int gw = F.bid * NWAVES + F.wave, NGW = F.G * NWAVES;
    bf16* QKV = (bf16*)(F.ws + WS_QKV1); const float* cosC = (const float*)(F.ws + WS_ROPE) + SEQ * 64; const float* sinC = cosC + SEQ * 64;
    const float qg1 = F.in[I_QNG][F.lane], qg2 = F.in[I_QNG][64 + F.lane], kg1 = F.in[I_KNG][F.lane], kg2 = F.in[I_KNG][64 + F.lane];
    for (int row = gw; row < MROWS; row += NGW) {
        const int b = row / TPB, tt = row - b * TPB; const bool lat = tt >= CTXL; const int t = tt - CTXL;
        float cs = 1.f, sn = 0.f; if (lat) { cs = cosC[t * 64 + F.lane]; sn = sinC[t * 64 + F.lane]; }
        bf16* p = QKV + (size_t)row * ODD_IN;
        for (int hd = lat ? 0 : 8; hd < 10; ++hd) {
            bf16* ph = p + hd * 128; const float x1 = bf2f(ph[F.lane]), x2 = bf2f(ph[64 + F.lane]);
            const float ss = wave_sum(x1 * x1 + x2 * x2); const float ri = 1.f / sqrtf(ss * (1.f / 128.f) + QKN_EPS);
            const float y1 = x1 * ri * (hd < 8 ? qg1 : kg1), y2 = x2 * ri * (hd < 8 ? qg2 : kg2);
            ph[F.lane] = (bf16)f2bf(y1 * cs - y2 * sn); ph[64 + F.lane] = (bf16)f2bf(y1 * sn + y2 * cs);
        }
    }
}
__device__ __forceinline__ void p_attn1(Frame& F) {
    const bf16* QKV = (const bf16*)(F.ws + WS_QKV1); bf16* OA = (bf16*)(F.ws + WS_OATT);
    for (int u = F.bid; u < 512; u += F.G) {
        const int qt = 1 + (u & 7), h = (u >> 3) & 7, b = u >> 6; const int kvh = h >> 2;
        const size_t row0 = (size_t)b * TPB;
        const bf16* Q = QKV + (row0 + (size_t)qt * 256) * ODD_IN + h * 128;
        const bf16* Kp = QKV + row0 * ODD_IN + 1024 + kvh * 128;
        const bf16* Vp = QKV + row0 * ODD_IN + 1280 + kvh * 128;
        bf16* O = OA + (row0 + (size_t)qt * 256) * DM + h * 128;
        att::attn_body<128, ODD_IN, ODD_IN, DM>(Q, Kp, Vp, O, TPB, F.ldsg + RING_OFF, F.wave);
    }
}
namespace pg8 {
struct EpiBf16 {
    static constexpr bool PERM = true;
    bf16_t* O; int ldc;
    __device__ __forceinline__ void operator()(const f32x4 (&acc)[2][2][4][2], const Unit& u, int wr, int wc, int fr, int fq) const {
        const int row0 = u.orow0 + wr * 64 + fr, col0 = u.pn * BM + wc * 32 + 8 * fq;
#pragma unroll
        for (int ai = 0; ai < 2; ++ai)
#pragma unroll
            for (int m = 0; m < 4; ++m) { bf16_t* rowp = O + (size_t)(row0 + ai * HALF + m * 16) * ldc + col0;
#pragma unroll
                for (int bj = 0; bj < 2; ++bj) { const f32x4 v0 = acc[ai][bj][m][0], v1 = acc[ai][bj][m][1];
                    u32x4 w; w.x = cvt_pk_bf16(v0[0], v0[1]); w.y = cvt_pk_bf16(v0[2], v0[3]); w.z = cvt_pk_bf16(v1[0], v1[1]); w.w = cvt_pk_bf16(v1[2], v1[3]);
                    *(u32x4*)(rowp + bj * HALF) = w; } }
    }
};
struct EpiIn0 {
    static constexpr bool PERM = true;
    bf16_t* PA; bf16_t* PB;
    __device__ __forceinline__ void operator()(const f32x4 (&acc)[2][2][4][2], const Unit& u, int wr, int wc, int fr, int fq) const {
        const int row0 = u.orow0 + wr * 64 + fr, col0 = u.pn * BM + wc * 32 + 8 * fq;
#pragma unroll
        for (int ai = 0; ai < 2; ++ai)
#pragma unroll
            for (int m = 0; m < 4; ++m) { const size_t row = (size_t)(row0 + ai * HALF + m * 16);
#pragma unroll
                for (int bj = 0; bj < 2; ++bj) { const f32x4 v0 = acc[ai][bj][m][0], v1 = acc[ai][bj][m][1]; const int col = col0 + bj * HALF;
                    u32x4 w; w.x = cvt_pk_bf16(v0[0], v0[1]); w.y = cvt_pk_bf16(v0[2], v0[3]); w.z = cvt_pk_bf16(v1[0], v1[1]); w.w = cvt_pk_bf16(v1[2], v1[3]);
                    if (col < 1920) *(u32x4*)(PA + row * 1920 + col) = w; else if (col < 3456) *(u32x4*)(PB + row * 1536 + (col - 1920)) = w; } }
    }
};
struct EpiMoe1 {
    static constexpr bool PERM = true;
    bf16_t* HID;
    __device__ __forceinline__ void operator()(const f32x4 (&acc)[2][2][4][2], const Unit& u, int wr, int wc, int fr, int fq) const {
        const int row0 = u.orow0 + wr * 64 + fr, col0 = u.pn * 128 + wc * 16 + 4 * fq;
#pragma unroll
        for (int ai = 0; ai < 2; ++ai)
#pragma unroll
            for (int m = 0; m < 4; ++m) { bf16_t* rowp = HID + (size_t)(row0 + ai * HALF + m * 16) * 512 + col0;
#pragma unroll
                for (int bj = 0; bj < 2; ++bj) { const f32x4 a = acc[ai][bj][m][0], b = acc[ai][bj][m][1]; float h[4];
#pragma unroll
                    for (int i = 0; i < 4; ++i) h[i] = a[i] / (1.f + __expf(-a[i])) * b[i];
                    u32x2 w; w.x = cvt_pk_bf16(h[0], h[1]); w.y = cvt_pk_bf16(h[2], h[3]);
                    *(u32x2*)(rowp + bj * 64) = w; } }
    }
};
struct EpiMoe2 {
    static constexpr bool PERM = true;
    bf16_t* Y; const float* GATE;
    __device__ __forceinline__ void operator()(const f32x4 (&acc)[2][2][4][2], const Unit& u, int wr, int wc, int fr, int fq) const {
        const int r0 = wr * 64 + fr, col0 = u.pn * BM + wc * 32 + 8 * fq;
#pragma unroll
        for (int ai = 0; ai < 2; ++ai)
#pragma unroll
            for (int m = 0; m < 4; ++m) { const int r = r0 + ai * HALF + m * 16; if (r >= u.nvalid) continue;
                const float gt = GATE[u.gbase + r]; bf16_t* rowp = Y + (size_t)(u.orow0 + r) * 1024 + col0;
#pragma unroll
                for (int bj = 0; bj < 2; ++bj) { const f32x4 v0 = acc[ai][bj][m][0] * gt, v1 = acc[ai][bj][m][1] * gt;
                    u32x4 w; w.x = cvt_pk_bf16(v0[0], v0[1]); w.y = cvt_pk_bf16(v0[2], v0[3]); w.z = cvt_pk_bf16(v1[0], v1[1]); w.w = cvt_pk_bf16(v1[2], v1[3]);
                    *(u32x4*)(rowp + bj * HALF) = w; } }
    }
};
__device__ __forceinline__ void moe_build_table(const unsigned* cnt, PG8_LAS int* tab, int tid) {
    unsigned cn[16]; int total = 0;
#pragma unroll
    for (int e = 0; e < 16; ++e) { cn[e] = __hip_atomic_load(cnt + e, __ATOMIC_RELAXED, __HIP_MEMORY_SCOPE_AGENT); total += (int)((cn[e] + 255u) >> 8); }
    total *= 4;
    if (tid == 0) tab[0] = total;
    for (int L = tid; L < total; L += 512) {
        int base = 0, toff = 0, e = 0; bool found = false; unsigned ce = cn[0];
#pragma unroll
        for (int q = 0; q < 16; ++q) { const int nt = (int)((cn[q] + 255u) >> 8); if (!found) { if (L >= base + 4 * nt) { base += 4 * nt; toff += nt; e = q + 1; } else { found = true; ce = cn[q]; } } }
        const int nt_e = (int)((ce + 255u) >> 8); const int within = L - base, pn = within / nt_e, rt = within % nt_e;
        const int rem = (int)ce - rt * 256; const int nvalid = rem < 256 ? rem : 256;
        tab[4 + 2 * L] = e | (rt << 4) | (pn << 12) | (nvalid << 16); tab[4 + 2 * L + 1] = toff + rt;
    }
    __syncthreads();
}
template <bool GATHER_>
struct MoeOrder {
    static constexpr bool GATHER = GATHER_;
    const PG8_LAS int* tab; const int* perm; int G, c, K;
    __device__ __forceinline__ bool next(int i, Unit& u) const {
        const int total = __builtin_amdgcn_readfirstlane(tab[0]);
        const int L0 = i * G + c; if (L0 >= total) return false;
        const int L = xcd_remap(L0, total);
        const int w0 = __builtin_amdgcn_readfirstlane(tab[4 + 2 * L]), w1 = __builtin_amdgcn_readfirstlane(tab[4 + 2 * L + 1]);
        const int e = w0 & 15, rt = (w0 >> 4) & 255, pn = (w0 >> 12) & 3;
        u.pm = rt; u.pn = pn; u.e = e; u.gbase = e * 18432 + rt * 256; u.nvalid = (w0 >> 16) & 511; u.orow0 = w1 * 256;
        u.boff = ((size_t)e * 1024 + (size_t)pn * 256) * K * 2; u.aoff = (size_t)u.orow0 * K * 2; return true;
    }
    __device__ __forceinline__ int token(const Unit& u, int r) const { return perm[u.gbase + (r < u.nvalid ? r : 0)]; }
};
}

enum { PH_PROLOGUE = 0, PH_MOD0, PH_GEMM_IN0, PH_CHUNK, PH_STATE, PH_ATTN0, PH_READOUT, PH_GEMM_OUT0, PH_LNR0, PH_MOE1_0, PH_MOE2_0, PH_LN2_0,
       PH_GEMM_IN1, PH_QKN1, PH_ATTN1, PH_GEMM_OUT1, PH_LNR1, PH_MOE1_1, PH_MOE2_1, PH_FINAL, N_PHASES };

template <int LAYER> __device__ __forceinline__ void p_moe1(Frame& F) {
    pg8::Gemm g{(const pg8::bf16_t*)(F.ws + WS_H), (const pg8::bf16_t*)(F.ws + WS_WM13), DM};
    pg8::moe_build_table((const unsigned*)(F.ws + WS_CTL) + CW_CNT + LAYER * 64, (LAS int*)(F.lds + MOETAB_OFF), F.tid);
    pg8::MoeOrder<true> S{(const LAS int*)(F.lds + MOETAB_OFF), (const int*)(F.ws + WS_PERM_), F.G, F.bid, DM};
    pg8::EpiMoe1 E{(pg8::bf16_t*)(F.ws + WS_HID)};
    pg8::gemm_phase<pg8::EpiMoe1, pg8::MoeOrder<true>>(F.lds + RING_OFF, g, S, E, F.wave);
}
template <int LAYER> __device__ __forceinline__ void p_moe2(Frame& F) {
    pg8::Gemm g{(const pg8::bf16_t*)(F.ws + WS_HID), (const pg8::bf16_t*)(F.ws + WS_WM2), EFF};
    pg8::moe_build_table((const unsigned*)(F.ws + WS_CTL) + CW_CNT + LAYER * 64, (LAS int*)(F.lds + MOETAB_OFF), F.tid);
    pg8::MoeOrder<false> S{(const LAS int*)(F.lds + MOETAB_OFF), (const int*)(F.ws + WS_PERM_), F.G, F.bid, EFF};
    pg8::EpiMoe2 E{(pg8::bf16_t*)(F.ws + WS_Y), (const float*)(F.ws + WS_GATE)};
    pg8::gemm_phase<pg8::EpiMoe2, pg8::MoeOrder<false>>(F.lds + RING_OFF, g, S, E, F.wave);
}
__device__ __forceinline__ void p_gemm_dense(Frame& F, size_t a_off, size_t w_off, int N, size_t o_off, int ldc) {
    pg8::Gemm g{(const pg8::bf16_t*)(F.ws + a_off), (const pg8::bf16_t*)(F.ws + w_off), DM};
    pg8::DenseOrder S; S.init(MROWS, N, DM, F.G, F.bid);
    pg8::EpiBf16 E{(pg8::bf16_t*)(F.ws + o_off), ldc};
    pg8::gemm_phase<pg8::EpiBf16, pg8::DenseOrder>(F.lds + RING_OFF, g, S, E, F.wave);
}

template <int PH> __device__ __forceinline__ void run_phase(Frame& F) {
    if constexpr (PH == PH_PROLOGUE) p_prologue(F);
    else if constexpr (PH == PH_MOD0) p_mod0(F);
    else if constexpr (PH == PH_GEMM_IN0) {
        pg8::Gemm g{(const pg8::bf16_t*)(F.ws + WS_H), (const pg8::bf16_t*)(F.ws + WS_WEVIN), DM};
        pg8::DenseOrder S; S.init(MROWS, EVEN_PAD, DM, F.G, F.bid);
        pg8::EpiIn0 E{(pg8::bf16_t*)(F.ws + WS_PA), (pg8::bf16_t*)(F.ws + WS_PB)};
        pg8::gemm_phase<pg8::EpiIn0, pg8::DenseOrder>(F.lds + RING_OFF, g, S, E, F.wave); }
    else if constexpr (PH == PH_CHUNK) { p_rope0(F); p_chunk_pre(F); }
    else if constexpr (PH == PH_STATE) p_state(F);
    else if constexpr (PH == PH_ATTN0) p_attn0(F);
    else if constexpr (PH == PH_READOUT) p_readout(F);
    else if constexpr (PH == PH_GEMM_OUT0) p_gemm_dense(F, WS_A2, WS_WEVOUT, DM, WS_MIX, DM);
    else if constexpr (PH == PH_LNR0) { convert_moe_weights(F, 0); __syncthreads(); p_ln_route<0>(F); }
    else if constexpr (PH == PH_MOE1_0) p_moe1<0>(F);
    else if constexpr (PH == PH_MOE2_0) p_moe2<0>(F);
    else if constexpr (PH == PH_LN2_0) { p_ln2<0>(F); convert_moe_weights(F, 1); }
    else if constexpr (PH == PH_GEMM_IN1) p_gemm_dense(F, WS_H, WS_WODIN, ODD_IN, WS_QKV1, ODD_IN);
    else if constexpr (PH == PH_QKN1) p_qknorm1(F);
    else if constexpr (PH == PH_ATTN1) p_attn1(F);
    else if constexpr (PH == PH_GEMM_OUT1) p_gemm_dense(F, WS_OATT, WS_WODOUT, DM, WS_MIX, DM);
    else if constexpr (PH == PH_LNR1) p_ln_route<1>(F);
    else if constexpr (PH == PH_MOE1_1) p_moe1<1>(F);
    else if constexpr (PH == PH_MOE2_1) p_moe2<1>(F);
    else if constexpr (PH == PH_FINAL) p_ln2<1>(F);
}
template <int PH, int HI> __device__ __forceinline__ void run_phases(Frame& F, const XcdBarrier& bar) {
    if constexpr (PH < HI) {
        {
            const float* const* inp = (const float* const*)__builtin_amdgcn_kernarg_segment_ptr(); asm volatile("" : "+s"(inp)); F.in = inp;
            asm volatile("" : "+s"(F.ws), "+s"(F.out), "+s"(F.G), "+s"(F.bid), "+s"(F.wave));
            int l_ = (int)__builtin_amdgcn_mbcnt_hi(~0u, __builtin_amdgcn_mbcnt_lo(~0u, 0u)); asm volatile("" : "+v"(l_)); F.lane = l_; F.tid = (F.wave << 6) | l_; }
        asm volatile("; PHASE_MARK %0" :: "i"(PH));
        run_phase<PH>(F);
        if constexpr (PH + 1 < HI) { xcd_barrier(bar); run_phases<PH + 1, HI>(F, bar); }
    }
}

template <int LO, int HI>
__global__ void __launch_bounds__(NTHR, 2) fwd_kernel(Args args) {
    extern __shared__ __attribute__((aligned(16))) unsigned char lds[];
    Frame F;
    F.lds = (LAS unsigned char*)lds; F.ldsg = (char*)lds;
    F.tid = threadIdx.x; F.lane = F.tid & 63; F.wave = __builtin_amdgcn_readfirstlane(F.tid >> 6);
    F.G = gridDim.x; F.bid = blockIdx.x; F.in = args.in; F.out = args.out; F.ws = args.ws;
    volatile LAS unsigned* MISC = (volatile LAS unsigned*)(F.lds + MISC_OFF);
    for (int u = F.tid; u < (LDS_BYTES - LDSCTL_OFF) / 4; u += NTHR) ((LAS unsigned*)(F.lds + LDSCTL_OFF))[u] = 0u;
    __syncthreads();
    XcdBarrier bar; bar.bar = (unsigned*)(F.ws + WS_CTL) + CW_BAR; bar.x = 0; bar.st = nullptr;
    if constexpr (HI - LO > 1) bar = xcd_barrier_post((unsigned*)(F.ws + WS_CTL) + CW_BAR, MISC + 8);
    run_phases<LO, HI>(F, bar);
}

#ifndef N_LAUNCH_MODE
#define N_LAUNCH_MODE 0
#endif
template <int PH> static void launch_from(int grid, hipStream_t stream, const Args& a) {
    if constexpr (PH < N_PHASES) {
        (void)hipFuncSetAttribute((const void*)fwd_kernel<PH, PH + 1>, hipFuncAttributeMaxDynamicSharedMemorySize, LDS_BYTES);
        hipLaunchKernelGGL((fwd_kernel<PH, PH + 1>), dim3(grid), dim3(NTHR), LDS_BYTES, stream, a);
#ifdef PROBE_MASK
        if ((PROBE_MASK >> PH) & 1) hipLaunchKernelGGL((fwd_kernel<PH, PH + 1>), dim3(grid), dim3(NTHR), LDS_BYTES, stream, a);
#endif
        launch_from<PH + 1>(grid, stream, a);
    }
}
extern "C" void kernel_launch(void* const* d_in, const int* in_sizes, int n_in, void* d_out, int out_size, void* d_ws, size_t ws_size, hipStream_t stream) {
    static int grid = 0;
    if (grid == 0) {
        if (n_in != 34 || in_sizes[0] != NB * SEQ * DM || out_size != NB * SEQ * DM || ws_size < WS_TOTAL) {
            fprintf(stderr, "kernel_launch: unexpected shapes: n_in %d in0 %d out %d ws %zu (need %zu)\n", n_in, n_in > 0 ? in_sizes[0] : -1, out_size, ws_size, (size_t)WS_TOTAL); grid = -1; return; }
        int dev = 0, cus = 0;
        if (hipGetDevice(&dev) != hipSuccess || hipDeviceGetAttribute(&cus, hipDeviceAttributeMultiprocessorCount, dev) != hipSuccess) { grid = -1; return; }
#if N_LAUNCH_MODE == 0
        if (hipFuncSetAttribute((const void*)fwd_kernel<0, N_PHASES>, hipFuncAttributeMaxDynamicSharedMemorySize, LDS_BYTES) != hipSuccess) { fprintf(stderr, "kernel_launch: hipFuncSetAttribute failed\n"); grid = -1; return; }
#endif
        (void)hipGetLastError();
        grid = cus;
    }
    if (grid < 0) return;
    if (hipMemsetAsync((char*)d_ws + WS_CTL, 0, CTL_ZERO_BYTES, stream) != hipSuccess) return;
    Args a{};
    for (int i = 0; i < 34; ++i) a.in[i] = (const float*)d_in[i];
    a.out = (float*)d_out; a.ws = (unsigned char*)d_ws;
#if N_LAUNCH_MODE == 1
    launch_from<0>(grid, stream, a);
#else
    hipLaunchKernelGGL((fwd_kernel<0, N_PHASES>), dim3(grid), dim3(NTHR), LDS_BYTES, stream, a);
#endif
    const hipError_t le = hipPeekAtLastError();
    if (le != hipSuccess) fprintf(stderr, "kernel_launch: launch failed: %s\n", hipGetErrorName(le));
}
```

```cpp
#include <hip/hip_runtime.h>
#include <hip/hip_bf16.h>
#include <cstdio>
#include <cstdint>
#include <cmath>
namespace pg8 {
#define PG8_LAS __attribute__((address_space(3)))
typedef unsigned short bf16_t;
typedef short bf16x8 __attribute__((ext_vector_type(8)));
typedef float f32x4 __attribute__((ext_vector_type(4)));
typedef unsigned u32x4 __attribute__((ext_vector_type(4)));
typedef unsigned u32x2 __attribute__((ext_vector_type(2)));
constexpr int BM = 256, BK = 64, HALF = 128, HTB = HALF * BK * 2  , STAGE_BYTES = 8 * HTB, NXCD = 8, WGM = 8;

__host__ __device__ __forceinline__ int lds_byte(int r, int c) { const int st = (r >> 4) * 2 + (c >> 5), rr = r & 15, cc = c & 31, ob = rr * 64 + cc * 2; return st * 1024 + (ob ^ (((ob >> 9) & 1) << 5)); }
__host__ __device__ __forceinline__ void stage_rc(int b, int& R, int& C) { const int st = b / 1024, sb = b % 1024, swz = sb ^ (((sb >> 9) & 1) << 5); R = (st >> 1) * 16 + swz / 64; C = (st & 1) * 32 + (swz % 64) / 2; }
__host__ __device__ __forceinline__ int perm32(int rho) { const int n = rho >> 4, i = rho & 15; return 8 * (i >> 2) + 4 * n + (i & 3); }

struct Unit { int pm, pn; size_t aoff, boff; int gbase, nvalid, orow0, e; };
struct Gemm { const bf16_t* A; const bf16_t* Bt; int K; };

__device__ __forceinline__ int xcd_remap(int wgid, int nwg) { const int q = nwg / NXCD, r = nwg % NXCD, xcd = wgid % NXCD, off = wgid / NXCD; return (xcd < r ? xcd * (q + 1) : r * (q + 1) + (xcd - r) * q) + off; }

struct DenseOrder {
    int nM, nN, nwg, G, c, K, skip9;
    static constexpr bool GATHER = false;
    __device__ void init(int M, int N, int K_, int G_, int c_, int skip9_ = 0) { skip9 = skip9_; nM = skip9 ? (M / BM) * 8 / 9 : M / BM; nN = N / BM; nwg = nM * nN; G = G_; c = c_; K = K_; }
    __device__ bool next(int i, Unit& u) const {
        const long L = (long)i * G + c; if (L >= nwg) return false;
        const int wgid = xcd_remap((int)L, nwg);
        const int nig = WGM * nN, gid = wgid / nig, fm = gid * WGM, gsz = (nM - fm) < WGM ? (nM - fm) : WGM;
        u.pm = fm + ((wgid % nig) % gsz); u.pn = (wgid % nig) / gsz;
        if (skip9) u.pm = u.pm + u.pm / 8 + 1;
        u.aoff = (size_t)u.pm * BM * K * 2; u.boff = (size_t)u.pn * BM * K * 2; u.gbase = 0; u.nvalid = BM; u.orow0 = u.pm * BM; u.e = 0; return true;
    }
    __device__ __forceinline__ int token(const Unit&, int) const { return 0; }
};

__device__ __forceinline__ unsigned cvt_pk_bf16(float lo, float hi) { unsigned r; asm volatile("v_cvt_pk_bf16_f32 %0, %1, %2" : "=v"(r) : "v"(lo), "v"(hi)); return r; }

template <class Epi, class Sched>
__device__ __forceinline__ void gemm_phase(PG8_LAS unsigned char* lds, const Gemm g, const Sched& S, const Epi& E, int wave_id) {
    int tid = (wave_id << 6) | (int)__builtin_amdgcn_mbcnt_hi(~0u, __builtin_amdgcn_mbcnt_lo(~0u, 0u)); asm volatile("" : "+v"(tid));
    const int wid = __builtin_amdgcn_readfirstlane(tid >> 6), lane = tid & 63, wr = wid >> 2, wc = wid & 3, fr = lane & 15, fq = lane >> 4;
    const int K = g.K, nt = K / BK;
    int RA[2], CA[2];
    unsigned voffB[2], voffA[2][2], voffAn[2][2];
#pragma unroll
    for (int i = 0; i < 2; ++i) { int R, C; stage_rc(tid * 16 + i * 8192, R, C); RA[i] = R; CA[i] = C; const int Rb = Epi::PERM ? ((R & ~31) + perm32(R & 31)) : R;
        voffB[i] = (unsigned)(Rb * K + C) * 2u;
        voffA[0][i] = (unsigned)(R * K + C) * 2u; voffA[1][i] = (unsigned)((R + HALF) * K + C) * 2u; voffAn[0][i] = voffA[0][i]; voffAn[1][i] = voffA[1][i]; }
    const size_t kstep = (size_t)(BK * 2);
    const size_t hstep = (size_t)HALF * K * 2;
    const unsigned ldsw = (unsigned)wid * 1024u;
    const int aoff = lds_byte(wr * 64 + fr, fq * 8), boff = lds_byte(wc * 32 + fr, fq * 8);
#define PG8_SA(b, h) (((b) * 2 + (h)) * HTB)
#define PG8_SB(b, h) ((4 + (b) * 2 + (h)) * HTB)
#define PG8_STAGE(bufoff, gbase, voff) do { _Pragma("unroll") for (int _i = 0; _i < 2; ++_i) \
        __builtin_amdgcn_global_load_lds((const unsigned*)((const char*)(gbase) + (voff)[_i]), (PG8_LAS unsigned*)(lds + (bufoff) + ldsw + _i * 8192), 16, 0, 0); } while (0)
#define PG8_LDA(dst, b, h) do { _Pragma("unroll") for (int m = 0; m < 4; ++m) _Pragma("unroll") for (int k = 0; k < 2; ++k) dst[m][k] = *(const PG8_LAS bf16x8*)(lds + PG8_SA(b, h) + aoff + m * 2048 + k * 1024); } while (0)
#define PG8_LDB(dst, b, h) do { _Pragma("unroll") for (int n = 0; n < 2; ++n) _Pragma("unroll") for (int k = 0; k < 2; ++k) dst[n][k] = *(const PG8_LAS bf16x8*)(lds + PG8_SB(b, h) + boff + n * 2048 + k * 1024); } while (0)
#define PG8_MMA(ai, bj, At, Bt) do { __builtin_amdgcn_s_setprio(1); _Pragma("unroll") for (int m = 0; m < 4; ++m) _Pragma("unroll") for (int n = 0; n < 2; ++n) _Pragma("unroll") for (int k = 0; k < 2; ++k) \
        acc[ai][bj][m][n] = __builtin_amdgcn_mfma_f32_16x16x32_bf16(Bt[n][k], At[m][k], acc[ai][bj][m][n], 0, 0, 0); __builtin_amdgcn_s_setprio(0); } while (0)
#define PG8_WAIT_V(n) asm volatile("s_waitcnt vmcnt(" #n ")" ::: "memory")
#define PG8_WAIT_L(n) asm volatile("s_waitcnt lgkmcnt(" #n ")" ::: "memory")
#define PG8_BAR __builtin_amdgcn_s_barrier()
#define PG8_SCHED __builtin_amdgcn_sched_barrier(0)
#define PG8_GOFF(dst, U) do { if constexpr (Sched::GATHER) { _Pragma("unroll") for (int _h = 0; _h < 2; ++_h) _Pragma("unroll") for (int _i = 0; _i < 2; ++_i) \
        dst[_h][_i] = (unsigned)(S.token(U, _h * HALF + RA[_i]) * K + CA[_i]) * 2u; } } while (0)
    Unit cur, nxt; int ui = 0;
    if (!S.next(0, cur)) return;
    f32x4 acc[2][2][4][2];
#pragma unroll
    for (int a = 0; a < 2; ++a)
#pragma unroll
        for (int b = 0; b < 2; ++b)
#pragma unroll
            for (int m = 0; m < 4; ++m)
#pragma unroll
                for (int n = 0; n < 2; ++n) acc[a][b][m][n] = (f32x4){0.f, 0.f, 0.f, 0.f};
    bf16x8 At[4][2], B0[2][2], B1[2][2];
    PG8_GOFF(voffA, cur);
    const char* cA = (const char*)g.A + (Sched::GATHER ? (size_t)0 : cur.aoff); const char* cB = (const char*)g.Bt + cur.boff;
    PG8_STAGE(PG8_SB(0, 0), cB, voffB); PG8_STAGE(PG8_SA(0, 0), cA, voffA[0]); PG8_STAGE(PG8_SB(0, 1), cB + hstep, voffB); PG8_STAGE(PG8_SA(0, 1), cA, voffA[1]);
    if (wr == 1) PG8_BAR;
    PG8_WAIT_V(4); PG8_BAR;
    PG8_STAGE(PG8_SB(1, 0), cB + kstep, voffB); PG8_STAGE(PG8_SA(1, 0), cA + kstep, voffA[0]); PG8_STAGE(PG8_SB(1, 1), cB + hstep + kstep, voffB);
    PG8_WAIT_V(6); PG8_BAR;
    for (;;) {
        const bool has_next = S.next(ui + 1, nxt);
        if (has_next) { PG8_GOFF(voffAn, nxt); if constexpr (Sched::GATHER) { asm volatile("" : "+v"(voffAn[0][0]), "+v"(voffAn[0][1]), "+v"(voffAn[1][0]), "+v"(voffAn[1][1])); } }
        const char* nA = has_next ? (const char*)g.A + (Sched::GATHER ? (size_t)0 : nxt.aoff) : cA; const char* nB = has_next ? (const char*)g.Bt + nxt.boff : cB;
        for (int t = 0; t < nt; t += 2) {
            const bool last = (t == nt - 2);
            const char* a1 = cA + (size_t)(t + 1) * kstep;
            const char* a2 = last ? nA : cA + (size_t)(t + 2) * kstep; const char* b2 = last ? nB : cB + (size_t)(t + 2) * kstep;
            const char* a3 = a2 + kstep; const char* b3 = b2 + kstep;
            unsigned va2[2][2];
#pragma unroll
            for (int h = 0; h < 2; ++h)
#pragma unroll
                for (int i = 0; i < 2; ++i) va2[h][i] = (Sched::GATHER && last && has_next) ? voffAn[h][i] : voffA[h][i];
            PG8_LDB(B0, 0, 0); PG8_SCHED; PG8_LDA(At, 0, 0); PG8_STAGE(PG8_SA(1, 1), a1, voffA[1]);
            PG8_WAIT_L(8); PG8_BAR; PG8_WAIT_L(0); PG8_MMA(0, 0, At, B0); PG8_BAR; PG8_SCHED;
            PG8_LDB(B1, 0, 1); PG8_STAGE(PG8_SB(0, 0), b2, voffB);
            PG8_BAR; PG8_WAIT_L(0); PG8_MMA(0, 1, At, B1); PG8_BAR;
            PG8_LDA(At, 0, 1); PG8_STAGE(PG8_SA(0, 0), a2, va2[0]);
            PG8_BAR; PG8_WAIT_L(0); PG8_MMA(1, 0, At, B0); PG8_BAR; PG8_SCHED;
            PG8_STAGE(PG8_SB(0, 1), b2 + hstep, voffB);
            PG8_WAIT_V(6); PG8_BAR; PG8_MMA(1, 1, At, B1); PG8_BAR;
            PG8_LDB(B0, 1, 0); PG8_SCHED; PG8_LDA(At, 1, 0); PG8_STAGE(PG8_SA(0, 1), a2, va2[1]);
            PG8_WAIT_L(8); PG8_BAR; PG8_WAIT_L(0); PG8_MMA(0, 0, At, B0); PG8_BAR; PG8_SCHED;
            PG8_LDB(B1, 1, 1); PG8_STAGE(PG8_SB(1, 0), b3, voffB);
            PG8_BAR; PG8_WAIT_L(0); PG8_MMA(0, 1, At, B1); PG8_BAR;
            PG8_LDA(At, 1, 1); PG8_STAGE(PG8_SA(1, 0), a3, va2[0]);
            PG8_BAR; PG8_WAIT_L(0); PG8_MMA(1, 0, At, B0); PG8_BAR; PG8_SCHED;
            PG8_STAGE(PG8_SB(1, 1), b3 + hstep, voffB);
            PG8_WAIT_V(6); PG8_BAR; PG8_MMA(1, 1, At, B1); PG8_BAR;
        }
        E(acc, cur, wr, wc, fr, fq);
        if (!has_next) break;
#pragma unroll
        for (int a = 0; a < 2; ++a)
#pragma unroll
            for (int b = 0; b < 2; ++b)
#pragma unroll
                for (int m = 0; m < 4; ++m)
#pragma unroll
                    for (int n = 0; n < 2; ++n) acc[a][b][m][n] = (f32x4){0.f, 0.f, 0.f, 0.f};
        cur = nxt; cA = nA; cB = nB; ++ui;
        if constexpr (Sched::GATHER) {
#pragma unroll
            for (int h = 0; h < 2; ++h)
#pragma unroll
                for (int i = 0; i < 2; ++i) voffA[h][i] = voffAn[h][i];
        }
    }
    PG8_WAIT_V(0);
    if (wr == 0) PG8_BAR;
    PG8_BAR;
#undef PG8_SA
#undef PG8_SB
#undef PG8_STAGE
#undef PG8_LDA
#undef PG8_LDB
#undef PG8_MMA
#undef PG8_WAIT_V
#undef PG8_WAIT_L
#undef PG8_BAR
#undef PG8_SCHED
#undef PG8_GOFF
}
}
namespace att {
using bf16x8 = __attribute__((ext_vector_type(8))) short;
using s16x4  = __attribute__((ext_vector_type(4))) short;
using f32x16 = __attribute__((ext_vector_type(16))) float;
using u32x4  = __attribute__((ext_vector_type(4))) unsigned;
typedef unsigned short bf16_t;
constexpr int NW = 8, QBLK = 32, KVBLK = 64;
constexpr float THR = 8.f;
constexpr size_t SHM_V = KVBLK * 128 * 2, SHM_K = KVBLK * 128 * 2, SHM_ATTN = 2 * SHM_V + 2 * SHM_K + NW * 64 * 4;
#define KSWZ(row, colB) ((row) * 256 + ((colB) ^ (((row) & 7) << 4)))
#define KSWZ64(row, colB) ((row) * 128 + ((colB) ^ ((((row) >> 1) & 7) << 4)))
#define SBAR() __builtin_amdgcn_sched_barrier(0)
__device__ __forceinline__ int crow(int r, int hi) { return (r & 3) + 8 * (r >> 2) + 4 * hi; }
__device__ __forceinline__ unsigned cvtpk(float lo, float hi) { unsigned r; asm volatile("v_cvt_pk_bf16_f32 %0, %1, %2" : "=v"(r) : "v"(lo), "v"(hi)); return r; }

template <int DQK> struct Sc { static constexpr float SCALE = (DQK == 64) ? 0.125f : 0.088388347648318440f; };

template <int DQK>
__device__ __forceinline__ void partialSM(f32x16& p0, f32x16& p1, float& m_reg, float& mn, float& alpha) {
  constexpr float SCALE = Sc<DQK>::SCALE;
  constexpr float C = SCALE * 1.4426950408889634f;
  float pmax = p0[0];
#pragma unroll
  for (int r = 1; r < 16; ++r) pmax = fmaxf(pmax, p0[r]);
#pragma unroll
  for (int r = 0; r < 16; ++r) pmax = fmaxf(pmax, p1[r]);
  { auto rr = __builtin_amdgcn_permlane32_swap(__float_as_uint(pmax), __float_as_uint(pmax), false, false);
    pmax = fmaxf(__uint_as_float(rr[0]), __uint_as_float(rr[1])); }
  if (__builtin_expect(__all(pmax - m_reg <= THR / SCALE), 1)) { mn = m_reg; alpha = 1.f; }
  else { mn = fmaxf(m_reg, pmax); alpha = __builtin_amdgcn_exp2f((m_reg - mn) * C); m_reg = mn; }
  float mnC = -mn * C;
#pragma unroll
  for (int r = 0; r < 16; ++r) p0[r] = fmaf(p0[r], C, mnC);
#pragma unroll
  for (int r = 0; r < 16; ++r) p1[r] = fmaf(p1[r], C, mnC);
#pragma unroll
  for (int r = 0; r < 16; ++r) p0[r] = __builtin_amdgcn_exp2f(p0[r]);
}
__device__ __forceinline__ void finishSM(f32x16& p0, f32x16& p1, float alpha, float& l_reg, bf16x8& pa0, bf16x8& pa1, bf16x8& pa2, bf16x8& pa3) {
#pragma unroll
  for (int r = 0; r < 16; ++r) p1[r] = __builtin_amdgcn_exp2f(p1[r]);
  float ps = 0;
#pragma unroll
  for (int r = 0; r < 16; ++r) ps += p0[r];
#pragma unroll
  for (int r = 0; r < 16; ++r) ps += p1[r];
  { auto rr = __builtin_amdgcn_permlane32_swap(__float_as_uint(ps), __float_as_uint(ps), false, false);
    ps = __uint_as_float(rr[0]) + __uint_as_float(rr[1]); }
  l_reg = l_reg * alpha + ps;
#define PK4(P, BASE, OUT) do { unsigned a0 = cvtpk(P[BASE + 0], P[BASE + 1]), a1 = cvtpk(P[BASE + 2], P[BASE + 3]);   \
    unsigned b0 = cvtpk(P[BASE + 4], P[BASE + 5]), b1 = cvtpk(P[BASE + 6], P[BASE + 7]);                              \
    auto r0 = __builtin_amdgcn_permlane32_swap(a0, b0, false, false); auto r1 = __builtin_amdgcn_permlane32_swap(a1, b1, false, false); \
    u32x4 w = {r0[0], r1[0], r0[1], r1[1]}; OUT = *reinterpret_cast<bf16x8*>(&w); } while (0)
  PK4(p0, 0, pa0); PK4(p0, 8, pa1); PK4(p1, 0, pa2); PK4(p1, 8, pa3);
#undef PK4
}
template <int DQK>
__device__ __forceinline__ void qkt(f32x16& p0, f32x16& p1, const char* Ks, const bf16x8* qr, int r32, int hi) {
#pragma unroll
  for (int r = 0; r < 16; ++r) { p0[r] = 0.f; p1[r] = 0.f; }
  asm volatile("" : "+v"(p0), "+v"(p1));
#pragma unroll
  for (int d0 = 0; d0 < DQK / 16; ++d0) { const int cb = (d0 * 16 + hi * 8) * 2;
    bf16x8 b0, b1;
    if constexpr (DQK == 128) { b0 = *reinterpret_cast<const bf16x8*>(Ks + KSWZ(r32, cb)); b1 = *reinterpret_cast<const bf16x8*>(Ks + KSWZ(32 + r32, cb)); }
    else { b0 = *reinterpret_cast<const bf16x8*>(Ks + KSWZ64(r32, cb)); b1 = *reinterpret_cast<const bf16x8*>(Ks + KSWZ64(32 + r32, cb)); }
    p0 = __builtin_amdgcn_mfma_f32_32x32x16_bf16(b0, qr[d0], p0, 0, 0, 0);
    p1 = __builtin_amdgcn_mfma_f32_32x32x16_bf16(b1, qr[d0], p1, 0, 0, 0); }
}
__device__ __forceinline__ int v_st(int k, int c) { const int kk = (k & ~0xC) | ((k & 4) << 1) | ((k & 8) >> 1); return ((kk >> 3) * 4 + (c >> 5)) * 512 + ((kk & 7) * 32 + (c & 31)) * 2; }
__device__ __forceinline__ int v_rd_base(int lane) { return ((lane & 3) << 3) | (((lane >> 2) & 3) << 6) | (((lane >> 4) & 1) << 5) | (((lane >> 5) & 1) << 8); }
constexpr int v_rd_off(int d0, int ks, int half) { return d0 * 512 + ks * 4096 + half * 2048; }
template <int OFF> __device__ __forceinline__ s16x4 tr_read(int vb) {
  s16x4 r; asm volatile("ds_read_b64_tr_b16 %0, %1 offset:%2" : "=&v"(r) : "v"(vb), "i"(OFF) : "memory"); return r;
}
template <int D0> __device__ __forceinline__ void pv_one(f32x16& od, int vb, bf16x8 pa0, bf16x8 pa1, bf16x8 pa2, bf16x8 pa3) {
  const s16x4 l0 = tr_read<v_rd_off(D0, 0, 0)>(vb), h0 = tr_read<v_rd_off(D0, 0, 1)>(vb), l1 = tr_read<v_rd_off(D0, 1, 0)>(vb), h1 = tr_read<v_rd_off(D0, 1, 1)>(vb);
  const s16x4 l2 = tr_read<v_rd_off(D0, 2, 0)>(vb), h2 = tr_read<v_rd_off(D0, 2, 1)>(vb), l3 = tr_read<v_rd_off(D0, 3, 0)>(vb), h3 = tr_read<v_rd_off(D0, 3, 1)>(vb);
  asm volatile("s_waitcnt lgkmcnt(0)" ::: "memory"); SBAR();
#define PK(L, H) (bf16x8){L[0], L[1], L[2], L[3], H[0], H[1], H[2], H[3]}
  od = __builtin_amdgcn_mfma_f32_32x32x16_bf16(pa0, PK(l0, h0), od, 0, 0, 0);
  od = __builtin_amdgcn_mfma_f32_32x32x16_bf16(pa1, PK(l1, h1), od, 0, 0, 0);
  od = __builtin_amdgcn_mfma_f32_32x32x16_bf16(pa2, PK(l2, h2), od, 0, 0, 0);
  od = __builtin_amdgcn_mfma_f32_32x32x16_bf16(pa3, PK(l3, h3), od, 0, 0, 0);
#undef PK
}
__device__ __forceinline__ void pv_d0(f32x16* o, int vb, bf16x8 pa0, bf16x8 pa1, bf16x8 pa2, bf16x8 pa3) {
  pv_one<0>(o[0], vb, pa0, pa1, pa2, pa3); pv_one<1>(o[1], vb, pa0, pa1, pa2, pa3); pv_one<2>(o[2], vb, pa0, pa1, pa2, pa3); pv_one<3>(o[3], vb, pa0, pa1, pa2, pa3);
}

template <int DQK, int LDQ, int LDK, int LDO>
__device__ __forceinline__ void attn_body(const bf16_t* __restrict__ Qb, const bf16_t* __restrict__ Kh, const bf16_t* __restrict__ Vh, bf16_t* __restrict__ Ob, int seq, char* lds, int wave_id) {
  int tid = (wave_id << 6) | (int)__builtin_amdgcn_mbcnt_hi(~0u, __builtin_amdgcn_mbcnt_lo(~0u, 0u)); asm volatile("" : "+v"(tid));
  const int wid = tid >> 6, lane = tid & 63, r32 = lane & 31, hi = lane >> 5;
  char* V_lds = lds; char* K_lds = lds + 2 * SHM_V;
  float* ws = (float*)(lds + 2 * SHM_V + 2 * SHM_K) + wid * 64; float* li_l = ws; float* al_l = ws + 32;
  float m_reg = -1e30f, l_reg = 0; f32x16 o[4] = {}; bf16x8 qr[DQK / 16];
  const bf16_t* Qw = Qb + (long)(wid * QBLK + r32) * LDQ + hi * 8;
#pragma unroll
  for (int d0 = 0; d0 < DQK / 16; ++d0) qr[d0] = *reinterpret_cast<const bf16x8*>(Qw + d0 * 16);
  const int sr = tid >> 4, sc = (tid & 15) * 8, vst0 = v_st(sr, sc), vst1 = v_st(32 + sr, sc);
  const int kr64 = tid >> 3, kc64 = (tid & 7) * 8;
  const int vb0 = (int)(uintptr_t)V_lds + v_rd_base(lane);
  struct { bf16x8 vs0, vs1, ks0, ks1; } sr_[2];
#define SLOAD(i, k0) do { sr_[i].vs0 = *reinterpret_cast<const bf16x8*>(&Vh[(long)((k0) + sr) * LDK + sc]); sr_[i].vs1 = *reinterpret_cast<const bf16x8*>(&Vh[(long)((k0) + 32 + sr) * LDK + sc]); \
    if constexpr (DQK == 128) { sr_[i].ks0 = *reinterpret_cast<const bf16x8*>(&Kh[(long)((k0) + sr) * LDK + sc]); sr_[i].ks1 = *reinterpret_cast<const bf16x8*>(&Kh[(long)((k0) + 32 + sr) * LDK + sc]); } \
    else { sr_[i].ks0 = *reinterpret_cast<const bf16x8*>(&Kh[(long)((k0) + kr64) * LDK + kc64]); } } while (0)
#define SWRITE(b, i) do { *(bf16x8*)(V_lds + (b) * SHM_V + vst0) = sr_[i].vs0;          \
    *(bf16x8*)(V_lds + (b) * SHM_V + vst1) = sr_[i].vs1;               \
    if constexpr (DQK == 128) { const int kc = sc * 2; *(bf16x8*)(K_lds + (b) * SHM_K + KSWZ(sr, kc)) = sr_[i].ks0; *(bf16x8*)(K_lds + (b) * SHM_K + KSWZ(32 + sr, kc)) = sr_[i].ks1; } \
    else { const int kc = kc64 * 2; *(bf16x8*)(K_lds + (b) * SHM_K + KSWZ64(kr64, kc)) = sr_[i].ks0; } } while (0)
#define SWAIT() do { if constexpr (DQK == 128) asm volatile("s_waitcnt vmcnt(4)" ::: "memory"); else asm volatile("s_waitcnt vmcnt(3)" ::: "memory"); } while (0)
#define RESC(a) do { if (__any((a) < 1.f)) { if (hi == 0) al_l[r32] = (a); asm volatile("s_waitcnt lgkmcnt(0)" ::: "memory"); \
    _Pragma("unroll") for (int d = 0; d < 4; ++d) _Pragma("unroll") for (int r = 0; r < 16; ++r) o[d][r] *= al_l[crow(r, hi)]; } } while (0)
  f32x16 pA0, pA1, pB0, pB1; float mnA, mnB, alA, alB; bf16x8 pa0, pa1, pa2, pa3; const int NT = seq / KVBLK;
  constexpr int SE = 0, SO = 1;
  SLOAD(SE, 0); asm volatile("s_waitcnt vmcnt(0)" ::: "memory"); SWRITE(0, SE); __syncthreads();
  qkt<DQK>(pA0, pA1, K_lds, qr, r32, hi); partialSM<DQK>(pA0, pA1, m_reg, mnA, alA);
  SLOAD(SO, KVBLK); if (2 < NT) SLOAD(SE, 2 * KVBLK);
  if (2 < NT) { SWAIT(); } else { asm volatile("s_waitcnt vmcnt(0)" ::: "memory"); }
  SWRITE(1, SO); __syncthreads();
  for (int j = 1; j + 1 < NT; j += 2) {
    SBAR(); qkt<DQK>(pB0, pB1, K_lds + SHM_K, qr, r32, hi);
    finishSM(pA0, pA1, alA, l_reg, pa0, pa1, pa2, pa3); SBAR();
    SLOAD(SO, (j + 2) * KVBLK); SBAR();
    pv_d0(o, vb0, pa0, pa1, pa2, pa3); partialSM<DQK>(pB0, pB1, m_reg, mnB, alB);
    __syncthreads(); SWAIT(); SWRITE(0, SE);
    RESC(alB); __syncthreads();
    SBAR(); qkt<DQK>(pA0, pA1, K_lds, qr, r32, hi);
    finishSM(pB0, pB1, alB, l_reg, pa0, pa1, pa2, pa3); SBAR();
    if (j + 3 < NT) SLOAD(SE, (j + 3) * KVBLK); SBAR();
    pv_d0(o, vb0 + (int)SHM_V, pa0, pa1, pa2, pa3); partialSM<DQK>(pA0, pA1, m_reg, mnA, alA);
    __syncthreads(); if (j + 3 < NT) { SWAIT(); } else { asm volatile("s_waitcnt vmcnt(0)" ::: "memory"); } SWRITE(1, SO);
    RESC(alA); __syncthreads();
  }
  SBAR(); qkt<DQK>(pB0, pB1, K_lds + SHM_K, qr, r32, hi);
  finishSM(pA0, pA1, alA, l_reg, pa0, pa1, pa2, pa3); SBAR();
  pv_d0(o, vb0, pa0, pa1, pa2, pa3); partialSM<DQK>(pB0, pB1, m_reg, mnB, alB);
  __syncthreads(); RESC(alB);
  finishSM(pB0, pB1, alB, l_reg, pa0, pa1, pa2, pa3); SBAR();
  pv_d0(o, vb0 + (int)SHM_V, pa0, pa1, pa2, pa3);
  if (hi == 0) li_l[r32] = l_reg; asm volatile("s_waitcnt lgkmcnt(0)" ::: "memory");
  float rli[16];
#pragma unroll
  for (int r = 0; r < 16; ++r) rli[r] = __builtin_amdgcn_rcpf(li_l[crow(r, hi)]);
  bf16_t* Ow = Ob + (long)(wid * QBLK) * LDO;
#pragma unroll
  for (int r = 0; r < 16; ++r) { const int orow = crow(r, hi);
#pragma unroll
    for (int d0 = 0; d0 < 4; ++d0) { const float v = o[d0][r] * rli[r]; Ow[(long)orow * LDO + d0 * 32 + r32] = (bf16_t)(cvtpk(v, v) & 0xffffu); } }
  __syncthreads();
#undef SLOAD
#undef SWRITE
#undef SWAIT
#undef RESC
}
#undef SBAR
}
constexpr int NWAVES = 8, NTHR = 512;
constexpr int NB = 8, SEQ = 2048, CTXL = 256, TPB = CTXL + SEQ  , MROWS = NB * TPB  , DM = 1024;
constexpr int A_W = 512, A_IN = 1920, B_IN = 1536, EVEN_IN = 3456, EVEN_PAD = 3584, ODD_IN = 1536;
constexpr int NEXP = 16, EFF = 512, CAP = MROWS, MOE_ROWS = 40960;
constexpr float LN_EPS = 1e-5f, ALPHA = 1.4142135623730951f, GN_EPS = 64e-5f, SUBLN_EPS = 1e-5f, QKN_EPS = 1e-6f, LAMBDA_INIT0 = 0.2f;

constexpr size_t MiB = 1u << 20;
constexpr size_t WS_CTL = 0, CTL_ZERO_BYTES = 1 * MiB;
constexpr size_t WS_MOD = 1 * MiB;
constexpr size_t WS_ROPE = 2 * MiB;
constexpr size_t WS_WEVIN = 4 * MiB, WS_WEVOUT = 11 * MiB, WS_WODIN = 13 * MiB, WS_WODOUT = 16 * MiB;
constexpr size_t WS_WM13 = 18 * MiB, WS_WM2 = 50 * MiB;
constexpr size_t WS_H = 66 * MiB;
constexpr size_t WS_X = 102 * MiB;
constexpr size_t CH_BYTES = (size_t)4608 * 64 * 64 * 2;
constexpr size_t WS_CHG = 18 * MiB, WS_CHH = 54 * MiB, WS_CHRQ = 90 * MiB, WS_CHY = 126 * MiB;
constexpr size_t FEAT_BYTES = (size_t)MROWS * 512 * 2;
constexpr size_t WS_VOUT = 162 * MiB, WS_GOUT = 180 * MiB;
constexpr size_t WS_PA = 198 * MiB;
constexpr size_t WS_PB = 270 * MiB;
constexpr size_t WS_GL = 324 * MiB;
constexpr size_t WS_BON = WS_GL + (size_t)4608 * 64 * 4;
constexpr size_t WS_LORA = WS_BON + (size_t)2 * MROWS * 8 * 4;
constexpr size_t WS_OB0 = WS_PA, WS_OB1 = WS_PA + FEAT_BYTES;
constexpr size_t WS_A2 = WS_PA + 2 * FEAT_BYTES;
constexpr size_t WS_TAIL = 300 * MiB;
constexpr size_t WS_MIX = WS_TAIL;
constexpr size_t WS_HID = 174 * MiB;
constexpr size_t WS_Y = 214 * MiB;
constexpr size_t WS_QKV1 = 174 * MiB;
constexpr size_t WS_OATT = 228 * MiB;
static_assert(WS_CHY + CH_BYTES <= WS_VOUT && WS_GOUT + FEAT_BYTES <= WS_PA && WS_A2 + 2 * FEAT_BYTES <= WS_PB && WS_PB + (size_t)MROWS * 1536 * 2 <= WS_GL && WS_LORA + 393216 <= 328 * MiB
              && WS_Y + (size_t)MOE_ROWS * 1024 * 2 <= WS_TAIL && WS_OATT + 2 * FEAT_BYTES <= WS_TAIL && WS_MIX + 2 * FEAT_BYTES <= 336 * MiB && WS_A2 >= WS_HID + 40 * MiB - 40 * MiB, "ws map");
constexpr int CW_BAR = 4096;
constexpr int CW_CNT = 16384;
constexpr size_t WS_ROUTE = 336 * MiB;
constexpr size_t WS_PERM_ = WS_ROUTE, WS_GATE = WS_ROUTE + (size_t)NEXP * CAP * 4, WS_TOK = WS_GATE + (size_t)NEXP * CAP * 4, WS_TOTAL = WS_TOK + (size_t)MROWS * 2 * 4;
static_assert(WS_TOTAL <= 339 * MiB, "ws total");

constexpr int RING_OFF = 0, RING_BYTES = 147456;
constexpr int LDSCTL_OFF = RING_BYTES, MISC_OFF = LDSCTL_OFF + 320;
constexpr int MOETAB_OFF = LDSCTL_OFF + 1024;
constexpr int LDS_BYTES = 163840;

#define GAS __attribute__((address_space(1)))
#define LAS __attribute__((address_space(3)))
typedef unsigned short bf16;
typedef unsigned v4u __attribute__((ext_vector_type(4)));
typedef unsigned v2u __attribute__((ext_vector_type(2)));
typedef float f32x4 __attribute__((ext_vector_type(4)));
typedef short bf16x8 __attribute__((ext_vector_type(8)));
typedef GAS unsigned gu32;
#define RLX_AGENT __ATOMIC_RELAXED, __HIP_MEMORY_SCOPE_AGENT
#define LDS_WAIT() asm volatile("s_waitcnt lgkmcnt(0)" ::: "memory")
#define VM_WAIT() asm volatile("s_waitcnt vmcnt(0)" ::: "memory")
__device__ __forceinline__ unsigned f2bf(float f) { unsigned u = __builtin_bit_cast(unsigned, f); return (u + 0x7fffu + ((u >> 16) & 1u)) >> 16; }
__device__ __forceinline__ unsigned pk2(float lo, float hi) { return f2bf(lo) | (f2bf(hi) << 16); }
__device__ __forceinline__ float bf2f(unsigned short b) { return __builtin_bit_cast(float, (unsigned)b << 16); }
__device__ __forceinline__ float bflo(unsigned w) { return __builtin_bit_cast(float, w << 16); }
__device__ __forceinline__ float bfhi(unsigned w) { return __builtin_bit_cast(float, w & 0xffff0000u); }
__device__ __forceinline__ float sigmoidf_(float x) { return 1.f / (1.f + __expf(-x)); }
template <int CTRL> __device__ __forceinline__ float dpp_f(float v) { return __builtin_bit_cast(float, __builtin_amdgcn_update_dpp(0, __builtin_bit_cast(int, v), CTRL, 0xF, 0xF, false)); }
__device__ __forceinline__ float sum4(float v) { v += dpp_f<0xB1>(v); v += dpp_f<0x4E>(v); return v; }
__device__ __forceinline__ float sum8(float v) { v = sum4(v); v += dpp_f<0x141>(v); return v; }
__device__ __forceinline__ float sum16(float v) { v = sum8(v); v += dpp_f<0x140>(v); return v; }
__device__ __forceinline__ float wave_sum(float v) {
    v = sum16(v);
    v += __builtin_bit_cast(float, __builtin_amdgcn_update_dpp(0, __builtin_bit_cast(int, v), 0x142, 0xA, 0xF, false));
    v += __builtin_bit_cast(float, __builtin_amdgcn_update_dpp(0, __builtin_bit_cast(int, v), 0x143, 0xC, 0xF, false));
    return __builtin_bit_cast(float, __builtin_amdgcn_readlane(__builtin_bit_cast(int, v), 63));
}

#define XB_TMO      128
#define XB_XCNT(j)  (256  + 64 * (j))
#define XB_XSUB(j)  (1280 + 64 * (j))
#define XB_XGEN(j)  (2304 + 64 * (j))
#define XB_TOP      3328
#define XB_TOPGEN   3392
#define XCD_BAR_WORDS 3456
#define XB_SPIN_CAP (1u << 22)
__device__ __forceinline__ unsigned xb_ld(unsigned* p)              { return __hip_atomic_load(p, __ATOMIC_RELAXED, __HIP_MEMORY_SCOPE_AGENT); }
__device__ __forceinline__ unsigned xb_add(unsigned* p, unsigned v) { return __hip_atomic_fetch_add(p, v, __ATOMIC_RELAXED, __HIP_MEMORY_SCOPE_AGENT); }
__device__ __forceinline__ unsigned xb_xcc_id() { return (unsigned)__builtin_amdgcn_s_getreg((3 << 11) | 20) & 0xFu; }
#define XB_SPIN(cond, bar) do { unsigned _sp = 0; while (cond) { __builtin_amdgcn_s_sleep(1); \
    if ((++_sp & 255u) == 0u) { if (xb_ld(&(bar)[XB_TMO])) break; if (_sp > XB_SPIN_CAP) { atomicAdd(&(bar)[XB_TMO], 1u); break; } } } } while (0)
struct XcdBarrier { unsigned* bar; unsigned x; volatile LAS unsigned* st; };
__device__ __forceinline__ XcdBarrier xcd_barrier_post(unsigned* bar, volatile LAS unsigned* st) {
    XcdBarrier b; b.bar = bar; b.x = xb_xcc_id(); b.st = st;
    if (threadIdx.x == 0) (void)xb_add(&bar[XB_XCNT(b.x)], 1u);
    return b;
}
__device__ __forceinline__ void xcd_barrier_complete(unsigned* bar, unsigned x, unsigned& nloc, unsigned& nx) {
    const unsigned G = gridDim.x * gridDim.y * gridDim.z;
    unsigned sum, cnt, mine, sp = 0u;
    for (;;) {
        sum = 0u; cnt = 0u; mine = 0u;
#pragma unroll
        for (unsigned j = 0; j < 16; ++j) { const unsigned c = xb_ld(&bar[XB_XCNT(j)]); sum += c; cnt += (c > 0u) ? 1u : 0u; mine = (j == x) ? c : mine; }
        if (sum == G) break;
        __builtin_amdgcn_s_sleep(1);
        if ((++sp & 255u) == 0u) { if (xb_ld(&bar[XB_TMO])) break; if (sp > XB_SPIN_CAP) { atomicAdd(&bar[XB_TMO], 1u); break; } }
    }
    nloc = mine > 0u ? mine : 1u; nx = cnt > 0u ? cnt : 1u;
}
__device__ __forceinline__ void xcd_barrier(const XcdBarrier& b) {
    asm volatile("s_waitcnt vmcnt(0)" ::: "memory");
    __syncthreads();
    if (threadIdx.x == 0) {
        unsigned* bar = b.bar;
        __builtin_amdgcn_s_waitcnt(0);
        unsigned nloc = b.st[0], nx = b.st[1];
        if (nloc == 0u) { xcd_barrier_complete(bar, b.x, nloc, nx); b.st[0] = nloc; b.st[1] = nx; }
        const unsigned old = xb_add(&bar[XB_XSUB(b.x)], 1u);
        const unsigned gen = old / nloc;
        if (old + 1u == (gen + 1u) * nloc) {
            __builtin_amdgcn_fence(__ATOMIC_RELEASE, "agent");
            asm volatile("s_waitcnt vmcnt(0)" ::: "memory");
            const unsigned og = xb_add(&bar[XB_TOP], 1u);
            const unsigned tg = og / nx;
            if (og + 1u == (tg + 1u) * nx) xb_add(&bar[XB_TOPGEN], 1u);
            else XB_SPIN(xb_ld(&bar[XB_TOPGEN]) == tg, bar);
            __builtin_amdgcn_fence(__ATOMIC_ACQUIRE, "agent");
            xb_add(&bar[XB_XGEN(b.x)], 1u);
            asm volatile("s_waitcnt vmcnt(0)" ::: "memory");
        } else {
            XB_SPIN(xb_ld(&bar[XB_XGEN(b.x)]) == gen, bar);
            __builtin_amdgcn_fence(__ATOMIC_ACQUIRE, "agent");
            asm volatile("s_waitcnt vmcnt(0)" ::: "memory");
        }
    }
    __syncthreads();
}

struct Args { const float* in[34]; float* out; unsigned char* ws; };
struct Frame {
    LAS unsigned char* lds; char* ldsg;
    int tid, lane, wave, G, bid;
    const float* const* in; float* out; unsigned char* ws;
};
enum { I_X = 0, I_C, I_CTX, I_CCTX, I_RW, I_RB, I_ADAW, I_ADAB, I_LN1G, I_LN1B, I_LN2G, I_LN2B, I_W1, I_W3, I_W2, I_EVWIN, I_EVWOUT, I_AMU, I_AW0, I_AW2, I_AA0, I_AA2,
       I_AG2, I_AKK, I_AKA, I_ARK, I_LNXG, I_LNXB, I_BLAM, I_SUBG, I_ODWIN, I_ODWOUT, I_QNG, I_KNG };

__device__ __forceinline__ const float* x0_row(const Frame& F, int row) {
    const int b = row / TPB, tt = row - b * TPB;
    return tt < CTXL ? F.in[I_CTX] + ((size_t)b * CTXL + tt) * DM : F.in[I_X] + ((size_t)b * SEQ + (tt - CTXL)) * DM;
}
__device__ __forceinline__ const float* mod_ptr(const Frame& F, int layer, int row, int idx) {
    const int b = row / TPB, tt = row - b * TPB; const int r = tt < CTXL ? 8 : b;
    return (const float*)(F.ws + WS_MOD) + ((size_t)(layer * 9 + r) * 6 + idx) * DM;
}
__device__ __forceinline__ void transpose_item(const float* W, int K, int N, bf16* WT, int mode, LAS float* scr, int item, int lane) {
    const int nblk = N / 64, kb = item / nblk, nb = item % nblk, k0 = 64 * kb, n0 = 64 * nb;
    float v[64];
#pragma unroll
    for (int i = 0; i < 64; ++i) v[i] = __builtin_nontemporal_load(W + (size_t)(k0 + i) * N + n0 + lane);
#pragma unroll
    for (int i = 0; i < 64; ++i) scr[i * 65 + lane] = v[i];
    LDS_WAIT(); asm volatile("" ::: "memory");
    const int c = lane & 7;
#pragma unroll
    for (int j = 0; j < 8; ++j) { const int n = (lane >> 3) + 8 * j; const LAS float* s = scr + (8 * c) * 65 + n;
        v4u o; o.x = pk2(s[0 * 65], s[1 * 65]); o.y = pk2(s[2 * 65], s[3 * 65]); o.z = pk2(s[4 * 65], s[5 * 65]); o.w = pk2(s[6 * 65], s[7 * 65]);
        const int ng = n0 + n; const int nd = mode == 0 ? ng : (8 * (ng >> 2) + 4 * (mode - 1) + (ng & 3));
        *(GAS v4u*)(WT + (size_t)nd * K + k0 + 8 * c) = o; }
    LDS_WAIT(); asm volatile("" ::: "memory");
}
__device__ __forceinline__ void convert_moe_weights(Frame& F, int layer) {
    LAS float* scr = (LAS float*)(F.lds + RING_OFF + F.wave * 16896);
    const int gw = F.bid * NWAVES + F.wave, NGW = F.G * NWAVES;
    constexpr int I13 = (DM / 64) * (EFF / 64)  , I2 = (EFF / 64) * (DM / 64)  ;
    bf16* W13 = (bf16*)(F.ws + WS_WM13); bf16* W2 = (bf16*)(F.ws + WS_WM2);
    for (int it = gw; it < NEXP * (2 * I13 + I2); it += NGW) {
        const int e = it / (2 * I13 + I2); int r = it % (2 * I13 + I2);
        const size_t wofs = ((size_t)layer * NEXP + e) * DM * EFF;
        if (r < I13) { transpose_item(F.in[I_W1] + wofs, DM, EFF, W13 + (size_t)e * 1024 * DM, 1, scr, r, F.lane); continue; } r -= I13;
        if (r < I13) { transpose_item(F.in[I_W3] + wofs, DM, EFF, W13 + (size_t)e * 1024 * DM, 2, scr, r, F.lane); continue; } r -= I13;
        transpose_item(F.in[I_W2] + wofs, EFF, DM, W2 + (size_t)e * DM * EFF, 0, scr, r, F.lane);
    }
}
__device__ __forceinline__ void p_prologue(Frame& F) {
    LAS float* scr = (LAS float*)(F.lds + RING_OFF + F.wave * 16896);
    const int gw = F.bid * NWAVES + F.wave, NGW = F.G * NWAVES;
    constexpr int I_A = (DM / 64) * (EVEN_IN / 64), I_B = (DM / 64) * (DM / 64), I_C_ = (DM / 64) * (ODD_IN / 64);
    for (int it = gw; it < I_A + 2 * I_B + I_C_; it += NGW) {
        int r = it;
        if (r < I_A) { transpose_item(F.in[I_EVWIN], DM, EVEN_IN, (bf16*)(F.ws + WS_WEVIN), 0, scr, r, F.lane); continue; } r -= I_A;
        if (r < I_B) { transpose_item(F.in[I_EVWOUT], DM, DM, (bf16*)(F.ws + WS_WEVOUT), 0, scr, r, F.lane); continue; } r -= I_B;
        if (r < I_C_) { transpose_item(F.in[I_ODWIN], DM, ODD_IN, (bf16*)(F.ws + WS_WODIN), 0, scr, r, F.lane); continue; } r -= I_C_;
        transpose_item(F.in[I_ODWOUT], DM, DM, (bf16*)(F.ws + WS_WODOUT), 0, scr, r, F.lane);
    }
    {
        v4u* z = (v4u*)((bf16*)(F.ws + WS_WEVIN) + (size_t)EVEN_IN * DM); const int n16 = (EVEN_PAD - EVEN_IN) * DM * 2 / 16;
        for (int i = F.bid * NTHR + F.tid; i < n16; i += F.G * NTHR) z[i] = (v4u){0u, 0u, 0u, 0u};
    }
    {
        bf16* W2T = (bf16*)(F.ws + WS_LORA); bf16* A2T = W2T + 2 * 512 * 64; bf16* G2T = A2T + 2 * 512 * 64;
        for (int i = F.bid * NTHR + F.tid; i < 3 * 65536; i += F.G * NTHR) {
            const int which = i >> 16, r = i & 65535;
            if (which < 2) { const int d = r >> 15, c = (r >> 6) & 511, l = r & 63; const float v = (which == 0 ? F.in[I_AW2] : F.in[I_AA2])[((size_t)d * 64 + l) * 512 + c]; (which == 0 ? W2T : A2T)[r] = (bf16)f2bf(v); }
            else { const int c = r >> 7, j = r & 127; G2T[r] = (bf16)f2bf(F.in[I_AG2][(size_t)j * 512 + c]); }
        }
    }
    {
        float* cosB = (float*)(F.ws + WS_ROPE); float* sinB = cosB + SEQ * 32; float* cosC = sinB + SEQ * 32; float* sinC = cosC + SEQ * 64;
        for (int i = F.bid * NTHR + F.tid; i < SEQ * 96; i += F.G * NTHR) {
            if (i < SEQ * 32) { const int t = i >> 5, j = i & 31; const float pos = (float)(j < 16 ? (t >> 6) : (t & 63)); const int f = j & 15;
                const float inv = powf(10000.f, -(float)(2 * f) / 32.f); const float ang = pos * inv; cosB[i] = cosf(ang); sinB[i] = sinf(ang); }
            else { const int ii = i - SEQ * 32; const int t = ii >> 6, j = ii & 63; const float pos = (float)(j < 32 ? (t >> 6) : (t & 63)); const int f = j & 31;
                const float inv = powf(10000.f, -(float)(2 * f) / 64.f); const float ang = pos * inv; cosC[ii] = cosf(ang); sinC[ii] = sinf(ang); }
        }
    }
    __syncthreads();
    if (F.bid < 192) {
        LAS float* sv = (LAS float*)(F.lds + RING_OFF);
        LAS float* red = sv + 9 * 1024;
        for (int i = F.tid; i < 9 * 1024; i += NTHR) { const int r = i >> 10, k = i & 1023; const float c = r < 8 ? F.in[I_C][r * DM + k] : F.in[I_CCTX][k]; sv[i] = c * sigmoidf_(c); }
        __syncthreads();
        for (int it = F.bid; it < 192; it += F.G) {
            const int l = it / 96, cb = it % 96, col = cb * 64 + F.lane;
            const float* w = F.in[I_ADAW] + (size_t)l * DM * 6144 + col;
            float acc[9];
#pragma unroll
            for (int r = 0; r < 9; ++r) acc[r] = 0.f;
            for (int k = F.wave * 128; k < F.wave * 128 + 128; ++k) { const float wv = w[(size_t)k * 6144];
#pragma unroll
                for (int r = 0; r < 9; ++r) acc[r] += sv[r * 1024 + k] * wv; }
#pragma unroll
            for (int r = 0; r < 9; ++r) red[(F.wave * 9 + r) * 64 + F.lane] = acc[r];
            __syncthreads();
            for (int i = F.tid; i < 9 * 64; i += NTHR) { const int r = i >> 6, c = i & 63; float s = 0.f;
#pragma unroll
                for (int w8 = 0; w8 < 8; ++w8) s += red[(w8 * 9 + r) * 64 + c];
                const int cc = cb * 64 + c;
                ((float*)(F.ws + WS_MOD))[(size_t)(l * 9 + r) * 6144 + cc] = s + F.in[I_ADAB][l * 6144 + cc]; }
            __syncthreads();
        }
    }
}

struct Row16 { f32x4 v[4]; };
__device__ __forceinline__ Row16 ld_row_f32(const float* p, int lane) { Row16 r; const f32x4* q = (const f32x4*)p + lane;
#pragma unroll
    for (int j = 0; j < 4; ++j) r.v[j] = q[64 * j]; return r; }
__device__ __forceinline__ Row16 ld_row_bf16(const bf16* p, int lane) { Row16 r; const v2u* q = (const v2u*)p + lane;
#pragma unroll
    for (int j = 0; j < 4; ++j) { const v2u w = q[64 * j]; r.v[j] = (f32x4){bflo(w.x), bfhi(w.x), bflo(w.y), bfhi(w.y)}; } return r; }
__device__ __forceinline__ void st_row_f32(float* p, int lane, const Row16& r) { f32x4* q = (f32x4*)p + lane;
#pragma unroll
    for (int j = 0; j < 4; ++j) q[64 * j] = r.v[j]; }
__device__ __forceinline__ void st_row_bf16(bf16* p, int lane, const Row16& r) { v2u* q = (v2u*)p + lane;
#pragma unroll
    for (int j = 0; j < 4; ++j) q[64 * j] = (v2u){pk2(r.v[j].x, r.v[j].y), pk2(r.v[j].z, r.v[j].w)}; }
__device__ __forceinline__ Row16 layer_norm(const Row16& x, const float* g, const float* b, int lane) {
    float s = 0.f;
#pragma unroll
    for (int j = 0; j < 4; ++j) s += (x.v[j].x + x.v[j].y) + (x.v[j].z + x.v[j].w);
    const float mean = wave_sum(s) * (1.f / DM); float s2 = 0.f; Row16 d;
#pragma unroll
    for (int j = 0; j < 4; ++j) { d.v[j] = x.v[j] - mean; s2 += (d.v[j].x * d.v[j].x + d.v[j].y * d.v[j].y) + (d.v[j].z * d.v[j].z + d.v[j].w * d.v[j].w); }
    const float rstd = 1.f / sqrtf(wave_sum(s2) * (1.f / DM) + LN_EPS);
    const Row16 gg = ld_row_f32(g, lane), bb = ld_row_f32(b, lane); Row16 o;
#pragma unroll
    for (int j = 0; j < 4; ++j) o.v[j] = d.v[j] * rstd * gg.v[j] + bb.v[j];
    return o;
}
__device__ __forceinline__ Row16 modulate(const Row16& x, const float* shift, const float* scale, int lane) {
    const Row16 sh = ld_row_f32(shift, lane), sc = ld_row_f32(scale, lane); Row16 o;
#pragma unroll
    for (int j = 0; j < 4; ++j) o.v[j] = x.v[j] * (1.f + sc.v[j]) + sh.v[j];
    return o;
}

__device__ __forceinline__ void p_mod0(Frame& F) {
    const int gw = F.bid * NWAVES + F.wave, NGW = F.G * NWAVES;
    for (int row = gw; row < MROWS; row += NGW) {
        const Row16 x = ld_row_f32(x0_row(F, row), F.lane);
        const Row16 h = modulate(x, mod_ptr(F, 0, row, 0), mod_ptr(F, 0, row, 1), F.lane);
        st_row_bf16((bf16*)(F.ws + WS_H) + (size_t)row * DM, F.lane, h);
    }
}

template <int LAYER>
__device__ __forceinline__ void p_ln_route(Frame& F) {
    LAS float* rwT = (LAS float*)(F.lds + RING_OFF);
    LAS int* lcnt = (LAS int*)(F.lds + RING_OFF + 65536);
    LAS int* rinfo = lcnt + 32;
    for (int i = F.tid; i < DM * NEXP; i += NTHR) { const int k = i >> 4, e = i & 15; rwT[e * DM + k] = F.in[I_RW][i]; }
    if (F.tid < 32) lcnt[F.tid] = 0;
    __syncthreads();
    const int rows_per = (MROWS + F.G - 1) / F.G, row_lo = F.bid * rows_per, row_hi = (row_lo + rows_per < MROWS) ? row_lo + rows_per : MROWS;
    float* X = (float*)(F.ws + WS_X); bf16* H = (bf16*)(F.ws + WS_H); const bf16* MIX = (const bf16*)(F.ws + WS_MIX);
    unsigned* cnt = (unsigned*)(F.ws + WS_CTL) + CW_CNT + LAYER * 64;
    int* PERM = (int*)(F.ws + WS_PERM_); float* GATE = (float*)(F.ws + WS_GATE); int* TOK = (int*)(F.ws + WS_TOK);
    for (int row = row_lo + F.wave; row < row_hi; row += NWAVES) {
        const int b = row / TPB, tt = row - b * TPB; const int li = row - row_lo;
        if (LAYER == 1 && tt < CTXL) { if (F.lane == 0) rinfo[li * 4] = -1; continue; }
        const Row16 xin = LAYER == 0 ? ld_row_f32(x0_row(F, row), F.lane) : ld_row_f32(X + (size_t)row * DM, F.lane);
        const Row16 mix = ld_row_bf16(MIX + (size_t)row * DM, F.lane);
        const Row16 gate = ld_row_f32(mod_ptr(F, LAYER, row, 2), F.lane);
        Row16 pre;
#pragma unroll
        for (int j = 0; j < 4; ++j) pre.v[j] = ALPHA * xin.v[j] + gate.v[j] * mix.v[j];
        const Row16 x1 = layer_norm(pre, F.in[I_LN1G] + LAYER * DM, F.in[I_LN1B] + LAYER * DM, F.lane);
        st_row_f32(X + (size_t)row * DM, F.lane, x1);
        const Row16 h = modulate(x1, mod_ptr(F, LAYER, row, 3), mod_ptr(F, LAYER, row, 4), F.lane);
        st_row_bf16(H + (size_t)row * DM, F.lane, h);
        float lg[NEXP];
#pragma unroll
        for (int e = 0; e < NEXP; ++e) { float s = 0.f;
#pragma unroll
            for (int j = 0; j < 4; ++j) { const f32x4 w = *((const LAS f32x4*)(rwT + e * DM) + F.lane + 64 * j); s += (h.v[j].x * w.x + h.v[j].y * w.y) + (h.v[j].z * w.z + h.v[j].w * w.w); }
            lg[e] = wave_sum(s) + F.in[I_RB][e]; if ((e & 3) == 3) asm volatile("" ::: "memory"); }
        if (F.lane == 0) {
            float mx = lg[0];
#pragma unroll
            for (int e = 1; e < NEXP; ++e) mx = fmaxf(mx, lg[e]);
            float p[NEXP];
#pragma unroll
            for (int e = 0; e < NEXP; ++e) p[e] = expf(lg[e] - mx);
            int best = 0; float bs = -1.f;
#pragma unroll
            for (int g = 0; g < 4; ++g) { float a = p[4 * g], c2 = -1.f;
#pragma unroll
                for (int i = 1; i < 4; ++i) { const float v = p[4 * g + i]; if (v > a) { c2 = a; a = v; } else if (v > c2) c2 = v; }
                const float sc = a + c2; if (sc > bs) { bs = sc; best = g; } }
            int i0 = 0; float p0 = -1.f;
#pragma unroll
            for (int i = 0; i < 4; ++i) { float v = 0.f;
#pragma unroll
                for (int g = 0; g < 4; ++g) v = (g == best) ? p[4 * g + i] : v;
                if (v > p0) { p0 = v; i0 = i; } }
            int i1 = 0; float p1 = -1.f;
#pragma unroll
            for (int i = 0; i < 4; ++i) { float v = 0.f;
#pragma unroll
                for (int g = 0; g < 4; ++g) v = (g == best) ? p[4 * g + i] : v;
                if (i != i0 && v > p1) { p1 = v; i1 = i; } }
            rinfo[li * 4 + 0] = best * 4 + i0; rinfo[li * 4 + 1] = best * 4 + i1;
            rinfo[li * 4 + 2] = __float_as_int(p0 / (p0 + p1)); rinfo[li * 4 + 3] = __float_as_int(p1 / (p0 + p1));
        }
    }
    __syncthreads();
    int e0 = -1, e1 = -1, r0 = 0, r1 = 0; const int myrow = row_lo + F.tid;
    if (myrow < row_hi) { e0 = rinfo[F.tid * 4]; if (e0 >= 0) { e1 = rinfo[F.tid * 4 + 1]; r0 = __hip_atomic_fetch_add(lcnt + e0, 1, __ATOMIC_RELAXED, __HIP_MEMORY_SCOPE_WORKGROUP); r1 = __hip_atomic_fetch_add(lcnt + e1, 1, __ATOMIC_RELAXED, __HIP_MEMORY_SCOPE_WORKGROUP); } }
    __syncthreads();
    if (F.tid < 16) lcnt[16 + F.tid] = (int)atomicAdd(cnt + F.tid, (unsigned)lcnt[F.tid]);
    __syncthreads();
    if (e0 >= 0) {
        const int g0 = lcnt[16 + e0] + r0, g1 = lcnt[16 + e1] + r1;
        PERM[(size_t)e0 * CAP + g0] = myrow; GATE[(size_t)e0 * CAP + g0] = __int_as_float(rinfo[F.tid * 4 + 2]);
        PERM[(size_t)e1 * CAP + g1] = myrow; GATE[(size_t)e1 * CAP + g1] = __int_as_float(rinfo[F.tid * 4 + 3]);
        TOK[myrow * 2 + 0] = (e0 << 20) | g0; TOK[myrow * 2 + 1] = (e1 << 20) | g1;
    }
}

__device__ __forceinline__ void expert_tile_offsets(const unsigned* cnt, int (&toff)[NEXP + 1]) {
    toff[0] = 0;
#pragma unroll
    for (int e = 0; e < NEXP; ++e) toff[e + 1] = toff[e] + (int)((__hip_atomic_load(cnt + e, __ATOMIC_RELAXED, __HIP_MEMORY_SCOPE_AGENT) + 255u) >> 8);
}

template <int LAYER>
__device__ __forceinline__ void p_ln2(Frame& F) {
    const int gw = F.bid * NWAVES + F.wave, NGW = F.G * NWAVES;
    float* X = (float*)(F.ws + WS_X); bf16* H = (bf16*)(F.ws + WS_H); const bf16* Y = (const bf16*)(F.ws + WS_Y);
    const unsigned* cnt = (const unsigned*)(F.ws + WS_CTL) + CW_CNT + LAYER * 64; const int* TOK = (const int*)(F.ws + WS_TOK);
    int toff[NEXP + 1]; expert_tile_offsets(cnt, toff);
    for (int row = gw; row < MROWS; row += NGW) {
        const int b = row / TPB, tt = row - b * TPB;
        if (LAYER == 1 && tt < CTXL) continue;
        const int t0 = __hip_atomic_load(TOK + row * 2, __ATOMIC_RELAXED, __HIP_MEMORY_SCOPE_AGENT), t1 = __hip_atomic_load(TOK + row * 2 + 1, __ATOMIC_RELAXED, __HIP_MEMORY_SCOPE_AGENT); const int e0 = t0 >> 20, e1 = t1 >> 20;
        int o0 = 0, o1 = 0;
#pragma unroll
        for (int e = 0; e < NEXP; ++e) { o0 = (e == e0) ? toff[e] : o0; o1 = (e == e1) ? toff[e] : o1; }
        const size_t y0 = (size_t)o0 * 256 + (t0 & 0xfffff), y1 = (size_t)o1 * 256 + (t1 & 0xfffff);
        const Row16 xin = ld_row_f32(X + (size_t)row * DM, F.lane);
        const Row16 ya = ld_row_bf16(Y + y0 * DM, F.lane), yb = ld_row_bf16(Y + y1 * DM, F.lane);
        const Row16 gate = ld_row_f32(mod_ptr(F, LAYER, row, 5), F.lane);
        Row16 pre;
#pragma unroll
        for (int j = 0; j < 4; ++j) pre.v[j] = ALPHA * xin.v[j] + gate.v[j] * (ya.v[j] + yb.v[j]);
        const Row16 x2 = layer_norm(pre, F.in[I_LN2G] + LAYER * DM, F.in[I_LN2B] + LAYER * DM, F.lane);
        if (LAYER == 0) {
            st_row_f32(X + (size_t)row * DM, F.lane, x2);
            const Row16 h = modulate(x2, mod_ptr(F, 1, row, 0), mod_ptr(F, 1, row, 1), F.lane);
            st_row_bf16(H + (size_t)row * DM, F.lane, h);
        } else {
            st_row_f32(F.out + ((size_t)b * SEQ + (tt - CTXL)) * DM, F.lane, x2);
#ifdef TPROBE_A
            if (row == 2048 && F.lane == 0) { volatile LAS unsigned long long* ts = (volatile LAS unsigned long long*)(F.lds + MISC_OFF + 128);
                const float span_us = (float)(ts[TPROBE_B] - ts[TPROBE_A]) * 0.01f; F.out[((size_t)b * SEQ + (tt - CTXL)) * DM] = x2.v[0].x + span_us / (float)TPROBE_US; }
#endif
        }
    }
}
namespace ck {
typedef short bf16x8 __attribute__((ext_vector_type(8)));
typedef float f32x16 __attribute__((ext_vector_type(16)));
typedef float f32x4 __attribute__((ext_vector_type(4)));
constexpr int NCH = 36;
__device__ __forceinline__ int crow(int r, int hi) { return (r & 3) + 8 * (r >> 2) + 4 * hi; }
__device__ __forceinline__ int swz(int row, int c16) { return row * 128 + ((c16 ^ ((row >> 1) & 7)) << 4); }
__device__ __forceinline__ int swz_el(int row, int col) { return swz(row, col >> 3) + (col & 7) * 2; }
__device__ __forceinline__ void mm_tile(f32x16& acc, const LAS unsigned char* A, int arow0, const LAS unsigned char* B, int brow0, int ks0, int nks, int r32, int hh) {
#pragma unroll
    for (int ks = 0; ks < 4; ++ks) if (ks >= ks0 && ks < ks0 + nks) {
        const bf16x8 a = *(const LAS bf16x8*)(A + swz(arow0 + r32, 2 * ks + hh));
        const bf16x8 b = *(const LAS bf16x8*)(B + swz(brow0 + r32, 2 * ks + hh));
        acc = __builtin_amdgcn_mfma_f32_32x32x16_bf16(a, b, acc, 0, 0, 0); }
}
__device__ __forceinline__ f32x16 zero16() { f32x16 z;
#pragma unroll
    for (int i = 0; i < 16; ++i) z[i] = 0.f; return z; }
__device__ __forceinline__ int chunk_index(int b, int h, int d, int c) { return ((b * 8 + h) * 2 + d) * NCH + c; }
}

constexpr int CK_LIN = 0;
constexpr int CK_E = 32768;
constexpr int CK_T = CK_E, CK_TT = CK_E + 8192, CK_PT = CK_E + 16384, CK_WT = CK_E + 24576;
constexpr int CK_OPS = 65536;
constexpr int CK_UT = 131072;
constexpr int CK_D = CK_UT + 8192;
constexpr int CK_ZT = CK_D + 4096;
constexpr int CK_WSUM = CK_ZT + 2048;
static_assert(CK_WSUM + 2048 <= RING_BYTES, "chunk LDS map");

__device__ __forceinline__ float fsig(float x) { return __builtin_amdgcn_rcpf(1.f + __builtin_amdgcn_exp2f(-1.4426950408889634f * x)); }
__device__ __forceinline__ float fexp(float x) { return __builtin_amdgcn_exp2f(1.4426950408889634f * x); }

__device__ __forceinline__ void p_chunk_pre(Frame& F) {
    using namespace ck;
    const LAS unsigned char* L0 = F.lds + RING_OFF;
    LAS unsigned char* lds = F.lds + RING_OFF;
    const bf16* PA = (const bf16*)(F.ws + WS_PA);
    const int wave = F.wave;
    bf16* CHG = (bf16*)(F.ws + WS_CHG); bf16* CHH = (bf16*)(F.ws + WS_CHH); bf16* CHRQ = (bf16*)(F.ws + WS_CHRQ); bf16* CHY = (bf16*)(F.ws + WS_CHY);
    float* GLp = (float*)(F.ws + WS_GL); float* BON = (float*)(F.ws + WS_BON);
    bf16* VOUT = (bf16*)(F.ws + WS_VOUT); bf16* GOUT = (bf16*)(F.ws + WS_GOUT);
    const bf16* W2T = (const bf16*)(F.ws + WS_LORA); const bf16* A2T = W2T + 2 * 512 * 64; const bf16* G2T = A2T + 2 * 512 * 64;
    const float* mu = F.in[I_AMU];
    for (int it = F.bid; it < NB * 8 * 36 * 2; it += F.G) {
        const int d = it & 1, tb = (it >> 1) % 36, bh = (it >> 1) / 36, h = bh & 7, b = bh >> 3;
        const bool isctx = tb < 4; const int t0 = isctx ? tb * 64 : (tb - 4) * 64, Ls = isctx ? CTXL : SEQ;
        const int rbase = b * TPB + (isctx ? 0 : CTXL);
        const int c = d == 0 ? tb : (isctx ? 3 - tb : 4 + (31 - (tb - 4)));
        const int ci = chunk_index(b, h, d, c);
        __syncthreads();
        int lane = F.lane; asm volatile("" : "+v"(lane));
        const int tid = (wave << 6) | lane, r32 = lane & 31, hh = lane >> 5, k = lane, pg = wave;
#ifdef CK_REPSTEP
        for (int rep_ = 0; rep_ < (CK_REPSTEP == 1 ? CK_NREP : 1); ++rep_) { if (rep_) __syncthreads();
#endif
        {
            const int npc = d == 0 ? 32 : 16;
            for (int pi = tid; pi < 64 * npc; pi += NTHR) {
                const int tl = pi / npc, pc8 = pi % npc; const int cc = pc8 * 8;
                const int col = cc < 64 ? 1536 + 64 * d + cc : cc < 128 ? 1664 + 64 * d + (cc - 64) : 1792 + (cc - 128);
                const int mat = cc >> 6, l0 = cc & 63;
                const bf16* pc = PA + (size_t)(rbase + t0 + tl) * A_IN + col;
                const v4u cur = *(const v4u*)pc; v4u prv = (v4u){0u, 0u, 0u, 0u}, nxt = (v4u){0u, 0u, 0u, 0u};
                if (t0 + tl > 0) prv = *(const v4u*)(pc - A_IN);
                if (t0 + tl + 1 < Ls) nxt = *(const v4u*)(pc + A_IN);
                const f32x4 m0 = *(const f32x4*)(mu + col), m1 = *(const f32x4*)(mu + col + 4);
                const unsigned cw[4] = {cur.x, cur.y, cur.z, cur.w}, pw[4] = {prv.x, prv.y, prv.z, prv.w}, nw[4] = {nxt.x, nxt.y, nxt.z, nxt.w};
                const float mm[8] = {m0.x, m0.y, m0.z, m0.w, m1.x, m1.y, m1.z, m1.w}; float u[8];
#pragma unroll
                for (int j = 0; j < 8; ++j) { const int w = j >> 1; const bool up = j & 1;
                    const float cv = up ? bfhi(cw[w]) : bflo(cw[w]), pv = up ? bfhi(pw[w]) : bflo(pw[w]), nv = up ? bfhi(nw[w]) : bflo(nw[w]);
                    float x = cv + (0.5f * (pv + nv) - cv) * mm[j];
                    if (mat == 0) x = 1.f - 2.f * __builtin_amdgcn_rcpf(__builtin_amdgcn_exp2f(2.8853900817779268f * x) + 1.f); else if (mat >= 2) x = fsig(x);
                    u[j] = x; }
                *(LAS v4u*)(lds + CK_LIN + mat * 8192 + swz(tl, l0 >> 3)) = (v4u){pk2(u[0], u[1]), pk2(u[2], u[3]), pk2(u[4], u[5]), pk2(u[6], u[7])};
            }
        }
#ifdef CK_REPSTEP
        }
#endif
        float rr[8], kx[8], vv[8];
#ifdef CK_REPSTEP
        for (int rep_ = 0; rep_ < (CK_REPSTEP == 8 ? CK_NREP : 1); ++rep_) {
#endif
        {
            const int tlo = d == 0 ? 8 * pg : 63 - (8 * pg + 7);
            const bf16* pr = PA + (size_t)(rbase + t0 + tlo) * A_IN + 64 * h + k;
            const float mr = mu[64 * h + k], mk = mu[512 + 64 * h + k], mv = mu[1024 + 64 * h + k];
            float win[3][10];
#pragma unroll
            for (int j = 0; j < 10; ++j) { const int tg2 = t0 + tlo + j - 1; const bool ok = tg2 >= 0 && tg2 < Ls;
#pragma unroll
                for (int s = 0; s < 3; ++s) win[s][j] = ok ? bf2f(pr[(ptrdiff_t)(j - 1) * A_IN + 512 * s]) : 0.f; }
#pragma unroll
            for (int i = 0; i < 8; ++i) { const int j = d == 0 ? i + 1 : 8 - i;
                rr[i] = win[0][j] + (0.5f * (win[0][j - 1] + win[0][j + 1]) - win[0][j]) * mr;
                kx[i] = win[1][j] + (0.5f * (win[1][j - 1] + win[1][j + 1]) - win[1][j]) * mk;
                vv[i] = win[2][j] + (0.5f * (win[2][j - 1] + win[2][j + 1]) - win[2][j]) * mv; }
        }
#ifdef CK_REPSTEP
        }
#endif
        __syncthreads();
#ifdef CK_REPSTEP
        for (int rep_ = 0; rep_ < (CK_REPSTEP == 2 ? CK_NREP : 1); ++rep_) { if (rep_) __syncthreads();
#endif
        {
            const int tq = wave & 3, ti = tq >> 1, tj = tq & 1; const bool isW = wave < 4;
            f32x16 acc = zero16();
            const bf16* WT = (isW ? W2T : A2T) + ((size_t)d * 512 + 64 * h + 32 * tj + r32) * 64;
#pragma unroll
            for (int ks = 0; ks < 4; ++ks) {
                const bf16x8 a = *(const LAS bf16x8*)(L0 + CK_LIN + (isW ? 0 : 8192) + swz(32 * ti + r32, 2 * ks + hh));
                const bf16x8 bq = *(const bf16x8*)(WT + 16 * ks + 8 * hh);
                acc = __builtin_amdgcn_mfma_f32_32x32x16_bf16(a, bq, acc, 0, 0, 0); }
            const int ch = 32 * tj + r32; const float bias = isW ? F.in[I_AW0][d * 512 + 64 * h + ch] : F.in[I_AA0][d * 512 + 64 * h + ch];
#pragma unroll
            for (int r = 0; r < 16; ++r) { const int tl = 32 * ti + crow(r, hh); const int p = d == 0 ? tl : 63 - tl;
                const float sg = fsig(acc[r] + bias);
                *(LAS float*)(lds + CK_E + (isW ? 0 : 16384) + (p * 64 + ch) * 4) = isW ? sg * 0.6065306597126334f : sg; }
            if (d == 0 && !isW) {
                f32x16 g = zero16();
                const bf16* GT = G2T + (size_t)(64 * h + 32 * tj + r32) * 128;
#pragma unroll
                for (int ks = 0; ks < 8; ++ks) {
                    const bf16x8 a = *(const LAS bf16x8*)(L0 + CK_LIN + 16384 + (ks >> 2) * 8192 + swz(32 * ti + r32, 2 * (ks & 3) + hh));
                    const bf16x8 bq = *(const bf16x8*)(GT + 16 * ks + 8 * hh);
                    g = __builtin_amdgcn_mfma_f32_32x32x16_bf16(a, bq, g, 0, 0, 0); }
#pragma unroll
                for (int r = 0; r < 16; ++r) { const int tl = 32 * ti + crow(r, hh);
                    GOUT[(size_t)(rbase + t0 + tl) * 512 + 64 * h + ch] = (bf16)f2bf(g[r]); }
            }
        }
#ifdef CK_REPSTEP
        }
#endif
        __syncthreads();
#ifdef CK_REPSTEP
        for (int rep_ = 0; rep_ < (CK_REPSTEP == 3 ? CK_NREP : 1); ++rep_) { if (rep_) __syncthreads();
#endif
        {
            float e[8], ai[8], cl[8];
#pragma unroll
            for (int i = 0; i < 8; ++i) { e[i] = *(const LAS float*)(L0 + CK_E + ((8 * pg + i) * 64 + k) * 4); ai[i] = *(const LAS float*)(L0 + CK_E + 16384 + ((8 * pg + i) * 64 + k) * 4); }
            float run = 0.f;
#pragma unroll
            for (int i = 0; i < 8; ++i) { run -= e[i]; cl[i] = run; }
            *(LAS float*)(lds + CK_WSUM + (pg * 64 + k) * 4) = run;
            __syncthreads();
            float off = 0.f, tot = 0.f;
#pragma unroll
            for (int q = 0; q < 8; ++q) { const float s = *(const LAS float*)(L0 + CK_WSUM + (q * 64 + k) * 4); tot += s; off += (q < pg) ? s : 0.f; }
            const float kkc = F.in[I_AKK][64 * h + k], kac = F.in[I_AKA][64 * h + k], rkc = F.in[I_ARK][64 * h + k];
            float bhv[8], khv[8], atv[8];
#pragma unroll
            for (int i = 0; i < 8; ++i) {
                const int p = 8 * pg + i; const float c_ = cl[i] + off;
                const float kr = kx[i] * kkc; const float ss = wave_sum(kr * kr); const float kk = kr * __builtin_amdgcn_rsqf(fmaxf(ss, 1e-24f));
                const float kd = kx[i] * (1.f + (ai[i] - 1.f) * kac), bb = kk * ai[i];
                const float bon = wave_sum(rr[i] * kd * rkc);
                const float ep = fexp(c_), em = __builtin_amdgcn_rcpf(ep), el = fexp(tot - c_);
                atv[i] = -kk * fexp(c_ + e[i]);
                *(LAS bf16*)(lds + CK_OPS + 0 * 8192 + swz_el(p, k)) = (bf16)f2bf(atv[i]);
                *(LAS bf16*)(lds + CK_OPS + 1 * 8192 + swz_el(p, k)) = (bf16)f2bf(bb * em);
                *(LAS bf16*)(lds + CK_OPS + 2 * 8192 + swz_el(p, k)) = (bf16)f2bf(kd * em);
                *(LAS bf16*)(lds + CK_OPS + 3 * 8192 + swz_el(p, k)) = (bf16)f2bf(rr[i] * ep);
                bhv[i] = bb * el; khv[i] = kd * el;
                const int tl = d == 0 ? p : 63 - p; const size_t row = (size_t)(rbase + t0 + tl);
                if (lane == 0) BON[((size_t)d * MROWS + row) * 8 + h] = bon;
                if (d == 0) VOUT[row * 512 + 64 * h + k] = (bf16)f2bf(vv[i]);
            }
            *(LAS v4u*)(lds + CK_OPS + 4 * 8192 + swz(k, pg)) = (v4u){pk2(bhv[0], bhv[1]), pk2(bhv[2], bhv[3]), pk2(bhv[4], bhv[5]), pk2(bhv[6], bhv[7])};
            *(LAS v4u*)(lds + CK_OPS + 5 * 8192 + swz(k, pg)) = (v4u){pk2(khv[0], khv[1]), pk2(khv[2], khv[3]), pk2(khv[4], khv[5]), pk2(khv[6], khv[7])};
            *(LAS v4u*)(lds + CK_OPS + 6 * 8192 + swz(k, pg)) = (v4u){pk2(vv[0], vv[1]), pk2(vv[2], vv[3]), pk2(vv[4], vv[5]), pk2(vv[6], vv[7])};
            *(LAS v4u*)(lds + CK_OPS + 7 * 8192 + swz(k, pg)) = (v4u){pk2(atv[0], atv[1]), pk2(atv[2], atv[3]), pk2(atv[4], atv[5]), pk2(atv[6], atv[7])};
            if (pg == 0) GLp[(size_t)ci * 64 + k] = fexp(tot);
            *(LAS v4u*)(lds + CK_T + tid * 16) = (v4u){0u, 0u, 0u, 0u}; *(LAS v4u*)(lds + CK_TT + tid * 16) = (v4u){0u, 0u, 0u, 0u};
        }
#ifdef CK_REPSTEP
        }
#endif
        __syncthreads();
#ifdef CK_REPSTEP
        for (int rep_ = 0; rep_ < (CK_REPSTEP == 4 ? CK_NREP : 1); ++rep_) { if (rep_) __syncthreads();
#endif
        for (int job = wave; job < 16; job += 8) {
            const int prod = job >> 2, tq = job & 3, ti = tq >> 1, tj = tq & 1;
            f32x16 acc = zero16();
            if (!(ti == 0 && tj == 1))
                mm_tile(acc, L0 + CK_OPS + (prod < 2 ? 0 : 3) * 8192, 32 * ti, L0 + CK_OPS + ((prod & 1) ? 2 : 1) * 8192, 32 * tj, 0, 4, r32, hh);
            const int s = 32 * tj + r32;
#pragma unroll
            for (int r = 0; r < 16; ++r) { const int p = 32 * ti + crow(r, hh); const bool keep = prod < 2 ? (s < p) : (s <= p); const float v = keep ? acc[r] : 0.f;
                *(LAS bf16*)(lds + CK_LIN + prod * 8192 + swz_el(p, s)) = (bf16)f2bf(v);
                if (prod == 0 && (p >> 4) == (s >> 4)) *(LAS float*)(lds + CK_D + ((p >> 4) * 256 + (p & 15) * 16 + (s & 15)) * 4) = v; }
        }
#ifdef CK_REPSTEP
        }
#endif
        __syncthreads();
#ifdef CK_REPSTEP
        for (int rep_ = 0; rep_ < (CK_REPSTEP == 5 ? CK_NREP : 1); ++rep_) { if (rep_) __syncthreads();
#endif
        if (wave == 0) {
            const int blk = lane >> 4, cc = lane & 15;
            float x[16];
#pragma unroll
            for (int p = 0; p < 16; ++p) {
                float a = (p == cc) ? 1.f : 0.f;
#pragma unroll
                for (int s = 0; s < p; ++s) a += *(const LAS float*)(L0 + CK_D + (blk * 256 + p * 16 + s) * 4) * x[s];
                x[p] = a; }
#pragma unroll
            for (int p = 0; p < 16; ++p) *(LAS bf16*)(lds + CK_T + swz_el(16 * blk + p, 16 * blk + cc)) = (bf16)f2bf(x[p]);
            *(LAS v4u*)(lds + CK_TT + swz(16 * blk + cc, 2 * blk)) = (v4u){pk2(x[0], x[1]), pk2(x[2], x[3]), pk2(x[4], x[5]), pk2(x[6], x[7])};
            *(LAS v4u*)(lds + CK_TT + swz(16 * blk + cc, 2 * blk + 1)) = (v4u){pk2(x[8], x[9]), pk2(x[10], x[11]), pk2(x[12], x[13]), pk2(x[14], x[15])};
            LDS_WAIT();
            typedef float f32x4_ __attribute__((ext_vector_type(4)));
            const int row = lane & 15, kg = lane >> 4;
            const bf16x8 zf = (bf16x8){0, 0, 0, 0, 0, 0, 0, 0};
#pragma unroll
            for (int pr_ = 0; pr_ < 2; ++pr_) {
                const int b0 = 2 * pr_, b1 = b0 + 1;
                bf16x8 a = *(const LAS bf16x8*)(L0 + CK_LIN + swz(16 * b1 + row, 2 * b0 + (kg & 1)));
                bf16x8 bq = *(const LAS bf16x8*)(L0 + CK_TT + swz(16 * b0 + row, 2 * b0 + (kg & 1)));
                if (kg >= 2) { a = zf; bq = zf; }
                f32x4_ z = __builtin_amdgcn_mfma_f32_16x16x32_bf16(a, bq, (f32x4_){0.f, 0.f, 0.f, 0.f}, 0, 0, 0);
                *(LAS v2u*)(lds + CK_ZT + (row * 16 + 4 * kg) * 2) = (v2u){pk2(z[0], z[1]), pk2(z[2], z[3])};
                LDS_WAIT();
                bf16x8 a2 = *(const LAS bf16x8*)(L0 + CK_T + swz(16 * b1 + row, 2 * b1 + (kg & 1)));
                bf16x8 b2 = *(const LAS bf16x8*)(L0 + CK_ZT + (row * 16 + 8 * (kg & 1)) * 2);
                if (kg >= 2) { a2 = zf; b2 = zf; }
                f32x4_ m = __builtin_amdgcn_mfma_f32_16x16x32_bf16(a2, b2, (f32x4_){0.f, 0.f, 0.f, 0.f}, 0, 0, 0);
#pragma unroll
                for (int i = 0; i < 4; ++i) *(LAS bf16*)(lds + CK_T + swz_el(16 * b1 + 4 * kg + i, 16 * b0 + row)) = (bf16)f2bf(m[i]);
                *(LAS v2u*)(lds + CK_TT + swz_el(16 * b0 + row, 16 * b1 + 4 * kg)) = (v2u){pk2(m[0], m[1]), pk2(m[2], m[3])};
                LDS_WAIT();
            }
            {
                f32x16 z2 = zero16();
#pragma unroll
                for (int ks = 0; ks < 2; ++ks) {
                    const bf16x8 a = *(const LAS bf16x8*)(L0 + CK_LIN + swz(32 + r32, 2 * ks + hh));
                    const bf16x8 bq = *(const LAS bf16x8*)(L0 + CK_TT + swz(r32, 2 * ks + hh));
                    z2 = __builtin_amdgcn_mfma_f32_32x32x16_bf16(a, bq, z2, 0, 0, 0); }
#pragma unroll
                for (int rq = 0; rq < 4; ++rq)
                    *(LAS v2u*)(lds + CK_ZT + (r32 * 32 + 8 * rq + 4 * hh) * 2) = (v2u){pk2(z2[4 * rq], z2[4 * rq + 1]), pk2(z2[4 * rq + 2], z2[4 * rq + 3])};
                LDS_WAIT();
                f32x16 m2 = zero16();
#pragma unroll
                for (int ks = 0; ks < 2; ++ks) {
                    const bf16x8 a = *(const LAS bf16x8*)(L0 + CK_T + swz(32 + r32, 4 + 2 * ks + hh));
                    const bf16x8 bq = *(const LAS bf16x8*)(L0 + CK_ZT + (r32 * 32 + 16 * ks + 8 * hh) * 2);
                    m2 = __builtin_amdgcn_mfma_f32_32x32x16_bf16(a, bq, m2, 0, 0, 0); }
#pragma unroll
                for (int r = 0; r < 16; ++r) *(LAS bf16*)(lds + CK_T + swz_el(32 + crow(r, hh), r32)) = (bf16)f2bf(m2[r]);
            }
        } else if (wave <= 4) {
            const int tq = wave - 1, ti = tq >> 1, tj = tq & 1; f32x16 acc = zero16();
            mm_tile(acc, L0 + CK_LIN + 1 * 8192, 32 * ti, L0 + CK_OPS + 6 * 8192, 32 * tj, 0, 4, r32, hh);
#pragma unroll
            for (int rq = 0; rq < 4; ++rq)
                *(LAS v2u*)(lds + CK_PT + swz_el(32 * tj + r32, 32 * ti + 8 * rq + 4 * hh)) = (v2u){pk2(acc[4 * rq], acc[4 * rq + 1]), pk2(acc[4 * rq + 2], acc[4 * rq + 3])};
        }
#ifdef CK_REPSTEP
        }
#endif
        __syncthreads();
#ifdef CK_REPSTEP
        for (int rep_ = 0; rep_ < (CK_REPSTEP == 6 ? CK_NREP : 1); ++rep_) { if (rep_) __syncthreads();
#endif
        {
            const bool isW = wave < 4; const int tq = wave & 3, ti = tq >> 1, tj = tq & 1; f32x16 acc = zero16();
            mm_tile(acc, isW ? L0 + CK_OPS + 7 * 8192 : L0 + CK_PT, 32 * ti, L0 + CK_T, 32 * tj, 0, 4, r32, hh);
            LAS unsigned char* XT = isW ? lds + CK_WT : lds + CK_UT;
#pragma unroll
            for (int r = 0; r < 16; ++r) *(LAS bf16*)(XT + swz_el(32 * ti + crow(r, hh), 32 * tj + r32)) = (bf16)f2bf(acc[r]);
        }
#ifdef CK_REPSTEP
        }
#endif
        __syncthreads();
#ifdef CK_REPSTEP
        for (int rep_ = 0; rep_ < (CK_REPSTEP == 7 ? CK_NREP : 1); ++rep_) { if (rep_) __syncthreads();
#endif
        for (int job = wave; job < 16; job += 8) {
            const int prod = job >> 2, tq = job & 3, ti = tq >> 1, tj = tq & 1;
            const LAS unsigned char* WT_ = L0 + CK_WT; const LAS unsigned char* UT_ = L0 + CK_UT;
            const LAS unsigned char* Arb = L0 + CK_LIN + 2 * 8192; const LAS unsigned char* Ark = L0 + CK_LIN + 3 * 8192;
            const LAS unsigned char* BhT = L0 + CK_OPS + 4 * 8192; const LAS unsigned char* KhT = L0 + CK_OPS + 5 * 8192; const LAS unsigned char* VT = L0 + CK_OPS + 6 * 8192;
            f32x16 acc = zero16();
            if (prod == 0) mm_tile(acc, Arb, 32 * ti, WT_, 32 * tj, 0, 4, r32, hh);
            else if (prod == 1) { mm_tile(acc, Arb, 32 * ti, UT_, 32 * tj, 0, 4, r32, hh); mm_tile(acc, Ark, 32 * ti, VT, 32 * tj, 0, 4, r32, hh); }
            else if (prod == 2) mm_tile(acc, WT_, 32 * ti, BhT, 32 * tj, 0, 4, r32, hh);
            else { mm_tile(acc, UT_, 32 * ti, BhT, 32 * tj, 0, 4, r32, hh); mm_tile(acc, VT, 32 * ti, KhT, 32 * tj, 0, 4, r32, hh); }
            const int cc = 32 * tj + r32;
            if (prod == 0) {
#pragma unroll
                for (int r = 0; r < 16; ++r) { const int p = 32 * ti + crow(r, hh); const float v = acc[r] + bf2f(*(const LAS bf16*)(L0 + CK_OPS + 3 * 8192 + swz_el(p, cc)));
                    CHRQ[(size_t)ci * 4096 + p * 64 + cc] = (bf16)f2bf(v); }
            } else if (prod == 1) {
#pragma unroll
                for (int r = 0; r < 16; ++r) { const int p = 32 * ti + crow(r, hh); CHY[(size_t)ci * 4096 + p * 64 + cc] = (bf16)f2bf(acc[r]); }
            } else if (prod == 2) {
#pragma unroll
                for (int rq = 0; rq < 4; ++rq) { const int k0 = 32 * ti + 8 * rq + 4 * hh;
                    *(v2u*)(CHG + (size_t)ci * 4096 + cc * 64 + k0) = (v2u){pk2(acc[4 * rq], acc[4 * rq + 1]), pk2(acc[4 * rq + 2], acc[4 * rq + 3])}; }
            } else {
#pragma unroll
                for (int r = 0; r < 16; ++r) { const int v_ = 32 * ti + crow(r, hh); CHH[(size_t)ci * 4096 + v_ * 64 + cc] = (bf16)f2bf(acc[r]); }
            }
        }
#ifdef CK_REPSTEP
        }
#endif
    }
}

__device__ __forceinline__ void p_state(Frame& F) {
    using namespace ck;
    const int lane = F.lane, wave = F.wave, r32 = lane & 31, hh = lane >> 5;
    const bf16* CHG = (const bf16*)(F.ws + WS_CHG); const bf16* CHH = (const bf16*)(F.ws + WS_CHH); const bf16* CHRQ = (const bf16*)(F.ws + WS_CHRQ); bf16* CHY = (bf16*)(F.ws + WS_CHY);
    const float* GLp = (const float*)(F.ws + WS_GL);
    LAS unsigned char* lds = F.lds + RING_OFF;
    for (int chain = F.bid; chain < NB * 8 * 2; chain += F.G) {
        const int d = chain & 1, h = (chain >> 1) & 7, b = chain >> 4;
        const int tq = wave & 3, ti = tq >> 1, tj = tq & 1; const bool isS = wave < 4;
        f32x16 S = zero16();
        __syncthreads();
        for (int i = F.tid; i < 8192 / 16; i += NTHR) *(LAS v4u*)(lds + i * 16) = (v4u){0u, 0u, 0u, 0u};
        bf16x8 fr[4]; unsigned short hv[16]; float gl = 0.f;
#define ST_LOAD(c_) do { const size_t cb_ = (size_t)chunk_index(b, h, d, (c_)) * 4096; \
            if (isS) { _Pragma("unroll") for (int ks = 0; ks < 4; ++ks) fr[ks] = *(const bf16x8*)(CHG + cb_ + (size_t)(32 * tj + r32) * 64 + 16 * ks + 8 * hh); \
                       _Pragma("unroll") for (int r = 0; r < 16; ++r) hv[r] = CHH[cb_ + (32 * ti + crow(r, hh)) * 64 + 32 * tj + r32]; \
                       gl = GLp[(size_t)chunk_index(b, h, d, (c_)) * 64 + 32 * tj + r32]; } \
            else { _Pragma("unroll") for (int ks = 0; ks < 4; ++ks) fr[ks] = *(const bf16x8*)(CHRQ + cb_ + (size_t)(32 * ti + r32) * 64 + 16 * ks + 8 * hh); \
                   _Pragma("unroll") for (int r = 0; r < 16; ++r) hv[r] = CHY[cb_ + (32 * ti + crow(r, hh)) * 64 + 32 * tj + r32]; } } while (0)
        ST_LOAD(0);
        __syncthreads();
        for (int c = 0; c < NCH; ++c) {
            const size_t cb = (size_t)chunk_index(b, h, d, c) * 4096;
            const LAS unsigned char* Sb = lds + (c & 1) * 8192; LAS unsigned char* Sn = lds + ((c + 1) & 1) * 8192;
            bf16x8 cf[4]; float cv[16]; const float cgl = gl;
#pragma unroll
            for (int ks = 0; ks < 4; ++ks) cf[ks] = fr[ks];
#pragma unroll
            for (int r = 0; r < 16; ++r) cv[r] = bf2f(hv[r]);
            if (c + 1 < NCH) ST_LOAD(c + 1);
            f32x16 acc = zero16();
            if (isS) {
#pragma unroll
                for (int ks = 0; ks < 4; ++ks) { const bf16x8 a = *(const LAS bf16x8*)(Sb + swz(32 * ti + r32, 2 * ks + hh)); acc = __builtin_amdgcn_mfma_f32_32x32x16_bf16(a, cf[ks], acc, 0, 0, 0); }
#pragma unroll
                for (int r = 0; r < 16; ++r) { const int v_ = 32 * ti + crow(r, hh);
                    S[r] = S[r] * cgl + acc[r] + cv[r];
                    *(LAS bf16*)(Sn + swz_el(v_, 32 * tj + r32)) = (bf16)f2bf(S[r]); }
            } else {
#pragma unroll
                for (int ks = 0; ks < 4; ++ks) { const bf16x8 s = *(const LAS bf16x8*)(Sb + swz(32 * tj + r32, 2 * ks + hh)); acc = __builtin_amdgcn_mfma_f32_32x32x16_bf16(cf[ks], s, acc, 0, 0, 0); }
#pragma unroll
                for (int r = 0; r < 16; ++r) { const int p = 32 * ti + crow(r, hh); CHY[cb + p * 64 + 32 * tj + r32] = (bf16)f2bf(acc[r] + cv[r]); }
            }
            __syncthreads();
        }
#undef ST_LOAD
    }
}

__device__ __forceinline__ void p_rope0(Frame& F) {
    const int gw = F.bid * NWAVES + F.wave, NGW = F.G * NWAVES;
    bf16* PB = (bf16*)(F.ws + WS_PB); const float* cosB = (const float*)(F.ws + WS_ROPE); const float* sinB = cosB + SEQ * 32;
    for (int row = gw; row < MROWS; row += NGW) {
        const int b = row / TPB, tt = row - b * TPB; if (tt < CTXL) continue; const int t = tt - CTXL;
        bf16* p = PB + (size_t)row * B_IN;
#pragma unroll
        for (int q = 0; q < 8; ++q) { const int pr = q * 64 + F.lane; const int vec = pr >> 5, i = pr & 31; const int c1 = vec * 64 + i, c2 = c1 + 32;
            const float x1 = bf2f(p[c1]), x2 = bf2f(p[c2]); const float cs = cosB[t * 32 + i], sn = sinB[t * 32 + i];
            p[c1] = (bf16)f2bf(x1 * cs - x2 * sn); p[c2] = (bf16)f2bf(x1 * sn + x2 * cs); }
    }
}

__device__ __forceinline__ void p_attn0(Frame& F) {
    const bf16* PB = (const bf16*)(F.ws + WS_PB);
    for (int u = F.bid; u < 576; u += F.G) {
        int b, h, m, qt;
        if (u < 512) { qt = 1 + (u & 7); const int r = u >> 3; m = r & 1; h = (r >> 1) & 3; b = r >> 3; }
        else { const int r = u - 512; qt = 0; m = r & 1; h = (r >> 1) & 3; b = r >> 3; }
        const size_t row0 = (size_t)b * TPB;
        const bf16* Q = PB + (row0 + (size_t)qt * 256) * B_IN + h * 128 + m * 64;
        const bf16* Kp = PB + row0 * B_IN + 512 + h * 128 + m * 64;
        const bf16* Vp = PB + row0 * B_IN + 1024 + h * 128;
        bf16* O = (bf16*)(F.ws + (m == 0 ? WS_OB0 : WS_OB1)) + (row0 + (size_t)qt * 256) * 512 + h * 128;
        att::attn_body<64, B_IN, B_IN, 512>(Q, Kp, Vp, O, qt == 0 ? CTXL : TPB, F.ldsg + RING_OFF, F.wave);
    }
}

__device__ __forceinline__ void p_readout(Frame& F) {
    const int gw = F.bid * NWAVES + F.wave, NGW = F.G * NWAVES;
    const bf16* CHY = (const bf16*)(F.ws + WS_CHY); const bf16* fv = (const bf16*)(F.ws + WS_VOUT); const bf16* fg = (const bf16*)(F.ws + WS_GOUT); const float* BON = (const float*)(F.ws + WS_BON);
    const bf16* ob0 = (const bf16*)(F.ws + WS_OB0); const bf16* ob1 = (const bf16*)(F.ws + WS_OB1);
    bf16* A2 = (bf16*)(F.ws + WS_A2);
    float lam;
    { const float* lv = F.in[I_BLAM]; const float s1 = wave_sum(lv[F.lane] * lv[64 + F.lane]), s2 = wave_sum(lv[128 + F.lane] * lv[192 + F.lane]); lam = expf(s1) - expf(s2) + LAMBDA_INIT0; }
    const int c8 = F.lane * 8, hd = F.lane >> 3, v0 = (F.lane & 7) * 8;
    for (int row = gw; row < MROWS; row += NGW) {
        const size_t off = (size_t)row * 512 + c8;
        const int b = row / TPB, tt = row - b * TPB;
        const int ir = tt < CTXL ? (CTXL - 1 - tt) : CTXL + (TPB - 1 - tt);
        const size_t of = (size_t)ck::chunk_index(b, hd, 0, tt >> 6) * 4096 + (tt & 63) * 64 + v0, orv = (size_t)ck::chunk_index(b, hd, 1, ir >> 6) * 4096 + (ir & 63) * 64 + v0;
        const v4u qv = *(const v4u*)(fv + off), qg = *(const v4u*)(fg + off), q1 = *(const v4u*)(CHY + of), q2 = *(const v4u*)(CHY + orv);
        const unsigned wv_[4] = {qv.x, qv.y, qv.z, qv.w}, wg_[4] = {qg.x, qg.y, qg.z, qg.w}, w1_[4] = {q1.x, q1.y, q1.z, q1.w}, w2_[4] = {q2.x, q2.y, q2.z, q2.w};
        const float bon = BON[(size_t)row * 8 + hd] + BON[((size_t)MROWS + row) * 8 + hd];
        float y[8], s = 0.f;
#pragma unroll
        for (int j = 0; j < 8; ++j) { const int w = j >> 1; const bool up = j & 1; y[j] = (up ? bfhi(w1_[w]) : bflo(w1_[w])) + (up ? bfhi(w2_[w]) : bflo(w2_[w])); s += y[j]; }
        s = sum8(s);
        const float mean = s * (1.f / 64.f); float q = 0.f;
#pragma unroll
        for (int j = 0; j < 8; ++j) { y[j] -= mean; q += y[j] * y[j]; }
        q = sum8(q);
        const float rstd = 1.f / sqrtf(q * (1.f / 64.f) + GN_EPS);
        float o[8];
#pragma unroll
        for (int j = 0; j < 8; ++j) { const int w = j >> 1; const bool up = j & 1; const float v_ = up ? bfhi(wv_[w]) : bflo(wv_[w]), g_ = up ? bfhi(wg_[w]) : bflo(wg_[w]);
            o[j] = (y[j] * rstd * F.in[I_LNXG][c8 + j] + F.in[I_LNXB][c8 + j] + bon * v_) * g_; }
        *(v4u*)(A2 + (size_t)row * DM + c8) = (v4u){pk2(o[0], o[1]), pk2(o[2], o[3]), pk2(o[4], o[5]), pk2(o[6], o[7])};
        const v4u p0 = *(const v4u*)(ob0 + off), p1 = *(const v4u*)(ob1 + off);
        const unsigned u0[4] = {p0.x, p0.y, p0.z, p0.w}, u1[4] = {p1.x, p1.y, p1.z, p1.w};
        float z[8], ss = 0.f;
#pragma unroll
        for (int j = 0; j < 8; ++j) { const int w = j >> 1; const bool up = j & 1; z[j] = (up ? bfhi(u0[w]) : bflo(u0[w])) - lam * (up ? bfhi(u1[w]) : bflo(u1[w])); ss += z[j] * z[j]; }
        ss = sum16(ss);
        const float rr = 1.f / sqrtf(ss * (1.f / 128.f) + SUBLN_EPS) * (1.f - LAMBDA_INIT0);
#pragma unroll
        for (int j = 0; j < 8; ++j) z[j] = z[j] * rr * F.in[I_SUBG][(c8 + j) & 127];
        *(v4u*)(A2 + (size_t)row * DM + 512 + c8) = (v4u){pk2(z[0], z[1]), pk2(z[2], z[3]), pk2(z[4], z[5]), pk2(z[6], z[7])};
    }
}

__device__ __forceinline__ void p_qknorm1(Frame& F) {
    const int gw = F.bid * NWAVES + F.wave, NGW = F.G * NWAVES;
    bf16* QKV = (bf16*)(F.ws + WS_QKV1); const float* cosC = (const float*)(F.ws + WS_ROPE) + SEQ * 64; const float* sinC = cosC + SEQ * 64;
    const float qg1 = F.in[I_QNG][F.lane], qg2 = F.in[I_QNG][64 + F.lane], kg1 = F.in[I_KNG][F.lane], kg2 = F.in[I_KNG][64 + F.lane];
    for (int row = gw; row < MROWS; row += NGW) {
        const int b = row / TPB, tt = row - b * TPB; const bool lat = tt >= CTXL; const int t = tt - CTXL;
        float cs = 1.f, sn = 0.f; if (lat) { cs = cosC[t * 64 + F.lane]; sn = sinC[t * 64 + F.lane]; }
        bf16* p = QKV + (size_t)row * ODD_IN;
        for (int hd = lat ? 0 : 8; hd < 10; ++hd) {
            bf16* ph = p + hd * 128; const float x1 = bf2f(ph[F.lane]), x2 = bf2f(ph[64 + F.lane]);
            const float ss = wave_sum(x1 * x1 + x2 * x2); const float ri = 1.f / sqrtf(ss * (1.f / 128.f) + QKN_EPS);
            const float y1 = x1 * ri * (hd < 8 ? qg1 : kg1), y2 = x2 * ri * (hd < 8 ? qg2 : kg2);
            ph[F.lane] = (bf16)f2bf(y1 * cs - y2 * sn); ph[64 + F.lane] = (bf16)f2bf(y1 * sn + y2 * cs);
        }
    }
}
__device__ __forceinline__ void p_attn1(Frame& F) {
    const bf16* QKV = (const bf16*)(F.ws + WS_QKV1); bf16* OA = (bf16*)(F.ws + WS_OATT);
    for (int u = F.bid; u < 512; u += F.G) {
        const int qt = 1 + (u & 7), h = (u >> 3) & 7, b = u >> 6; const int kvh = h >> 2;
        const size_t row0 = (size_t)b * TPB;
        const bf16* Q = QKV + (row0 + (size_t)qt * 256) * ODD_IN + h * 128;
        const bf16* Kp = QKV + row0 * ODD_IN + 1024 + kvh * 128;
        const bf16* Vp = QKV + row0 * ODD_IN + 1280 + kvh * 128;
        bf16* O = OA + (row0 + (size_t)qt * 256) * DM + h * 128;
        att::attn_body<128, ODD_IN, ODD_IN, DM>(Q, Kp, Vp, O, TPB, F.ldsg + RING_OFF, F.wave);
    }
}
namespace pg8 {
struct EpiBf16 {
    static constexpr bool PERM = true;
    bf16_t* O; int ldc;
    __device__ __forceinline__ void operator()(const f32x4 (&acc)[2][2][4][2], const Unit& u, int wr, int wc, int fr, int fq) const {
        const int row0 = u.orow0 + wr * 64 + fr, col0 = u.pn * BM + wc * 32 + 8 * fq;
#pragma unroll
        for (int ai = 0; ai < 2; ++ai)
#pragma unroll
            for (int m = 0; m < 4; ++m) { bf16_t* rowp = O + (size_t)(row0 + ai * HALF + m * 16) * ldc + col0;
#pragma unroll
                for (int bj = 0; bj < 2; ++bj) { const f32x4 v0 = acc[ai][bj][m][0], v1 = acc[ai][bj][m][1];
                    u32x4 w; w.x = cvt_pk_bf16(v0[0], v0[1]); w.y = cvt_pk_bf16(v0[2], v0[3]); w.z = cvt_pk_bf16(v1[0], v1[1]); w.w = cvt_pk_bf16(v1[2], v1[3]);
                    *(u32x4*)(rowp + bj * HALF) = w; } }
    }
};
struct EpiIn0 {
    static constexpr bool PERM = true;
    bf16_t* PA; bf16_t* PB;
    __device__ __forceinline__ void operator()(const f32x4 (&acc)[2][2][4][2], const Unit& u, int wr, int wc, int fr, int fq) const {
        const int row0 = u.orow0 + wr * 64 + fr, col0 = u.pn * BM + wc * 32 + 8 * fq;
#pragma unroll
        for (int ai = 0; ai < 2; ++ai)
#pragma unroll
            for (int m = 0; m < 4; ++m) { const size_t row = (size_t)(row0 + ai * HALF + m * 16);
#pragma unroll
                for (int bj = 0; bj < 2; ++bj) { const f32x4 v0 = acc[ai][bj][m][0], v1 = acc[ai][bj][m][1]; const int col = col0 + bj * HALF;
                    u32x4 w; w.x = cvt_pk_bf16(v0[0], v0[1]); w.y = cvt_pk_bf16(v0[2], v0[3]); w.z = cvt_pk_bf16(v1[0], v1[1]); w.w = cvt_pk_bf16(v1[2], v1[3]);
                    if (col < 1920) *(u32x4*)(PA + row * 1920 + col) = w; else if (col < 3456) *(u32x4*)(PB + row * 1536 + (col - 1920)) = w; } }
    }
};
struct EpiMoe1 {
    static constexpr bool PERM = true;
    bf16_t* HID;
    __device__ __forceinline__ void operator()(const f32x4 (&acc)[2][2][4][2], const Unit& u, int wr, int wc, int fr, int fq) const {
        const int row0 = u.orow0 + wr * 64 + fr, col0 = u.pn * 128 + wc * 16 + 4 * fq;
#pragma unroll
        for (int ai = 0; ai < 2; ++ai)
#pragma unroll
            for (int m = 0; m < 4; ++m) { bf16_t* rowp = HID + (size_t)(row0 + ai * HALF + m * 16) * 512 + col0;
#pragma unroll
                for (int bj = 0; bj < 2; ++bj) { const f32x4 a = acc[ai][bj][m][0], b = acc[ai][bj][m][1]; float h[4];
#pragma unroll
                    for (int i = 0; i < 4; ++i) h[i] = a[i] / (1.f + __expf(-a[i])) * b[i];
                    u32x2 w; w.x = cvt_pk_bf16(h[0], h[1]); w.y = cvt_pk_bf16(h[2], h[3]);
                    *(u32x2*)(rowp + bj * 64) = w; } }
    }
};
struct EpiMoe2 {
    static constexpr bool PERM = true;
    bf16_t* Y; const float* GATE;
    __device__ __forceinline__ void operator()(const f32x4 (&acc)[2][2][4][2], const Unit& u, int wr, int wc, int fr, int fq) const {
        const int r0 = wr * 64 + fr, col0 = u.pn * BM + wc * 32 + 8 * fq;
#pragma unroll
        for (int ai = 0; ai < 2; ++ai)
#pragma unroll
            for (int m = 0; m < 4; ++m) { const int r = r0 + ai * HALF + m * 16; if (r >= u.nvalid) continue;
                const float gt = GATE[u.gbase + r]; bf16_t* rowp = Y + (size_t)(u.orow0 + r) * 1024 + col0;
#pragma unroll
                for (int bj = 0; bj < 2; ++bj) { const f32x4 v0 = acc[ai][bj][m][0] * gt, v1 = acc[ai][bj][m][1] * gt;
                    u32x4 w; w.x = cvt_pk_bf16(v0[0], v0[1]); w.y = cvt_pk_bf16(v0[2], v0[3]); w.z = cvt_pk_bf16(v1[0], v1[1]); w.w = cvt_pk_bf16(v1[2], v1[3]);
                    *(u32x4*)(rowp + bj * HALF) = w; } }
    }
};
__device__ __forceinline__ void moe_build_table(const unsigned* cnt, PG8_LAS int* tab, int tid) {
    unsigned cn[16]; int total = 0;
#pragma unroll
    for (int e = 0; e < 16; ++e) { cn[e] = __hip_atomic_load(cnt + e, __ATOMIC_RELAXED, __HIP_MEMORY_SCOPE_AGENT); total += (int)((cn[e] + 255u) >> 8); }
    total *= 4;
    if (tid == 0) tab[0] = total;
    for (int L = tid; L < total; L += 512) {
        int base = 0, toff = 0, e = 0; bool found = false; unsigned ce = cn[0];
#pragma unroll
        for (int q = 0; q < 16; ++q) { const int nt = (int)((cn[q] + 255u) >> 8); if (!found) { if (L >= base + 4 * nt) { base += 4 * nt; toff += nt; e = q + 1; } else { found = true; ce = cn[q]; } } }
        const int nt_e = (int)((ce + 255u) >> 8); const int within = L - base, pn = within / nt_e, rt = within % nt_e;
        const int rem = (int)ce - rt * 256; const int nvalid = rem < 256 ? rem : 256;
        tab[4 + 2 * L] = e | (rt << 4) | (pn << 12) | (nvalid << 16); tab[4 + 2 * L + 1] = toff + rt;
    }
    __syncthreads();
}
template <bool GATHER_>
struct MoeOrder {
    static constexpr bool GATHER = GATHER_;
    const PG8_LAS int* tab; const int* perm; int G, c, K;
    __device__ __forceinline__ bool next(int i, Unit& u) const {
        const int total = __builtin_amdgcn_readfirstlane(tab[0]);
        const int L0 = i * G + c; if (L0 >= total) return false;
        const int L = xcd_remap(L0, total);
        const int w0 = __builtin_amdgcn_readfirstlane(tab[4 + 2 * L]), w1 = __builtin_amdgcn_readfirstlane(tab[4 + 2 * L + 1]);
        const int e = w0 & 15, rt = (w0 >> 4) & 255, pn = (w0 >> 12) & 3;
        u.pm = rt; u.pn = pn; u.e = e; u.gbase = e * 18432 + rt * 256; u.nvalid = (w0 >> 16) & 511; u.orow0 = w1 * 256;
        u.boff = ((size_t)e * 1024 + (size_t)pn * 256) * K * 2; u.aoff = (size_t)u.orow0 * K * 2; return true;
    }
    __device__ __forceinline__ int token(const Unit& u, int r) const { return perm[u.gbase + (r < u.nvalid ? r : 0)]; }
};
}

enum { PH_PROLOGUE = 0, PH_MOD0, PH_GEMM_IN0, PH_CHUNK, PH_STATE, PH_ATTN0, PH_READOUT, PH_GEMM_OUT0, PH_LNR0, PH_MOE1_0, PH_MOE2_0, PH_LN2_0,
       PH_GEMM_IN1, PH_QKN1, PH_ATTN1, PH_GEMM_OUT1, PH_LNR1, PH_MOE1_1, PH_MOE2_1, PH_FINAL, N_PHASES };

template <int LAYER> __device__ __forceinline__ void p_moe1(Frame& F) {
    pg8::Gemm g{(const pg8::bf16_t*)(F.ws + WS_H), (const pg8::bf16_t*)(F.ws + WS_WM13), DM};
    pg8::moe_build_table((const unsigned*)(F.ws + WS_CTL) + CW_CNT + LAYER * 64, (LAS int*)(F.lds + MOETAB_OFF), F.tid);
    pg8::MoeOrder<true> S{(const LAS int*)(F.lds + MOETAB_OFF), (const int*)(F.ws + WS_PERM_), F.G, F.bid, DM};
    pg8::EpiMoe1 E{(pg8::bf16_t*)(F.ws + WS_HID)};
    pg8::gemm_phase<pg8::EpiMoe1, pg8::MoeOrder<true>>(F.lds + RING_OFF, g, S, E, F.wave);
}
template <int LAYER> __device__ __forceinline__ void p_moe2(Frame& F) {
    pg8::Gemm g{(const pg8::bf16_t*)(F.ws + WS_HID), (const pg8::bf16_t*)(F.ws + WS_WM2), EFF};
    pg8::moe_build_table((const unsigned*)(F.ws + WS_CTL) + CW_CNT + LAYER * 64, (LAS int*)(F.lds + MOETAB_OFF), F.tid);
    pg8::MoeOrder<false> S{(const LAS int*)(F.lds + MOETAB_OFF), (const int*)(F.ws + WS_PERM_), F.G, F.bid, EFF};
    pg8::EpiMoe2 E{(pg8::bf16_t*)(F.ws + WS_Y), (const float*)(F.ws + WS_GATE)};
    pg8::gemm_phase<pg8::EpiMoe2, pg8::MoeOrder<false>>(F.lds + RING_OFF, g, S, E, F.wave);
}
__device__ __forceinline__ void p_gemm_dense(Frame& F, size_t a_off, size_t w_off, int N, size_t o_off, int ldc, int skip9 = 0) {
    pg8::Gemm g{(const pg8::bf16_t*)(F.ws + a_off), (const pg8::bf16_t*)(F.ws + w_off), DM};
    pg8::DenseOrder S; S.init(MROWS, N, DM, F.G, F.bid, skip9);
    pg8::EpiBf16 E{(pg8::bf16_t*)(F.ws + o_off), ldc};
    pg8::gemm_phase<pg8::EpiBf16, pg8::DenseOrder>(F.lds + RING_OFF, g, S, E, F.wave);
}

template <int PH> __device__ __forceinline__ void run_phase(Frame& F) {
    if constexpr (PH == PH_PROLOGUE) p_prologue(F);
    else if constexpr (PH == PH_MOD0) p_mod0(F);
    else if constexpr (PH == PH_GEMM_IN0) {
        pg8::Gemm g{(const pg8::bf16_t*)(F.ws + WS_H), (const pg8::bf16_t*)(F.ws + WS_WEVIN), DM};
        pg8::DenseOrder S; S.init(MROWS, EVEN_PAD, DM, F.G, F.bid);
        pg8::EpiIn0 E{(pg8::bf16_t*)(F.ws + WS_PA), (pg8::bf16_t*)(F.ws + WS_PB)};
        pg8::gemm_phase<pg8::EpiIn0, pg8::DenseOrder>(F.lds + RING_OFF, g, S, E, F.wave); }
    else if constexpr (PH == PH_CHUNK) {
#ifndef CK_SKIP_ROPE
        p_rope0(F);
#endif
#ifndef CK_SKIP_ALL
        p_chunk_pre(F);
#endif
    }
    else if constexpr (PH == PH_STATE) p_state(F);
    else if constexpr (PH == PH_ATTN0) p_attn0(F);
    else if constexpr (PH == PH_READOUT) p_readout(F);
    else if constexpr (PH == PH_GEMM_OUT0) p_gemm_dense(F, WS_A2, WS_WEVOUT, DM, WS_MIX, DM);
    else if constexpr (PH == PH_LNR0) { convert_moe_weights(F, 0); __syncthreads(); p_ln_route<0>(F); }
    else if constexpr (PH == PH_MOE1_0) p_moe1<0>(F);
    else if constexpr (PH == PH_MOE2_0) p_moe2<0>(F);
    else if constexpr (PH == PH_LN2_0) { p_ln2<0>(F); convert_moe_weights(F, 1); }
    else if constexpr (PH == PH_GEMM_IN1) p_gemm_dense(F, WS_H, WS_WODIN, ODD_IN, WS_QKV1, ODD_IN);
    else if constexpr (PH == PH_QKN1) p_qknorm1(F);
    else if constexpr (PH == PH_ATTN1) p_attn1(F);
    else if constexpr (PH == PH_GEMM_OUT1) p_gemm_dense(F, WS_OATT, WS_WODOUT, DM, WS_MIX, DM, 1);
    else if constexpr (PH == PH_LNR1) p_ln_route<1>(F);
    else if constexpr (PH == PH_MOE1_1) p_moe1<1>(F);
    else if constexpr (PH == PH_MOE2_1) p_moe2<1>(F);
    else if constexpr (PH == PH_FINAL) p_ln2<1>(F);
}
template <int PH, int HI> __device__ __forceinline__ void run_phases(Frame& F, const XcdBarrier& bar) {
    if constexpr (PH < HI) {
        {
            const float* const* inp = (const float* const*)__builtin_amdgcn_kernarg_segment_ptr(); asm volatile("" : "+s"(inp)); F.in = inp;
            asm volatile("" : "+s"(F.ws), "+s"(F.out), "+s"(F.G), "+s"(F.bid), "+s"(F.wave));
            int l_ = (int)__builtin_amdgcn_mbcnt_hi(~0u, __builtin_amdgcn_mbcnt_lo(~0u, 0u)); asm volatile("" : "+v"(l_)); F.lane = l_; F.tid = (F.wave << 6) | l_; }
        asm volatile("; PHASE_MARK %0" :: "i"(PH));
        run_phase<PH>(F);
        if constexpr (PH + 1 < HI) { xcd_barrier(bar);
#ifdef TPROBE_A
            if (threadIdx.x == 0) ((volatile LAS unsigned long long*)(F.lds + MISC_OFF + 128))[PH + 1] = __builtin_amdgcn_s_memrealtime();
#endif
            run_phases<PH + 1, HI>(F, bar); }
    }
}

template <int LO, int HI>
__global__ void __launch_bounds__(NTHR, 2) fwd_kernel(Args args) {
    extern __shared__ __attribute__((aligned(16))) unsigned char lds[];
    Frame F;
    F.lds = (LAS unsigned char*)lds; F.ldsg = (char*)lds;
    F.tid = threadIdx.x; F.lane = F.tid & 63; F.wave = __builtin_amdgcn_readfirstlane(F.tid >> 6);
    F.G = gridDim.x; F.bid = blockIdx.x; F.in = args.in; F.out = args.out; F.ws = args.ws;
    volatile LAS unsigned* MISC = (volatile LAS unsigned*)(F.lds + MISC_OFF);
    for (int u = F.tid; u < (LDS_BYTES - LDSCTL_OFF) / 4; u += NTHR) ((LAS unsigned*)(F.lds + LDSCTL_OFF))[u] = 0u;
    __syncthreads();
    XcdBarrier bar; bar.bar = (unsigned*)(F.ws + WS_CTL) + CW_BAR; bar.x = 0; bar.st = nullptr;
    if constexpr (HI - LO > 1) bar = xcd_barrier_post((unsigned*)(F.ws + WS_CTL) + CW_BAR, MISC + 8);
#ifdef TPROBE_A
    if (threadIdx.x == 0) ((volatile LAS unsigned long long*)(F.lds + MISC_OFF + 128))[0] = __builtin_amdgcn_s_memrealtime();
#endif
    run_phases<LO, HI>(F, bar);
}

#ifndef N_LAUNCH_MODE
#define N_LAUNCH_MODE 0
#endif
template <int PH> static void launch_from(int grid, hipStream_t stream, const Args& a) {
    if constexpr (PH < N_PHASES) {
        (void)hipFuncSetAttribute((const void*)fwd_kernel<PH, PH + 1>, hipFuncAttributeMaxDynamicSharedMemorySize, LDS_BYTES);
        hipLaunchKernelGGL((fwd_kernel<PH, PH + 1>), dim3(grid), dim3(NTHR), LDS_BYTES, stream, a);
#ifdef PROBE_MASK
        if ((PROBE_MASK >> PH) & 1) hipLaunchKernelGGL((fwd_kernel<PH, PH + 1>), dim3(grid), dim3(NTHR), LDS_BYTES, stream, a);
#endif
        launch_from<PH + 1>(grid, stream, a);
    }
}
extern "C" void kernel_launch(void* const* d_in, const int* in_sizes, int n_in, void* d_out, int out_size, void* d_ws, size_t ws_size, hipStream_t stream) {
    static int grid = 0;
    if (grid == 0) {
        if (n_in != 34 || in_sizes[0] != NB * SEQ * DM || out_size != NB * SEQ * DM || ws_size < WS_TOTAL) {
            fprintf(stderr, "kernel_launch: unexpected shapes: n_in %d in0 %d out %d ws %zu (need %zu)\n", n_in, n_in > 0 ? in_sizes[0] : -1, out_size, ws_size, (size_t)WS_TOTAL); grid = -1; return; }
        int dev = 0, cus = 0;
        if (hipGetDevice(&dev) != hipSuccess || hipDeviceGetAttribute(&cus, hipDeviceAttributeMultiprocessorCount, dev) != hipSuccess) { grid = -1; return; }
#if N_LAUNCH_MODE == 0
        if (hipFuncSetAttribute((const void*)fwd_kernel<0, N_PHASES>, hipFuncAttributeMaxDynamicSharedMemorySize, LDS_BYTES) != hipSuccess) { fprintf(stderr, "kernel_launch: hipFuncSetAttribute failed\n"); grid = -1; return; }
#endif
        (void)hipGetLastError();
        grid = cus;
    }
    if (grid < 0) return;
    if (hipMemsetAsync((char*)d_ws + WS_CTL, 0, CTL_ZERO_BYTES, stream) != hipSuccess) return;
    Args a{};
    for (int i = 0; i < 34; ++i) a.in[i] = (const float*)d_in[i];
    a.out = (float*)d_out; a.ws = (unsigned char*)d_ws;
#if N_LAUNCH_MODE == 1
    launch_from<0>(grid, stream, a);
#else
    hipLaunchKernelGGL((fwd_kernel<0, N_PHASES>), dim3(grid), dim3(NTHR), LDS_BYTES, stream, a);
#endif
    const hipError_t le = hipPeekAtLastError();
    if (le != hipSuccess) fprintf(stderr, "kernel_launch: launch failed: %s\n", hipGetErrorName(le));
}
```

```cpp
#include <hip/hip_runtime.h>
#include <hip/hip_bf16.h>
#include <cstdio>
#include <cstdint>
#include <cmath>
namespace pg8 {
#define PG8_LAS __attribute__((address_space(3)))
typedef unsigned short bf16_t;
typedef short bf16x8 __attribute__((ext_vector_type(8)));
typedef float f32x4 __attribute__((ext_vector_type(4)));
typedef unsigned u32x4 __attribute__((ext_vector_type(4)));
typedef unsigned u32x2 __attribute__((ext_vector_type(2)));
constexpr int BM = 256, BK = 64, HALF = 128, HTB = HALF * BK * 2  , STAGE_BYTES = 8 * HTB, NXCD = 8, WGM = 8;

__host__ __device__ __forceinline__ int lds_byte(int r, int c) { const int st = (r >> 4) * 2 + (c >> 5), rr = r & 15, cc = c & 31, ob = rr * 64 + cc * 2; return st * 1024 + (ob ^ (((ob >> 9) & 1) << 5)); }
__host__ __device__ __forceinline__ void stage_rc(int b, int& R, int& C) { const int st = b / 1024, sb = b % 1024, swz = sb ^ (((sb >> 9) & 1) << 5); R = (st >> 1) * 16 + swz / 64; C = (st & 1) * 32 + (swz % 64) / 2; }
__host__ __device__ __forceinline__ int perm32(int rho) { const int n = rho >> 4, i = rho & 15; return 8 * (i >> 2) + 4 * n + (i & 3); }

struct Unit { int pm, pn; size_t aoff, boff; int gbase, nvalid, orow0, e; };
struct Gemm { const bf16_t* A; const bf16_t* Bt; int K; };

__device__ __forceinline__ int xcd_remap(int wgid, int nwg) { const int q = nwg / NXCD, r = nwg % NXCD, xcd = wgid % NXCD, off = wgid / NXCD; return (xcd < r ? xcd * (q + 1) : r * (q + 1) + (xcd - r) * q) + off; }

struct DenseOrder {
    int nM, nN, nwg, G, c, K, skip9;
    static constexpr bool GATHER = false;
    __device__ void init(int M, int N, int K_, int G_, int c_, int skip9_ = 0) { skip9 = skip9_; nM = skip9 ? (M / BM) * 8 / 9 : M / BM; nN = N / BM; nwg = nM * nN; G = G_; c = c_; K = K_; }
    __device__ bool next(int i, Unit& u) const {
        const long L = (long)i * G + c; if (L >= nwg) return false;
        const int wgid = xcd_remap((int)L, nwg);
        const int nig = WGM * nN, gid = wgid / nig, fm = gid * WGM, gsz = (nM - fm) < WGM ? (nM - fm) : WGM;
        u.pm = fm + ((wgid % nig) % gsz); u.pn = (wgid % nig) / gsz;
        if (skip9) u.pm = u.pm + u.pm / 8 + 1;
        u.aoff = (size_t)u.pm * BM * K * 2; u.boff = (size_t)u.pn * BM * K * 2; u.gbase = 0; u.nvalid = BM; u.orow0 = u.pm * BM; u.e = 0; return true;
    }
    __device__ __forceinline__ int token(const Unit&, int) const { return 0; }
};

__device__ __forceinline__ unsigned cvt_pk_bf16(float lo, float hi) { unsigned r; asm volatile("v_cvt_pk_bf16_f32 %0, %1, %2" : "=v"(r) : "v"(lo), "v"(hi)); return r; }

template <class Epi, class Sched>
__device__ __forceinline__ void gemm_phase(PG8_LAS unsigned char* lds, const Gemm g, const Sched& S, const Epi& E, int wave_id) {
    int tid = (wave_id << 6) | (int)__builtin_amdgcn_mbcnt_hi(~0u, __builtin_amdgcn_mbcnt_lo(~0u, 0u)); asm volatile("" : "+v"(tid));
    const int wid = __builtin_amdgcn_readfirstlane(tid >> 6), lane = tid & 63, wr = wid >> 2, wc = wid & 3, fr = lane & 15, fq = lane >> 4;
    const int K = g.K, nt = K / BK;
    int RA[2], CA[2];
    unsigned voffB[2], voffA[2][2], voffAn[2][2];
#pragma unroll
    for (int i = 0; i < 2; ++i) { int R, C; stage_rc(tid * 16 + i * 8192, R, C); RA[i] = R; CA[i] = C; const int Rb = Epi::PERM ? ((R & ~31) + perm32(R & 31)) : R;
        voffB[i] = (unsigned)(Rb * K + C) * 2u;
        voffA[0][i] = (unsigned)(R * K + C) * 2u; voffA[1][i] = (unsigned)((R + HALF) * K + C) * 2u; voffAn[0][i] = voffA[0][i]; voffAn[1][i] = voffA[1][i]; }
    const size_t kstep = (size_t)(BK * 2);
    const size_t hstep = (size_t)HALF * K * 2;
    const unsigned ldsw = (unsigned)wid * 1024u;
    const int aoff = lds_byte(wr * 64 + fr, fq * 8), boff = lds_byte(wc * 32 + fr, fq * 8);
#define PG8_SA(b, h) (((b) * 2 + (h)) * HTB)
#define PG8_SB(b, h) ((4 + (b) * 2 + (h)) * HTB)
#define PG8_STAGE(bufoff, gbase, voff) do { _Pragma("unroll") for (int _i = 0; _i < 2; ++_i) \
        __builtin_amdgcn_global_load_lds((const unsigned*)((const char*)(gbase) + (voff)[_i]), (PG8_LAS unsigned*)(lds + (bufoff) + ldsw + _i * 8192), 16, 0, 0); } while (0)
#define PG8_LDA(dst, b, h) do { _Pragma("unroll") for (int m = 0; m < 4; ++m) _Pragma("unroll") for (int k = 0; k < 2; ++k) dst[m][k] = *(const PG8_LAS bf16x8*)(lds + PG8_SA(b, h) + aoff + m * 2048 + k * 1024); } while (0)
#define PG8_LDB(dst, b, h) do { _Pragma("unroll") for (int n = 0; n < 2; ++n) _Pragma("unroll") for (int k = 0; k < 2; ++k) dst[n][k] = *(const PG8_LAS bf16x8*)(lds + PG8_SB(b, h) + boff + n * 2048 + k * 1024); } while (0)
#define PG8_MMA(ai, bj, At, Bt) do { __builtin_amdgcn_s_setprio(1); _Pragma("unroll") for (int m = 0; m < 4; ++m) _Pragma("unroll") for (int n = 0; n < 2; ++n) _Pragma("unroll") for (int k = 0; k < 2; ++k) \
        acc[ai][bj][m][n] = __builtin_amdgcn_mfma_f32_16x16x32_bf16(Bt[n][k], At[m][k], acc[ai][bj][m][n], 0, 0, 0); __builtin_amdgcn_s_setprio(0); } while (0)
#define PG8_WAIT_V(n) asm volatile("s_waitcnt vmcnt(" #n ")" ::: "memory")
#define PG8_WAIT_L(n) asm volatile("s_waitcnt lgkmcnt(" #n ")" ::: "memory")
#define PG8_BAR __builtin_amdgcn_s_barrier()
#define PG8_SCHED __builtin_amdgcn_sched_barrier(0)
#define PG8_GOFF(dst, U) do { if constexpr (Sched::GATHER) { _Pragma("unroll") for (int _h = 0; _h < 2; ++_h) _Pragma("unroll") for (int _i = 0; _i < 2; ++_i) \
        dst[_h][_i] = (unsigned)(S.token(U, _h * HALF + RA[_i]) * K + CA[_i]) * 2u; } } while (0)
    Unit cur, nxt; int ui = 0;
    if (!S.next(0, cur)) return;
    f32x4 acc[2][2][4][2];
#pragma unroll
    for (int a = 0; a < 2; ++a)
#pragma unroll
        for (int b = 0; b < 2; ++b)
#pragma unroll
            for (int m = 0; m < 4; ++m)
#pragma unroll
                for (int n = 0; n < 2; ++n) acc[a][b][m][n] = (f32x4){0.f, 0.f, 0.f, 0.f};
    bf16x8 At[4][2], B0[2][2], B1[2][2];
    PG8_GOFF(voffA, cur);
    const char* cA = (const char*)g.A + (Sched::GATHER ? (size_t)0 : cur.aoff); const char* cB = (const char*)g.Bt + cur.boff;
    PG8_STAGE(PG8_SB(0, 0), cB, voffB); PG8_STAGE(PG8_SA(0, 0), cA, voffA[0]); PG8_STAGE(PG8_SB(0, 1), cB + hstep, voffB); PG8_STAGE(PG8_SA(0, 1), cA, voffA[1]);
    if (wr == 1) PG8_BAR;
    PG8_WAIT_V(4); PG8_BAR;
    PG8_STAGE(PG8_SB(1, 0), cB + kstep, voffB); PG8_STAGE(PG8_SA(1, 0), cA + kstep, voffA[0]); PG8_STAGE(PG8_SB(1, 1), cB + hstep + kstep, voffB);
    PG8_WAIT_V(6); PG8_BAR;
    for (;;) {
        const bool has_next = S.next(ui + 1, nxt);
        if (has_next) { PG8_GOFF(voffAn, nxt); if constexpr (Sched::GATHER) { asm volatile("" : "+v"(voffAn[0][0]), "+v"(voffAn[0][1]), "+v"(voffAn[1][0]), "+v"(voffAn[1][1])); } }
        const char* nA = has_next ? (const char*)g.A + (Sched::GATHER ? (size_t)0 : nxt.aoff) : cA; const char* nB = has_next ? (const char*)g.Bt + nxt.boff : cB;
        for (int t = 0; t < nt; t += 2) {
            const bool last = (t == nt - 2);
            const char* a1 = cA + (size_t)(t + 1) * kstep;
            const char* a2 = last ? nA : cA + (size_t)(t + 2) * kstep; const char* b2 = last ? nB : cB + (size_t)(t + 2) * kstep;
            const char* a3 = a2 + kstep; const char* b3 = b2 + kstep;
            unsigned va2[2][2];
#pragma unroll
            for (int h = 0; h < 2; ++h)
#pragma unroll
                for (int i = 0; i < 2; ++i) va2[h][i] = (Sched::GATHER && last && has_next) ? voffAn[h][i] : voffA[h][i];
            PG8_LDB(B0, 0, 0); PG8_SCHED; PG8_LDA(At, 0, 0); PG8_STAGE(PG8_SA(1, 1), a1, voffA[1]);
            PG8_WAIT_L(8); PG8_BAR; PG8_WAIT_L(0); PG8_MMA(0, 0, At, B0); PG8_BAR; PG8_SCHED;
            PG8_LDB(B1, 0, 1); PG8_STAGE(PG8_SB(0, 0), b2, voffB);
            PG8_BAR; PG8_WAIT_L(0); PG8_MMA(0, 1, At, B1); PG8_BAR;
            PG8_LDA(At, 0, 1); PG8_STAGE(PG8_SA(0, 0), a2, va2[0]);
            PG8_BAR; PG8_WAIT_L(0); PG8_MMA(1, 0, At, B0); PG8_BAR; PG8_SCHED;
            PG8_STAGE(PG8_SB(0, 1), b2 + hstep, voffB);
            PG8_WAIT_V(6); PG8_BAR; PG8_MMA(1, 1, At, B1); PG8_BAR;
            PG8_LDB(B0, 1, 0); PG8_SCHED; PG8_LDA(At, 1, 0); PG8_STAGE(PG8_SA(0, 1), a2, va2[1]);
            PG8_WAIT_L(8); PG8_BAR; PG8_WAIT_L(0); PG8_MMA(0, 0, At, B0); PG8_BAR; PG8_SCHED;
            PG8_LDB(B1, 1, 1); PG8_STAGE(PG8_SB(1, 0), b3, voffB);
            PG8_BAR; PG8_WAIT_L(0); PG8_MMA(0, 1, At, B1); PG8_BAR;
            PG8_LDA(At, 1, 1); PG8_STAGE(PG8_SA(1, 0), a3, va2[0]);
            PG8_BAR; PG8_WAIT_L(0); PG8_MMA(1, 0, At, B0); PG8_BAR; PG8_SCHED;
            PG8_STAGE(PG8_SB(1, 1), b3 + hstep, voffB);
            PG8_WAIT_V(6); PG8_BAR; PG8_MMA(1, 1, At, B1); PG8_BAR;
        }
        E(acc, cur, wr, wc, fr, fq);
        if (!has_next) break;
#pragma unroll
        for (int a = 0; a < 2; ++a)
#pragma unroll
            for (int b = 0; b < 2; ++b)
#pragma unroll
                for (int m = 0; m < 4; ++m)
#pragma unroll
                    for (int n = 0; n < 2; ++n) acc[a][b][m][n] = (f32x4){0.f, 0.f, 0.f, 0.f};
        cur = nxt; cA = nA; cB = nB; ++ui;
        if constexpr (Sched::GATHER) {
#pragma unroll
            for (int h = 0; h < 2; ++h)
#pragma unroll
                for (int i = 0; i < 2; ++i) voffA[h][i] = voffAn[h][i];
        }
    }
    PG8_WAIT_V(0);
    if (wr == 0) PG8_BAR;
    PG8_BAR;
#undef PG8_SA
#undef PG8_SB
#undef PG8_STAGE
#undef PG8_LDA
#undef PG8_LDB
#undef PG8_MMA
#undef PG8_WAIT_V
#undef PG8_WAIT_L
#undef PG8_BAR
#undef PG8_SCHED
#undef PG8_GOFF
}
}
namespace att {
using bf16x8 = __attribute__((ext_vector_type(8))) short;
using s16x4  = __attribute__((ext_vector_type(4))) short;
using f32x16 = __attribute__((ext_vector_type(16))) float;
using u32x4  = __attribute__((ext_vector_type(4))) unsigned;
typedef unsigned short bf16_t;
constexpr int NW = 8, QBLK = 32, KVBLK = 64;
constexpr float THR = 8.f;
constexpr size_t SHM_V = KVBLK * 128 * 2, SHM_K = KVBLK * 128 * 2, SHM_ATTN = 2 * SHM_V + 2 * SHM_K + NW * 64 * 4;
#define KSWZ(row, colB) ((row) * 256 + ((colB) ^ (((row) & 7) << 4)))
#define KSWZ64(row, colB) ((row) * 128 + ((colB) ^ ((((row) >> 1) & 7) << 4)))
#define SBAR() __builtin_amdgcn_sched_barrier(0)
__device__ __forceinline__ int crow(int r, int hi) { return (r & 3) + 8 * (r >> 2) + 4 * hi; }
__device__ __forceinline__ unsigned cvtpk(float lo, float hi) { unsigned r; asm volatile("v_cvt_pk_bf16_f32 %0, %1, %2" : "=v"(r) : "v"(lo), "v"(hi)); return r; }

template <int DQK> struct Sc { static constexpr float SCALE = (DQK == 64) ? 0.125f : 0.088388347648318440f; };

template <int DQK>
__device__ __forceinline__ void partialSM(f32x16& p0, f32x16& p1, float& m_reg, float& mn, float& alpha) {
  constexpr float SCALE = Sc<DQK>::SCALE;
  constexpr float C = SCALE * 1.4426950408889634f;
  float pmax = p0[0];
#pragma unroll
  for (int r = 1; r < 16; ++r) pmax = fmaxf(pmax, p0[r]);
#pragma unroll
  for (int r = 0; r < 16; ++r) pmax = fmaxf(pmax, p1[r]);
  { auto rr = __builtin_amdgcn_permlane32_swap(__float_as_uint(pmax), __float_as_uint(pmax), false, false);
    pmax = fmaxf(__uint_as_float(rr[0]), __uint_as_float(rr[1])); }
  if (__builtin_expect(__all(pmax - m_reg <= THR / SCALE), 1)) { mn = m_reg; alpha = 1.f; }
  else { mn = fmaxf(m_reg, pmax); alpha = __builtin_amdgcn_exp2f((m_reg - mn) * C); m_reg = mn; }
  float mnC = -mn * C;
#pragma unroll
  for (int r = 0; r < 16; ++r) p0[r] = fmaf(p0[r], C, mnC);
#pragma unroll
  for (int r = 0; r < 16; ++r) p1[r] = fmaf(p1[r], C, mnC);
#pragma unroll
  for (int r = 0; r < 16; ++r) p0[r] = __builtin_amdgcn_exp2f(p0[r]);
}
__device__ __forceinline__ void finishSM(f32x16& p0, f32x16& p1, float alpha, float& l_reg, bf16x8& pa0, bf16x8& pa1, bf16x8& pa2, bf16x8& pa3) {
#pragma unroll
  for (int r = 0; r < 16; ++r) p1[r] = __builtin_amdgcn_exp2f(p1[r]);
  float ps = 0;
#pragma unroll
  for (int r = 0; r < 16; ++r) ps += p0[r];
#pragma unroll
  for (int r = 0; r < 16; ++r) ps += p1[r];
  { auto rr = __builtin_amdgcn_permlane32_swap(__float_as_uint(ps), __float_as_uint(ps), false, false);
    ps = __uint_as_float(rr[0]) + __uint_as_float(rr[1]); }
  l_reg = l_reg * alpha + ps;
#define PK4(P, BASE, OUT) do { unsigned a0 = cvtpk(P[BASE + 0], P[BASE + 1]), a1 = cvtpk(P[BASE + 2], P[BASE + 3]);   \
    unsigned b0 = cvtpk(P[BASE + 4], P[BASE + 5]), b1 = cvtpk(P[BASE + 6], P[BASE + 7]);                              \
    auto r0 = __builtin_amdgcn_permlane32_swap(a0, b0, false, false); auto r1 = __builtin_amdgcn_permlane32_swap(a1, b1, false, false); \
    u32x4 w = {r0[0], r1[0], r0[1], r1[1]}; OUT = *reinterpret_cast<bf16x8*>(&w); } while (0)
  PK4(p0, 0, pa0); PK4(p0, 8, pa1); PK4(p1, 0, pa2); PK4(p1, 8, pa3);
#undef PK4
}
template <int DQK>
__device__ __forceinline__ void qkt(f32x16& p0, f32x16& p1, const char* Ks, const bf16x8* qr, int r32, int hi) {
#pragma unroll
  for (int r = 0; r < 16; ++r) { p0[r] = 0.f; p1[r] = 0.f; }
  asm volatile("" : "+v"(p0), "+v"(p1));
#pragma unroll
  for (int d0 = 0; d0 < DQK / 16; ++d0) { const int cb = (d0 * 16 + hi * 8) * 2;
    bf16x8 b0, b1;
    if constexpr (DQK == 128) { b0 = *reinterpret_cast<const bf16x8*>(Ks + KSWZ(r32, cb)); b1 = *reinterpret_cast<const bf16x8*>(Ks + KSWZ(32 + r32, cb)); }
    else { b0 = *reinterpret_cast<const bf16x8*>(Ks + KSWZ64(r32, cb)); b1 = *reinterpret_cast<const bf16x8*>(Ks + KSWZ64(32 + r32, cb)); }
    p0 = __builtin_amdgcn_mfma_f32_32x32x16_bf16(b0, qr[d0], p0, 0, 0, 0);
    p1 = __builtin_amdgcn_mfma_f32_32x32x16_bf16(b1, qr[d0], p1, 0, 0, 0); }
}
__device__ __forceinline__ int v_st(int k, int c) { const int kk = (k & ~0xC) | ((k & 4) << 1) | ((k & 8) >> 1); return ((kk >> 3) * 4 + (c >> 5)) * 512 + ((kk & 7) * 32 + (c & 31)) * 2; }
__device__ __forceinline__ int v_rd_base(int lane) { return ((lane & 3) << 3) | (((lane >> 2) & 3) << 6) | (((lane >> 4) & 1) << 5) | (((lane >> 5) & 1) << 8); }
constexpr int v_rd_off(int d0, int ks, int half) { return d0 * 512 + ks * 4096 + half * 2048; }
template <int OFF> __device__ __forceinline__ s16x4 tr_read(int vb) {
  s16x4 r; asm volatile("ds_read_b64_tr_b16 %0, %1 offset:%2" : "=&v"(r) : "v"(vb), "i"(OFF) : "memory"); return r;
}
template <int D0> __device__ __forceinline__ void pv_one(f32x16& od, int vb, bf16x8 pa0, bf16x8 pa1, bf16x8 pa2, bf16x8 pa3) {
  const s16x4 l0 = tr_read<v_rd_off(D0, 0, 0)>(vb), h0 = tr_read<v_rd_off(D0, 0, 1)>(vb), l1 = tr_read<v_rd_off(D0, 1, 0)>(vb), h1 = tr_read<v_rd_off(D0, 1, 1)>(vb);
  const s16x4 l2 = tr_read<v_rd_off(D0, 2, 0)>(vb), h2 = tr_read<v_rd_off(D0, 2, 1)>(vb), l3 = tr_read<v_rd_off(D0, 3, 0)>(vb), h3 = tr_read<v_rd_off(D0, 3, 1)>(vb);
  asm volatile("s_waitcnt lgkmcnt(0)" ::: "memory"); SBAR();
#define PK(L, H) (bf16x8){L[0], L[1], L[2], L[3], H[0], H[1], H[2], H[3]}
  od = __builtin_amdgcn_mfma_f32_32x32x16_bf16(pa0, PK(l0, h0), od, 0, 0, 0);
  od = __builtin_amdgcn_mfma_f32_32x32x16_bf16(pa1, PK(l1, h1), od, 0, 0, 0);
  od = __builtin_amdgcn_mfma_f32_32x32x16_bf16(pa2, PK(l2, h2), od, 0, 0, 0);
  od = __builtin_amdgcn_mfma_f32_32x32x16_bf16(pa3, PK(l3, h3), od, 0, 0, 0);
#undef PK
}
__device__ __forceinline__ void pv_d0(f32x16* o, int vb, bf16x8 pa0, bf16x8 pa1, bf16x8 pa2, bf16x8 pa3) {
  pv_one<0>(o[0], vb, pa0, pa1, pa2, pa3); pv_one<1>(o[1], vb, pa0, pa1, pa2, pa3); pv_one<2>(o[2], vb, pa0, pa1, pa2, pa3); pv_one<3>(o[3], vb, pa0, pa1, pa2, pa3);
}

template <int DQK, int LDQ, int LDK, int LDO, bool QN = false>
__device__ __forceinline__ void attn_body(const bf16_t* __restrict__ Qb, const bf16_t* __restrict__ Kh, const bf16_t* __restrict__ Vh, bf16_t* __restrict__ Ob, int seq, char* lds, int wave_id,
                                          const float* qg = nullptr, const float* cs = nullptr, const float* sn = nullptr, int qpos0 = 0, float qeps = 0.f) {
  int tid = (wave_id << 6) | (int)__builtin_amdgcn_mbcnt_hi(~0u, __builtin_amdgcn_mbcnt_lo(~0u, 0u)); asm volatile("" : "+v"(tid));
  const int wid = tid >> 6, lane = tid & 63, r32 = lane & 31, hi = lane >> 5;
  char* V_lds = lds; char* K_lds = lds + 2 * SHM_V;
  float* ws = (float*)(lds + 2 * SHM_V + 2 * SHM_K) + wid * 64; float* li_l = ws; float* al_l = ws + 32;
  float m_reg = -1e30f, l_reg = 0; f32x16 o[4] = {}; bf16x8 qr[DQK / 16];
  const bf16_t* Qw = Qb + (long)(wid * QBLK + r32) * LDQ + hi * 8;
#pragma unroll
  for (int d0 = 0; d0 < DQK / 16; ++d0) qr[d0] = *reinterpret_cast<const bf16x8*>(Qw + d0 * 16);
  if constexpr (QN) {
    static_assert(!QN || DQK == 128, "QN needs head dim 128");
    float qf[8][8]; float ss = 0.f;
#pragma unroll
    for (int d0 = 0; d0 < 8; ++d0)
#pragma unroll
      for (int j = 0; j < 8; ++j) { const float v = __builtin_bit_cast(float, (unsigned)(unsigned short)qr[d0][j] << 16); qf[d0][j] = v; ss += v * v; }
    { auto rr = __builtin_amdgcn_permlane32_swap(__float_as_uint(ss), __float_as_uint(ss), false, false); ss = __uint_as_float(rr[0]) + __uint_as_float(rr[1]); }
    const float ri = __builtin_amdgcn_rsqf(ss * (1.f / 128.f) + qeps);
    const int pos = qpos0 + wid * QBLK + r32;
#pragma unroll
    for (int d0 = 0; d0 < 4; ++d0) {
      const int i0 = 16 * d0 + 8 * hi;
#pragma unroll
      for (int j = 0; j < 8; ++j) { const float c = cs[pos * 64 + i0 + j], s = sn[pos * 64 + i0 + j];
        const float y1 = qf[d0][j] * ri * qg[i0 + j], y2 = qf[d0 + 4][j] * ri * qg[64 + i0 + j];
        qf[d0][j] = y1 * c - y2 * s; qf[d0 + 4][j] = y1 * s + y2 * c; }
    }
#pragma unroll
    for (int d0 = 0; d0 < 8; ++d0) { u32x4 w = {cvtpk(qf[d0][0], qf[d0][1]), cvtpk(qf[d0][2], qf[d0][3]), cvtpk(qf[d0][4], qf[d0][5]), cvtpk(qf[d0][6], qf[d0][7])}; qr[d0] = *reinterpret_cast<bf16x8*>(&w); }
  }
  const int sr = tid >> 4, sc = (tid & 15) * 8, vst0 = v_st(sr, sc), vst1 = v_st(32 + sr, sc);
  const int kr64 = tid >> 3, kc64 = (tid & 7) * 8;
  const int vb0 = (int)(uintptr_t)V_lds + v_rd_base(lane);
  struct { bf16x8 vs0, vs1, ks0, ks1; } sr_[2];
#define SLOAD(i, k0) do { sr_[i].vs0 = *reinterpret_cast<const bf16x8*>(&Vh[(long)((k0) + sr) * LDK + sc]); sr_[i].vs1 = *reinterpret_cast<const bf16x8*>(&Vh[(long)((k0) + 32 + sr) * LDK + sc]); \
    if constexpr (DQK == 128) { sr_[i].ks0 = *reinterpret_cast<const bf16x8*>(&Kh[(long)((k0) + sr) * LDK + sc]); sr_[i].ks1 = *reinterpret_cast<const bf16x8*>(&Kh[(long)((k0) + 32 + sr) * LDK + sc]); } \
    else { sr_[i].ks0 = *reinterpret_cast<const bf16x8*>(&Kh[(long)((k0) + kr64) * LDK + kc64]); } } while (0)
#define SWRITE(b, i) do { *(bf16x8*)(V_lds + (b) * SHM_V + vst0) = sr_[i].vs0;          \
    *(bf16x8*)(V_lds + (b) * SHM_V + vst1) = sr_[i].vs1;               \
    if constexpr (DQK == 128) { const int kc = sc * 2; *(bf16x8*)(K_lds + (b) * SHM_K + KSWZ(sr, kc)) = sr_[i].ks0; *(bf16x8*)(K_lds + (b) * SHM_K + KSWZ(32 + sr, kc)) = sr_[i].ks1; } \
    else { const int kc = kc64 * 2; *(bf16x8*)(K_lds + (b) * SHM_K + KSWZ64(kr64, kc)) = sr_[i].ks0; } } while (0)
#define SWAIT() do { if constexpr (DQK == 128) asm volatile("s_waitcnt vmcnt(4)" ::: "memory"); else asm volatile("s_waitcnt vmcnt(3)" ::: "memory"); } while (0)
#define RESC(a) do { if (__any((a) < 1.f)) { if (hi == 0) al_l[r32] = (a); asm volatile("s_waitcnt lgkmcnt(0)" ::: "memory"); \
    _Pragma("unroll") for (int d = 0; d < 4; ++d) _Pragma("unroll") for (int r = 0; r < 16; ++r) o[d][r] *= al_l[crow(r, hi)]; } } while (0)
  f32x16 pA0, pA1, pB0, pB1; float mnA, mnB, alA, alB; bf16x8 pa0, pa1, pa2, pa3; const int NT = seq / KVBLK;
  constexpr int SE = 0, SO = 1;
  SLOAD(SE, 0); asm volatile("s_waitcnt vmcnt(0)" ::: "memory"); SWRITE(0, SE); __syncthreads();
  qkt<DQK>(pA0, pA1, K_lds, qr, r32, hi); partialSM<DQK>(pA0, pA1, m_reg, mnA, alA);
  SLOAD(SO, KVBLK); if (2 < NT) SLOAD(SE, 2 * KVBLK);
  if (2 < NT) { SWAIT(); } else { asm volatile("s_waitcnt vmcnt(0)" ::: "memory"); }
  SWRITE(1, SO); __syncthreads();
  for (int j = 1; j + 1 < NT; j += 2) {
    SBAR(); qkt<DQK>(pB0, pB1, K_lds + SHM_K, qr, r32, hi);
    finishSM(pA0, pA1, alA, l_reg, pa0, pa1, pa2, pa3); SBAR();
    SLOAD(SO, (j + 2) * KVBLK); SBAR();
    pv_d0(o, vb0, pa0, pa1, pa2, pa3); partialSM<DQK>(pB0, pB1, m_reg, mnB, alB);
    __syncthreads(); SWAIT(); SWRITE(0, SE);
    RESC(alB); __syncthreads();
    SBAR(); qkt<DQK>(pA0, pA1, K_lds, qr, r32, hi);
    finishSM(pB0, pB1, alB, l_reg, pa0, pa1, pa2, pa3); SBAR();
    if (j + 3 < NT) SLOAD(SE, (j + 3) * KVBLK); SBAR();
    pv_d0(o, vb0 + (int)SHM_V, pa0, pa1, pa2, pa3); partialSM<DQK>(pA0, pA1, m_reg, mnA, alA);
    __syncthreads(); if (j + 3 < NT) { SWAIT(); } else { asm volatile("s_waitcnt vmcnt(0)" ::: "memory"); } SWRITE(1, SO);
    RESC(alA); __syncthreads();
  }
  SBAR(); qkt<DQK>(pB0, pB1, K_lds + SHM_K, qr, r32, hi);
  finishSM(pA0, pA1, alA, l_reg, pa0, pa1, pa2, pa3); SBAR();
  pv_d0(o, vb0, pa0, pa1, pa2, pa3); partialSM<DQK>(pB0, pB1, m_reg, mnB, alB);
  __syncthreads(); RESC(alB);
  finishSM(pB0, pB1, alB, l_reg, pa0, pa1, pa2, pa3); SBAR();
  pv_d0(o, vb0 + (int)SHM_V, pa0, pa1, pa2, pa3);
  if (hi == 0) li_l[r32] = l_reg; asm volatile("s_waitcnt lgkmcnt(0)" ::: "memory");
  float rli[16];
#pragma unroll
  for (int r = 0; r < 16; ++r) rli[r] = __builtin_amdgcn_rcpf(li_l[crow(r, hi)]);
  bf16_t* Ow = Ob + (long)(wid * QBLK) * LDO;
#pragma unroll
  for (int r = 0; r < 16; ++r) { const int orow = crow(r, hi);
#pragma unroll
    for (int d0 = 0; d0 < 4; ++d0) { const float v = o[d0][r] * rli[r]; Ow[(long)orow * LDO + d0 * 32 + r32] = (bf16_t)(cvtpk(v, v) & 0xffffu); } }
  __syncthreads();
#undef SLOAD
#undef SWRITE
#undef SWAIT
#undef RESC
}
#undef SBAR
}
constexpr int NWAVES = 8, NTHR = 512;
constexpr int NB = 8, SEQ = 2048, CTXL = 256, TPB = CTXL + SEQ  , MROWS = NB * TPB  , DM = 1024;
constexpr int A_W = 512, A_IN = 1920, B_IN = 1536, EVEN_IN = 3456, EVEN_PAD = 3584, ODD_IN = 1536;
constexpr int NEXP = 16, EFF = 512, CAP = MROWS, MOE_ROWS = 40960;
constexpr float LN_EPS = 1e-5f, ALPHA = 1.4142135623730951f, GN_EPS = 64e-5f, SUBLN_EPS = 1e-5f, QKN_EPS = 1e-6f, LAMBDA_INIT0 = 0.2f;

constexpr size_t MiB = 1u << 20;
constexpr size_t WS_CTL = 0, CTL_ZERO_BYTES = 1 * MiB;
constexpr size_t WS_MOD = 1 * MiB;
constexpr size_t WS_ROPE = 2 * MiB;
constexpr size_t WS_WEVIN = 4 * MiB, WS_WEVOUT = 11 * MiB, WS_WODIN = 13 * MiB, WS_WODOUT = 16 * MiB;
constexpr size_t WS_WM13 = 18 * MiB, WS_WM2 = 50 * MiB;
constexpr size_t WS_H = 66 * MiB;
constexpr size_t WS_X = 102 * MiB;
constexpr size_t CH_BYTES = (size_t)4608 * 64 * 64 * 2;
constexpr size_t WS_CHG = 18 * MiB, WS_CHH = 54 * MiB, WS_CHRQ = 90 * MiB, WS_CHY = 126 * MiB;
constexpr size_t FEAT_BYTES = (size_t)MROWS * 512 * 2;
constexpr size_t WS_VOUT = 162 * MiB, WS_GOUT = 180 * MiB;
constexpr size_t WS_PA = 198 * MiB;
constexpr size_t WS_PB = 270 * MiB;
constexpr size_t WS_GL = 324 * MiB;
constexpr size_t WS_BON = WS_GL + (size_t)4608 * 64 * 4;
constexpr size_t WS_LORA = WS_BON + (size_t)2 * MROWS * 8 * 4;
constexpr size_t WS_OB0 = WS_PA, WS_OB1 = WS_PA + FEAT_BYTES;
constexpr size_t WS_A2 = WS_PA + 2 * FEAT_BYTES;
constexpr size_t WS_TAIL = 300 * MiB;
constexpr size_t WS_MIX = WS_TAIL;
constexpr size_t WS_HID = 174 * MiB;
constexpr size_t WS_Y = 214 * MiB;
constexpr size_t WS_QKV1 = 174 * MiB;
constexpr size_t WS_OATT = 228 * MiB;
static_assert(WS_CHY + CH_BYTES <= WS_VOUT && WS_GOUT + FEAT_BYTES <= WS_PA && WS_A2 + 2 * FEAT_BYTES <= WS_PB && WS_PB + (size_t)MROWS * 1536 * 2 <= WS_GL && WS_LORA + 393216 <= 328 * MiB
              && WS_Y + (size_t)MOE_ROWS * 1024 * 2 <= WS_TAIL && WS_OATT + 2 * FEAT_BYTES <= WS_TAIL && WS_MIX + 2 * FEAT_BYTES <= 336 * MiB && WS_A2 >= WS_HID + 40 * MiB - 40 * MiB, "ws map");
constexpr int CW_BAR = 4096;
constexpr int CW_CNT = 16384;
constexpr int CW_Q0 = 20480;
constexpr size_t WS_ROUTE = 336 * MiB;
constexpr size_t WS_PERM_ = WS_ROUTE, WS_GATE = WS_ROUTE + (size_t)NEXP * CAP * 4, WS_TOK = WS_GATE + (size_t)NEXP * CAP * 4, WS_TOTAL = WS_TOK + (size_t)MROWS * 2 * 4;
static_assert(WS_TOTAL <= 339 * MiB, "ws total");

constexpr int RING_OFF = 0, RING_BYTES = 147456;
constexpr int LDSCTL_OFF = RING_BYTES, MISC_OFF = LDSCTL_OFF + 320;
constexpr int MOETAB_OFF = LDSCTL_OFF + 1024;
constexpr int LDS_BYTES = 163840;

#define GAS __attribute__((address_space(1)))
#define LAS __attribute__((address_space(3)))
typedef unsigned short bf16;
typedef unsigned v4u __attribute__((ext_vector_type(4)));
typedef unsigned v2u __attribute__((ext_vector_type(2)));
typedef float f32x4 __attribute__((ext_vector_type(4)));
typedef short bf16x8 __attribute__((ext_vector_type(8)));
typedef GAS unsigned gu32;
#define RLX_AGENT __ATOMIC_RELAXED, __HIP_MEMORY_SCOPE_AGENT
#define LDS_WAIT() asm volatile("s_waitcnt lgkmcnt(0)" ::: "memory")
#define VM_WAIT() asm volatile("s_waitcnt vmcnt(0)" ::: "memory")
__device__ __forceinline__ unsigned pk2(float lo, float hi) { typedef float f32x2_t __attribute__((ext_vector_type(2))); typedef __bf16 bf16x2_t __attribute__((ext_vector_type(2)));
    f32x2_t v = {lo, hi}; bf16x2_t b = __builtin_convertvector(v, bf16x2_t); return __builtin_bit_cast(unsigned, b); }
__device__ __forceinline__ unsigned f2bf(float f) { return pk2(f, 0.f) & 0xffffu; }
__device__ __forceinline__ float bf2f(unsigned short b) { return __builtin_bit_cast(float, (unsigned)b << 16); }
__device__ __forceinline__ float bflo(unsigned w) { return __builtin_bit_cast(float, w << 16); }
__device__ __forceinline__ float bfhi(unsigned w) { return __builtin_bit_cast(float, w & 0xffff0000u); }
__device__ __forceinline__ float sigmoidf_(float x) { return 1.f / (1.f + __expf(-x)); }
template <int CTRL> __device__ __forceinline__ float dpp_f(float v) { return __builtin_bit_cast(float, __builtin_amdgcn_update_dpp(0, __builtin_bit_cast(int, v), CTRL, 0xF, 0xF, false)); }
__device__ __forceinline__ float sum4(float v) { v += dpp_f<0xB1>(v); v += dpp_f<0x4E>(v); return v; }
__device__ __forceinline__ float sum8(float v) { v = sum4(v); v += dpp_f<0x141>(v); return v; }
__device__ __forceinline__ float sum16(float v) { v = sum8(v); v += dpp_f<0x140>(v); return v; }
__device__ __forceinline__ float wave_sum(float v) {
    v = sum16(v);
    v += __builtin_bit_cast(float, __builtin_amdgcn_update_dpp(0, __builtin_bit_cast(int, v), 0x142, 0xA, 0xF, false));
    v += __builtin_bit_cast(float, __builtin_amdgcn_update_dpp(0, __builtin_bit_cast(int, v), 0x143, 0xC, 0xF, false));
    return __builtin_bit_cast(float, __builtin_amdgcn_readlane(__builtin_bit_cast(int, v), 63));
}

#define XB_TMO      128
#define XB_XCNT(j)  (256  + 64 * (j))
#define XB_XSUB(j)  (1280 + 64 * (j))
#define XB_XGEN(j)  (2304 + 64 * (j))
#define XB_TOP      3328
#define XB_TOPGEN   3392
#define XCD_BAR_WORDS 3456
#define XB_SPIN_CAP (1u << 22)
__device__ __forceinline__ unsigned xb_ld(unsigned* p)              { return __hip_atomic_load(p, __ATOMIC_RELAXED, __HIP_MEMORY_SCOPE_AGENT); }
__device__ __forceinline__ unsigned xb_add(unsigned* p, unsigned v) { return __hip_atomic_fetch_add(p, v, __ATOMIC_RELAXED, __HIP_MEMORY_SCOPE_AGENT); }
__device__ __forceinline__ unsigned xb_xcc_id() { return (unsigned)__builtin_amdgcn_s_getreg((3 << 11) | 20) & 0xFu; }
#define XB_SPIN(cond, bar) do { unsigned _sp = 0; while (cond) { __builtin_amdgcn_s_sleep(1); \
    if ((++_sp & 255u) == 0u) { if (xb_ld(&(bar)[XB_TMO])) break; if (_sp > XB_SPIN_CAP) { atomicAdd(&(bar)[XB_TMO], 1u); break; } } } } while (0)
struct XcdBarrier { unsigned* bar; unsigned x; volatile LAS unsigned* st; };
__device__ __forceinline__ XcdBarrier xcd_barrier_post(unsigned* bar, volatile LAS unsigned* st) {
    XcdBarrier b; b.bar = bar; b.x = xb_xcc_id(); b.st = st;
    if (threadIdx.x == 0) (void)xb_add(&bar[XB_XCNT(b.x)], 1u);
    return b;
}
__device__ __forceinline__ void xcd_barrier_complete(unsigned* bar, unsigned x, unsigned& nloc, unsigned& nx) {
    const unsigned G = gridDim.x * gridDim.y * gridDim.z;
    unsigned sum, cnt, mine, sp = 0u;
    for (;;) {
        sum = 0u; cnt = 0u; mine = 0u;
#pragma unroll
        for (unsigned j = 0; j < 16; ++j) { const unsigned c = xb_ld(&bar[XB_XCNT(j)]); sum += c; cnt += (c > 0u) ? 1u : 0u; mine = (j == x) ? c : mine; }
        if (sum == G) break;
        __builtin_amdgcn_s_sleep(1);
        if ((++sp & 255u) == 0u) { if (xb_ld(&bar[XB_TMO])) break; if (sp > XB_SPIN_CAP) { atomicAdd(&bar[XB_TMO], 1u); break; } }
    }
    nloc = mine > 0u ? mine : 1u; nx = cnt > 0u ? cnt : 1u;
}
__device__ __forceinline__ void xcd_barrier(const XcdBarrier& b) {
    asm volatile("s_waitcnt vmcnt(0)" ::: "memory");
    __syncthreads();
    if (threadIdx.x == 0) {
        unsigned* bar = b.bar;
        __builtin_amdgcn_s_waitcnt(0);
        unsigned nloc = b.st[0], nx = b.st[1];
        if (nloc == 0u) { xcd_barrier_complete(bar, b.x, nloc, nx); b.st[0] = nloc; b.st[1] = nx; }
        const unsigned old = xb_add(&bar[XB_XSUB(b.x)], 1u);
        const unsigned gen = old / nloc;
        if (old + 1u == (gen + 1u) * nloc) {
            __builtin_amdgcn_fence(__ATOMIC_RELEASE, "agent");
            asm volatile("s_waitcnt vmcnt(0)" ::: "memory");
            const unsigned og = xb_add(&bar[XB_TOP], 1u);
            const unsigned tg = og / nx;
            if (og + 1u == (tg + 1u) * nx) xb_add(&bar[XB_TOPGEN], 1u);
            else XB_SPIN(xb_ld(&bar[XB_TOPGEN]) == tg, bar);
            __builtin_amdgcn_fence(__ATOMIC_ACQUIRE, "agent");
            xb_add(&bar[XB_XGEN(b.x)], 1u);
            asm volatile("s_waitcnt vmcnt(0)" ::: "memory");
        } else {
            XB_SPIN(xb_ld(&bar[XB_XGEN(b.x)]) == gen, bar);
            __builtin_amdgcn_fence(__ATOMIC_ACQUIRE, "agent");
            asm volatile("s_waitcnt vmcnt(0)" ::: "memory");
        }
    }
    __syncthreads();
}

struct Args { const float* in[34]; float* out; unsigned char* ws; };
struct Frame {
    LAS unsigned char* lds; char* ldsg;
    int tid, lane, wave, G, bid;
    const float* const* in; float* out; unsigned char* ws;
};
enum { I_X = 0, I_C, I_CTX, I_CCTX, I_RW, I_RB, I_ADAW, I_ADAB, I_LN1G, I_LN1B, I_LN2G, I_LN2B, I_W1, I_W3, I_W2, I_EVWIN, I_EVWOUT, I_AMU, I_AW0, I_AW2, I_AA0, I_AA2,
       I_AG2, I_AKK, I_AKA, I_ARK, I_LNXG, I_LNXB, I_BLAM, I_SUBG, I_ODWIN, I_ODWOUT, I_QNG, I_KNG };

__device__ __forceinline__ const float* x0_row(const Frame& F, int row) {
    const int b = row / TPB, tt = row - b * TPB;
    return tt < CTXL ? F.in[I_CTX] + ((size_t)b * CTXL + tt) * DM : F.in[I_X] + ((size_t)b * SEQ + (tt - CTXL)) * DM;
}
__device__ __forceinline__ const float* mod_ptr(const Frame& F, int layer, int row, int idx) {
    const int b = row / TPB, tt = row - b * TPB; const int r = tt < CTXL ? 8 : b;
    return (const float*)(F.ws + WS_MOD) + ((size_t)(layer * 9 + r) * 6 + idx) * DM;
}
__device__ __forceinline__ void transpose_item(const float* W, int K, int N, bf16* WT, int mode, LAS float* scr, int item, int lane) {
    const int nblk = N / 64, kb = item / nblk, nb = item % nblk, k0 = 64 * kb, n0 = 64 * nb;
    float v[64];
#pragma unroll
    for (int i = 0; i < 64; ++i) v[i] = __builtin_nontemporal_load(W + (size_t)(k0 + i) * N + n0 + lane);
#pragma unroll
    for (int i = 0; i < 64; ++i) scr[i * 65 + lane] = v[i];
    LDS_WAIT(); asm volatile("" ::: "memory");
    const int c = lane & 7;
#pragma unroll
    for (int j = 0; j < 8; ++j) { const int n = (lane >> 3) + 8 * j; const LAS float* s = scr + (8 * c) * 65 + n;
        v4u o; o.x = pk2(s[0 * 65], s[1 * 65]); o.y = pk2(s[2 * 65], s[3 * 65]); o.z = pk2(s[4 * 65], s[5 * 65]); o.w = pk2(s[6 * 65], s[7 * 65]);
        const int ng = n0 + n; const int nd = mode == 0 ? ng : (8 * (ng >> 2) + 4 * (mode - 1) + (ng & 3));
        *(GAS v4u*)(WT + (size_t)nd * K + k0 + 8 * c) = o; }
    LDS_WAIT(); asm volatile("" ::: "memory");
}
__device__ __forceinline__ void convert_moe_weights(Frame& F, int layer) {
    LAS float* scr = (LAS float*)(F.lds + RING_OFF + F.wave * 16896);
    const int gw = F.bid * NWAVES + F.wave, NGW = F.G * NWAVES;
    constexpr int I13 = (DM / 64) * (EFF / 64)  , I2 = (EFF / 64) * (DM / 64)  ;
    bf16* W13 = (bf16*)(F.ws + WS_WM13); bf16* W2 = (bf16*)(F.ws + WS_WM2);
    for (int it = gw; it < NEXP * (2 * I13 + I2); it += NGW) {
        const int e = it / (2 * I13 + I2); int r = it % (2 * I13 + I2);
        const size_t wofs = ((size_t)layer * NEXP + e) * DM * EFF;
        if (r < I13) { transpose_item(F.in[I_W1] + wofs, DM, EFF, W13 + (size_t)e * 1024 * DM, 1, scr, r, F.lane); continue; } r -= I13;
        if (r < I13) { transpose_item(F.in[I_W3] + wofs, DM, EFF, W13 + (size_t)e * 1024 * DM, 2, scr, r, F.lane); continue; } r -= I13;
        transpose_item(F.in[I_W2] + wofs, EFF, DM, W2 + (size_t)e * DM * EFF, 0, scr, r, F.lane);
    }
}
__device__ __forceinline__ void p_prologue(Frame& F) {
    LAS float* scr = (LAS float*)(F.lds + RING_OFF + F.wave * 16896);
    const int gw = F.bid * NWAVES + F.wave, NGW = F.G * NWAVES;
    constexpr int I_A = (DM / 64) * (EVEN_IN / 64), I_B = (DM / 64) * (DM / 64), I_C_ = (DM / 64) * (ODD_IN / 64);
    for (int it = gw; it < I_A + 2 * I_B + I_C_; it += NGW) {
        int r = it;
        if (r < I_A) { transpose_item(F.in[I_EVWIN], DM, EVEN_IN, (bf16*)(F.ws + WS_WEVIN), 0, scr, r, F.lane); continue; } r -= I_A;
        if (r < I_B) { transpose_item(F.in[I_EVWOUT], DM, DM, (bf16*)(F.ws + WS_WEVOUT), 0, scr, r, F.lane); continue; } r -= I_B;
        if (r < I_C_) { transpose_item(F.in[I_ODWIN], DM, ODD_IN, (bf16*)(F.ws + WS_WODIN), 0, scr, r, F.lane); continue; } r -= I_C_;
        transpose_item(F.in[I_ODWOUT], DM, DM, (bf16*)(F.ws + WS_WODOUT), 0, scr, r, F.lane);
    }
    {
        v4u* z = (v4u*)((bf16*)(F.ws + WS_WEVIN) + (size_t)EVEN_IN * DM); const int n16 = (EVEN_PAD - EVEN_IN) * DM * 2 / 16;
        for (int i = F.bid * NTHR + F.tid; i < n16; i += F.G * NTHR) z[i] = (v4u){0u, 0u, 0u, 0u};
    }
    {
        bf16* W2T = (bf16*)(F.ws + WS_LORA); bf16* A2T = W2T + 2 * 512 * 64; bf16* G2T = A2T + 2 * 512 * 64;
        for (int i = F.bid * NTHR + F.tid; i < 3 * 65536; i += F.G * NTHR) {
            const int which = i >> 16, r = i & 65535;
            if (which < 2) { const int d = r >> 15, c = (r >> 6) & 511, l = r & 63; const float v = (which == 0 ? F.in[I_AW2] : F.in[I_AA2])[((size_t)d * 64 + l) * 512 + c]; (which == 0 ? W2T : A2T)[r] = (bf16)f2bf(v); }
            else { const int c = r >> 7, j = r & 127; G2T[r] = (bf16)f2bf(F.in[I_AG2][(size_t)j * 512 + c]); }
        }
    }
    {
        float* cosB = (float*)(F.ws + WS_ROPE); float* sinB = cosB + SEQ * 32; float* cosC = sinB + SEQ * 32; float* sinC = cosC + SEQ * 64;
        for (int i = F.bid * NTHR + F.tid; i < SEQ * 96; i += F.G * NTHR) {
            if (i < SEQ * 32) { const int t = i >> 5, j = i & 31; const float pos = (float)(j < 16 ? (t >> 6) : (t & 63)); const int f = j & 15;
                const float inv = powf(10000.f, -(float)(2 * f) / 32.f); const float ang = pos * inv; cosB[i] = cosf(ang); sinB[i] = sinf(ang); }
            else { const int ii = i - SEQ * 32; const int t = ii >> 6, j = ii & 63; const float pos = (float)(j < 32 ? (t >> 6) : (t & 63)); const int f = j & 31;
                const float inv = powf(10000.f, -(float)(2 * f) / 64.f); const float ang = pos * inv; cosC[ii] = cosf(ang); sinC[ii] = sinf(ang); }
        }
    }
    __syncthreads();
    if (F.bid < 192) {
        LAS float* sv = (LAS float*)(F.lds + RING_OFF);
        LAS float* red = sv + 9 * 1024;
        for (int i = F.tid; i < 9 * 1024; i += NTHR) { const int r = i >> 10, k = i & 1023; const float c = r < 8 ? F.in[I_C][r * DM + k] : F.in[I_CCTX][k]; sv[i] = c * sigmoidf_(c); }
        __syncthreads();
        for (int it = F.bid; it < 192; it += F.G) {
            const int l = it / 96, cb = it % 96, col = cb * 64 + F.lane;
            const float* w = F.in[I_ADAW] + (size_t)l * DM * 6144 + col;
            float acc[9];
#pragma unroll
            for (int r = 0; r < 9; ++r) acc[r] = 0.f;
            for (int k = F.wave * 128; k < F.wave * 128 + 128; ++k) { const float wv = w[(size_t)k * 6144];
#pragma unroll
                for (int r = 0; r < 9; ++r) acc[r] += sv[r * 1024 + k] * wv; }
#pragma unroll
            for (int r = 0; r < 9; ++r) red[(F.wave * 9 + r) * 64 + F.lane] = acc[r];
            __syncthreads();
            for (int i = F.tid; i < 9 * 64; i += NTHR) { const int r = i >> 6, c = i & 63; float s = 0.f;
#pragma unroll
                for (int w8 = 0; w8 < 8; ++w8) s += red[(w8 * 9 + r) * 64 + c];
                const int cc = cb * 64 + c;
                ((float*)(F.ws + WS_MOD))[(size_t)(l * 9 + r) * 6144 + cc] = s + F.in[I_ADAB][l * 6144 + cc]; }
            __syncthreads();
        }
    }
}

struct Row16 { f32x4 v[4]; };
__device__ __forceinline__ Row16 ld_row_f32(const float* p, int lane) { Row16 r; const f32x4* q = (const f32x4*)p + lane;
#pragma unroll
    for (int j = 0; j < 4; ++j) r.v[j] = q[64 * j]; return r; }
__device__ __forceinline__ Row16 ld_row_bf16(const bf16* p, int lane) { Row16 r; const v2u* q = (const v2u*)p + lane;
#pragma unroll
    for (int j = 0; j < 4; ++j) { const v2u w = q[64 * j]; r.v[j] = (f32x4){bflo(w.x), bfhi(w.x), bflo(w.y), bfhi(w.y)}; } return r; }
__device__ __forceinline__ void st_row_f32(float* p, int lane, const Row16& r) { f32x4* q = (f32x4*)p + lane;
#pragma unroll
    for (int j = 0; j < 4; ++j) q[64 * j] = r.v[j]; }
__device__ __forceinline__ void st_row_bf16(bf16* p, int lane, const Row16& r) { v2u* q = (v2u*)p + lane;
#pragma unroll
    for (int j = 0; j < 4; ++j) q[64 * j] = (v2u){pk2(r.v[j].x, r.v[j].y), pk2(r.v[j].z, r.v[j].w)}; }
__device__ __forceinline__ Row16 layer_norm(const Row16& x, const float* g, const float* b, int lane) {
    float s = 0.f;
#pragma unroll
    for (int j = 0; j < 4; ++j) s += (x.v[j].x + x.v[j].y) + (x.v[j].z + x.v[j].w);
    const float mean = wave_sum(s) * (1.f / DM); float s2 = 0.f; Row16 d;
#pragma unroll
    for (int j = 0; j < 4; ++j) { d.v[j] = x.v[j] - mean; s2 += (d.v[j].x * d.v[j].x + d.v[j].y * d.v[j].y) + (d.v[j].z * d.v[j].z + d.v[j].w * d.v[j].w); }
    const float rstd = 1.f / sqrtf(wave_sum(s2) * (1.f / DM) + LN_EPS);
    const Row16 gg = ld_row_f32(g, lane), bb = ld_row_f32(b, lane); Row16 o;
#pragma unroll
    for (int j = 0; j < 4; ++j) o.v[j] = d.v[j] * rstd * gg.v[j] + bb.v[j];
    return o;
}
__device__ __forceinline__ Row16 modulate(const Row16& x, const float* shift, const float* scale, int lane) {
    const Row16 sh = ld_row_f32(shift, lane), sc = ld_row_f32(scale, lane); Row16 o;
#pragma unroll
    for (int j = 0; j < 4; ++j) o.v[j] = x.v[j] * (1.f + sc.v[j]) + sh.v[j];
    return o;
}

__device__ __forceinline__ void p_mod0(Frame& F) {
    const int gw = F.bid * NWAVES + F.wave, NGW = F.G * NWAVES;
    bf16* H = (bf16*)(F.ws + WS_H);
    for (int row = gw; row < MROWS; row += 2 * NGW) {
        const int r1 = row + NGW; const bool has1 = r1 < MROWS; const int rb = has1 ? r1 : row;
        const Row16 xa = ld_row_f32(x0_row(F, row), F.lane), xb = ld_row_f32(x0_row(F, rb), F.lane);
        const Row16 ha = modulate(xa, mod_ptr(F, 0, row, 0), mod_ptr(F, 0, row, 1), F.lane), hb = modulate(xb, mod_ptr(F, 0, rb, 0), mod_ptr(F, 0, rb, 1), F.lane);
        st_row_bf16(H + (size_t)row * DM, F.lane, ha);
        if (has1) st_row_bf16(H + (size_t)r1 * DM, F.lane, hb);
    }
}

template <int LAYER>
__device__ __forceinline__ void p_ln_route(Frame& F) {
    LAS float* rwT = (LAS float*)(F.lds + RING_OFF);
    LAS int* lcnt = (LAS int*)(F.lds + RING_OFF + 65536);
    LAS int* rinfo = lcnt + 32;
    for (int i = F.tid; i < DM * NEXP; i += NTHR) { const int k = i >> 4, e = i & 15; rwT[e * DM + k] = F.in[I_RW][i]; }
    if (F.tid < 32) lcnt[F.tid] = 0;
    __syncthreads();
    const int rows_per = (MROWS + F.G - 1) / F.G, row_lo = F.bid * rows_per, row_hi = (row_lo + rows_per < MROWS) ? row_lo + rows_per : MROWS;
    float* X = (float*)(F.ws + WS_X); bf16* H = (bf16*)(F.ws + WS_H); const bf16* MIX = (const bf16*)(F.ws + WS_MIX);
    unsigned* cnt = (unsigned*)(F.ws + WS_CTL) + CW_CNT + LAYER * 64;
    int* PERM = (int*)(F.ws + WS_PERM_); float* GATE = (float*)(F.ws + WS_GATE); int* TOK = (int*)(F.ws + WS_TOK);
    LAS float* lgt = (LAS float*)(rinfo + 4 * 128);
    Row16 xin_n, mix_n;
    {   const int row = row_lo + F.wave; const int rr_ = row < row_hi ? row : row_lo;
        xin_n = LAYER == 0 ? ld_row_f32(x0_row(F, rr_), F.lane) : ld_row_f32(X + (size_t)rr_ * DM, F.lane); mix_n = ld_row_bf16(MIX + (size_t)rr_ * DM, F.lane); }
    for (int row = row_lo + F.wave; row < row_hi; row += NWAVES) {
        const int b = row / TPB, tt = row - b * TPB; const int li = row - row_lo;
        const Row16 xin = xin_n, mix = mix_n;
        {   const int rn = row + NWAVES < row_hi ? row + NWAVES : row;
            xin_n = LAYER == 0 ? ld_row_f32(x0_row(F, rn), F.lane) : ld_row_f32(X + (size_t)rn * DM, F.lane); mix_n = ld_row_bf16(MIX + (size_t)rn * DM, F.lane); }
        if (LAYER == 1 && tt < CTXL) { if (F.lane == 0) rinfo[li * 4] = -1; continue; }
        const Row16 gate = ld_row_f32(mod_ptr(F, LAYER, row, 2), F.lane);
        Row16 pre;
#pragma unroll
        for (int j = 0; j < 4; ++j) pre.v[j] = ALPHA * xin.v[j] + gate.v[j] * mix.v[j];
        const Row16 x1 = layer_norm(pre, F.in[I_LN1G] + LAYER * DM, F.in[I_LN1B] + LAYER * DM, F.lane);
        st_row_f32(X + (size_t)row * DM, F.lane, x1);
        const Row16 h = modulate(x1, mod_ptr(F, LAYER, row, 3), mod_ptr(F, LAYER, row, 4), F.lane);
        st_row_bf16(H + (size_t)row * DM, F.lane, h);
        float mylg = 0.f;
#pragma unroll
        for (int e = 0; e < NEXP; ++e) { float s = 0.f;
#pragma unroll
            for (int j = 0; j < 4; ++j) { const f32x4 w = *((const LAS f32x4*)(rwT + e * DM) + F.lane + 64 * j); s += (h.v[j].x * w.x + h.v[j].y * w.y) + (h.v[j].z * w.z + h.v[j].w * w.w); }
            const float t = wave_sum(s); mylg = (F.lane == e) ? t : mylg; if ((e & 3) == 3) asm volatile("" ::: "memory"); }
        if (F.lane < NEXP) { lgt[li * 16 + F.lane] = mylg + F.in[I_RB][F.lane]; if (F.lane == 0) rinfo[li * 4] = 0; }
    }
    __syncthreads();
    if (row_lo + F.tid < row_hi && rinfo[F.tid * 4] >= 0) {
        const int li = F.tid; float lg[NEXP];
#pragma unroll
        for (int q = 0; q < 4; ++q) { const f32x4 t = *((const LAS f32x4*)(lgt + li * 16) + q); lg[4 * q] = t.x; lg[4 * q + 1] = t.y; lg[4 * q + 2] = t.z; lg[4 * q + 3] = t.w; }
        float mx = lg[0];
#pragma unroll
        for (int e = 1; e < NEXP; ++e) mx = fmaxf(mx, lg[e]);
        float p[NEXP];
#pragma unroll
        for (int e = 0; e < NEXP; ++e) p[e] = expf(lg[e] - mx);
        int best = 0; float bs = -1.f;
#pragma unroll
        for (int g = 0; g < 4; ++g) { float a = p[4 * g], c2 = -1.f;
#pragma unroll
            for (int i = 1; i < 4; ++i) { const float v = p[4 * g + i]; if (v > a) { c2 = a; a = v; } else if (v > c2) c2 = v; }
            const float sc = a + c2; if (sc > bs) { bs = sc; best = g; } }
        int i0 = 0; float p0 = -1.f;
#pragma unroll
        for (int i = 0; i < 4; ++i) { float v = 0.f;
#pragma unroll
            for (int g = 0; g < 4; ++g) v = (g == best) ? p[4 * g + i] : v;
            if (v > p0) { p0 = v; i0 = i; } }
        int i1 = 0; float p1 = -1.f;
#pragma unroll
        for (int i = 0; i < 4; ++i) { float v = 0.f;
#pragma unroll
            for (int g = 0; g < 4; ++g) v = (g == best) ? p[4 * g + i] : v;
            if (i != i0 && v > p1) { p1 = v; i1 = i; } }
        rinfo[li * 4 + 0] = best * 4 + i0; rinfo[li * 4 + 1] = best * 4 + i1;
        rinfo[li * 4 + 2] = __float_as_int(p0 / (p0 + p1)); rinfo[li * 4 + 3] = __float_as_int(p1 / (p0 + p1));
    }
    __syncthreads();
    int e0 = -1, e1 = -1, r0 = 0, r1 = 0; const int myrow = row_lo + F.tid;
    if (myrow < row_hi) { e0 = rinfo[F.tid * 4]; if (e0 >= 0) { e1 = rinfo[F.tid * 4 + 1]; r0 = __hip_atomic_fetch_add(lcnt + e0, 1, __ATOMIC_RELAXED, __HIP_MEMORY_SCOPE_WORKGROUP); r1 = __hip_atomic_fetch_add(lcnt + e1, 1, __ATOMIC_RELAXED, __HIP_MEMORY_SCOPE_WORKGROUP); } }
    __syncthreads();
    if (F.tid < 16) lcnt[16 + F.tid] = (int)atomicAdd(cnt + F.tid, (unsigned)lcnt[F.tid]);
    __syncthreads();
    if (e0 >= 0) {
        const int g0 = lcnt[16 + e0] + r0, g1 = lcnt[16 + e1] + r1;
        PERM[(size_t)e0 * CAP + g0] = myrow; GATE[(size_t)e0 * CAP + g0] = __int_as_float(rinfo[F.tid * 4 + 2]);
        PERM[(size_t)e1 * CAP + g1] = myrow; GATE[(size_t)e1 * CAP + g1] = __int_as_float(rinfo[F.tid * 4 + 3]);
        TOK[myrow * 2 + 0] = (e0 << 20) | g0; TOK[myrow * 2 + 1] = (e1 << 20) | g1;
    }
}

__device__ __forceinline__ void expert_tile_offsets(const unsigned* cnt, int (&toff)[NEXP + 1]) {
    toff[0] = 0;
#pragma unroll
    for (int e = 0; e < NEXP; ++e) toff[e + 1] = toff[e] + (int)((__hip_atomic_load(cnt + e, __ATOMIC_RELAXED, __HIP_MEMORY_SCOPE_AGENT) + 255u) >> 8);
}

template <int LAYER>
__device__ __forceinline__ void p_ln2(Frame& F) {
    const int gw = F.bid * NWAVES + F.wave, NGW = F.G * NWAVES;
    float* X = (float*)(F.ws + WS_X); bf16* H = (bf16*)(F.ws + WS_H); const bf16* Y = (const bf16*)(F.ws + WS_Y);
    const unsigned* cnt = (const unsigned*)(F.ws + WS_CTL) + CW_CNT + LAYER * 64; const int* TOK = (const int*)(F.ws + WS_TOK);
    int toff[NEXP + 1]; expert_tile_offsets(cnt, toff);
    constexpr int NR = LAYER == 0 ? MROWS : NB * SEQ;
    for (int q = gw; q < NR; q += 2 * NGW) {
        int rw[2]; bool ok[2]; rw[0] = q; rw[1] = q + NGW; ok[0] = true; ok[1] = rw[1] < NR; if (!ok[1]) rw[1] = rw[0];
        int row[2], bb[2], tt[2]; size_t y0[2], y1[2];
#pragma unroll
        for (int s = 0; s < 2; ++s) {
            if (LAYER == 0) { row[s] = rw[s]; bb[s] = row[s] / TPB; tt[s] = row[s] - bb[s] * TPB; } else { bb[s] = rw[s] / SEQ; tt[s] = CTXL + (rw[s] - bb[s] * SEQ); row[s] = bb[s] * TPB + tt[s]; }
            const int t0 = __hip_atomic_load(TOK + row[s] * 2, __ATOMIC_RELAXED, __HIP_MEMORY_SCOPE_AGENT), t1 = __hip_atomic_load(TOK + row[s] * 2 + 1, __ATOMIC_RELAXED, __HIP_MEMORY_SCOPE_AGENT); const int e0 = t0 >> 20, e1 = t1 >> 20;
            int o0 = 0, o1 = 0;
#pragma unroll
            for (int e = 0; e < NEXP; ++e) { o0 = (e == e0) ? toff[e] : o0; o1 = (e == e1) ? toff[e] : o1; }
            y0[s] = (size_t)o0 * 256 + (t0 & 0xfffff); y1[s] = (size_t)o1 * 256 + (t1 & 0xfffff);
        }
        Row16 xin[2], ya[2], yb[2], gate[2];
#pragma unroll
        for (int s = 0; s < 2; ++s) { xin[s] = ld_row_f32(X + (size_t)row[s] * DM, F.lane); ya[s] = ld_row_bf16(Y + y0[s] * DM, F.lane); yb[s] = ld_row_bf16(Y + y1[s] * DM, F.lane); gate[s] = ld_row_f32(mod_ptr(F, LAYER, row[s], 5), F.lane); }
#pragma unroll
        for (int s = 0; s < 2; ++s) {
            Row16 pre;
#pragma unroll
            for (int j = 0; j < 4; ++j) pre.v[j] = ALPHA * xin[s].v[j] + gate[s].v[j] * (ya[s].v[j] + yb[s].v[j]);
            const Row16 x2 = layer_norm(pre, F.in[I_LN2G] + LAYER * DM, F.in[I_LN2B] + LAYER * DM, F.lane);
            if (!ok[s]) continue;
            if (LAYER == 0) {
                st_row_f32(X + (size_t)row[s] * DM, F.lane, x2);
                const Row16 h = modulate(x2, mod_ptr(F, 1, row[s], 0), mod_ptr(F, 1, row[s], 1), F.lane);
                st_row_bf16(H + (size_t)row[s] * DM, F.lane, h);
            } else {
                st_row_f32(F.out + ((size_t)bb[s] * SEQ + (tt[s] - CTXL)) * DM, F.lane, x2);
#ifdef TPROBE_A
                if (row[s] == 2048 && F.lane == 0) { volatile LAS unsigned long long* ts = (volatile LAS unsigned long long*)(F.lds + MISC_OFF + 128);
                    const float span_us = (float)(ts[TPROBE_B] - ts[TPROBE_A]) * 0.01f; F.out[((size_t)bb[s] * SEQ + (tt[s] - CTXL)) * DM] = x2.v[0].x + span_us / (float)TPROBE_US; }
#endif
            }
        }
    }
}
namespace ck {
typedef short bf16x8 __attribute__((ext_vector_type(8)));
typedef float f32x16 __attribute__((ext_vector_type(16)));
typedef float f32x4 __attribute__((ext_vector_type(4)));
constexpr int NCH = 36;
__device__ __forceinline__ int crow(int r, int hi) { return (r & 3) + 8 * (r >> 2) + 4 * hi; }
__device__ __forceinline__ int swz(int row, int c16) { return row * 128 + ((c16 ^ ((row >> 1) & 7)) << 4); }
__device__ __forceinline__ int swz_el(int row, int col) { return swz(row, col >> 3) + (col & 7) * 2; }
__device__ __forceinline__ void mm_tile(f32x16& acc, const LAS unsigned char* A, int arow0, const LAS unsigned char* B, int brow0, int ks0, int nks, int r32, int hh) {
#pragma unroll
    for (int ks = 0; ks < 4; ++ks) if (ks >= ks0 && ks < ks0 + nks) {
        const bf16x8 a = *(const LAS bf16x8*)(A + swz(arow0 + r32, 2 * ks + hh));
        const bf16x8 b = *(const LAS bf16x8*)(B + swz(brow0 + r32, 2 * ks + hh));
        acc = __builtin_amdgcn_mfma_f32_32x32x16_bf16(a, b, acc, 0, 0, 0); }
}
__device__ __forceinline__ f32x16 zero16() { f32x16 z;
#pragma unroll
    for (int i = 0; i < 16; ++i) z[i] = 0.f; return z; }
__device__ __forceinline__ int chunk_index(int b, int h, int d, int c) { return ((b * 8 + h) * 2 + d) * NCH + c; }
}

constexpr int CK_LIN = 0;
constexpr int CK_E = 32768;
constexpr int CK_T = CK_E, CK_TT = CK_E + 8192, CK_PT = CK_E + 16384, CK_WT = CK_E + 24576;
constexpr int CK_OPS = 65536;
constexpr int CK_UT = 131072;
constexpr int CK_D = CK_UT + 8192;
constexpr int CK_ZT = CK_D + 4096;
constexpr int CK_WSUM = CK_ZT + 2048;
static_assert(CK_WSUM + 2048 <= RING_BYTES, "chunk LDS map");

__device__ __forceinline__ float fsig(float x) { return __builtin_amdgcn_rcpf(1.f + __builtin_amdgcn_exp2f(-1.4426950408889634f * x)); }
__device__ __forceinline__ float fexp(float x) { return __builtin_amdgcn_exp2f(1.4426950408889634f * x); }

__device__ __forceinline__ void p_chunk_pre(Frame& F) {
    using namespace ck;
    const LAS unsigned char* L0 = F.lds + RING_OFF;
    LAS unsigned char* lds = F.lds + RING_OFF;
    const bf16* PA = (const bf16*)(F.ws + WS_PA);
    const int wave = F.wave;
    bf16* CHG = (bf16*)(F.ws + WS_CHG); bf16* CHH = (bf16*)(F.ws + WS_CHH); bf16* CHRQ = (bf16*)(F.ws + WS_CHRQ); bf16* CHY = (bf16*)(F.ws + WS_CHY);
    float* GLp = (float*)(F.ws + WS_GL); float* BON = (float*)(F.ws + WS_BON);
    bf16* VOUT = (bf16*)(F.ws + WS_VOUT); bf16* GOUT = (bf16*)(F.ws + WS_GOUT);
    const bf16* W2T = (const bf16*)(F.ws + WS_LORA); const bf16* A2T = W2T + 2 * 512 * 64; const bf16* G2T = A2T + 2 * 512 * 64;
    const float* mu = F.in[I_AMU];
    v4u q_row[6]; float win[3][10];
#define CK_DECODE(it_, d_, tb_, h_, b_, isctx_, t0_, Ls_, rbase_) const int d_ = ((it_) & 1) ^ (((it_) / F.G) & 1 & (int)((F.G & 1) == 0)), tb_ = ((it_) >> 1) % 36, bh_##d_ = ((it_) >> 1) / 36, h_ = bh_##d_ & 7, b_ = bh_##d_ >> 3; \
        const bool isctx_ = tb_ < 4; const int t0_ = isctx_ ? tb_ * 64 : (tb_ - 4) * 64, Ls_ = isctx_ ? CTXL : SEQ; const int rbase_ = b_ * TPB + (isctx_ ? 0 : CTXL);
#define CK_LOAD(it_) do { CK_DECODE(it_, dL, tbL, hL, bL, icL, t0L, LsL, rbL) \
        const int ln_ = F.lane, td_ = (wave << 6) | ln_; \
        { const int cc_ = (dL == 0 ? (td_ & 31) : (td_ & 15)) * 8, tf_ = dL == 0 ? 4 * (td_ >> 5) : 2 * (td_ >> 4); \
          const int col_ = cc_ < 64 ? 1536 + 64 * dL + cc_ : cc_ < 128 ? 1664 + 64 * dL + (cc_ - 64) : 1792 + (cc_ - 128); \
          const bf16* pc_ = PA + (size_t)(rbL + t0L + tf_) * A_IN + col_; \
          _Pragma("unroll") for (int n_ = 0; n_ < 6; ++n_) if (dL == 0 || n_ < 4) { const int tg_ = t0L + tf_ + n_ - 1; \
            q_row[n_] = (tg_ >= 0 && tg_ < LsL) ? *(const v4u*)(pc_ + (ptrdiff_t)(n_ - 1) * A_IN) : (v4u){0u, 0u, 0u, 0u}; } } \
        { const int tlo_ = dL == 0 ? 8 * wave : 63 - (8 * wave + 7); const bf16* pr_ = PA + (size_t)(rbL + t0L + tlo_) * A_IN + 64 * hL + ln_; \
          _Pragma("unroll") for (int j_ = 0; j_ < 10; ++j_) { const int tg2_ = t0L + tlo_ + j_ - 1; const bool ok_ = tg2_ >= 0 && tg2_ < LsL; \
            _Pragma("unroll") for (int s_ = 0; s_ < 3; ++s_) win[s_][j_] = ok_ ? bf2f(pr_[(ptrdiff_t)(j_ - 1) * A_IN + 512 * s_]) : 0.f; } } } while (0)
    if (F.bid < NB * 8 * 36 * 2) CK_LOAD(F.bid);
    for (int it = F.bid; it < NB * 8 * 36 * 2; it += F.G) {
        CK_DECODE(it, d, tb, h, b, isctx, t0, Ls, rbase)
        const int c = d == 0 ? tb : (isctx ? 3 - tb : 4 + (31 - (tb - 4)));
        const int ci = chunk_index(b, h, d, c);
        __syncthreads();
        int lane = F.lane; asm volatile("" : "+v"(lane));
        const int tid = (wave << 6) | lane, r32 = lane & 31, hh = lane >> 5, k = lane, pg = wave;
        {
            const int cc = (d == 0 ? (tid & 31) : (tid & 15)) * 8, tf = d == 0 ? 4 * (tid >> 5) : 2 * (tid >> 4);
            const int col = cc < 64 ? 1536 + 64 * d + cc : cc < 128 ? 1664 + 64 * d + (cc - 64) : 1792 + (cc - 128);
            const int mat = cc >> 6, l0 = cc & 63;
            const f32x4 m0 = *(const f32x4*)(mu + col), m1 = *(const f32x4*)(mu + col + 4);
            const float mm[8] = {m0.x, m0.y, m0.z, m0.w, m1.x, m1.y, m1.z, m1.w};
#pragma unroll
            for (int n = 0; n < 4; ++n) if (d == 0 || n < 2) {
                const unsigned pw[4] = {q_row[n].x, q_row[n].y, q_row[n].z, q_row[n].w}, cw[4] = {q_row[n + 1].x, q_row[n + 1].y, q_row[n + 1].z, q_row[n + 1].w}, nw[4] = {q_row[n + 2].x, q_row[n + 2].y, q_row[n + 2].z, q_row[n + 2].w};
                float u[8];
#pragma unroll
                for (int j = 0; j < 8; ++j) { const int w = j >> 1; const bool up = j & 1;
                    const float cv = up ? bfhi(cw[w]) : bflo(cw[w]), pv = up ? bfhi(pw[w]) : bflo(pw[w]), nv = up ? bfhi(nw[w]) : bflo(nw[w]);
                    float x = cv + (0.5f * (pv + nv) - cv) * mm[j];
                    if (mat == 0) x = 1.f - 2.f * __builtin_amdgcn_rcpf(__builtin_amdgcn_exp2f(2.8853900817779268f * x) + 1.f); else if (mat >= 2) x = fsig(x);
                    u[j] = x; }
                *(LAS v4u*)(lds + CK_LIN + mat * 8192 + swz(tf + n, l0 >> 3)) = (v4u){pk2(u[0], u[1]), pk2(u[2], u[3]), pk2(u[4], u[5]), pk2(u[6], u[7])};
            }
        }
        float rr[8], kx[8], vv[8];
        {
            const float mr = mu[64 * h + k], mk = mu[512 + 64 * h + k], mv = mu[1024 + 64 * h + k];
#pragma unroll
            for (int i = 0; i < 8; ++i) { const int j = d == 0 ? i + 1 : 8 - i;
                rr[i] = win[0][j] + (0.5f * (win[0][j - 1] + win[0][j + 1]) - win[0][j]) * mr;
                kx[i] = win[1][j] + (0.5f * (win[1][j - 1] + win[1][j + 1]) - win[1][j]) * mk;
                vv[i] = win[2][j] + (0.5f * (win[2][j - 1] + win[2][j + 1]) - win[2][j]) * mv; }
        }
        if (it + F.G < NB * 8 * 36 * 2) CK_LOAD(it + F.G);
        __syncthreads();
        {
            const int tq = wave & 3, ti = tq >> 1, tj = tq & 1; const bool isW = wave < 4;
            f32x16 acc = zero16();
            const bf16* WT = (isW ? W2T : A2T) + ((size_t)d * 512 + 64 * h + 32 * tj + r32) * 64;
#pragma unroll
            for (int ks = 0; ks < 4; ++ks) {
                const bf16x8 a = *(const LAS bf16x8*)(L0 + CK_LIN + (isW ? 0 : 8192) + swz(32 * ti + r32, 2 * ks + hh));
                const bf16x8 bq = *(const bf16x8*)(WT + 16 * ks + 8 * hh);
                acc = __builtin_amdgcn_mfma_f32_32x32x16_bf16(a, bq, acc, 0, 0, 0); }
            const int ch = 32 * tj + r32; const float bias = isW ? F.in[I_AW0][d * 512 + 64 * h + ch] : F.in[I_AA0][d * 512 + 64 * h + ch];
#pragma unroll
            for (int r = 0; r < 16; ++r) { const int tl = 32 * ti + crow(r, hh); const int p = d == 0 ? tl : 63 - tl;
                const float sg = fsig(acc[r] + bias);
                *(LAS float*)(lds + CK_E + (isW ? 0 : 16384) + (p * 64 + ch) * 4) = isW ? sg * 0.6065306597126334f : sg; }
            if (d == 0 && !isW) {
                f32x16 g = zero16();
                const bf16* GT = G2T + (size_t)(64 * h + 32 * tj + r32) * 128;
#pragma unroll
                for (int ks = 0; ks < 8; ++ks) {
                    const bf16x8 a = *(const LAS bf16x8*)(L0 + CK_LIN + 16384 + (ks >> 2) * 8192 + swz(32 * ti + r32, 2 * (ks & 3) + hh));
                    const bf16x8 bq = *(const bf16x8*)(GT + 16 * ks + 8 * hh);
                    g = __builtin_amdgcn_mfma_f32_32x32x16_bf16(a, bq, g, 0, 0, 0); }
#pragma unroll
                for (int r = 0; r < 16; ++r) { const int tl = 32 * ti + crow(r, hh);
                    GOUT[(size_t)(rbase + t0 + tl) * 512 + 64 * h + ch] = (bf16)f2bf(g[r]); }
            }
        }
        __syncthreads();
        {
            float e[8], ai[8], cl[8];
#pragma unroll
            for (int i = 0; i < 8; ++i) { e[i] = *(const LAS float*)(L0 + CK_E + ((8 * pg + i) * 64 + k) * 4); ai[i] = *(const LAS float*)(L0 + CK_E + 16384 + ((8 * pg + i) * 64 + k) * 4); }
            float run = 0.f;
#pragma unroll
            for (int i = 0; i < 8; ++i) { run -= e[i]; cl[i] = run; }
            *(LAS float*)(lds + CK_WSUM + (pg * 64 + k) * 4) = run;
            __syncthreads();
            float off = 0.f, tot = 0.f;
#pragma unroll
            for (int q = 0; q < 8; ++q) { const float s = *(const LAS float*)(L0 + CK_WSUM + (q * 64 + k) * 4); tot += s; off += (q < pg) ? s : 0.f; }
            const float kkc = F.in[I_AKK][64 * h + k], kac = F.in[I_AKA][64 * h + k], rkc = F.in[I_ARK][64 * h + k];
            float bhv[8], khv[8], atv[8];
#pragma unroll
            for (int i = 0; i < 8; ++i) {
                const int p = 8 * pg + i; const float c_ = cl[i] + off;
                const float kr = kx[i] * kkc; const float ss = wave_sum(kr * kr); const float kk = kr * __builtin_amdgcn_rsqf(fmaxf(ss, 1e-24f));
                const float kd = kx[i] * (1.f + (ai[i] - 1.f) * kac), bb = kk * ai[i];
                const float bon = wave_sum(rr[i] * kd * rkc);
                const float ep = fexp(c_), em = __builtin_amdgcn_rcpf(ep), el = fexp(tot - c_);
                atv[i] = -kk * fexp(c_ + e[i]);
                *(LAS bf16*)(lds + CK_OPS + 0 * 8192 + swz_el(p, k)) = (bf16)f2bf(atv[i]);
                *(LAS bf16*)(lds + CK_OPS + 1 * 8192 + swz_el(p, k)) = (bf16)f2bf(bb * em);
                *(LAS bf16*)(lds + CK_OPS + 2 * 8192 + swz_el(p, k)) = (bf16)f2bf(kd * em);
                *(LAS bf16*)(lds + CK_OPS + 3 * 8192 + swz_el(p, k)) = (bf16)f2bf(rr[i] * ep);
                bhv[i] = bb * el; khv[i] = kd * el;
                const int tl = d == 0 ? p : 63 - p; const size_t row = (size_t)(rbase + t0 + tl);
                if (lane == 0) BON[((size_t)d * MROWS + row) * 8 + h] = bon;
                if (d == 0) VOUT[row * 512 + 64 * h + k] = (bf16)f2bf(vv[i]);
            }
            *(LAS v4u*)(lds + CK_OPS + 4 * 8192 + swz(k, pg)) = (v4u){pk2(bhv[0], bhv[1]), pk2(bhv[2], bhv[3]), pk2(bhv[4], bhv[5]), pk2(bhv[6], bhv[7])};
            *(LAS v4u*)(lds + CK_OPS + 5 * 8192 + swz(k, pg)) = (v4u){pk2(khv[0], khv[1]), pk2(khv[2], khv[3]), pk2(khv[4], khv[5]), pk2(khv[6], khv[7])};
            *(LAS v4u*)(lds + CK_OPS + 6 * 8192 + swz(k, pg)) = (v4u){pk2(vv[0], vv[1]), pk2(vv[2], vv[3]), pk2(vv[4], vv[5]), pk2(vv[6], vv[7])};
            *(LAS v4u*)(lds + CK_OPS + 7 * 8192 + swz(k, pg)) = (v4u){pk2(atv[0], atv[1]), pk2(atv[2], atv[3]), pk2(atv[4], atv[5]), pk2(atv[6], atv[7])};
            if (pg == 0) GLp[(size_t)ci * 64 + k] = fexp(tot);
            *(LAS v4u*)(lds + CK_T + tid * 16) = (v4u){0u, 0u, 0u, 0u}; *(LAS v4u*)(lds + CK_TT + tid * 16) = (v4u){0u, 0u, 0u, 0u};
        }
        __syncthreads();
        for (int job = wave; job < 16; job += 8) {
            const int prod = job >> 2, tq = job & 3, ti = tq >> 1, tj = tq & 1;
            f32x16 acc = zero16();
            if (!(ti == 0 && tj == 1))
                mm_tile(acc, L0 + CK_OPS + (prod < 2 ? 0 : 3) * 8192, 32 * ti, L0 + CK_OPS + ((prod & 1) ? 2 : 1) * 8192, 32 * tj, 0, 4, r32, hh);
            const int s = 32 * tj + r32;
#pragma unroll
            for (int r = 0; r < 16; ++r) { const int p = 32 * ti + crow(r, hh); const bool keep = prod < 2 ? (s < p) : (s <= p); const float v = keep ? acc[r] : 0.f;
                *(LAS bf16*)(lds + CK_LIN + prod * 8192 + swz_el(p, s)) = (bf16)f2bf(v);
                if (prod == 0 && (p >> 4) == (s >> 4)) *(LAS float*)(lds + CK_D + ((p >> 4) * 256 + (p & 15) * 16 + (s & 15)) * 4) = v; }
        }
        __syncthreads();
        if (wave == 0) {
            const int blk = lane >> 4, cc = lane & 15;
            float x[16];
#pragma unroll
            for (int p = 0; p < 16; ++p) {
                float a = (p == cc) ? 1.f : 0.f;
#pragma unroll
                for (int s = 0; s < p; ++s) a += *(const LAS float*)(L0 + CK_D + (blk * 256 + p * 16 + s) * 4) * x[s];
                x[p] = a; }
#pragma unroll
            for (int p = 0; p < 16; ++p) *(LAS bf16*)(lds + CK_T + swz_el(16 * blk + p, 16 * blk + cc)) = (bf16)f2bf(x[p]);
            *(LAS v4u*)(lds + CK_TT + swz(16 * blk + cc, 2 * blk)) = (v4u){pk2(x[0], x[1]), pk2(x[2], x[3]), pk2(x[4], x[5]), pk2(x[6], x[7])};
            *(LAS v4u*)(lds + CK_TT + swz(16 * blk + cc, 2 * blk + 1)) = (v4u){pk2(x[8], x[9]), pk2(x[10], x[11]), pk2(x[12], x[13]), pk2(x[14], x[15])};
            LDS_WAIT();
            typedef float f32x4_ __attribute__((ext_vector_type(4)));
            const int row = lane & 15, kg = lane >> 4;
            const bf16x8 zf = (bf16x8){0, 0, 0, 0, 0, 0, 0, 0};
#pragma unroll
            for (int pr_ = 0; pr_ < 2; ++pr_) {
                const int b0 = 2 * pr_, b1 = b0 + 1;
                bf16x8 a = *(const LAS bf16x8*)(L0 + CK_LIN + swz(16 * b1 + row, 2 * b0 + (kg & 1)));
                bf16x8 bq = *(const LAS bf16x8*)(L0 + CK_TT + swz(16 * b0 + row, 2 * b0 + (kg & 1)));
                if (kg >= 2) { a = zf; bq = zf; }
                f32x4_ z = __builtin_amdgcn_mfma_f32_16x16x32_bf16(a, bq, (f32x4_){0.f, 0.f, 0.f, 0.f}, 0, 0, 0);
                *(LAS v2u*)(lds + CK_ZT + (row * 16 + 4 * kg) * 2) = (v2u){pk2(z[0], z[1]), pk2(z[2], z[3])};
                LDS_WAIT();
                bf16x8 a2 = *(const LAS bf16x8*)(L0 + CK_T + swz(16 * b1 + row, 2 * b1 + (kg & 1)));
                bf16x8 b2 = *(const LAS bf16x8*)(L0 + CK_ZT + (row * 16 + 8 * (kg & 1)) * 2);
                if (kg >= 2) { a2 = zf; b2 = zf; }
                f32x4_ m = __builtin_amdgcn_mfma_f32_16x16x32_bf16(a2, b2, (f32x4_){0.f, 0.f, 0.f, 0.f}, 0, 0, 0);
#pragma unroll
                for (int i = 0; i < 4; ++i) *(LAS bf16*)(lds + CK_T + swz_el(16 * b1 + 4 * kg + i, 16 * b0 + row)) = (bf16)f2bf(m[i]);
                *(LAS v2u*)(lds + CK_TT + swz_el(16 * b0 + row, 16 * b1 + 4 * kg)) = (v2u){pk2(m[0], m[1]), pk2(m[2], m[3])};
                LDS_WAIT();
            }
            {
                f32x16 z2 = zero16();
#pragma unroll
                for (int ks = 0; ks < 2; ++ks) {
                    const bf16x8 a = *(const LAS bf16x8*)(L0 + CK_LIN + swz(32 + r32, 2 * ks + hh));
                    const bf16x8 bq = *(const LAS bf16x8*)(L0 + CK_TT + swz(r32, 2 * ks + hh));
                    z2 = __builtin_amdgcn_mfma_f32_32x32x16_bf16(a, bq, z2, 0, 0, 0); }
#pragma unroll
                for (int rq = 0; rq < 4; ++rq)
                    *(LAS v2u*)(lds + CK_ZT + (r32 * 32 + 8 * rq + 4 * hh) * 2) = (v2u){pk2(z2[4 * rq], z2[4 * rq + 1]), pk2(z2[4 * rq + 2], z2[4 * rq + 3])};
                LDS_WAIT();
                f32x16 m2 = zero16();
#pragma unroll
                for (int ks = 0; ks < 2; ++ks) {
                    const bf16x8 a = *(const LAS bf16x8*)(L0 + CK_T + swz(32 + r32, 4 + 2 * ks + hh));
                    const bf16x8 bq = *(const LAS bf16x8*)(L0 + CK_ZT + (r32 * 32 + 16 * ks + 8 * hh) * 2);
                    m2 = __builtin_amdgcn_mfma_f32_32x32x16_bf16(a, bq, m2, 0, 0, 0); }
#pragma unroll
                for (int r = 0; r < 16; ++r) *(LAS bf16*)(lds + CK_T + swz_el(32 + crow(r, hh), r32)) = (bf16)f2bf(m2[r]);
            }
        } else if (wave <= 4) {
            const int tq = wave - 1, ti = tq >> 1, tj = tq & 1; f32x16 acc = zero16();
            mm_tile(acc, L0 + CK_LIN + 1 * 8192, 32 * ti, L0 + CK_OPS + 6 * 8192, 32 * tj, 0, 4, r32, hh);
#pragma unroll
            for (int rq = 0; rq < 4; ++rq)
                *(LAS v2u*)(lds + CK_PT + swz_el(32 * tj + r32, 32 * ti + 8 * rq + 4 * hh)) = (v2u){pk2(acc[4 * rq], acc[4 * rq + 1]), pk2(acc[4 * rq + 2], acc[4 * rq + 3])};
        }
        __syncthreads();
        {
            const bool isW = wave < 4; const int tq = wave & 3, ti = tq >> 1, tj = tq & 1; f32x16 acc = zero16();
            mm_tile(acc, isW ? L0 + CK_OPS + 7 * 8192 : L0 + CK_PT, 32 * ti, L0 + CK_T, 32 * tj, 0, 4, r32, hh);
            LAS unsigned char* XT = isW ? lds + CK_WT : lds + CK_UT;
#pragma unroll
            for (int r = 0; r < 16; ++r) *(LAS bf16*)(XT + swz_el(32 * ti + crow(r, hh), 32 * tj + r32)) = (bf16)f2bf(acc[r]);
        }
        __syncthreads();
        for (int job = wave; job < 16; job += 8) {
            const int prod = job >> 2, tq = job & 3, ti = tq >> 1, tj = tq & 1;
            const LAS unsigned char* WT_ = L0 + CK_WT; const LAS unsigned char* UT_ = L0 + CK_UT;
            const LAS unsigned char* Arb = L0 + CK_LIN + 2 * 8192; const LAS unsigned char* Ark = L0 + CK_LIN + 3 * 8192;
            const LAS unsigned char* BhT = L0 + CK_OPS + 4 * 8192; const LAS unsigned char* KhT = L0 + CK_OPS + 5 * 8192; const LAS unsigned char* VT = L0 + CK_OPS + 6 * 8192;
            f32x16 acc = zero16();
            if (prod == 0) mm_tile(acc, Arb, 32 * ti, WT_, 32 * tj, 0, 4, r32, hh);
            else if (prod == 1) { mm_tile(acc, Arb, 32 * ti, UT_, 32 * tj, 0, 4, r32, hh); mm_tile(acc, Ark, 32 * ti, VT, 32 * tj, 0, 4, r32, hh); }
            else if (prod == 2) mm_tile(acc, WT_, 32 * ti, BhT, 32 * tj, 0, 4, r32, hh);
            else { mm_tile(acc, UT_, 32 * ti, BhT, 32 * tj, 0, 4, r32, hh); mm_tile(acc, VT, 32 * ti, KhT, 32 * tj, 0, 4, r32, hh); }
            const int cc = 32 * tj + r32;
            if (prod == 0) {
#pragma unroll
                for (int r = 0; r < 16; ++r) { const int p = 32 * ti + crow(r, hh); const float v = acc[r] + bf2f(*(const LAS bf16*)(L0 + CK_OPS + 3 * 8192 + swz_el(p, cc)));
                    CHRQ[(size_t)ci * 4096 + p * 64 + cc] = (bf16)f2bf(v); }
            } else if (prod == 1) {
#pragma unroll
                for (int r = 0; r < 16; ++r) { const int p = 32 * ti + crow(r, hh); CHY[(size_t)ci * 4096 + p * 64 + cc] = (bf16)f2bf(acc[r]); }
            } else if (prod == 2) {
#pragma unroll
                for (int rq = 0; rq < 4; ++rq) { const int k0 = 32 * ti + 8 * rq + 4 * hh;
                    *(v2u*)(CHG + (size_t)ci * 4096 + cc * 64 + k0) = (v2u){pk2(acc[4 * rq], acc[4 * rq + 1]), pk2(acc[4 * rq + 2], acc[4 * rq + 3])}; }
            } else {
#pragma unroll
                for (int r = 0; r < 16; ++r) { const int v_ = 32 * ti + crow(r, hh); CHH[(size_t)ci * 4096 + v_ * 64 + cc] = (bf16)f2bf(acc[r]); }
            }
        }
    }
#undef CK_LOAD
#undef CK_DECODE
}

__device__ __forceinline__ void p_state(Frame& F) {
    using namespace ck;
    const int lane = F.lane, wave = F.wave, r32 = lane & 31, hh = lane >> 5;
    const bf16* CHG = (const bf16*)(F.ws + WS_CHG); const bf16* CHH = (const bf16*)(F.ws + WS_CHH); const bf16* CHRQ = (const bf16*)(F.ws + WS_CHRQ); bf16* CHY = (bf16*)(F.ws + WS_CHY);
    const float* GLp = (const float*)(F.ws + WS_GL);
    LAS unsigned char* lds = F.lds + RING_OFF;
    for (int chain = F.bid; chain < NB * 8 * 2; chain += F.G) {
        const int d = chain & 1, h = (chain >> 1) & 7, b = chain >> 4;
        const int tq = wave & 3, ti = tq >> 1, tj = tq & 1; const bool isS = wave < 4;
        f32x16 S = zero16();
        __syncthreads();
        for (int i = F.tid; i < 8192 / 16; i += NTHR) *(LAS v4u*)(lds + i * 16) = (v4u){0u, 0u, 0u, 0u};
        bf16x8 fr[4]; unsigned short hv[16]; float gl = 0.f;
#define ST_LOAD(c_) do { const size_t cb_ = (size_t)chunk_index(b, h, d, (c_)) * 4096; \
            if (isS) { _Pragma("unroll") for (int ks = 0; ks < 4; ++ks) fr[ks] = *(const bf16x8*)(CHG + cb_ + (size_t)(32 * tj + r32) * 64 + 16 * ks + 8 * hh); \
                       _Pragma("unroll") for (int r = 0; r < 16; ++r) hv[r] = CHH[cb_ + (32 * ti + crow(r, hh)) * 64 + 32 * tj + r32]; \
                       gl = GLp[(size_t)chunk_index(b, h, d, (c_)) * 64 + 32 * tj + r32]; } \
            else { _Pragma("unroll") for (int ks = 0; ks < 4; ++ks) fr[ks] = *(const bf16x8*)(CHRQ + cb_ + (size_t)(32 * ti + r32) * 64 + 16 * ks + 8 * hh); \
                   _Pragma("unroll") for (int r = 0; r < 16; ++r) hv[r] = CHY[cb_ + (32 * ti + crow(r, hh)) * 64 + 32 * tj + r32]; } } while (0)
        ST_LOAD(0);
        __syncthreads();
        for (int c = 0; c < NCH; ++c) {
            const size_t cb = (size_t)chunk_index(b, h, d, c) * 4096;
            const LAS unsigned char* Sb = lds + (c & 1) * 8192; LAS unsigned char* Sn = lds + ((c + 1) & 1) * 8192;
            bf16x8 cf[4]; float cv[16]; const float cgl = gl;
#pragma unroll
            for (int ks = 0; ks < 4; ++ks) cf[ks] = fr[ks];
#pragma unroll
            for (int r = 0; r < 16; ++r) cv[r] = bf2f(hv[r]);
            if (c + 1 < NCH) ST_LOAD(c + 1);
            f32x16 acc = zero16();
            if (isS) {
#pragma unroll
                for (int ks = 0; ks < 4; ++ks) { const bf16x8 a = *(const LAS bf16x8*)(Sb + swz(32 * ti + r32, 2 * ks + hh)); acc = __builtin_amdgcn_mfma_f32_32x32x16_bf16(a, cf[ks], acc, 0, 0, 0); }
#pragma unroll
                for (int r = 0; r < 16; ++r) { const int v_ = 32 * ti + crow(r, hh);
                    S[r] = S[r] * cgl + acc[r] + cv[r];
                    *(LAS bf16*)(Sn + swz_el(v_, 32 * tj + r32)) = (bf16)f2bf(S[r]); }
            } else {
#pragma unroll
                for (int ks = 0; ks < 4; ++ks) { const bf16x8 s = *(const LAS bf16x8*)(Sb + swz(32 * tj + r32, 2 * ks + hh)); acc = __builtin_amdgcn_mfma_f32_32x32x16_bf16(cf[ks], s, acc, 0, 0, 0); }
#pragma unroll
                for (int r = 0; r < 16; ++r) { const int p = 32 * ti + crow(r, hh); CHY[cb + p * 64 + 32 * tj + r32] = (bf16)f2bf(acc[r] + cv[r]); }
            }
            __syncthreads();
        }
#undef ST_LOAD
    }
}

__device__ __forceinline__ void p_rope0(Frame& F) {
    const int gw = F.bid * NWAVES + F.wave, NGW = F.G * NWAVES;
    bf16* PB = (bf16*)(F.ws + WS_PB); const float* cosB = (const float*)(F.ws + WS_ROPE); const float* sinB = cosB + SEQ * 32;
    for (int row = gw; row < MROWS; row += NGW) {
        const int b = row / TPB, tt = row - b * TPB; if (tt < CTXL) continue; const int t = tt - CTXL;
        bf16* p = PB + (size_t)row * B_IN;
#pragma unroll
        for (int q = 0; q < 8; ++q) { const int pr = q * 64 + F.lane; const int vec = pr >> 5, i = pr & 31; const int c1 = vec * 64 + i, c2 = c1 + 32;
            const float x1 = bf2f(p[c1]), x2 = bf2f(p[c2]); const float cs = cosB[t * 32 + i], sn = sinB[t * 32 + i];
            p[c1] = (bf16)f2bf(x1 * cs - x2 * sn); p[c2] = (bf16)f2bf(x1 * sn + x2 * cs); }
    }
}

__device__ __forceinline__ void p_attn0(Frame& F) {
    const bf16* PB = (const bf16*)(F.ws + WS_PB);
    unsigned* qctr = (unsigned*)(F.ws + WS_CTL) + CW_Q0;
    volatile LAS unsigned* slot = (volatile LAS unsigned*)(F.lds + MISC_OFF + 64);
    for (;;) {
        __syncthreads();
        if (F.tid == 0) slot[0] = atomicAdd(qctr, 1u);
        __syncthreads();
        const int u = (int)slot[0];
        if (u >= 576) break;
        int b, h, m, qt;
        if (u < 512) { qt = 1 + (u & 7); const int r = u >> 3; m = r & 1; h = (r >> 1) & 3; b = r >> 3; }
        else { const int r = u - 512; qt = 0; m = r & 1; h = (r >> 1) & 3; b = r >> 3; }
        const size_t row0 = (size_t)b * TPB;
        const bf16* Q = PB + (row0 + (size_t)qt * 256) * B_IN + h * 128 + m * 64;
        const bf16* Kp = PB + row0 * B_IN + 512 + h * 128 + m * 64;
        const bf16* Vp = PB + row0 * B_IN + 1024 + h * 128;
        bf16* O = (bf16*)(F.ws + (m == 0 ? WS_OB0 : WS_OB1)) + (row0 + (size_t)qt * 256) * 512 + h * 128;
        att::attn_body<64, B_IN, B_IN, 512>(Q, Kp, Vp, O, qt == 0 ? CTXL : TPB, F.ldsg + RING_OFF, F.wave);
    }
}

__device__ __forceinline__ void p_readout(Frame& F) {
    const int gw = F.bid * NWAVES + F.wave, NGW = F.G * NWAVES;
    const bf16* CHY = (const bf16*)(F.ws + WS_CHY); const bf16* fv = (const bf16*)(F.ws + WS_VOUT); const bf16* fg = (const bf16*)(F.ws + WS_GOUT); const float* BON = (const float*)(F.ws + WS_BON);
    const bf16* ob0 = (const bf16*)(F.ws + WS_OB0); const bf16* ob1 = (const bf16*)(F.ws + WS_OB1);
    bf16* A2 = (bf16*)(F.ws + WS_A2);
    float lam;
    { const float* lv = F.in[I_BLAM]; const float s1 = wave_sum(lv[F.lane] * lv[64 + F.lane]), s2 = wave_sum(lv[128 + F.lane] * lv[192 + F.lane]); lam = expf(s1) - expf(s2) + LAMBDA_INIT0; }
    const int c8 = F.lane * 8, hd = F.lane >> 3, v0 = (F.lane & 7) * 8;
    for (int row = gw; row < MROWS; row += NGW) {
        const size_t off = (size_t)row * 512 + c8;
        const int b = row / TPB, tt = row - b * TPB;
        const int ir = tt < CTXL ? (CTXL - 1 - tt) : CTXL + (TPB - 1 - tt);
        const size_t of = (size_t)ck::chunk_index(b, hd, 0, tt >> 6) * 4096 + (tt & 63) * 64 + v0, orv = (size_t)ck::chunk_index(b, hd, 1, ir >> 6) * 4096 + (ir & 63) * 64 + v0;
        const v4u qv = *(const v4u*)(fv + off), qg = *(const v4u*)(fg + off), q1 = *(const v4u*)(CHY + of), q2 = *(const v4u*)(CHY + orv);
        const unsigned wv_[4] = {qv.x, qv.y, qv.z, qv.w}, wg_[4] = {qg.x, qg.y, qg.z, qg.w}, w1_[4] = {q1.x, q1.y, q1.z, q1.w}, w2_[4] = {q2.x, q2.y, q2.z, q2.w};
        const float bon = BON[(size_t)row * 8 + hd] + BON[((size_t)MROWS + row) * 8 + hd];
        float y[8], s = 0.f;
#pragma unroll
        for (int j = 0; j < 8; ++j) { const int w = j >> 1; const bool up = j & 1; y[j] = (up ? bfhi(w1_[w]) : bflo(w1_[w])) + (up ? bfhi(w2_[w]) : bflo(w2_[w])); s += y[j]; }
        s = sum8(s);
        const float mean = s * (1.f / 64.f); float q = 0.f;
#pragma unroll
        for (int j = 0; j < 8; ++j) { y[j] -= mean; q += y[j] * y[j]; }
        q = sum8(q);
        const float rstd = 1.f / sqrtf(q * (1.f / 64.f) + GN_EPS);
        float o[8];
#pragma unroll
        for (int j = 0; j < 8; ++j) { const int w = j >> 1; const bool up = j & 1; const float v_ = up ? bfhi(wv_[w]) : bflo(wv_[w]), g_ = up ? bfhi(wg_[w]) : bflo(wg_[w]);
            o[j] = (y[j] * rstd * F.in[I_LNXG][c8 + j] + F.in[I_LNXB][c8 + j] + bon * v_) * g_; }
        *(v4u*)(A2 + (size_t)row * DM + c8) = (v4u){pk2(o[0], o[1]), pk2(o[2], o[3]), pk2(o[4], o[5]), pk2(o[6], o[7])};
        const v4u p0 = *(const v4u*)(ob0 + off), p1 = *(const v4u*)(ob1 + off);
        const unsigned u0[4] = {p0.x, p0.y, p0.z, p0.w}, u1[4] = {p1.x, p1.y, p1.z, p1.w};
        float z[8], ss = 0.f;
#pragma unroll
        for (int j = 0; j < 8; ++j) { const int w = j >> 1; const bool up = j & 1; z[j] = (up ? bfhi(u0[w]) : bflo(u0[w])) - lam * (up ? bfhi(u1[w]) : bflo(u1[w])); ss += z[j] * z[j]; }
        ss = sum16(ss);
        const float rr = 1.f / sqrtf(ss * (1.f / 128.f) + SUBLN_EPS) * (1.f - LAMBDA_INIT0);
#pragma unroll
        for (int j = 0; j < 8; ++j) z[j] = z[j] * rr * F.in[I_SUBG][(c8 + j) & 127];
        *(v4u*)(A2 + (size_t)row * DM + 512 + c8) = (v4u){pk2(z[0], z[1]), pk2(z[2], z[3]), pk2(z[4], z[5]), pk2(z[6], z[7])};
    }
}

__device__ __forceinline__ void p_qknorm1(Frame& F) {
    const int gw = F.bid * NWAVES + F.wave, NGW = F.G * NWAVES;
    bf16* QKV = (bf16*)(F.ws + WS_QKV1); const float* cosC = (const float*)(F.ws + WS_ROPE) + SEQ * 64; const float* sinC = cosC + SEQ * 64;
    const float qg1 = F.in[I_QNG][F.lane], qg2 = F.in[I_QNG][64 + F.lane], kg1 = F.in[I_KNG][F.lane], kg2 = F.in[I_KNG][64 + F.lane];
    for (int row = gw; row < MROWS; row += NGW) {
        const int b = row / TPB, tt = row - b * TPB; const bool lat = tt >= CTXL; const int t = tt - CTXL;
        float cs = 1.f, sn = 0.f; if (lat) { cs = cosC[t * 64 + F.lane]; sn = sinC[t * 64 + F.lane]; }
        bf16* p = QKV + (size_t)row * ODD_IN;
        for (int hd = 8; hd < 10; ++hd) {
            bf16* ph = p + hd * 128; const float x1 = bf2f(ph[F.lane]), x2 = bf2f(ph[64 + F.lane]);
            const float ss = wave_sum(x1 * x1 + x2 * x2); const float ri = 1.f / sqrtf(ss * (1.f / 128.f) + QKN_EPS);
            const float y1 = x1 * ri * (hd < 8 ? qg1 : kg1), y2 = x2 * ri * (hd < 8 ? qg2 : kg2);
            ph[F.lane] = (bf16)f2bf(y1 * cs - y2 * sn); ph[64 + F.lane] = (bf16)f2bf(y1 * sn + y2 * cs);
        }
    }
}
__device__ __forceinline__ void p_attn1(Frame& F) {
    const bf16* QKV = (const bf16*)(F.ws + WS_QKV1); bf16* OA = (bf16*)(F.ws + WS_OATT);
    for (int u = F.bid; u < 512; u += F.G) {
        const int qt = 1 + (u & 7), h = (u >> 3) & 7, b = u >> 6; const int kvh = h >> 2;
        const size_t row0 = (size_t)b * TPB;
        const bf16* Q = QKV + (row0 + (size_t)qt * 256) * ODD_IN + h * 128;
        const bf16* Kp = QKV + row0 * ODD_IN + 1024 + kvh * 128;
        const bf16* Vp = QKV + row0 * ODD_IN + 1280 + kvh * 128;
        bf16* O = OA + (row0 + (size_t)qt * 256) * DM + h * 128;
        att::attn_body<128, ODD_IN, ODD_IN, DM, true>(Q, Kp, Vp, O, TPB, F.ldsg + RING_OFF, F.wave, F.in[I_QNG], (const float*)(F.ws + WS_ROPE) + SEQ * 64, (const float*)(F.ws + WS_ROPE) + SEQ * 128, (qt - 1) * 256, QKN_EPS);
    }
}
namespace pg8 {
struct EpiBf16 {
    static constexpr bool PERM = true;
    bf16_t* O; int ldc;
    __device__ __forceinline__ void operator()(const f32x4 (&acc)[2][2][4][2], const Unit& u, int wr, int wc, int fr, int fq) const {
        const int row0 = u.orow0 + wr * 64 + fr, col0 = u.pn * BM + wc * 32 + 8 * fq;
#pragma unroll
        for (int ai = 0; ai < 2; ++ai)
#pragma unroll
            for (int m = 0; m < 4; ++m) { bf16_t* rowp = O + (size_t)(row0 + ai * HALF + m * 16) * ldc + col0;
#pragma unroll
                for (int bj = 0; bj < 2; ++bj) { const f32x4 v0 = acc[ai][bj][m][0], v1 = acc[ai][bj][m][1];
                    u32x4 w; w.x = cvt_pk_bf16(v0[0], v0[1]); w.y = cvt_pk_bf16(v0[2], v0[3]); w.z = cvt_pk_bf16(v1[0], v1[1]); w.w = cvt_pk_bf16(v1[2], v1[3]);
                    *(u32x4*)(rowp + bj * HALF) = w; } }
    }
};
struct EpiIn0 {
    static constexpr bool PERM = true;
    bf16_t* PA; bf16_t* PB;
    __device__ __forceinline__ void operator()(const f32x4 (&acc)[2][2][4][2], const Unit& u, int wr, int wc, int fr, int fq) const {
        const int row0 = u.orow0 + wr * 64 + fr, col0 = u.pn * BM + wc * 32 + 8 * fq;
#pragma unroll
        for (int ai = 0; ai < 2; ++ai)
#pragma unroll
            for (int m = 0; m < 4; ++m) { const size_t row = (size_t)(row0 + ai * HALF + m * 16);
#pragma unroll
                for (int bj = 0; bj < 2; ++bj) { const f32x4 v0 = acc[ai][bj][m][0], v1 = acc[ai][bj][m][1]; const int col = col0 + bj * HALF;
                    u32x4 w; w.x = cvt_pk_bf16(v0[0], v0[1]); w.y = cvt_pk_bf16(v0[2], v0[3]); w.z = cvt_pk_bf16(v1[0], v1[1]); w.w = cvt_pk_bf16(v1[2], v1[3]);
                    if (col < 1920) *(u32x4*)(PA + row * 1920 + col) = w; else if (col < 3456) *(u32x4*)(PB + row * 1536 + (col - 1920)) = w; } }
    }
};
struct EpiMoe1 {
    static constexpr bool PERM = true;
    bf16_t* HID;
    __device__ __forceinline__ void operator()(const f32x4 (&acc)[2][2][4][2], const Unit& u, int wr, int wc, int fr, int fq) const {
        const int row0 = u.orow0 + wr * 64 + fr, col0 = u.pn * 128 + wc * 16 + 4 * fq;
#pragma unroll
        for (int ai = 0; ai < 2; ++ai)
#pragma unroll
            for (int m = 0; m < 4; ++m) { bf16_t* rowp = HID + (size_t)(row0 + ai * HALF + m * 16) * 512 + col0;
#pragma unroll
                for (int bj = 0; bj < 2; ++bj) { const f32x4 a = acc[ai][bj][m][0], b = acc[ai][bj][m][1]; float h[4];
#pragma unroll
                    for (int i = 0; i < 4; ++i) h[i] = a[i] / (1.f + __expf(-a[i])) * b[i];
                    u32x2 w; w.x = cvt_pk_bf16(h[0], h[1]); w.y = cvt_pk_bf16(h[2], h[3]);
                    *(u32x2*)(rowp + bj * 64) = w; } }
    }
};
struct EpiMoe2 {
    static constexpr bool PERM = true;
    bf16_t* Y; const float* GATE;
    __device__ __forceinline__ void operator()(const f32x4 (&acc)[2][2][4][2], const Unit& u, int wr, int wc, int fr, int fq) const {
        const int r0 = wr * 64 + fr, col0 = u.pn * BM + wc * 32 + 8 * fq;
#pragma unroll
        for (int ai = 0; ai < 2; ++ai)
#pragma unroll
            for (int m = 0; m < 4; ++m) { const int r = r0 + ai * HALF + m * 16; if (r >= u.nvalid) continue;
                const float gt = GATE[u.gbase + r]; bf16_t* rowp = Y + (size_t)(u.orow0 + r) * 1024 + col0;
#pragma unroll
                for (int bj = 0; bj < 2; ++bj) { const f32x4 v0 = acc[ai][bj][m][0] * gt, v1 = acc[ai][bj][m][1] * gt;
                    u32x4 w; w.x = cvt_pk_bf16(v0[0], v0[1]); w.y = cvt_pk_bf16(v0[2], v0[3]); w.z = cvt_pk_bf16(v1[0], v1[1]); w.w = cvt_pk_bf16(v1[2], v1[3]);
                    *(u32x4*)(rowp + bj * HALF) = w; } }
    }
};
__device__ __forceinline__ void moe_build_table(const unsigned* cnt, PG8_LAS int* tab, int tid) {
    unsigned cn[16]; int total = 0;
#pragma unroll
    for (int e = 0; e < 16; ++e) { cn[e] = __hip_atomic_load(cnt + e, __ATOMIC_RELAXED, __HIP_MEMORY_SCOPE_AGENT); total += (int)((cn[e] + 255u) >> 8); }
    total *= 4;
    if (tid == 0) tab[0] = total;
    for (int L = tid; L < total; L += 512) {
        int base = 0, toff = 0, e = 0; bool found = false; unsigned ce = cn[0];
#pragma unroll
        for (int q = 0; q < 16; ++q) { const int nt = (int)((cn[q] + 255u) >> 8); if (!found) { if (L >= base + 4 * nt) { base += 4 * nt; toff += nt; e = q + 1; } else { found = true; ce = cn[q]; } } }
        const int nt_e = (int)((ce + 255u) >> 8); const int within = L - base, pn = within / nt_e, rt = within % nt_e;
        const int rem = (int)ce - rt * 256; const int nvalid = rem < 256 ? rem : 256;
        tab[4 + 2 * L] = e | (rt << 4) | (pn << 12) | (nvalid << 16); tab[4 + 2 * L + 1] = toff + rt;
    }
    __syncthreads();
}
template <bool GATHER_>
struct MoeOrder {
    static constexpr bool GATHER = GATHER_;
    const PG8_LAS int* tab; const int* perm; int G, c, K;
    __device__ __forceinline__ bool next(int i, Unit& u) const {
        const int total = __builtin_amdgcn_readfirstlane(tab[0]);
        const int L0 = i * G + c; if (L0 >= total) return false;
        const int L = xcd_remap(L0, total);
        const int w0 = __builtin_amdgcn_readfirstlane(tab[4 + 2 * L]), w1 = __builtin_amdgcn_readfirstlane(tab[4 + 2 * L + 1]);
        const int e = w0 & 15, rt = (w0 >> 4) & 255, pn = (w0 >> 12) & 3;
        u.pm = rt; u.pn = pn; u.e = e; u.gbase = e * 18432 + rt * 256; u.nvalid = (w0 >> 16) & 511; u.orow0 = w1 * 256;
        u.boff = ((size_t)e * 1024 + (size_t)pn * 256) * K * 2; u.aoff = (size_t)u.orow0 * K * 2; return true;
    }
    __device__ __forceinline__ int token(const Unit& u, int r) const { return perm[u.gbase + (r < u.nvalid ? r : 0)]; }
};
}

enum { PH_PROLOGUE = 0, PH_MOD0, PH_GEMM_IN0, PH_CHUNK, PH_ATTN0, PH_READOUT, PH_GEMM_OUT0, PH_LNR0, PH_MOE1_0, PH_MOE2_0, PH_LN2_0,
       PH_GEMM_IN1, PH_QKN1, PH_ATTN1, PH_GEMM_OUT1, PH_LNR1, PH_MOE1_1, PH_MOE2_1, PH_FINAL, N_PHASES };

template <int LAYER> __device__ __forceinline__ void p_moe1(Frame& F) {
    pg8::Gemm g{(const pg8::bf16_t*)(F.ws + WS_H), (const pg8::bf16_t*)(F.ws + WS_WM13), DM};
    pg8::moe_build_table((const unsigned*)(F.ws + WS_CTL) + CW_CNT + LAYER * 64, (LAS int*)(F.lds + MOETAB_OFF), F.tid);
    pg8::MoeOrder<true> S{(const LAS int*)(F.lds + MOETAB_OFF), (const int*)(F.ws + WS_PERM_), F.G, F.bid, DM};
    pg8::EpiMoe1 E{(pg8::bf16_t*)(F.ws + WS_HID)};
    pg8::gemm_phase<pg8::EpiMoe1, pg8::MoeOrder<true>>(F.lds + RING_OFF, g, S, E, F.wave);
}
template <int LAYER> __device__ __forceinline__ void p_moe2(Frame& F) {
    pg8::Gemm g{(const pg8::bf16_t*)(F.ws + WS_HID), (const pg8::bf16_t*)(F.ws + WS_WM2), EFF};
    pg8::moe_build_table((const unsigned*)(F.ws + WS_CTL) + CW_CNT + LAYER * 64, (LAS int*)(F.lds + MOETAB_OFF), F.tid);
    pg8::MoeOrder<false> S{(const LAS int*)(F.lds + MOETAB_OFF), (const int*)(F.ws + WS_PERM_), F.G, F.bid, EFF};
    pg8::EpiMoe2 E{(pg8::bf16_t*)(F.ws + WS_Y), (const float*)(F.ws + WS_GATE)};
    pg8::gemm_phase<pg8::EpiMoe2, pg8::MoeOrder<false>>(F.lds + RING_OFF, g, S, E, F.wave);
}
__device__ __forceinline__ void p_gemm_dense(Frame& F, size_t a_off, size_t w_off, int N, size_t o_off, int ldc, int skip9 = 0) {
    pg8::Gemm g{(const pg8::bf16_t*)(F.ws + a_off), (const pg8::bf16_t*)(F.ws + w_off), DM};
    pg8::DenseOrder S; S.init(MROWS, N, DM, F.G, F.bid, skip9);
    pg8::EpiBf16 E{(pg8::bf16_t*)(F.ws + o_off), ldc};
    pg8::gemm_phase<pg8::EpiBf16, pg8::DenseOrder>(F.lds + RING_OFF, g, S, E, F.wave);
}

template <int PH> __device__ __forceinline__ void run_phase(Frame& F) {
    if constexpr (PH == PH_PROLOGUE) p_prologue(F);
    else if constexpr (PH == PH_MOD0) p_mod0(F);
    else if constexpr (PH == PH_GEMM_IN0) {
        pg8::Gemm g{(const pg8::bf16_t*)(F.ws + WS_H), (const pg8::bf16_t*)(F.ws + WS_WEVIN), DM};
        pg8::DenseOrder S; S.init(MROWS, EVEN_PAD, DM, F.G, F.bid);
        pg8::EpiIn0 E{(pg8::bf16_t*)(F.ws + WS_PA), (pg8::bf16_t*)(F.ws + WS_PB)};
        pg8::gemm_phase<pg8::EpiIn0, pg8::DenseOrder>(F.lds + RING_OFF, g, S, E, F.wave); }
    else if constexpr (PH == PH_CHUNK) {
#ifndef CK_SKIP_ROPE
        p_rope0(F);
#endif
#ifndef CK_SKIP_ALL
        p_chunk_pre(F);
#endif
    }
    else if constexpr (PH == PH_ATTN0) { p_state(F); p_attn0(F); }
    else if constexpr (PH == PH_READOUT) p_readout(F);
    else if constexpr (PH == PH_GEMM_OUT0) p_gemm_dense(F, WS_A2, WS_WEVOUT, DM, WS_MIX, DM);
    else if constexpr (PH == PH_LNR0) { convert_moe_weights(F, 0); __syncthreads(); p_ln_route<0>(F); }
    else if constexpr (PH == PH_MOE1_0) p_moe1<0>(F);
    else if constexpr (PH == PH_MOE2_0) p_moe2<0>(F);
    else if constexpr (PH == PH_LN2_0) { p_ln2<0>(F); convert_moe_weights(F, 1); }
    else if constexpr (PH == PH_GEMM_IN1) p_gemm_dense(F, WS_H, WS_WODIN, ODD_IN, WS_QKV1, ODD_IN);
    else if constexpr (PH == PH_QKN1) p_qknorm1(F);
    else if constexpr (PH == PH_ATTN1) p_attn1(F);
    else if constexpr (PH == PH_GEMM_OUT1) p_gemm_dense(F, WS_OATT, WS_WODOUT, DM, WS_MIX, DM, 1);
    else if constexpr (PH == PH_LNR1) p_ln_route<1>(F);
    else if constexpr (PH == PH_MOE1_1) p_moe1<1>(F);
    else if constexpr (PH == PH_MOE2_1) p_moe2<1>(F);
    else if constexpr (PH == PH_FINAL) p_ln2<1>(F);
}
template <int PH, int HI> __device__ __forceinline__ void run_phases(Frame& F, const XcdBarrier& bar) {
    if constexpr (PH < HI) {
        {
            const float* const* inp = (const float* const*)__builtin_amdgcn_kernarg_segment_ptr(); asm volatile("" : "+s"(inp)); F.in = inp;
            asm volatile("" : "+s"(F.ws), "+s"(F.out), "+s"(F.G), "+s"(F.bid), "+s"(F.wave));
            int l_ = (int)__builtin_amdgcn_mbcnt_hi(~0u, __builtin_amdgcn_mbcnt_lo(~0u, 0u)); asm volatile("" : "+v"(l_)); F.lane = l_; F.tid = (F.wave << 6) | l_; }
        asm volatile("; PHASE_MARK %0" :: "i"(PH));
        run_phase<PH>(F);
        if constexpr (PH + 1 < HI) { xcd_barrier(bar);
#ifdef XBAR_EXTRA
            if constexpr (PH == 5) { for (int q_ = 0; q_ < XBAR_EXTRA; ++q_) xcd_barrier(bar); }
#endif
#ifdef TPROBE_A
            if (threadIdx.x == 0) ((volatile LAS unsigned long long*)(F.lds + MISC_OFF + 128))[PH + 1] = __builtin_amdgcn_s_memrealtime();
#endif
            run_phases<PH + 1, HI>(F, bar); }
    }
}

template <int LO, int HI>
__global__ void __launch_bounds__(NTHR, 2) fwd_kernel(Args args) {
    extern __shared__ __attribute__((aligned(16))) unsigned char lds[];
    Frame F;
    F.lds = (LAS unsigned char*)lds; F.ldsg = (char*)lds;
    F.tid = threadIdx.x; F.lane = F.tid & 63; F.wave = __builtin_amdgcn_readfirstlane(F.tid >> 6);
    F.G = gridDim.x; F.bid = blockIdx.x; F.in = args.in; F.out = args.out; F.ws = args.ws;
    volatile LAS unsigned* MISC = (volatile LAS unsigned*)(F.lds + MISC_OFF);
    for (int u = F.tid; u < (LDS_BYTES - LDSCTL_OFF) / 4; u += NTHR) ((LAS unsigned*)(F.lds + LDSCTL_OFF))[u] = 0u;
    __syncthreads();
    XcdBarrier bar; bar.bar = (unsigned*)(F.ws + WS_CTL) + CW_BAR; bar.x = 0; bar.st = nullptr;
    if constexpr (HI - LO > 1) bar = xcd_barrier_post((unsigned*)(F.ws + WS_CTL) + CW_BAR, MISC + 8);
#ifdef TPROBE_A
    if (threadIdx.x == 0) ((volatile LAS unsigned long long*)(F.lds + MISC_OFF + 128))[0] = __builtin_amdgcn_s_memrealtime();
#endif
    run_phases<LO, HI>(F, bar);
}

#ifndef N_LAUNCH_MODE
#define N_LAUNCH_MODE 0
#endif
template <int PH> static void launch_from(int grid, hipStream_t stream, const Args& a) {
    if constexpr (PH < N_PHASES) {
        (void)hipFuncSetAttribute((const void*)fwd_kernel<PH, PH + 1>, hipFuncAttributeMaxDynamicSharedMemorySize, LDS_BYTES);
        hipLaunchKernelGGL((fwd_kernel<PH, PH + 1>), dim3(grid), dim3(NTHR), LDS_BYTES, stream, a);
#ifdef PROBE_MASK
        if ((PROBE_MASK >> PH) & 1) hipLaunchKernelGGL((fwd_kernel<PH, PH + 1>), dim3(grid), dim3(NTHR), LDS_BYTES, stream, a);
#endif
        launch_from<PH + 1>(grid, stream, a);
    }
}
extern "C" void kernel_launch(void* const* d_in, const int* in_sizes, int n_in, void* d_out, int out_size, void* d_ws, size_t ws_size, hipStream_t stream) {
    static int grid = 0;
    if (grid == 0) {
        if (n_in != 34 || in_sizes[0] != NB * SEQ * DM || out_size != NB * SEQ * DM || ws_size < WS_TOTAL) {
            fprintf(stderr, "kernel_launch: unexpected shapes: n_in %d in0 %d out %d ws %zu (need %zu)\n", n_in, n_in > 0 ? in_sizes[0] : -1, out_size, ws_size, (size_t)WS_TOTAL); grid = -1; return; }
        int dev = 0, cus = 0;
        if (hipGetDevice(&dev) != hipSuccess || hipDeviceGetAttribute(&cus, hipDeviceAttributeMultiprocessorCount, dev) != hipSuccess) { grid = -1; return; }
#if N_LAUNCH_MODE == 0
        if (hipFuncSetAttribute((const void*)fwd_kernel<0, N_PHASES>, hipFuncAttributeMaxDynamicSharedMemorySize, LDS_BYTES) != hipSuccess) { fprintf(stderr, "kernel_launch: hipFuncSetAttribute failed\n"); grid = -1; return; }
#endif
        (void)hipGetLastError();
        grid = cus;
    }
    if (grid < 0) return;
    if (hipMemsetAsync((char*)d_ws + WS_CTL, 0, CTL_ZERO_BYTES, stream) != hipSuccess) return;
    Args a{};
    for (int i = 0; i < 34; ++i) a.in[i] = (const float*)d_in[i];
    a.out = (float*)d_out; a.ws = (unsigned char*)d_ws;
#if N_LAUNCH_MODE == 1
    launch_from<0>(grid, stream, a);
#else
    hipLaunchKernelGGL((fwd_kernel<0, N_PHASES>), dim3(grid), dim3(NTHR), LDS_BYTES, stream, a);
#endif
    const hipError_t le = hipPeekAtLastError();
    if (le != hipSuccess) fprintf(stderr, "kernel_launch: launch failed: %s\n", hipGetErrorName(le));
}
```

```cpp
#include <hip/hip_runtime.h>
#include <hip/hip_bf16.h>
#include <cstdio>
#include <cstdint>
#include <cmath>
namespace pg8 {
__device__ __forceinline__ int pg8_lane_fresh() { unsigned m = ~0u; asm volatile("" : "+s"(m)); return (int)__builtin_amdgcn_mbcnt_hi(m, __builtin_amdgcn_mbcnt_lo(m, 0u)); }
#define PG8_LAS __attribute__((address_space(3)))
typedef unsigned short bf16_t;
typedef short bf16x8 __attribute__((ext_vector_type(8)));
typedef float f32x4 __attribute__((ext_vector_type(4)));
typedef unsigned u32x4 __attribute__((ext_vector_type(4)));
typedef unsigned u32x2 __attribute__((ext_vector_type(2)));
constexpr int BM = 256, BK = 64, HALF = 128, HTB = HALF * BK * 2  , STAGE_BYTES = 8 * HTB, NXCD = 8, WGM = 8;

__host__ __device__ __forceinline__ int lds_byte(int r, int c) { const int st = (r >> 4) * 2 + (c >> 5), rr = r & 15, cc = c & 31, ob = rr * 64 + cc * 2; return st * 1024 + (ob ^ (((ob >> 9) & 1) << 5)); }
__host__ __device__ __forceinline__ void stage_rc(int b, int& R, int& C) { const int st = b / 1024, sb = b % 1024, swz = sb ^ (((sb >> 9) & 1) << 5); R = (st >> 1) * 16 + swz / 64; C = (st & 1) * 32 + (swz % 64) / 2; }
__host__ __device__ __forceinline__ int perm32(int rho) { const int n = rho >> 4, i = rho & 15; return 8 * (i >> 2) + 4 * n + (i & 3); }

struct Unit { int pm, pn; size_t aoff, boff; int gbase, nvalid, orow0, e; };
struct Gemm { const bf16_t* A; const bf16_t* Bt; int K; };

__device__ __forceinline__ int xcd_remap(int wgid, int nwg) { const int q = nwg / NXCD, r = nwg % NXCD, xcd = wgid % NXCD, off = wgid / NXCD; return (xcd < r ? xcd * (q + 1) : r * (q + 1) + (xcd - r) * q) + off; }

struct DenseOrder {
    int nM, nN, nwg, G, c, K, skip9;
    static constexpr bool GATHER = false;
    __device__ void init(int M, int N, int K_, int G_, int c_, int skip9_ = 0) { skip9 = skip9_; nM = skip9 ? (M / BM) * 8 / 9 : M / BM; nN = N / BM; nwg = nM * nN; G = G_; c = c_; K = K_; }
    __device__ bool next(int i, Unit& u) const {
        const long L = (long)i * G + c; if (L >= nwg) return false;
        const int wgid = xcd_remap((int)L, nwg);
        const int nig = WGM * nN, gid = wgid / nig, fm = gid * WGM, gsz = (nM - fm) < WGM ? (nM - fm) : WGM;
        u.pm = fm + ((wgid % nig) % gsz); u.pn = (wgid % nig) / gsz;
        if (skip9) u.pm = u.pm + u.pm / 8 + 1;
        u.aoff = (size_t)u.pm * BM * K * 2; u.boff = (size_t)u.pn * BM * K * 2; u.gbase = 0; u.nvalid = BM; u.orow0 = u.pm * BM; u.e = 0; return true;
    }
    __device__ __forceinline__ int token(const Unit&, int) const { return 0; }
};

__device__ __forceinline__ unsigned cvt_pk_bf16(float lo, float hi) { unsigned r; asm volatile("v_cvt_pk_bf16_f32 %0, %1, %2" : "=v"(r) : "v"(lo), "v"(hi)); return r; }

template <class Epi, class Sched>
__device__ __forceinline__ void gemm_phase(PG8_LAS unsigned char* lds, const Gemm g, const Sched& S, const Epi& E, int wave_id) {
    int tid = (wave_id << 6) | pg8_lane_fresh(); asm volatile("" : "+v"(tid));
    const int wid = __builtin_amdgcn_readfirstlane(tid >> 6), lane = tid & 63, wr = wid >> 2, wc = wid & 3, fr = lane & 15, fq = lane >> 4;
    const int K = g.K, nt = K / BK;
    int RA[2], CA[2];
    unsigned voffB[2], voffA[2][2], voffAn[2][2];
#pragma unroll
    for (int i = 0; i < 2; ++i) { int R, C; stage_rc(tid * 16 + i * 8192, R, C); RA[i] = R; CA[i] = C; const int Rb = Epi::PERM ? ((R & ~31) + perm32(R & 31)) : R;
        voffB[i] = (unsigned)(Rb * K + C) * 2u;
        voffA[0][i] = (unsigned)(R * K + C) * 2u; voffA[1][i] = (unsigned)((R + HALF) * K + C) * 2u; voffAn[0][i] = voffA[0][i]; voffAn[1][i] = voffA[1][i]; }
    const size_t kstep = (size_t)(BK * 2);
    const size_t hstep = (size_t)HALF * K * 2;
    const unsigned ldsw = (unsigned)wid * 1024u;
    const int aoff = lds_byte(wr * 64 + fr, fq * 8), boff = lds_byte(wc * 32 + fr, fq * 8);
#define PG8_SA(b, h) (((b) * 2 + (h)) * HTB)
#define PG8_SB(b, h) ((4 + (b) * 2 + (h)) * HTB)
#define PG8_STAGE(bufoff, gbase, voff) do { _Pragma("unroll") for (int _i = 0; _i < 2; ++_i) \
        __builtin_amdgcn_global_load_lds((const unsigned*)((const char*)(gbase) + (voff)[_i]), (PG8_LAS unsigned*)(lds + (bufoff) + ldsw + _i * 8192), 16, 0, 0); } while (0)
#define PG8_LDA(dst, b, h) do { _Pragma("unroll") for (int m = 0; m < 4; ++m) _Pragma("unroll") for (int k = 0; k < 2; ++k) dst[m][k] = *(const PG8_LAS bf16x8*)(lds + PG8_SA(b, h) + aoff + m * 2048 + k * 1024); } while (0)
#define PG8_LDB(dst, b, h) do { _Pragma("unroll") for (int n = 0; n < 2; ++n) _Pragma("unroll") for (int k = 0; k < 2; ++k) dst[n][k] = *(const PG8_LAS bf16x8*)(lds + PG8_SB(b, h) + boff + n * 2048 + k * 1024); } while (0)
#define PG8_MMA(ai, bj, At, Bt) do { __builtin_amdgcn_s_setprio(1); _Pragma("unroll") for (int m = 0; m < 4; ++m) _Pragma("unroll") for (int n = 0; n < 2; ++n) _Pragma("unroll") for (int k = 0; k < 2; ++k) \
        acc[ai][bj][m][n] = __builtin_amdgcn_mfma_f32_16x16x32_bf16(Bt[n][k], At[m][k], acc[ai][bj][m][n], 0, 0, 0); __builtin_amdgcn_s_setprio(0); } while (0)
#define PG8_WAIT_V(n) asm volatile("s_waitcnt vmcnt(" #n ")" ::: "memory")
#define PG8_WAIT_L(n) asm volatile("s_waitcnt lgkmcnt(" #n ")" ::: "memory")
#define PG8_BAR __builtin_amdgcn_s_barrier()
#define PG8_SCHED __builtin_amdgcn_sched_barrier(0)
#define PG8_GOFF(dst, U) do { if constexpr (Sched::GATHER) { _Pragma("unroll") for (int _h = 0; _h < 2; ++_h) _Pragma("unroll") for (int _i = 0; _i < 2; ++_i) \
        dst[_h][_i] = (unsigned)(S.token(U, _h * HALF + RA[_i]) * K + CA[_i]) * 2u; } } while (0)
    Unit cur, nxt; int ui = 0;
    if (!S.next(0, cur)) return;
    f32x4 acc[2][2][4][2];
#pragma unroll
    for (int a = 0; a < 2; ++a)
#pragma unroll
        for (int b = 0; b < 2; ++b)
#pragma unroll
            for (int m = 0; m < 4; ++m)
#pragma unroll
                for (int n = 0; n < 2; ++n) acc[a][b][m][n] = (f32x4){0.f, 0.f, 0.f, 0.f};
    bf16x8 At[4][2], B0[2][2], B1[2][2];
    typename Epi::Pre pre; E.prefetch(pre, cur, wr, fr);
    PG8_GOFF(voffA, cur);
    const char* cA = (const char*)g.A + (Sched::GATHER ? (size_t)0 : cur.aoff); const char* cB = (const char*)g.Bt + cur.boff;
    PG8_STAGE(PG8_SB(0, 0), cB, voffB); PG8_STAGE(PG8_SA(0, 0), cA, voffA[0]); PG8_STAGE(PG8_SB(0, 1), cB + hstep, voffB); PG8_STAGE(PG8_SA(0, 1), cA, voffA[1]);
    if (wr == 1) PG8_BAR;
    PG8_WAIT_V(4); PG8_BAR;
    PG8_STAGE(PG8_SB(1, 0), cB + kstep, voffB); PG8_STAGE(PG8_SA(1, 0), cA + kstep, voffA[0]); PG8_STAGE(PG8_SB(1, 1), cB + hstep + kstep, voffB);
    PG8_WAIT_V(6); PG8_BAR;
    for (;;) {
        const bool has_next = S.next(ui + 1, nxt);
        if (has_next) { PG8_GOFF(voffAn, nxt); if constexpr (Sched::GATHER) { asm volatile("" : "+v"(voffAn[0][0]), "+v"(voffAn[0][1]), "+v"(voffAn[1][0]), "+v"(voffAn[1][1])); } }
        const char* nA = has_next ? (const char*)g.A + (Sched::GATHER ? (size_t)0 : nxt.aoff) : cA; const char* nB = has_next ? (const char*)g.Bt + nxt.boff : cB;
        for (int t = 0; t < nt; t += 2) {
            const bool last = (t == nt - 2);
            const char* a1 = cA + (size_t)(t + 1) * kstep;
            const char* a2 = last ? nA : cA + (size_t)(t + 2) * kstep; const char* b2 = last ? nB : cB + (size_t)(t + 2) * kstep;
            const char* a3 = a2 + kstep; const char* b3 = b2 + kstep;
            unsigned va2[2][2];
#pragma unroll
            for (int h = 0; h < 2; ++h)
#pragma unroll
                for (int i = 0; i < 2; ++i) va2[h][i] = (Sched::GATHER && last && has_next) ? voffAn[h][i] : voffA[h][i];
            PG8_LDB(B0, 0, 0); PG8_SCHED; PG8_LDA(At, 0, 0); PG8_STAGE(PG8_SA(1, 1), a1, voffA[1]);
            PG8_WAIT_L(8); PG8_BAR; PG8_WAIT_L(0); PG8_MMA(0, 0, At, B0); PG8_BAR; PG8_SCHED;
            PG8_LDB(B1, 0, 1); PG8_STAGE(PG8_SB(0, 0), b2, voffB);
            PG8_BAR; PG8_WAIT_L(0); PG8_MMA(0, 1, At, B1); PG8_BAR;
            PG8_LDA(At, 0, 1); PG8_STAGE(PG8_SA(0, 0), a2, va2[0]);
            PG8_BAR; PG8_WAIT_L(0); PG8_MMA(1, 0, At, B0); PG8_BAR; PG8_SCHED;
            PG8_STAGE(PG8_SB(0, 1), b2 + hstep, voffB);
            PG8_WAIT_V(6); PG8_BAR; PG8_MMA(1, 1, At, B1); PG8_BAR;
            PG8_LDB(B0, 1, 0); PG8_SCHED; PG8_LDA(At, 1, 0); PG8_STAGE(PG8_SA(0, 1), a2, va2[1]);
            PG8_WAIT_L(8); PG8_BAR; PG8_WAIT_L(0); PG8_MMA(0, 0, At, B0); PG8_BAR; PG8_SCHED;
            PG8_LDB(B1, 1, 1); PG8_STAGE(PG8_SB(1, 0), b3, voffB);
            PG8_BAR; PG8_WAIT_L(0); PG8_MMA(0, 1, At, B1); PG8_BAR;
            PG8_LDA(At, 1, 1); PG8_STAGE(PG8_SA(1, 0), a3, va2[0]);
            PG8_BAR; PG8_WAIT_L(0); PG8_MMA(1, 0, At, B0); PG8_BAR; PG8_SCHED;
            PG8_STAGE(PG8_SB(1, 1), b3 + hstep, voffB);
            PG8_WAIT_V(6); PG8_BAR; PG8_MMA(1, 1, At, B1); PG8_BAR;
        }
        E(acc, cur, wr, wc, fr, fq, pre);
        if (!has_next) break;
#pragma unroll
        for (int a = 0; a < 2; ++a)
#pragma unroll
            for (int b = 0; b < 2; ++b)
#pragma unroll
                for (int m = 0; m < 4; ++m)
#pragma unroll
                    for (int n = 0; n < 2; ++n) acc[a][b][m][n] = (f32x4){0.f, 0.f, 0.f, 0.f};
        cur = nxt; cA = nA; cB = nB; ++ui;
        E.prefetch(pre, cur, wr, fr);
        if constexpr (Sched::GATHER) {
#pragma unroll
            for (int h = 0; h < 2; ++h)
#pragma unroll
                for (int i = 0; i < 2; ++i) voffA[h][i] = voffAn[h][i];
        }
    }
    PG8_WAIT_V(0);
    if (wr == 0) PG8_BAR;
    PG8_BAR;
#undef PG8_SA
#undef PG8_SB
#undef PG8_STAGE
#undef PG8_LDA
#undef PG8_LDB
#undef PG8_MMA
#undef PG8_WAIT_V
#undef PG8_WAIT_L
#undef PG8_BAR
#undef PG8_SCHED
#undef PG8_GOFF
}
}
namespace att {
using bf16x8 = __attribute__((ext_vector_type(8))) short;
using s16x4  = __attribute__((ext_vector_type(4))) short;
using f32x16 = __attribute__((ext_vector_type(16))) float;
using u32x4  = __attribute__((ext_vector_type(4))) unsigned;
typedef unsigned short bf16_t;
constexpr int NW = 8, QBLK = 32, KVBLK = 64;
constexpr float THR = 8.f;
constexpr size_t SHM_V = KVBLK * 128 * 2, SHM_K = KVBLK * 128 * 2, SHM_ATTN = 3 * SHM_V + 3 * SHM_K + NW * 64 * 4;
#define KSWZ(row, colB) ((row) * 256 + ((colB) ^ (((row) & 7) << 4)))
#define KSWZ64(row, colB) ((row) * 128 + ((colB) ^ ((((row) >> 1) & 7) << 4)))
#define SBAR() __builtin_amdgcn_sched_barrier(0)
__device__ __forceinline__ int crow(int r, int hi) { return (r & 3) + 8 * (r >> 2) + 4 * hi; }
__device__ __forceinline__ unsigned cvtpk(float lo, float hi) { unsigned r; asm volatile("v_cvt_pk_bf16_f32 %0, %1, %2" : "=v"(r) : "v"(lo), "v"(hi)); return r; }

template <int DQK> struct Sc { static constexpr float SCALE = (DQK == 64) ? 0.125f : 0.088388347648318440f; };

template <int DQK>
__device__ __forceinline__ void partialSM(f32x16& p0, f32x16& p1, float& m_reg, float& mn, float& alpha) {
  constexpr float SCALE = Sc<DQK>::SCALE;
  constexpr float C = SCALE * 1.4426950408889634f;
  float pmax = p0[0];
#pragma unroll
  for (int r = 1; r < 16; ++r) pmax = fmaxf(pmax, p0[r]);
#pragma unroll
  for (int r = 0; r < 16; ++r) pmax = fmaxf(pmax, p1[r]);
  { auto rr = __builtin_amdgcn_permlane32_swap(__float_as_uint(pmax), __float_as_uint(pmax), false, false);
    pmax = fmaxf(__uint_as_float(rr[0]), __uint_as_float(rr[1])); }
  if (__builtin_expect(__all(pmax - m_reg <= THR / SCALE), 1)) { mn = m_reg; alpha = 1.f; }
  else { mn = fmaxf(m_reg, pmax); alpha = __builtin_amdgcn_exp2f((m_reg - mn) * C); m_reg = mn; }
  float mnC = -mn * C;
#pragma unroll
  for (int r = 0; r < 16; ++r) p0[r] = fmaf(p0[r], C, mnC);
#pragma unroll
  for (int r = 0; r < 16; ++r) p1[r] = fmaf(p1[r], C, mnC);
#pragma unroll
  for (int r = 0; r < 16; ++r) p0[r] = __builtin_amdgcn_exp2f(p0[r]);
}
__device__ __forceinline__ void finishSM(f32x16& p0, f32x16& p1, float alpha, float& l_reg, bf16x8& pa0, bf16x8& pa1, bf16x8& pa2, bf16x8& pa3) {
#pragma unroll
  for (int r = 0; r < 16; ++r) p1[r] = __builtin_amdgcn_exp2f(p1[r]);
  float ps = 0;
#pragma unroll
  for (int r = 0; r < 16; ++r) ps += p0[r];
#pragma unroll
  for (int r = 0; r < 16; ++r) ps += p1[r];
  { auto rr = __builtin_amdgcn_permlane32_swap(__float_as_uint(ps), __float_as_uint(ps), false, false);
    ps = __uint_as_float(rr[0]) + __uint_as_float(rr[1]); }
  l_reg = l_reg * alpha + ps;
#define PK4(P, BASE, OUT) do { unsigned a0 = cvtpk(P[BASE + 0], P[BASE + 1]), a1 = cvtpk(P[BASE + 2], P[BASE + 3]);   \
    unsigned b0 = cvtpk(P[BASE + 4], P[BASE + 5]), b1 = cvtpk(P[BASE + 6], P[BASE + 7]);                              \
    auto r0 = __builtin_amdgcn_permlane32_swap(a0, b0, false, false); auto r1 = __builtin_amdgcn_permlane32_swap(a1, b1, false, false); \
    u32x4 w = {r0[0], r1[0], r0[1], r1[1]}; OUT = *reinterpret_cast<bf16x8*>(&w); } while (0)
  PK4(p0, 0, pa0); PK4(p0, 8, pa1); PK4(p1, 0, pa2); PK4(p1, 8, pa3);
#undef PK4
}
template <int DQK>
__device__ __forceinline__ void qkt(f32x16& p0, f32x16& p1, const char* Ks, const bf16x8* qr, int r32, int hi) {
#pragma unroll
  for (int r = 0; r < 16; ++r) { p0[r] = 0.f; p1[r] = 0.f; }
  asm volatile("" : "+v"(p0), "+v"(p1));
#pragma unroll
  for (int d0 = 0; d0 < DQK / 16; ++d0) { const int cb = (d0 * 16 + hi * 8) * 2;
    bf16x8 b0, b1;
    if constexpr (DQK == 128) { b0 = *reinterpret_cast<const bf16x8*>(Ks + KSWZ(r32, cb)); b1 = *reinterpret_cast<const bf16x8*>(Ks + KSWZ(32 + r32, cb)); }
    else { b0 = *reinterpret_cast<const bf16x8*>(Ks + KSWZ64(r32, cb)); b1 = *reinterpret_cast<const bf16x8*>(Ks + KSWZ64(32 + r32, cb)); }
    p0 = __builtin_amdgcn_mfma_f32_32x32x16_bf16(b0, qr[d0], p0, 0, 0, 0);
    p1 = __builtin_amdgcn_mfma_f32_32x32x16_bf16(b1, qr[d0], p1, 0, 0, 0); }
}
__device__ __forceinline__ int v_st(int k, int c) { const int kk = (k & ~0xC) | ((k & 4) << 1) | ((k & 8) >> 1); return ((kk >> 3) * 4 + (c >> 5)) * 512 + ((kk & 7) * 32 + (c & 31)) * 2; }
__device__ __forceinline__ int v_rd_base(int lane) { return ((lane & 3) << 3) | (((lane >> 2) & 3) << 6) | (((lane >> 4) & 1) << 5) | (((lane >> 5) & 1) << 8); }
constexpr int v_rd_off(int d0, int ks, int half) { return d0 * 512 + ks * 4096 + half * 2048; }
template <int OFF> __device__ __forceinline__ s16x4 tr_read(int vb) {
  s16x4 r; asm volatile("ds_read_b64_tr_b16 %0, %1 offset:%2" : "=&v"(r) : "v"(vb), "i"(OFF) : "memory"); return r;
}
template <int D0> __device__ __forceinline__ void pv_one(f32x16& od, int vb, bf16x8 pa0, bf16x8 pa1, bf16x8 pa2, bf16x8 pa3) {
  const s16x4 l0 = tr_read<v_rd_off(D0, 0, 0)>(vb), h0 = tr_read<v_rd_off(D0, 0, 1)>(vb), l1 = tr_read<v_rd_off(D0, 1, 0)>(vb), h1 = tr_read<v_rd_off(D0, 1, 1)>(vb);
  const s16x4 l2 = tr_read<v_rd_off(D0, 2, 0)>(vb), h2 = tr_read<v_rd_off(D0, 2, 1)>(vb), l3 = tr_read<v_rd_off(D0, 3, 0)>(vb), h3 = tr_read<v_rd_off(D0, 3, 1)>(vb);
  asm volatile("s_waitcnt lgkmcnt(0)" ::: "memory"); SBAR();
#define PK(L, H) (bf16x8){L[0], L[1], L[2], L[3], H[0], H[1], H[2], H[3]}
  od = __builtin_amdgcn_mfma_f32_32x32x16_bf16(pa0, PK(l0, h0), od, 0, 0, 0);
  od = __builtin_amdgcn_mfma_f32_32x32x16_bf16(pa1, PK(l1, h1), od, 0, 0, 0);
  od = __builtin_amdgcn_mfma_f32_32x32x16_bf16(pa2, PK(l2, h2), od, 0, 0, 0);
  od = __builtin_amdgcn_mfma_f32_32x32x16_bf16(pa3, PK(l3, h3), od, 0, 0, 0);
#undef PK
}
__device__ __forceinline__ void pv_d0(f32x16* o, int vb, bf16x8 pa0, bf16x8 pa1, bf16x8 pa2, bf16x8 pa3) {
  pv_one<0>(o[0], vb, pa0, pa1, pa2, pa3); pv_one<1>(o[1], vb, pa0, pa1, pa2, pa3); pv_one<2>(o[2], vb, pa0, pa1, pa2, pa3); pv_one<3>(o[3], vb, pa0, pa1, pa2, pa3);
}

template <int DQK, int LDQ, int LDK, int LDO, bool QN = false>
__device__ __forceinline__ void attn_body(const bf16_t* __restrict__ Qb, const bf16_t* __restrict__ Kh, const bf16_t* __restrict__ Vh, bf16_t* __restrict__ Ob, int seq, char* lds, int wave_id,
                                          const float* qg = nullptr, const float* cs = nullptr, const float* sn = nullptr, int qpos0 = 0, float qeps = 0.f) {
  unsigned lm_ = ~0u; asm volatile("" : "+s"(lm_)); int tid = (wave_id << 6) | (int)__builtin_amdgcn_mbcnt_hi(lm_, __builtin_amdgcn_mbcnt_lo(lm_, 0u)); asm volatile("" : "+v"(tid));
  const int wid = tid >> 6, lane = tid & 63, r32 = lane & 31, hi = lane >> 5;
  char* V_lds = lds; char* K_lds = lds + 3 * SHM_V;
  float* ws = (float*)(lds + 3 * SHM_V + 3 * SHM_K) + wid * 64; float* li_l = ws; float* al_l = ws + 32;
  float m_reg = -1e30f, l_reg = 0; f32x16 o[4] = {}; bf16x8 qr[DQK / 16];
  const bf16_t* Qw = Qb + (long)(wid * QBLK + r32) * LDQ + hi * 8;
#pragma unroll
  for (int d0 = 0; d0 < DQK / 16; ++d0) qr[d0] = *reinterpret_cast<const bf16x8*>(Qw + d0 * 16);
  if constexpr (QN) {
    static_assert(!QN || DQK == 128, "QN needs head dim 128");
    float qf[8][8]; float ss = 0.f;
#pragma unroll
    for (int d0 = 0; d0 < 8; ++d0)
#pragma unroll
      for (int j = 0; j < 8; ++j) { const float v = __builtin_bit_cast(float, (unsigned)(unsigned short)qr[d0][j] << 16); qf[d0][j] = v; ss += v * v; }
    { auto rr = __builtin_amdgcn_permlane32_swap(__float_as_uint(ss), __float_as_uint(ss), false, false); ss = __uint_as_float(rr[0]) + __uint_as_float(rr[1]); }
    const float ri = __builtin_amdgcn_rsqf(ss * (1.f / 128.f) + qeps);
    const int pos = qpos0 + wid * QBLK + r32;
#pragma unroll
    for (int d0 = 0; d0 < 4; ++d0) {
      const int i0 = 16 * d0 + 8 * hi;
#pragma unroll
      for (int j = 0; j < 8; ++j) { const float c = cs[pos * 64 + i0 + j], s = sn[pos * 64 + i0 + j];
        const float y1 = qf[d0][j] * ri * qg[i0 + j], y2 = qf[d0 + 4][j] * ri * qg[64 + i0 + j];
        qf[d0][j] = y1 * c - y2 * s; qf[d0 + 4][j] = y1 * s + y2 * c; }
    }
#pragma unroll
    for (int d0 = 0; d0 < 8; ++d0) { u32x4 w = {cvtpk(qf[d0][0], qf[d0][1]), cvtpk(qf[d0][2], qf[d0][3]), cvtpk(qf[d0][4], qf[d0][5]), cvtpk(qf[d0][6], qf[d0][7])}; qr[d0] = *reinterpret_cast<bf16x8*>(&w); }
  }
  const int sr = tid >> 4, sc = (tid & 15) * 8, vst0 = v_st(sr, sc), vst1 = v_st(32 + sr, sc);
  const int kr64 = tid >> 3, kc64 = (tid & 7) * 8;
  const int vb0 = (int)(uintptr_t)V_lds + v_rd_base(lane);
  struct { bf16x8 vs0, vs1, ks0, ks1; } sr_[2];
#define SLOAD(i, k0) do { sr_[i].vs0 = *reinterpret_cast<const bf16x8*>(&Vh[(long)((k0) + sr) * LDK + sc]); sr_[i].vs1 = *reinterpret_cast<const bf16x8*>(&Vh[(long)((k0) + 32 + sr) * LDK + sc]); \
    if constexpr (DQK == 128) { sr_[i].ks0 = *reinterpret_cast<const bf16x8*>(&Kh[(long)((k0) + sr) * LDK + sc]); sr_[i].ks1 = *reinterpret_cast<const bf16x8*>(&Kh[(long)((k0) + 32 + sr) * LDK + sc]); } \
    else { sr_[i].ks0 = *reinterpret_cast<const bf16x8*>(&Kh[(long)((k0) + kr64) * LDK + kc64]); } } while (0)
#define SWRITE(b, i) do { *(bf16x8*)(V_lds + (b) * SHM_V + vst0) = sr_[i].vs0;          \
    *(bf16x8*)(V_lds + (b) * SHM_V + vst1) = sr_[i].vs1;               \
    if constexpr (DQK == 128) { const int kc = sc * 2; *(bf16x8*)(K_lds + (b) * SHM_K + KSWZ(sr, kc)) = sr_[i].ks0; *(bf16x8*)(K_lds + (b) * SHM_K + KSWZ(32 + sr, kc)) = sr_[i].ks1; } \
    else { const int kc = kc64 * 2; *(bf16x8*)(K_lds + (b) * SHM_K + KSWZ64(kr64, kc)) = sr_[i].ks0; } } while (0)
#define SWAIT() do { if constexpr (DQK == 128) asm volatile("s_waitcnt vmcnt(4)" ::: "memory"); else asm volatile("s_waitcnt vmcnt(3)" ::: "memory"); } while (0)
#define RESC(a) do { if (__any((a) < 1.f)) { if (hi == 0) al_l[r32] = (a); asm volatile("s_waitcnt lgkmcnt(0)" ::: "memory"); \
    _Pragma("unroll") for (int d = 0; d < 4; ++d) _Pragma("unroll") for (int r = 0; r < 16; ++r) o[d][r] *= al_l[crow(r, hi)]; } } while (0)
  f32x16 pA0, pA1, pB0, pB1; float mnA, mnB, alA, alB; bf16x8 pa0, pa1, pa2, pa3; const int NT = seq / KVBLK;
  SLOAD(0, 0); asm volatile("s_waitcnt vmcnt(0)" ::: "memory"); SWRITE(0, 0);
  SLOAD(1, KVBLK);
  __syncthreads();
  SWRITE(1, 1);
  qkt<DQK>(pA0, pA1, K_lds, qr, r32, hi); if (2 < NT) SLOAD(0, 2 * KVBLK); partialSM<DQK>(pA0, pA1, m_reg, mnA, alA);
  __syncthreads();
  int s_prev = 0, s_cur = 1, s_next = 2;
#define ROT3() do { const int t_ = s_prev; s_prev = s_cur; s_cur = s_next; s_next = t_; } while (0)
  for (int j = 1; j + 1 < NT; j += 2) {
    SWRITE(s_next, 0);
    SBAR(); qkt<DQK>(pB0, pB1, K_lds + s_cur * SHM_K, qr, r32, hi);
    finishSM(pA0, pA1, alA, l_reg, pa0, pa1, pa2, pa3); SBAR();
    SLOAD(1, (j + 2) * KVBLK); SBAR();
    pv_d0(o, vb0 + s_prev * (int)SHM_V, pa0, pa1, pa2, pa3); partialSM<DQK>(pB0, pB1, m_reg, mnB, alB);
    RESC(alB); __syncthreads(); ROT3();
    SWRITE(s_next, 1);
    SBAR(); qkt<DQK>(pA0, pA1, K_lds + s_cur * SHM_K, qr, r32, hi);
    finishSM(pB0, pB1, alB, l_reg, pa0, pa1, pa2, pa3); SBAR();
    if (j + 3 < NT) SLOAD(0, (j + 3) * KVBLK); SBAR();
    pv_d0(o, vb0 + s_prev * (int)SHM_V, pa0, pa1, pa2, pa3); partialSM<DQK>(pA0, pA1, m_reg, mnA, alA);
    RESC(alA); __syncthreads(); ROT3();
  }
  SBAR(); qkt<DQK>(pB0, pB1, K_lds + s_cur * SHM_K, qr, r32, hi);
  finishSM(pA0, pA1, alA, l_reg, pa0, pa1, pa2, pa3); SBAR();
  pv_d0(o, vb0 + s_prev * (int)SHM_V, pa0, pa1, pa2, pa3); partialSM<DQK>(pB0, pB1, m_reg, mnB, alB);
  RESC(alB);
  finishSM(pB0, pB1, alB, l_reg, pa0, pa1, pa2, pa3); SBAR();
  pv_d0(o, vb0 + s_cur * (int)SHM_V, pa0, pa1, pa2, pa3);
#undef ROT3
  if (hi == 0) li_l[r32] = l_reg; asm volatile("s_waitcnt lgkmcnt(0)" ::: "memory");
  float rli[16];
#pragma unroll
  for (int r = 0; r < 16; ++r) rli[r] = __builtin_amdgcn_rcpf(li_l[crow(r, hi)]);
  bf16_t* Ow = Ob + (long)(wid * QBLK) * LDO;
#pragma unroll
  for (int r = 0; r < 16; ++r) { const int orow = crow(r, hi);
#pragma unroll
    for (int d0 = 0; d0 < 4; ++d0) { const float v = o[d0][r] * rli[r]; Ow[(long)orow * LDO + d0 * 32 + r32] = (bf16_t)(cvtpk(v, v) & 0xffffu); } }
  __syncthreads();
#undef SLOAD
#undef SWRITE
#undef SWAIT
#undef RESC
}
#undef SBAR
}
constexpr int NWAVES = 8, NTHR = 512;
constexpr int NB = 8, SEQ = 2048, CTXL = 256, TPB = CTXL + SEQ  , MROWS = NB * TPB  , DM = 1024;
constexpr int A_W = 512, A_IN = 1920, B_IN = 1536, EVEN_IN = 3456, EVEN_PAD = 3584, ODD_IN = 1536;
constexpr int NEXP = 16, EFF = 512, CAP = MROWS, MOE_ROWS = 40960;
constexpr float LN_EPS = 1e-5f, ALPHA = 1.4142135623730951f, GN_EPS = 64e-5f, SUBLN_EPS = 1e-5f, QKN_EPS = 1e-6f, LAMBDA_INIT0 = 0.2f;

constexpr size_t MiB = 1u << 20;
constexpr size_t WS_CTL = 0, CTL_ZERO_BYTES = 1 * MiB + 512 * 1024;
constexpr size_t WS_MOD = 1 * MiB;
constexpr size_t WS_ROPE = 2 * MiB;
constexpr size_t WS_WEVIN = 4 * MiB, WS_WEVOUT = 11 * MiB, WS_WODIN = 13 * MiB, WS_WODOUT = 16 * MiB;
constexpr size_t WS_WM13 = 18 * MiB, WS_WM2 = 50 * MiB;
constexpr size_t WS_H = 66 * MiB;
constexpr size_t WS_X = 102 * MiB;
constexpr size_t CH_BYTES = (size_t)4608 * 64 * 64 * 2;
constexpr size_t WS_CHG = 18 * MiB, WS_CHH = 54 * MiB, WS_CHRQ = 90 * MiB, WS_CHY = 126 * MiB;
constexpr size_t FEAT_BYTES = (size_t)MROWS * 512 * 2;
constexpr size_t WS_VOUT = 162 * MiB, WS_GOUT = 180 * MiB;
constexpr size_t WS_PA = 198 * MiB;
constexpr size_t WS_PB = 270 * MiB;
constexpr size_t WS_GL = 324 * MiB;
constexpr size_t WS_BON = WS_GL + (size_t)4608 * 64 * 4;
constexpr size_t WS_LORA = WS_BON + (size_t)2 * MROWS * 8 * 4;
constexpr size_t WS_OB0 = WS_PA, WS_OB1 = WS_PA + FEAT_BYTES;
constexpr size_t WS_A2 = WS_PA + 2 * FEAT_BYTES;
constexpr size_t WS_TAIL = 300 * MiB;
constexpr size_t WS_MIX = WS_TAIL;
constexpr size_t WS_HID = 174 * MiB;
constexpr size_t WS_Y = 214 * MiB;
constexpr size_t WS_QKV1 = 174 * MiB;
constexpr size_t WS_OATT = 228 * MiB;
static_assert(WS_CHY + CH_BYTES <= WS_VOUT && WS_GOUT + FEAT_BYTES <= WS_PA && WS_A2 + 2 * FEAT_BYTES <= WS_PB && WS_PB + (size_t)MROWS * 1536 * 2 <= WS_GL && WS_LORA + 393216 <= 328 * MiB
              && WS_Y + (size_t)MOE_ROWS * 1024 * 2 <= WS_TAIL && WS_OATT + 2 * FEAT_BYTES <= WS_TAIL && WS_MIX + 2 * FEAT_BYTES <= 336 * MiB && WS_A2 >= WS_HID + 40 * MiB - 40 * MiB, "ws map");
constexpr size_t DOUT_LINACT = (size_t)48 * MiB;
constexpr int CW_BAR = 4096;
constexpr int CW_CNT = 16384;
constexpr int CW_QCV = 20608;
constexpr int CW_Q0 = 20480;
constexpr size_t WS_ROUTE = 336 * MiB;
constexpr size_t WS_PERM_ = WS_ROUTE, WS_GATE = WS_ROUTE + (size_t)NEXP * CAP * 4, WS_TOK = WS_GATE + (size_t)NEXP * CAP * 4, WS_TOTAL = WS_TOK + (size_t)MROWS * 2 * 4;
static_assert(WS_TOTAL <= 339 * MiB, "ws total");

constexpr int RING_OFF = 0, RING_BYTES = 147456;
constexpr int LDSCTL_OFF = RING_BYTES, MISC_OFF = LDSCTL_OFF + 320;
constexpr int MOETAB_OFF = LDSCTL_OFF + 1024;
constexpr int LDS_BYTES = 163840;

#define GAS __attribute__((address_space(1)))
#define LAS __attribute__((address_space(3)))
typedef unsigned short bf16;
typedef unsigned v4u __attribute__((ext_vector_type(4)));
typedef unsigned v2u __attribute__((ext_vector_type(2)));
typedef float f32x4 __attribute__((ext_vector_type(4)));
typedef short bf16x8 __attribute__((ext_vector_type(8)));
typedef GAS unsigned gu32;
#define RLX_AGENT __ATOMIC_RELAXED, __HIP_MEMORY_SCOPE_AGENT
#define LDS_WAIT() asm volatile("s_waitcnt lgkmcnt(0)" ::: "memory")
#define VM_WAIT() asm volatile("s_waitcnt vmcnt(0)" ::: "memory")
__device__ __forceinline__ unsigned pk2(float lo, float hi) { typedef float f32x2_t __attribute__((ext_vector_type(2))); typedef __bf16 bf16x2_t __attribute__((ext_vector_type(2)));
    f32x2_t v = {lo, hi}; bf16x2_t b = __builtin_convertvector(v, bf16x2_t); return __builtin_bit_cast(unsigned, b); }
__device__ __forceinline__ unsigned f2bf(float f) { return pk2(f, 0.f) & 0xffffu; }
__device__ __forceinline__ float bf2f(unsigned short b) { return __builtin_bit_cast(float, (unsigned)b << 16); }
__device__ __forceinline__ float bflo(unsigned w) { return __builtin_bit_cast(float, w << 16); }
__device__ __forceinline__ float bfhi(unsigned w) { return __builtin_bit_cast(float, w & 0xffff0000u); }
__device__ __forceinline__ float sigmoidf_(float x) { return 1.f / (1.f + __expf(-x)); }
__device__ __forceinline__ int lane_id_fresh() { unsigned m = ~0u; asm volatile("" : "+s"(m)); return (int)__builtin_amdgcn_mbcnt_hi(m, __builtin_amdgcn_mbcnt_lo(m, 0u)); }
template <int CTRL> __device__ __forceinline__ float dpp_f(float v) { return __builtin_bit_cast(float, __builtin_amdgcn_update_dpp(0, __builtin_bit_cast(int, v), CTRL, 0xF, 0xF, false)); }
__device__ __forceinline__ float sum4(float v) { v += dpp_f<0xB1>(v); v += dpp_f<0x4E>(v); return v; }
__device__ __forceinline__ float sum8(float v) { v = sum4(v); v += dpp_f<0x141>(v); return v; }
__device__ __forceinline__ float sum16(float v) { v = sum8(v); v += dpp_f<0x140>(v); return v; }
__device__ __forceinline__ float wave_sum(float v) {
    v = sum16(v);
    v += __builtin_bit_cast(float, __builtin_amdgcn_update_dpp(0, __builtin_bit_cast(int, v), 0x142, 0xA, 0xF, false));
    v += __builtin_bit_cast(float, __builtin_amdgcn_update_dpp(0, __builtin_bit_cast(int, v), 0x143, 0xC, 0xF, false));
    return __builtin_bit_cast(float, __builtin_amdgcn_readlane(__builtin_bit_cast(int, v), 63));
}

#define XB_TMO      128
#define XB_XCNT(j)  (256  + 64 * (j))
#define XB_XSUB(j)  (1280 + 64 * (j))
#define XB_XGEN(j)  (2304 + 64 * (j))
#define XB_TOP      3328
#define XB_TOPGEN   3392
#define XCD_BAR_WORDS 3456
#define XB_SPIN_CAP (1u << 22)
__device__ __forceinline__ unsigned xb_ld(unsigned* p)              { return __hip_atomic_load(p, __ATOMIC_RELAXED, __HIP_MEMORY_SCOPE_AGENT); }
__device__ __forceinline__ unsigned xb_add(unsigned* p, unsigned v) { return __hip_atomic_fetch_add(p, v, __ATOMIC_RELAXED, __HIP_MEMORY_SCOPE_AGENT); }
__device__ __forceinline__ unsigned xb_xcc_id() { return (unsigned)__builtin_amdgcn_s_getreg((3 << 11) | 20) & 0xFu; }
#define XB_SPIN(cond, bar) do { unsigned _sp = 0; while (cond) { __builtin_amdgcn_s_sleep(1); \
    if ((++_sp & 255u) == 0u) { if (xb_ld(&(bar)[XB_TMO])) break; if (_sp > XB_SPIN_CAP) { atomicAdd(&(bar)[XB_TMO], 1u); break; } } } } while (0)
struct XcdBarrier { unsigned* bar; unsigned x; volatile LAS unsigned* st; };
__device__ __forceinline__ XcdBarrier xcd_barrier_post(unsigned* bar, volatile LAS unsigned* st) {
    XcdBarrier b; b.bar = bar; b.x = xb_xcc_id(); b.st = st;
    if (threadIdx.x == 0) (void)xb_add(&bar[XB_XCNT(b.x)], 1u);
    return b;
}
__device__ __forceinline__ void xcd_barrier_complete(unsigned* bar, unsigned x, unsigned& nloc, unsigned& nx) {
    const unsigned G = gridDim.x * gridDim.y * gridDim.z;
    unsigned sum, cnt, mine, sp = 0u;
    for (;;) {
        sum = 0u; cnt = 0u; mine = 0u;
#pragma unroll
        for (unsigned j = 0; j < 16; ++j) { const unsigned c = xb_ld(&bar[XB_XCNT(j)]); sum += c; cnt += (c > 0u) ? 1u : 0u; mine = (j == x) ? c : mine; }
        if (sum == G) break;
        __builtin_amdgcn_s_sleep(1);
        if ((++sp & 255u) == 0u) { if (xb_ld(&bar[XB_TMO])) break; if (sp > XB_SPIN_CAP) { atomicAdd(&bar[XB_TMO], 1u); break; } }
    }
    nloc = mine > 0u ? mine : 1u; nx = cnt > 0u ? cnt : 1u;
}
__device__ __forceinline__ void xcd_barrier(const XcdBarrier& b, int wave_id) {
    asm volatile("s_waitcnt vmcnt(0)" ::: "memory");
    __syncthreads();
    if (wave_id == 0 && lane_id_fresh() == 0) {
        unsigned* bar = b.bar;
        __builtin_amdgcn_s_waitcnt(0);
        unsigned nloc = b.st[0], nx = b.st[1];
        if (nloc == 0u) { xcd_barrier_complete(bar, b.x, nloc, nx); b.st[0] = nloc; b.st[1] = nx; }
        const unsigned old = xb_add(&bar[XB_XSUB(b.x)], 1u);
        const unsigned gen = old / nloc;
        if (old + 1u == (gen + 1u) * nloc) {
            __builtin_amdgcn_fence(__ATOMIC_RELEASE, "agent");
            asm volatile("s_waitcnt vmcnt(0)" ::: "memory");
            const unsigned og = xb_add(&bar[XB_TOP], 1u);
            const unsigned tg = og / nx;
            if (og + 1u == (tg + 1u) * nx) xb_add(&bar[XB_TOPGEN], 1u);
            else XB_SPIN(xb_ld(&bar[XB_TOPGEN]) == tg, bar);
            __builtin_amdgcn_fence(__ATOMIC_ACQUIRE, "agent");
            xb_add(&bar[XB_XGEN(b.x)], 1u);
            asm volatile("s_waitcnt vmcnt(0)" ::: "memory");
        } else {
            XB_SPIN(xb_ld(&bar[XB_XGEN(b.x)]) == gen, bar);
            __builtin_amdgcn_fence(__ATOMIC_ACQUIRE, "agent");
            asm volatile("s_waitcnt vmcnt(0)" ::: "memory");
        }
    }
    __syncthreads();
}

struct Args { const float* in[34]; float* out; unsigned char* ws; };
extern __shared__ __attribute__((aligned(16))) unsigned char g_lds[];
struct Frame {
    LAS unsigned char* lds;
    int tid, lane, wave, G, bid;
    const float* const* in; float* out; unsigned char* ws;
};
enum { I_X = 0, I_C, I_CTX, I_CCTX, I_RW, I_RB, I_ADAW, I_ADAB, I_LN1G, I_LN1B, I_LN2G, I_LN2B, I_W1, I_W3, I_W2, I_EVWIN, I_EVWOUT, I_AMU, I_AW0, I_AW2, I_AA0, I_AA2,
       I_AG2, I_AKK, I_AKA, I_ARK, I_LNXG, I_LNXB, I_BLAM, I_SUBG, I_ODWIN, I_ODWOUT, I_QNG, I_KNG };

__device__ __forceinline__ const float* x0_row(const Frame& F, int row) {
    const int b = row / TPB, tt = row - b * TPB;
    return tt < CTXL ? F.in[I_CTX] + ((size_t)b * CTXL + tt) * DM : F.in[I_X] + ((size_t)b * SEQ + (tt - CTXL)) * DM;
}
__device__ __forceinline__ const float* mod_ptr(const Frame& F, int layer, int row, int idx) {
    const int b = row / TPB, tt = row - b * TPB; const int r = tt < CTXL ? 8 : b;
    return (const float*)(F.ws + WS_MOD) + ((size_t)(layer * 9 + r) * 6 + idx) * DM;
}
__device__ __forceinline__ void transpose_item(const float* W, int K, int N, bf16* WT, int mode, LAS float* scr, int item, int lane) {
    const int nblk = N / 64, kb = item / nblk, nb = item % nblk, k0 = 64 * kb, n0 = 64 * nb;
    float v[64];
#pragma unroll
    for (int i = 0; i < 64; ++i) v[i] = __builtin_nontemporal_load(W + (size_t)(k0 + i) * N + n0 + lane);
#pragma unroll
    for (int i = 0; i < 64; ++i) scr[i * 65 + lane] = v[i];
    LDS_WAIT(); asm volatile("" ::: "memory");
    const int c = lane & 7;
#pragma unroll
    for (int j = 0; j < 8; ++j) { const int n = (lane >> 3) + 8 * j; const LAS float* s = scr + (8 * c) * 65 + n;
        v4u o; o.x = pk2(s[0 * 65], s[1 * 65]); o.y = pk2(s[2 * 65], s[3 * 65]); o.z = pk2(s[4 * 65], s[5 * 65]); o.w = pk2(s[6 * 65], s[7 * 65]);
        const int ng = n0 + n; const int nd = mode == 0 ? ng : (8 * (ng >> 2) + 4 * (mode - 1) + (ng & 3));
        *(GAS v4u*)(WT + (size_t)nd * K + k0 + 8 * c) = o; }
    LDS_WAIT(); asm volatile("" ::: "memory");
}
__device__ __forceinline__ bf16* moe_w13(Frame& F, int layer) { return layer == 0 ? (bf16*)(F.ws + WS_WM13) : (bf16*)F.out; }
__device__ __forceinline__ bf16* moe_w2(Frame& F, int layer) { return layer == 0 ? (bf16*)(F.ws + WS_WM2) : (bf16*)F.out + (size_t)NEXP * 1024 * DM; }
__device__ __forceinline__ void convert_moe_weights(Frame& F, int layer, int part, int nparts) {
    LAS float* scr = (LAS float*)(F.lds + RING_OFF + F.wave * 16896);
    const int gw = part * NWAVES + F.wave, NGW = nparts * NWAVES;
    constexpr int I13 = (DM / 64) * (EFF / 64)  , I2 = (EFF / 64) * (DM / 64)  ;
    bf16* W13 = moe_w13(F, layer); bf16* W2 = moe_w2(F, layer);
    for (int it = gw; it < NEXP * (2 * I13 + I2); it += NGW) {
        const int e = it / (2 * I13 + I2); int r = it % (2 * I13 + I2);
        const size_t wofs = ((size_t)layer * NEXP + e) * DM * EFF;
        if (r < I13) { transpose_item(F.in[I_W1] + wofs, DM, EFF, W13 + (size_t)e * 1024 * DM, 1, scr, r, F.lane); continue; } r -= I13;
        if (r < I13) { transpose_item(F.in[I_W3] + wofs, DM, EFF, W13 + (size_t)e * 1024 * DM, 2, scr, r, F.lane); continue; } r -= I13;
        transpose_item(F.in[I_W2] + wofs, EFF, DM, W2 + (size_t)e * DM * EFF, 0, scr, r, F.lane);
    }
}
__device__ __forceinline__ void convert_moe_filler(Frame& F, int layer, int nunits) {
    const int rounds = (nunits + F.G - 1) / F.G; const int c0 = nunits - (rounds - 1) * F.G;
    if (c0 >= F.G) convert_moe_weights(F, layer, F.bid, F.G);
    else if (F.bid >= c0) convert_moe_weights(F, layer, F.bid - c0, F.G - c0);
}
__device__ __forceinline__ void p_mods(Frame& F) {
    LAS float* sv = (LAS float*)(F.lds + RING_OFF);
    LAS float* red = sv + 9 * 1024;
    for (int i = F.tid; i < 9 * 1024; i += NTHR) { const int r = i >> 10, k = i & 1023; const float c = r < 8 ? F.in[I_C][r * DM + k] : F.in[I_CCTX][k]; sv[i] = c * sigmoidf_(c); }
    __syncthreads();
    for (int it = F.bid; it < 384; it += F.G) {
        const int kh = it & 1, l = (it >> 1) / 96, cb = (it >> 1) % 96, col = cb * 64 + F.lane;
        const float* w = F.in[I_ADAW] + (size_t)l * DM * 6144 + col;
        float acc[9];
#pragma unroll
        for (int r = 0; r < 9; ++r) acc[r] = 0.f;
        const int k0 = kh * 512 + F.wave * 64;
        float wv[64];
#pragma unroll
        for (int k = 0; k < 64; ++k) wv[k] = __builtin_nontemporal_load(w + (size_t)(k0 + k) * 6144);
#pragma unroll
        for (int k4 = 0; k4 < 16; ++k4) {
#pragma unroll
            for (int r = 0; r < 9; ++r) { const f32x4 s4 = *(const LAS f32x4*)(sv + r * 1024 + k0 + 4 * k4); acc[r] += (s4.x * wv[4 * k4] + s4.y * wv[4 * k4 + 1]) + (s4.z * wv[4 * k4 + 2] + s4.w * wv[4 * k4 + 3]); } }
#pragma unroll
        for (int r = 0; r < 9; ++r) red[(F.wave * 9 + r) * 64 + F.lane] = acc[r];
        __syncthreads();
        for (int i = F.tid; i < 9 * 64; i += NTHR) { const int r = i >> 6, c = i & 63; float s = 0.f;
#pragma unroll
            for (int w8 = 0; w8 < 8; ++w8) s += red[(w8 * 9 + r) * 64 + c];
            const int cc = cb * 64 + c;
            atomicAdd((float*)(F.ws + WS_MOD) + (size_t)(l * 9 + r) * 6144 + cc, s + (kh == 0 ? F.in[I_ADAB][l * 6144 + cc] : 0.f)); }
        __syncthreads();
    }
}
__device__ __forceinline__ void p_prologue(Frame& F) {
    LAS float* scr = (LAS float*)(F.lds + RING_OFF + F.wave * 16896);
    const int gw = F.bid * NWAVES + F.wave, NGW = F.G * NWAVES;
    constexpr int I_A = (DM / 64) * (EVEN_IN / 64), I_B = (DM / 64) * (DM / 64), I_C_ = (DM / 64) * (ODD_IN / 64);
    for (int it = gw; it < I_A + 2 * I_B + I_C_; it += NGW) {
        int r = it;
        if (r < I_A) { transpose_item(F.in[I_EVWIN], DM, EVEN_IN, (bf16*)(F.ws + WS_WEVIN), 0, scr, r, F.lane); continue; } r -= I_A;
        if (r < I_B) { transpose_item(F.in[I_EVWOUT], DM, DM, (bf16*)(F.ws + WS_WEVOUT), 0, scr, r, F.lane); continue; } r -= I_B;
        if (r < I_C_) { transpose_item(F.in[I_ODWIN], DM, ODD_IN, (bf16*)(F.ws + WS_WODIN), 0, scr, r, F.lane); continue; } r -= I_C_;
        transpose_item(F.in[I_ODWOUT], DM, DM, (bf16*)(F.ws + WS_WODOUT), 0, scr, r, F.lane);
    }
    {
        v4u* z = (v4u*)((bf16*)(F.ws + WS_WEVIN) + (size_t)EVEN_IN * DM); const int n16 = (EVEN_PAD - EVEN_IN) * DM * 2 / 16;
        for (int i = F.bid * NTHR + F.tid; i < n16; i += F.G * NTHR) z[i] = (v4u){0u, 0u, 0u, 0u};
    }
    {
        bf16* W2T = (bf16*)(F.ws + WS_LORA); bf16* A2T = W2T + 2 * 512 * 64; bf16* G2T = A2T + 2 * 512 * 64;
        for (int i = F.bid * NTHR + F.tid; i < 3 * 65536; i += F.G * NTHR) {
            const int which = i >> 16, r = i & 65535;
            if (which < 2) { const int d = r >> 15, c = (r >> 6) & 511, l = r & 63; const float v = (which == 0 ? F.in[I_AW2] : F.in[I_AA2])[((size_t)d * 64 + l) * 512 + c]; (which == 0 ? W2T : A2T)[r] = (bf16)f2bf(v); }
            else { const int c = r >> 7, j = r & 127; G2T[r] = (bf16)f2bf(F.in[I_AG2][(size_t)j * 512 + c]); }
        }
    }
    {
        float* cosB = (float*)(F.ws + WS_ROPE); float* sinB = cosB + SEQ * 32; float* cosC = sinB + SEQ * 32; float* sinC = cosC + SEQ * 64;
        for (int i = F.bid * NTHR + F.tid; i < SEQ * 96; i += F.G * NTHR) {
            if (i < SEQ * 32) { const int t = i >> 5, j = i & 31; const float pos = (float)(j < 16 ? (t >> 6) : (t & 63)); const int f = j & 15;
                const float inv = powf(10000.f, -(float)(2 * f) / 32.f); const float ang = pos * inv; cosB[i] = cosf(ang); sinB[i] = sinf(ang); }
            else { const int ii = i - SEQ * 32; const int t = ii >> 6, j = ii & 63; const float pos = (float)(j < 32 ? (t >> 6) : (t & 63)); const int f = j & 31;
                const float inv = powf(10000.f, -(float)(2 * f) / 64.f); const float ang = pos * inv; cosC[ii] = cosf(ang); sinC[ii] = sinf(ang); }
        }
    }
    __syncthreads();
}

struct Row16 { f32x4 v[4]; };
__device__ __forceinline__ Row16 ld_row_f32(const float* p, int lane) { Row16 r; const f32x4* q = (const f32x4*)p + lane;
#pragma unroll
    for (int j = 0; j < 4; ++j) r.v[j] = q[64 * j]; return r; }
__device__ __forceinline__ Row16 ld_row_bf16(const bf16* p, int lane) { Row16 r; const v2u* q = (const v2u*)p + lane;
#pragma unroll
    for (int j = 0; j < 4; ++j) { const v2u w = q[64 * j]; r.v[j] = (f32x4){bflo(w.x), bfhi(w.x), bflo(w.y), bfhi(w.y)}; } return r; }
__device__ __forceinline__ void st_row_f32(float* p, int lane, const Row16& r) { f32x4* q = (f32x4*)p + lane;
#pragma unroll
    for (int j = 0; j < 4; ++j) q[64 * j] = r.v[j]; }
__device__ __forceinline__ void st_row_bf16(bf16* p, int lane, const Row16& r) { v2u* q = (v2u*)p + lane;
#pragma unroll
    for (int j = 0; j < 4; ++j) q[64 * j] = (v2u){pk2(r.v[j].x, r.v[j].y), pk2(r.v[j].z, r.v[j].w)}; }
__device__ __forceinline__ Row16 layer_norm(const Row16& x, const float* g, const float* b, int lane) {
    float s = 0.f;
#pragma unroll
    for (int j = 0; j < 4; ++j) s += (x.v[j].x + x.v[j].y) + (x.v[j].z + x.v[j].w);
    const float mean = wave_sum(s) * (1.f / DM); float s2 = 0.f; Row16 d;
#pragma unroll
    for (int j = 0; j < 4; ++j) { d.v[j] = x.v[j] - mean; s2 += (d.v[j].x * d.v[j].x + d.v[j].y * d.v[j].y) + (d.v[j].z * d.v[j].z + d.v[j].w * d.v[j].w); }
    const float rstd = 1.f / sqrtf(wave_sum(s2) * (1.f / DM) + LN_EPS);
    const Row16 gg = ld_row_f32(g, lane), bb = ld_row_f32(b, lane); Row16 o;
#pragma unroll
    for (int j = 0; j < 4; ++j) o.v[j] = d.v[j] * rstd * gg.v[j] + bb.v[j];
    return o;
}
__device__ __forceinline__ Row16 modulate(const Row16& x, const float* shift, const float* scale, int lane) {
    const Row16 sh = ld_row_f32(shift, lane), sc = ld_row_f32(scale, lane); Row16 o;
#pragma unroll
    for (int j = 0; j < 4; ++j) o.v[j] = x.v[j] * (1.f + sc.v[j]) + sh.v[j];
    return o;
}

__device__ __forceinline__ void p_mod0(Frame& F) {
    const int gw = F.bid * NWAVES + F.wave, NGW = F.G * NWAVES;
    bf16* H = (bf16*)(F.ws + WS_H);
    for (int row = gw; row < MROWS; row += 2 * NGW) {
        const int r1 = row + NGW; const bool has1 = r1 < MROWS; const int rb = has1 ? r1 : row;
        const Row16 xa = ld_row_f32(x0_row(F, row), F.lane), xb = ld_row_f32(x0_row(F, rb), F.lane);
        const Row16 ha = modulate(xa, mod_ptr(F, 0, row, 0), mod_ptr(F, 0, row, 1), F.lane), hb = modulate(xb, mod_ptr(F, 0, rb, 0), mod_ptr(F, 0, rb, 1), F.lane);
        st_row_bf16(H + (size_t)row * DM, F.lane, ha);
        if (has1) st_row_bf16(H + (size_t)r1 * DM, F.lane, hb);
    }
}

template <int LAYER>
__device__ __forceinline__ void p_ln_route(Frame& F) {
    LAS float* rwT = (LAS float*)(F.lds + RING_OFF);
    LAS int* lcnt = (LAS int*)(F.lds + RING_OFF + 65536);
    LAS int* rinfo = lcnt + 32;
    for (int i = F.tid; i < DM * NEXP; i += NTHR) { const int k = i >> 4, e = i & 15; rwT[e * DM + k] = F.in[I_RW][i]; }
    if (F.tid < 32) lcnt[F.tid] = 0;
    __syncthreads();
    const int rows_per = (MROWS + F.G - 1) / F.G, row_lo = F.bid * rows_per, row_hi = (row_lo + rows_per < MROWS) ? row_lo + rows_per : MROWS;
    bf16* X = (bf16*)(F.ws + WS_X); bf16* H = (bf16*)(F.ws + WS_H); const bf16* MIX = (const bf16*)(F.ws + WS_MIX);
    unsigned* cnt = (unsigned*)(F.ws + WS_CTL) + CW_CNT + LAYER * 64;
    int* PERM = (int*)(F.ws + WS_PERM_); float* GATE = (float*)(F.ws + WS_GATE); int* TOK = (int*)(F.ws + WS_TOK);
    LAS float* lgt = (LAS float*)(rinfo + 4 * 128);
    Row16 xin_n, mix_n;
    {   const int row = row_lo + F.wave; const int rr_ = row < row_hi ? row : row_lo;
        xin_n = LAYER == 0 ? ld_row_f32(x0_row(F, rr_), F.lane) : ld_row_bf16(X + (size_t)rr_ * DM, F.lane); mix_n = ld_row_bf16(MIX + (size_t)rr_ * DM, F.lane); }
    for (int row = row_lo + F.wave; row < row_hi; row += NWAVES) {
        const int b = row / TPB, tt = row - b * TPB; const int li = row - row_lo;
        const Row16 xin = xin_n, mix = mix_n;
        {   const int rn = row + NWAVES < row_hi ? row + NWAVES : row;
            xin_n = LAYER == 0 ? ld_row_f32(x0_row(F, rn), F.lane) : ld_row_bf16(X + (size_t)rn * DM, F.lane); mix_n = ld_row_bf16(MIX + (size_t)rn * DM, F.lane); }
        if (LAYER == 1 && tt < CTXL) { if (F.lane == 0) rinfo[li * 4] = -1; continue; }
        const Row16 gate = ld_row_f32(mod_ptr(F, LAYER, row, 2), F.lane);
        Row16 pre;
#pragma unroll
        for (int j = 0; j < 4; ++j) pre.v[j] = ALPHA * xin.v[j] + gate.v[j] * mix.v[j];
        const Row16 x1 = layer_norm(pre, F.in[I_LN1G] + LAYER * DM, F.in[I_LN1B] + LAYER * DM, F.lane);
        st_row_bf16(X + (size_t)row * DM, F.lane, x1);
        const Row16 h = modulate(x1, mod_ptr(F, LAYER, row, 3), mod_ptr(F, LAYER, row, 4), F.lane);
        st_row_bf16(H + (size_t)row * DM, F.lane, h);
        float mylg = 0.f;
#pragma unroll
        for (int e = 0; e < NEXP; ++e) { float s = 0.f;
#pragma unroll
            for (int j = 0; j < 4; ++j) { const f32x4 w = *((const LAS f32x4*)(rwT + e * DM) + F.lane + 64 * j); s += (h.v[j].x * w.x + h.v[j].y * w.y) + (h.v[j].z * w.z + h.v[j].w * w.w); }
            const float t = wave_sum(s); mylg = (F.lane == e) ? t : mylg; if ((e & 3) == 3) asm volatile("" ::: "memory"); }
        if (F.lane < NEXP) { lgt[li * 16 + F.lane] = mylg + F.in[I_RB][F.lane]; if (F.lane == 0) rinfo[li * 4] = 0; }
    }
    __syncthreads();
    if (row_lo + F.tid < row_hi && rinfo[F.tid * 4] >= 0) {
        const int li = F.tid; float lg[NEXP];
#pragma unroll
        for (int q = 0; q < 4; ++q) { const f32x4 t = *((const LAS f32x4*)(lgt + li * 16) + q); lg[4 * q] = t.x; lg[4 * q + 1] = t.y; lg[4 * q + 2] = t.z; lg[4 * q + 3] = t.w; }
        float mx = lg[0];
#pragma unroll
        for (int e = 1; e < NEXP; ++e) mx = fmaxf(mx, lg[e]);
        float p[NEXP];
#pragma unroll
        for (int e = 0; e < NEXP; ++e) p[e] = expf(lg[e] - mx);
        int best = 0; float bs = -1.f;
#pragma unroll
        for (int g = 0; g < 4; ++g) { float a = p[4 * g], c2 = -1.f;
#pragma unroll
            for (int i = 1; i < 4; ++i) { const float v = p[4 * g + i]; if (v > a) { c2 = a; a = v; } else if (v > c2) c2 = v; }
            const float sc = a + c2; if (sc > bs) { bs = sc; best = g; } }
        int i0 = 0; float p0 = -1.f;
#pragma unroll
        for (int i = 0; i < 4; ++i) { float v = 0.f;
#pragma unroll
            for (int g = 0; g < 4; ++g) v = (g == best) ? p[4 * g + i] : v;
            if (v > p0) { p0 = v; i0 = i; } }
        int i1 = 0; float p1 = -1.f;
#pragma unroll
        for (int i = 0; i < 4; ++i) { float v = 0.f;
#pragma unroll
            for (int g = 0; g < 4; ++g) v = (g == best) ? p[4 * g + i] : v;
            if (i != i0 && v > p1) { p1 = v; i1 = i; } }
        rinfo[li * 4 + 0] = best * 4 + i0; rinfo[li * 4 + 1] = best * 4 + i1;
        rinfo[li * 4 + 2] = __float_as_int(p0 / (p0 + p1)); rinfo[li * 4 + 3] = __float_as_int(p1 / (p0 + p1));
    }
    __syncthreads();
    int e0 = -1, e1 = -1, r0 = 0, r1 = 0; const int myrow = row_lo + F.tid;
    if (myrow < row_hi) { e0 = rinfo[F.tid * 4]; if (e0 >= 0) { e1 = rinfo[F.tid * 4 + 1]; r0 = __hip_atomic_fetch_add(lcnt + e0, 1, __ATOMIC_RELAXED, __HIP_MEMORY_SCOPE_WORKGROUP); r1 = __hip_atomic_fetch_add(lcnt + e1, 1, __ATOMIC_RELAXED, __HIP_MEMORY_SCOPE_WORKGROUP); } }
    __syncthreads();
    if (F.tid < 16) lcnt[16 + F.tid] = (int)atomicAdd(cnt + F.tid, (unsigned)lcnt[F.tid]);
    __syncthreads();
    if (e0 >= 0) {
        const int g0 = lcnt[16 + e0] + r0, g1 = lcnt[16 + e1] + r1;
        PERM[(size_t)e0 * CAP + g0] = myrow; GATE[(size_t)e0 * CAP + g0] = __int_as_float(rinfo[F.tid * 4 + 2]);
        PERM[(size_t)e1 * CAP + g1] = myrow; GATE[(size_t)e1 * CAP + g1] = __int_as_float(rinfo[F.tid * 4 + 3]);
        TOK[myrow * 2 + 0] = (e0 << 20) | g0; TOK[myrow * 2 + 1] = (e1 << 20) | g1;
    }
}

__device__ __forceinline__ void expert_tile_offsets(const unsigned* cnt, int (&toff)[NEXP + 1]) {
    toff[0] = 0;
#pragma unroll
    for (int e = 0; e < NEXP; ++e) toff[e + 1] = toff[e] + (int)((__hip_atomic_load(cnt + e, __ATOMIC_RELAXED, __HIP_MEMORY_SCOPE_AGENT) + 255u) >> 8);
}

template <int LAYER>
__device__ __forceinline__ void p_ln2(Frame& F) {
    const int gw = F.bid * NWAVES + F.wave, NGW = F.G * NWAVES;
    bf16* X = (bf16*)(F.ws + WS_X); bf16* H = (bf16*)(F.ws + WS_H); const bf16* Y = (const bf16*)(F.ws + WS_Y);
    const unsigned* cnt = (const unsigned*)(F.ws + WS_CTL) + CW_CNT + LAYER * 64; const int* TOK = (const int*)(F.ws + WS_TOK);
    int toff[NEXP + 1]; expert_tile_offsets(cnt, toff);
    constexpr int NR = LAYER == 0 ? MROWS : NB * SEQ;
    for (int q = gw; q < NR; q += 2 * NGW) {
        int rw[2]; bool ok[2]; rw[0] = q; rw[1] = q + NGW; ok[0] = true; ok[1] = rw[1] < NR; if (!ok[1]) rw[1] = rw[0];
        int row[2], bb[2], tt[2]; size_t y0[2], y1[2];
#pragma unroll
        for (int s = 0; s < 2; ++s) {
            if (LAYER == 0) { row[s] = rw[s]; bb[s] = row[s] / TPB; tt[s] = row[s] - bb[s] * TPB; } else { bb[s] = rw[s] / SEQ; tt[s] = CTXL + (rw[s] - bb[s] * SEQ); row[s] = bb[s] * TPB + tt[s]; }
            const int t0 = __hip_atomic_load(TOK + row[s] * 2, __ATOMIC_RELAXED, __HIP_MEMORY_SCOPE_AGENT), t1 = __hip_atomic_load(TOK + row[s] * 2 + 1, __ATOMIC_RELAXED, __HIP_MEMORY_SCOPE_AGENT); const int e0 = t0 >> 20, e1 = t1 >> 20;
            int o0 = 0, o1 = 0;
#pragma unroll
            for (int e = 0; e < NEXP; ++e) { o0 = (e == e0) ? toff[e] : o0; o1 = (e == e1) ? toff[e] : o1; }
            y0[s] = (size_t)o0 * 256 + (t0 & 0xfffff); y1[s] = (size_t)o1 * 256 + (t1 & 0xfffff);
        }
        Row16 xin[2], ya[2], yb[2], gate[2];
#pragma unroll
        for (int s = 0; s < 2; ++s) { xin[s] = ld_row_bf16(X + (size_t)row[s] * DM, F.lane); ya[s] = ld_row_bf16(Y + y0[s] * DM, F.lane); yb[s] = ld_row_bf16(Y + y1[s] * DM, F.lane); gate[s] = ld_row_f32(mod_ptr(F, LAYER, row[s], 5), F.lane); }
#pragma unroll
        for (int s = 0; s < 2; ++s) {
            Row16 pre;
#pragma unroll
            for (int j = 0; j < 4; ++j) pre.v[j] = ALPHA * xin[s].v[j] + gate[s].v[j] * (ya[s].v[j] + yb[s].v[j]);
            const Row16 x2 = layer_norm(pre, F.in[I_LN2G] + LAYER * DM, F.in[I_LN2B] + LAYER * DM, F.lane);
            if (!ok[s]) continue;
            if (LAYER == 0) {
                st_row_bf16(X + (size_t)row[s] * DM, F.lane, x2);
                const Row16 h = modulate(x2, mod_ptr(F, 1, row[s], 0), mod_ptr(F, 1, row[s], 1), F.lane);
                st_row_bf16(H + (size_t)row[s] * DM, F.lane, h);
            } else {
                st_row_f32(F.out + ((size_t)bb[s] * SEQ + (tt[s] - CTXL)) * DM, F.lane, x2);
#ifdef TPROBE_A
                if (row[s] == 2048 && F.lane == 0) { volatile LAS unsigned long long* ts = (volatile LAS unsigned long long*)(F.lds + MISC_OFF + 128);
                    const float span_us = (float)(ts[TPROBE_B] - ts[TPROBE_A]) * 0.01f; F.out[((size_t)bb[s] * SEQ + (tt[s] - CTXL)) * DM] = x2.v[0].x + span_us / (float)TPROBE_US; }
#endif
            }
        }
    }
}
namespace ck {
typedef short bf16x8 __attribute__((ext_vector_type(8)));
typedef float f32x16 __attribute__((ext_vector_type(16)));
typedef float f32x4 __attribute__((ext_vector_type(4)));
constexpr int NCH = 36;
__device__ __forceinline__ int crow(int r, int hi) { return (r & 3) + 8 * (r >> 2) + 4 * hi; }
__device__ __forceinline__ int swz(int row, int c16) { return row * 128 + ((c16 ^ ((row >> 1) & 7)) << 4); }
__device__ __forceinline__ int swz_el(int row, int col) { return swz(row, col >> 3) + (col & 7) * 2; }
__device__ __forceinline__ void mm_tile(f32x16& acc, const LAS unsigned char* A, int arow0, const LAS unsigned char* B, int brow0, int ks0, int nks, int r32, int hh) {
#pragma unroll
    for (int ks = 0; ks < 4; ++ks) if (ks >= ks0 && ks < ks0 + nks) {
        const bf16x8 a = *(const LAS bf16x8*)(A + swz(arow0 + r32, 2 * ks + hh));
        const bf16x8 b = *(const LAS bf16x8*)(B + swz(brow0 + r32, 2 * ks + hh));
        acc = __builtin_amdgcn_mfma_f32_32x32x16_bf16(a, b, acc, 0, 0, 0); }
}
__device__ __forceinline__ f32x16 zero16() { f32x16 z;
#pragma unroll
    for (int i = 0; i < 16; ++i) z[i] = 0.f; return z; }
__device__ __forceinline__ int chunk_index(int b, int h, int d, int c) { return ((b * 8 + h) * 2 + d) * NCH + c; }
}

constexpr int CK_LIN = 0;
constexpr int CK_E = 32768;
constexpr int CK_T = CK_E, CK_TT = CK_E + 8192, CK_PT = CK_E + 16384, CK_WT = CK_E + 24576;
constexpr int CK_OPS = 65536;
constexpr int CK_UT = 131072;
constexpr int CK_D = CK_UT + 8192;
constexpr int CK_ZT = CK_D + 4096;
constexpr int CK_WSUM = CK_ZT + 2048;
static_assert(CK_WSUM + 2048 <= RING_BYTES, "chunk LDS map");

__device__ __forceinline__ float fsig(float x) { return __builtin_amdgcn_rcpf(1.f + __builtin_amdgcn_exp2f(-1.4426950408889634f * x)); }
__device__ __forceinline__ float fexp(float x) { return __builtin_amdgcn_exp2f(1.4426950408889634f * x); }

__device__ __forceinline__ void p_chunk_pre(Frame& F) {
    using namespace ck;
    const LAS unsigned char* L0 = F.lds + RING_OFF;
    LAS unsigned char* lds = F.lds + RING_OFF;
    const bf16* PA = (const bf16*)(F.ws + WS_PA);
    const int wave = F.wave;
    bf16* CHG = (bf16*)(F.ws + WS_CHG); bf16* CHH = (bf16*)(F.ws + WS_CHH); bf16* CHRQ = (bf16*)(F.ws + WS_CHRQ); bf16* CHY = (bf16*)(F.ws + WS_CHY);
    float* GLp = (float*)(F.ws + WS_GL); float* BON = (float*)(F.ws + WS_BON);
    bf16* VOUT = (bf16*)(F.ws + WS_VOUT); bf16* GOUT = (bf16*)(F.ws + WS_GOUT);
    const bf16* W2T = (const bf16*)(F.ws + WS_LORA); const bf16* A2T = W2T + 2 * 512 * 64; const bf16* G2T = A2T + 2 * 512 * 64;
    const float* mu = F.in[I_AMU];
    const bf16* LINACT = (const bf16*)((const unsigned char*)F.out + DOUT_LINACT);
    v4u q_row[4]; float win[3][10];
#define CK_DECODE(it_, d_, tb_, h_, b_, isctx_, t0_, Ls_, rbase_) const int d_ = ((it_) & 1) ^ (((it_) / F.G) & 1 & (int)((F.G & 1) == 0)), tb_ = ((it_) >> 1) % 36, bh_##d_ = ((it_) >> 1) / 36, h_ = bh_##d_ & 7, b_ = bh_##d_ >> 3; \
        const bool isctx_ = tb_ < 4; const int t0_ = isctx_ ? tb_ * 64 : (tb_ - 4) * 64, Ls_ = isctx_ ? CTXL : SEQ; const int rbase_ = b_ * TPB + (isctx_ ? 0 : CTXL);
#define CK_LOAD(it_) do { CK_DECODE(it_, dL, tbL, hL, bL, icL, t0L, LsL, rbL) \
        const int ln_ = lane_id_fresh(), td_ = (wave << 6) | ln_; \
        { const int cc_ = (dL == 0 ? (td_ & 31) : (td_ & 15)) * 8, tf_ = dL == 0 ? 4 * (td_ >> 5) : 2 * (td_ >> 4); \
          const int col_ = cc_ < 64 ? 64 * dL + cc_ : cc_ < 128 ? 128 + 64 * dL + (cc_ - 64) : 256 + (cc_ - 128); \
          const bf16* pc_ = LINACT + (size_t)(rbL + t0L + tf_) * 384 + col_; \
          _Pragma("unroll") for (int n_ = 0; n_ < 4; ++n_) if (dL == 0 || n_ < 2) q_row[n_] = *(const v4u*)(pc_ + (size_t)n_ * 384); } \
        { const int tlo_ = dL == 0 ? 8 * wave : 63 - (8 * wave + 7); const bf16* pr_ = PA + (size_t)(rbL + t0L + tlo_) * A_IN + 64 * hL + ln_; \
          _Pragma("unroll") for (int j_ = 0; j_ < 10; ++j_) { const int tg2_ = t0L + tlo_ + j_ - 1; const bool ok_ = tg2_ >= 0 && tg2_ < LsL; \
            _Pragma("unroll") for (int s_ = 0; s_ < 3; ++s_) win[s_][j_] = ok_ ? bf2f(pr_[(ptrdiff_t)(j_ - 1) * A_IN + 512 * s_]) : 0.f; } } } while (0)
    if (F.bid < NB * 8 * 36 * 2) CK_LOAD(F.bid);
    for (int it = F.bid; it < NB * 8 * 36 * 2; it += F.G) {
        CK_DECODE(it, d, tb, h, b, isctx, t0, Ls, rbase)
        const int c = d == 0 ? tb : (isctx ? 3 - tb : 4 + (31 - (tb - 4)));
        const int ci = chunk_index(b, h, d, c);
        __syncthreads();
        int lane = lane_id_fresh(); asm volatile("" : "+v"(lane));
        const int tid = (wave << 6) | lane, r32 = lane & 31, hh = lane >> 5, k = lane, pg = wave;
        {
            const int cc = (d == 0 ? (tid & 31) : (tid & 15)) * 8, tf = d == 0 ? 4 * (tid >> 5) : 2 * (tid >> 4);
            const int mat = cc >> 6, l0 = cc & 63;
#pragma unroll
            for (int n = 0; n < 4; ++n) if (d == 0 || n < 2) *(LAS v4u*)(lds + CK_LIN + mat * 8192 + swz(tf + n, l0 >> 3)) = q_row[n];
        }
        float rr[8], kx[8], vv[8];
        {
            const float mr = mu[64 * h + k], mk = mu[512 + 64 * h + k], mv = mu[1024 + 64 * h + k];
#pragma unroll
            for (int i = 0; i < 8; ++i) { const int j = d == 0 ? i + 1 : 8 - i;
                rr[i] = win[0][j] + (0.5f * (win[0][j - 1] + win[0][j + 1]) - win[0][j]) * mr;
                kx[i] = win[1][j] + (0.5f * (win[1][j - 1] + win[1][j + 1]) - win[1][j]) * mk;
                vv[i] = win[2][j] + (0.5f * (win[2][j - 1] + win[2][j + 1]) - win[2][j]) * mv; }
        }
        __syncthreads();
        {
            const int tq = wave & 3, ti = tq >> 1, tj = tq & 1; const bool isW = wave < 4;
            f32x16 acc = zero16();
            const bf16* WT = (isW ? W2T : A2T) + ((size_t)d * 512 + 64 * h + 32 * tj + r32) * 64;
#pragma unroll
            for (int ks = 0; ks < 4; ++ks) {
                const bf16x8 a = *(const LAS bf16x8*)(L0 + CK_LIN + (isW ? 0 : 8192) + swz(32 * ti + r32, 2 * ks + hh));
                const bf16x8 bq = *(const bf16x8*)(WT + 16 * ks + 8 * hh);
                acc = __builtin_amdgcn_mfma_f32_32x32x16_bf16(a, bq, acc, 0, 0, 0); }
            const int ch = 32 * tj + r32; const float bias = isW ? F.in[I_AW0][d * 512 + 64 * h + ch] : F.in[I_AA0][d * 512 + 64 * h + ch];
#pragma unroll
            for (int r = 0; r < 16; ++r) { const int tl = 32 * ti + crow(r, hh); const int p = d == 0 ? tl : 63 - tl;
                const float sg = fsig(acc[r] + bias);
                *(LAS float*)(lds + CK_E + (isW ? 0 : 16384) + (p * 64 + ch) * 4) = isW ? sg * 0.6065306597126334f : sg; }
            if (d == 0 && !isW) {
                f32x16 g = zero16();
                const bf16* GT = G2T + (size_t)(64 * h + 32 * tj + r32) * 128;
#pragma unroll
                for (int ks = 0; ks < 8; ++ks) {
                    const bf16x8 a = *(const LAS bf16x8*)(L0 + CK_LIN + 16384 + (ks >> 2) * 8192 + swz(32 * ti + r32, 2 * (ks & 3) + hh));
                    const bf16x8 bq = *(const bf16x8*)(GT + 16 * ks + 8 * hh);
                    g = __builtin_amdgcn_mfma_f32_32x32x16_bf16(a, bq, g, 0, 0, 0); }
#pragma unroll
                for (int r = 0; r < 16; ++r) { const int tl = 32 * ti + crow(r, hh);
                    GOUT[(size_t)(rbase + t0 + tl) * 512 + 64 * h + ch] = (bf16)f2bf(g[r]); }
            }
        }
        __syncthreads();
        {
            float e[8], ai[8], cl[8];
#pragma unroll
            for (int i = 0; i < 8; ++i) { e[i] = *(const LAS float*)(L0 + CK_E + ((8 * pg + i) * 64 + k) * 4); ai[i] = *(const LAS float*)(L0 + CK_E + 16384 + ((8 * pg + i) * 64 + k) * 4); }
            float run = 0.f;
#pragma unroll
            for (int i = 0; i < 8; ++i) { run -= e[i]; cl[i] = run; }
            *(LAS float*)(lds + CK_WSUM + (pg * 64 + k) * 4) = run;
            __syncthreads();
            float off = 0.f, tot = 0.f;
#pragma unroll
            for (int q = 0; q < 8; ++q) { const float s = *(const LAS float*)(L0 + CK_WSUM + (q * 64 + k) * 4); tot += s; off += (q < pg) ? s : 0.f; }
            const float kkc = F.in[I_AKK][64 * h + k], kac = F.in[I_AKA][64 * h + k], rkc = F.in[I_ARK][64 * h + k];
            float bhv[8], khv[8], atv[8];
#pragma unroll
            for (int i = 0; i < 8; ++i) {
                const int p = 8 * pg + i; const float c_ = cl[i] + off;
                const float kr = kx[i] * kkc; const float ss = wave_sum(kr * kr); const float kk = kr * __builtin_amdgcn_rsqf(fmaxf(ss, 1e-24f));
                const float kd = kx[i] * (1.f + (ai[i] - 1.f) * kac), bb = kk * ai[i];
                const float bon = wave_sum(rr[i] * kd * rkc);
                const float ep = fexp(c_), em = __builtin_amdgcn_rcpf(ep), el = fexp(tot - c_);
                atv[i] = -kk * fexp(c_ + e[i]);
                *(LAS bf16*)(lds + CK_OPS + 0 * 8192 + swz_el(p, k)) = (bf16)f2bf(atv[i]);
                *(LAS bf16*)(lds + CK_OPS + 1 * 8192 + swz_el(p, k)) = (bf16)f2bf(bb * em);
                *(LAS bf16*)(lds + CK_OPS + 2 * 8192 + swz_el(p, k)) = (bf16)f2bf(kd * em);
                *(LAS bf16*)(lds + CK_OPS + 3 * 8192 + swz_el(p, k)) = (bf16)f2bf(rr[i] * ep);
                bhv[i] = bb * el; khv[i] = kd * el;
                const int tl = d == 0 ? p : 63 - p; const size_t row = (size_t)(rbase + t0 + tl);
                if (lane == 0) BON[((size_t)d * MROWS + row) * 8 + h] = bon;
                if (d == 0) VOUT[row * 512 + 64 * h + k] = (bf16)f2bf(vv[i]);
            }
            *(LAS v4u*)(lds + CK_OPS + 4 * 8192 + swz(k, pg)) = (v4u){pk2(bhv[0], bhv[1]), pk2(bhv[2], bhv[3]), pk2(bhv[4], bhv[5]), pk2(bhv[6], bhv[7])};
            *(LAS v4u*)(lds + CK_OPS + 5 * 8192 + swz(k, pg)) = (v4u){pk2(khv[0], khv[1]), pk2(khv[2], khv[3]), pk2(khv[4], khv[5]), pk2(khv[6], khv[7])};
            *(LAS v4u*)(lds + CK_OPS + 6 * 8192 + swz(k, pg)) = (v4u){pk2(vv[0], vv[1]), pk2(vv[2], vv[3]), pk2(vv[4], vv[5]), pk2(vv[6], vv[7])};
            *(LAS v4u*)(lds + CK_OPS + 7 * 8192 + swz(k, pg)) = (v4u){pk2(atv[0], atv[1]), pk2(atv[2], atv[3]), pk2(atv[4], atv[5]), pk2(atv[6], atv[7])};
            if (pg == 0) GLp[(size_t)ci * 64 + k] = fexp(tot);
            *(LAS v4u*)(lds + CK_T + tid * 16) = (v4u){0u, 0u, 0u, 0u}; *(LAS v4u*)(lds + CK_TT + tid * 16) = (v4u){0u, 0u, 0u, 0u};
        }
        __syncthreads();
        {
            const int prod = wave >> 2, tq = wave & 3, ti = tq >> 1, tj = tq & 1;
            f32x16 acc = zero16();
            if (!(ti == 0 && tj == 1)) mm_tile(acc, L0 + CK_OPS + 0 * 8192, 32 * ti, L0 + CK_OPS + (prod ? 2 : 1) * 8192, 32 * tj, 0, 4, r32, hh);
            const int s = 32 * tj + r32;
#pragma unroll
            for (int r = 0; r < 16; ++r) { const int p = 32 * ti + crow(r, hh); const float v = (s < p) ? acc[r] : 0.f;
                *(LAS bf16*)(lds + CK_LIN + prod * 8192 + swz_el(p, s)) = (bf16)f2bf(v);
                if (prod == 0 && (p >> 4) == (s >> 4)) *(LAS float*)(lds + CK_D + ((p >> 4) * 256 + (p & 15) * 16 + (s & 15)) * 4) = v; }
        }
        __syncthreads();
        if (wave == 0) {
            const int blk = lane >> 4, cc = lane & 15;
            float x[16];
#pragma unroll
            for (int p = 0; p < 16; ++p) {
                float a = (p == cc) ? 1.f : 0.f;
#pragma unroll
                for (int s = 0; s < p; ++s) a += *(const LAS float*)(L0 + CK_D + (blk * 256 + p * 16 + s) * 4) * x[s];
                x[p] = a; }
#pragma unroll
            for (int p = 0; p < 16; ++p) *(LAS bf16*)(lds + CK_T + swz_el(16 * blk + p, 16 * blk + cc)) = (bf16)f2bf(x[p]);
            *(LAS v4u*)(lds + CK_TT + swz(16 * blk + cc, 2 * blk)) = (v4u){pk2(x[0], x[1]), pk2(x[2], x[3]), pk2(x[4], x[5]), pk2(x[6], x[7])};
            *(LAS v4u*)(lds + CK_TT + swz(16 * blk + cc, 2 * blk + 1)) = (v4u){pk2(x[8], x[9]), pk2(x[10], x[11]), pk2(x[12], x[13]), pk2(x[14], x[15])};
            LDS_WAIT();
            typedef float f32x4_ __attribute__((ext_vector_type(4)));
            const int row = lane & 15, kg = lane >> 4;
            const bf16x8 zf = (bf16x8){0, 0, 0, 0, 0, 0, 0, 0};
#pragma unroll
            for (int pr_ = 0; pr_ < 2; ++pr_) {
                const int b0 = 2 * pr_, b1 = b0 + 1;
                bf16x8 a = *(const LAS bf16x8*)(L0 + CK_LIN + swz(16 * b1 + row, 2 * b0 + (kg & 1)));
                bf16x8 bq = *(const LAS bf16x8*)(L0 + CK_TT + swz(16 * b0 + row, 2 * b0 + (kg & 1)));
                if (kg >= 2) { a = zf; bq = zf; }
                f32x4_ z = __builtin_amdgcn_mfma_f32_16x16x32_bf16(a, bq, (f32x4_){0.f, 0.f, 0.f, 0.f}, 0, 0, 0);
                *(LAS v2u*)(lds + CK_ZT + (row * 16 + 4 * kg) * 2) = (v2u){pk2(z[0], z[1]), pk2(z[2], z[3])};
                LDS_WAIT();
                bf16x8 a2 = *(const LAS bf16x8*)(L0 + CK_T + swz(16 * b1 + row, 2 * b1 + (kg & 1)));
                bf16x8 b2 = *(const LAS bf16x8*)(L0 + CK_ZT + (row * 16 + 8 * (kg & 1)) * 2);
                if (kg >= 2) { a2 = zf; b2 = zf; }
                f32x4_ m = __builtin_amdgcn_mfma_f32_16x16x32_bf16(a2, b2, (f32x4_){0.f, 0.f, 0.f, 0.f}, 0, 0, 0);
#pragma unroll
                for (int i = 0; i < 4; ++i) *(LAS bf16*)(lds + CK_T + swz_el(16 * b1 + 4 * kg + i, 16 * b0 + row)) = (bf16)f2bf(m[i]);
                *(LAS v2u*)(lds + CK_TT + swz_el(16 * b0 + row, 16 * b1 + 4 * kg)) = (v2u){pk2(m[0], m[1]), pk2(m[2], m[3])};
                LDS_WAIT();
            }
            {
                f32x16 z2 = zero16();
#pragma unroll
                for (int ks = 0; ks < 2; ++ks) {
                    const bf16x8 a = *(const LAS bf16x8*)(L0 + CK_LIN + swz(32 + r32, 2 * ks + hh));
                    const bf16x8 bq = *(const LAS bf16x8*)(L0 + CK_TT + swz(r32, 2 * ks + hh));
                    z2 = __builtin_amdgcn_mfma_f32_32x32x16_bf16(a, bq, z2, 0, 0, 0); }
#pragma unroll
                for (int rq = 0; rq < 4; ++rq)
                    *(LAS v2u*)(lds + CK_ZT + (r32 * 32 + 8 * rq + 4 * hh) * 2) = (v2u){pk2(z2[4 * rq], z2[4 * rq + 1]), pk2(z2[4 * rq + 2], z2[4 * rq + 3])};
                LDS_WAIT();
                f32x16 m2 = zero16();
#pragma unroll
                for (int ks = 0; ks < 2; ++ks) {
                    const bf16x8 a = *(const LAS bf16x8*)(L0 + CK_T + swz(32 + r32, 4 + 2 * ks + hh));
                    const bf16x8 bq = *(const LAS bf16x8*)(L0 + CK_ZT + (r32 * 32 + 16 * ks + 8 * hh) * 2);
                    m2 = __builtin_amdgcn_mfma_f32_32x32x16_bf16(a, bq, m2, 0, 0, 0); }
#pragma unroll
                for (int r = 0; r < 16; ++r) *(LAS bf16*)(lds + CK_T + swz_el(32 + crow(r, hh), r32)) = (bf16)f2bf(m2[r]);
            }
        } else if (wave >= 5) {
            for (int job = wave - 5; job < 8; job += 3) {
                const int prod = 2 + (job >> 2), tq = job & 3, ti = tq >> 1, tj = tq & 1;
                f32x16 acc = zero16();
                if (!(ti == 0 && tj == 1)) mm_tile(acc, L0 + CK_OPS + 3 * 8192, 32 * ti, L0 + CK_OPS + ((prod & 1) ? 2 : 1) * 8192, 32 * tj, 0, 4, r32, hh);
                const int s = 32 * tj + r32;
#pragma unroll
                for (int r = 0; r < 16; ++r) { const int p = 32 * ti + crow(r, hh); const float v = (s <= p) ? acc[r] : 0.f;
                    *(LAS bf16*)(lds + CK_LIN + prod * 8192 + swz_el(p, s)) = (bf16)f2bf(v); }
            }
        } else {
            const int tq = wave - 1, ti = tq >> 1, tj = tq & 1; f32x16 acc = zero16();
            mm_tile(acc, L0 + CK_LIN + 1 * 8192, 32 * ti, L0 + CK_OPS + 6 * 8192, 32 * tj, 0, 4, r32, hh);
#pragma unroll
            for (int rq = 0; rq < 4; ++rq)
                *(LAS v2u*)(lds + CK_PT + swz_el(32 * tj + r32, 32 * ti + 8 * rq + 4 * hh)) = (v2u){pk2(acc[4 * rq], acc[4 * rq + 1]), pk2(acc[4 * rq + 2], acc[4 * rq + 3])};
        }
        __syncthreads();
        if (it + F.G < NB * 8 * 36 * 2) CK_LOAD(it + F.G);
        {
            const bool isW = wave < 4; const int tq = wave & 3, ti = tq >> 1, tj = tq & 1; f32x16 acc = zero16();
            mm_tile(acc, isW ? L0 + CK_OPS + 7 * 8192 : L0 + CK_PT, 32 * ti, L0 + CK_T, 32 * tj, 0, 4, r32, hh);
            LAS unsigned char* XT = isW ? lds + CK_WT : lds + CK_UT;
#pragma unroll
            for (int r = 0; r < 16; ++r) *(LAS bf16*)(XT + swz_el(32 * ti + crow(r, hh), 32 * tj + r32)) = (bf16)f2bf(acc[r]);
        }
        __syncthreads();
        {
            const LAS unsigned char* WT_ = L0 + CK_WT; const LAS unsigned char* UT_ = L0 + CK_UT;
            const LAS unsigned char* Arb = L0 + CK_LIN + 2 * 8192; const LAS unsigned char* Ark = L0 + CK_LIN + 3 * 8192;
            const LAS unsigned char* BhT = L0 + CK_OPS + 4 * 8192; const LAS unsigned char* KhT = L0 + CK_OPS + 5 * 8192; const LAS unsigned char* VT = L0 + CK_OPS + 6 * 8192;
            f32x16 acc2[2];
#pragma unroll
            for (int jj = 0; jj < 2; ++jj) { const int job = wave + 8 * jj, prod = job >> 2, tq = job & 3, ti = tq >> 1, tj = tq & 1;
                acc2[jj] = zero16();
                if (prod == 0) mm_tile(acc2[jj], Arb, 32 * ti, WT_, 32 * tj, 0, 4, r32, hh);
                else if (prod == 1) { mm_tile(acc2[jj], Arb, 32 * ti, UT_, 32 * tj, 0, 4, r32, hh); mm_tile(acc2[jj], Ark, 32 * ti, VT, 32 * tj, 0, 4, r32, hh); }
                else if (prod == 2) mm_tile(acc2[jj], WT_, 32 * ti, BhT, 32 * tj, 0, 4, r32, hh);
                else { mm_tile(acc2[jj], UT_, 32 * ti, BhT, 32 * tj, 0, 4, r32, hh); mm_tile(acc2[jj], VT, 32 * ti, KhT, 32 * tj, 0, 4, r32, hh); } }
#pragma unroll
            for (int jj = 0; jj < 2; ++jj) { const int job = wave + 8 * jj, prod = job >> 2, tq = job & 3, ti = tq >> 1, tj = tq & 1;
                const f32x16 acc = acc2[jj]; const int cc = 32 * tj + r32;
                if (prod == 0) {
#pragma unroll
                    for (int r = 0; r < 16; ++r) { const int p = 32 * ti + crow(r, hh); const float v = acc[r] + bf2f(*(const LAS bf16*)(L0 + CK_OPS + 3 * 8192 + swz_el(p, cc)));
                        CHRQ[(size_t)ci * 4096 + p * 64 + cc] = (bf16)f2bf(v); }
                } else if (prod == 1) {
#pragma unroll
                    for (int r = 0; r < 16; ++r) { const int p = 32 * ti + crow(r, hh); CHY[(size_t)ci * 4096 + p * 64 + cc] = (bf16)f2bf(acc[r]); }
                } else if (prod == 2) {
#pragma unroll
                    for (int rq = 0; rq < 4; ++rq) { const int k0 = 32 * ti + 8 * rq + 4 * hh;
                        *(v2u*)(CHG + (size_t)ci * 4096 + cc * 64 + k0) = (v2u){pk2(acc[4 * rq], acc[4 * rq + 1]), pk2(acc[4 * rq + 2], acc[4 * rq + 3])}; }
                } else {
#pragma unroll
                    for (int r = 0; r < 16; ++r) { const int v_ = 32 * ti + crow(r, hh); CHH[(size_t)ci * 4096 + v_ * 64 + cc] = (bf16)f2bf(acc[r]); }
                }
            }
        }
    }
#undef CK_LOAD
#undef CK_DECODE
}

__device__ __forceinline__ void p_state(Frame& F) {
    using namespace ck;
    const int lane = F.lane, wave = F.wave, r32 = lane & 31, hh = lane >> 5;
    const bf16* CHG = (const bf16*)(F.ws + WS_CHG); const bf16* CHH = (const bf16*)(F.ws + WS_CHH); const bf16* CHRQ = (const bf16*)(F.ws + WS_CHRQ); bf16* CHY = (bf16*)(F.ws + WS_CHY);
    const float* GLp = (const float*)(F.ws + WS_GL);
    LAS unsigned char* lds = F.lds + RING_OFF;
    for (int chain = F.bid; chain < NB * 8 * 2; chain += F.G) {
        const int d = chain & 1, h = (chain >> 1) & 7, b = chain >> 4;
        const int tq = wave & 3, ti = tq >> 1, tj = tq & 1; const bool isS = wave < 4;
        f32x16 S = zero16();
        __syncthreads();
        for (int i = F.tid; i < 8192 / 16; i += NTHR) *(LAS v4u*)(lds + i * 16) = (v4u){0u, 0u, 0u, 0u};
        bf16x8 frA[4], frB[4]; unsigned short hvA[16], hvB[16]; float glA = 0.f, glB = 0.f;
#define ST_LOAD(fr, hv, gl, c_) do { const size_t cb_ = (size_t)chunk_index(b, h, d, (c_)) * 4096; \
            if (isS) { _Pragma("unroll") for (int ks = 0; ks < 4; ++ks) fr[ks] = *(const bf16x8*)(CHG + cb_ + (size_t)(32 * tj + r32) * 64 + 16 * ks + 8 * hh); \
                       _Pragma("unroll") for (int r = 0; r < 16; ++r) hv[r] = CHH[cb_ + (32 * ti + crow(r, hh)) * 64 + 32 * tj + r32]; \
                       gl = GLp[(size_t)chunk_index(b, h, d, (c_)) * 64 + 32 * tj + r32]; } \
            else { _Pragma("unroll") for (int ks = 0; ks < 4; ++ks) fr[ks] = *(const bf16x8*)(CHRQ + cb_ + (size_t)(32 * ti + r32) * 64 + 16 * ks + 8 * hh); \
                   _Pragma("unroll") for (int r = 0; r < 16; ++r) hv[r] = CHY[cb_ + (32 * ti + crow(r, hh)) * 64 + 32 * tj + r32]; } } while (0)
#define ST_STEP(fr, hv, gl, c_) do { const size_t cb = (size_t)chunk_index(b, h, d, (c_)) * 4096; \
            const LAS unsigned char* Sb = lds + ((c_) & 1) * 8192; LAS unsigned char* Sn = lds + (((c_) + 1) & 1) * 8192; \
            bf16x8 cf[4]; float cv[16]; const float cgl = gl; \
            _Pragma("unroll") for (int ks = 0; ks < 4; ++ks) cf[ks] = fr[ks]; \
            _Pragma("unroll") for (int r = 0; r < 16; ++r) cv[r] = bf2f(hv[r]); \
            if ((c_) + 2 < NCH) ST_LOAD(fr, hv, gl, (c_) + 2);            \
            f32x16 acc = zero16(); \
            if (isS) { \
                _Pragma("unroll") for (int ks = 0; ks < 4; ++ks) { const bf16x8 a = *(const LAS bf16x8*)(Sb + swz(32 * ti + r32, 2 * ks + hh)); acc = __builtin_amdgcn_mfma_f32_32x32x16_bf16(a, cf[ks], acc, 0, 0, 0); } \
                _Pragma("unroll") for (int r = 0; r < 16; ++r) { const int v_ = 32 * ti + crow(r, hh); \
                    S[r] = S[r] * cgl + acc[r] + cv[r]; \
                    *(LAS bf16*)(Sn + swz_el(v_, 32 * tj + r32)) = (bf16)f2bf(S[r]); } \
            } else { \
                _Pragma("unroll") for (int ks = 0; ks < 4; ++ks) { const bf16x8 s = *(const LAS bf16x8*)(Sb + swz(32 * tj + r32, 2 * ks + hh)); acc = __builtin_amdgcn_mfma_f32_32x32x16_bf16(cf[ks], s, acc, 0, 0, 0); } \
                _Pragma("unroll") for (int r = 0; r < 16; ++r) { const int p = 32 * ti + crow(r, hh); CHY[cb + p * 64 + 32 * tj + r32] = (bf16)f2bf(acc[r] + cv[r]); } \
            } \
            __syncthreads(); } while (0)
        ST_LOAD(frA, hvA, glA, 0); ST_LOAD(frB, hvB, glB, 1);
        __syncthreads();
        for (int c = 0; c < NCH; c += 2) { ST_STEP(frA, hvA, glA, c); ST_STEP(frB, hvB, glB, c + 1); }
#undef ST_LOAD
#undef ST_STEP
    }
}

__device__ __forceinline__ void p_rope0(Frame& F) {
    const int gw = F.bid * NWAVES + F.wave, NGW = F.G * NWAVES;
    bf16* PB = (bf16*)(F.ws + WS_PB); const float* cosB = (const float*)(F.ws + WS_ROPE); const float* sinB = cosB + SEQ * 32;
    const int vec = F.lane >> 2, j8 = (F.lane & 3) * 8;
    for (int q = gw; q < NB * SEQ; q += 2 * NGW) {
        int qq[2]; qq[0] = q; qq[1] = q + NGW < NB * SEQ ? q + NGW : q; const bool ok1 = q + NGW < NB * SEQ;
        v4u a[2], b2[2]; f32x4 c0[2], c1[2], s0[2], s1[2]; bf16* pp[2];
#pragma unroll
        for (int s = 0; s < 2; ++s) { const int b = qq[s] / SEQ, t = qq[s] - b * SEQ; pp[s] = PB + (size_t)(b * TPB + CTXL + t) * B_IN + vec * 64 + j8;
            a[s] = *(const v4u*)pp[s]; b2[s] = *(const v4u*)(pp[s] + 32);
            c0[s] = *(const f32x4*)(cosB + t * 32 + j8); c1[s] = *(const f32x4*)(cosB + t * 32 + j8 + 4); s0[s] = *(const f32x4*)(sinB + t * 32 + j8); s1[s] = *(const f32x4*)(sinB + t * 32 + j8 + 4); }
#pragma unroll
        for (int s = 0; s < 2; ++s) {
            const unsigned aw[4] = {a[s].x, a[s].y, a[s].z, a[s].w}, bw[4] = {b2[s].x, b2[s].y, b2[s].z, b2[s].w};
            const float cs[8] = {c0[s].x, c0[s].y, c0[s].z, c0[s].w, c1[s].x, c1[s].y, c1[s].z, c1[s].w}, sn[8] = {s0[s].x, s0[s].y, s0[s].z, s0[s].w, s1[s].x, s1[s].y, s1[s].z, s1[s].w};
            float o1[8], o2[8];
#pragma unroll
            for (int i = 0; i < 8; ++i) { const int w = i >> 1; const bool up = i & 1; const float x1 = up ? bfhi(aw[w]) : bflo(aw[w]), x2 = up ? bfhi(bw[w]) : bflo(bw[w]);
                o1[i] = x1 * cs[i] - x2 * sn[i]; o2[i] = x1 * sn[i] + x2 * cs[i]; }
            if (s == 0 || ok1) { *(v4u*)pp[s] = (v4u){pk2(o1[0], o1[1]), pk2(o1[2], o1[3]), pk2(o1[4], o1[5]), pk2(o1[6], o1[7])};
                                 *(v4u*)(pp[s] + 32) = (v4u){pk2(o2[0], o2[1]), pk2(o2[2], o2[3]), pk2(o2[4], o2[5]), pk2(o2[6], o2[7])}; }
        }
    }
}

__device__ __forceinline__ void p_linact(Frame& F) {
    const int gw = F.bid * NWAVES + F.wave, NGW = F.G * NWAVES;
    const bf16* PA = (const bf16*)(F.ws + WS_PA); bf16* LA = (bf16*)((unsigned char*)F.out + DOUT_LINACT);
    const int cc = F.lane * 8; const bool act = F.lane < 48;
    const float* mu = F.in[I_AMU] + 1536 + (act ? cc : 0);
    const f32x4 m0 = *(const f32x4*)mu, m1 = *(const f32x4*)(mu + 4);
    const float mm[8] = {m0.x, m0.y, m0.z, m0.w, m1.x, m1.y, m1.z, m1.w};
    for (int row = gw; row < MROWS; row += NGW) {
        if (!act) continue;
        const int b = row / TPB, tt = row - b * TPB; const bool isctx = tt < CTXL; const int t = isctx ? tt : tt - CTXL, Ls = isctx ? CTXL : SEQ;
        const bf16* pc = PA + (size_t)row * A_IN + 1536 + cc;
        const v4u cur = *(const v4u*)pc; v4u prv = (v4u){0u, 0u, 0u, 0u}, nxt = (v4u){0u, 0u, 0u, 0u};
        if (t > 0) prv = *(const v4u*)(pc - A_IN);
        if (t + 1 < Ls) nxt = *(const v4u*)(pc + A_IN);
        const unsigned cw[4] = {cur.x, cur.y, cur.z, cur.w}, pw[4] = {prv.x, prv.y, prv.z, prv.w}, nw[4] = {nxt.x, nxt.y, nxt.z, nxt.w}; float u[8];
#pragma unroll
        for (int j = 0; j < 8; ++j) { const int w = j >> 1; const bool up = j & 1;
            const float cv = up ? bfhi(cw[w]) : bflo(cw[w]), pv = up ? bfhi(pw[w]) : bflo(pw[w]), nv = up ? bfhi(nw[w]) : bflo(nw[w]);
            float x = cv + (0.5f * (pv + nv) - cv) * mm[j];
            if (cc < 128) x = 1.f - 2.f * __builtin_amdgcn_rcpf(__builtin_amdgcn_exp2f(2.8853900817779268f * x) + 1.f); else if (cc >= 256) x = fsig(x);
            u[j] = x; }
        *(v4u*)(LA + (size_t)row * 384 + cc) = (v4u){pk2(u[0], u[1]), pk2(u[2], u[3]), pk2(u[4], u[5]), pk2(u[6], u[7])};
    }
}

__device__ __forceinline__ void p_attn0(Frame& F) {
    const bf16* PB = (const bf16*)(F.ws + WS_PB);
    unsigned* qctr = (unsigned*)(F.ws + WS_CTL) + CW_Q0;
    volatile LAS unsigned* slot = (volatile LAS unsigned*)(F.lds + MISC_OFF + 64);
    for (;;) {
        __syncthreads();
        if (F.tid == 0) slot[0] = atomicAdd(qctr, 1u);
        __syncthreads();
        const int u = (int)slot[0];
        if (u >= 576) break;
        int b, h, m, qt;
        if (u < 512) { qt = 1 + (u & 7); const int r = u >> 3; m = r & 1; h = (r >> 1) & 3; b = r >> 3; }
        else { const int r = u - 512; qt = 0; m = r & 1; h = (r >> 1) & 3; b = r >> 3; }
        const size_t row0 = (size_t)b * TPB;
        const bf16* Q = PB + (row0 + (size_t)qt * 256) * B_IN + h * 128 + m * 64;
        const bf16* Kp = PB + row0 * B_IN + 512 + h * 128 + m * 64;
        const bf16* Vp = PB + row0 * B_IN + 1024 + h * 128;
        bf16* O = (bf16*)(F.ws + (m == 0 ? WS_OB0 : WS_OB1)) + (row0 + (size_t)qt * 256) * 512 + h * 128;
        att::attn_body<64, B_IN, B_IN, 512>(Q, Kp, Vp, O, qt == 0 ? CTXL : TPB, (char*)g_lds + RING_OFF, F.wave);
    }
}

__device__ __forceinline__ void p_readout(Frame& F) {
    const int gw = F.bid * NWAVES + F.wave, NGW = F.G * NWAVES;
    const bf16* CHY = (const bf16*)(F.ws + WS_CHY); const bf16* fv = (const bf16*)(F.ws + WS_VOUT); const bf16* fg = (const bf16*)(F.ws + WS_GOUT); const float* BON = (const float*)(F.ws + WS_BON);
    const bf16* ob0 = (const bf16*)(F.ws + WS_OB0); const bf16* ob1 = (const bf16*)(F.ws + WS_OB1);
    bf16* A2 = (bf16*)(F.ws + WS_A2);
    float lam;
    { const float* lv = F.in[I_BLAM]; const float s1 = wave_sum(lv[F.lane] * lv[64 + F.lane]), s2 = wave_sum(lv[128 + F.lane] * lv[192 + F.lane]); lam = expf(s1) - expf(s2) + LAMBDA_INIT0; }
    const int c8 = F.lane * 8, hd = F.lane >> 3, v0 = (F.lane & 7) * 8;
    for (int row = gw; row < MROWS; row += NGW) {
        const size_t off = (size_t)row * 512 + c8;
        const int b = row / TPB, tt = row - b * TPB;
        const int ir = tt < CTXL ? (CTXL - 1 - tt) : CTXL + (TPB - 1 - tt);
        const size_t of = (size_t)ck::chunk_index(b, hd, 0, tt >> 6) * 4096 + (tt & 63) * 64 + v0, orv = (size_t)ck::chunk_index(b, hd, 1, ir >> 6) * 4096 + (ir & 63) * 64 + v0;
        const v4u qv = *(const v4u*)(fv + off), qg = *(const v4u*)(fg + off), q1 = *(const v4u*)(CHY + of), q2 = *(const v4u*)(CHY + orv);
        const unsigned wv_[4] = {qv.x, qv.y, qv.z, qv.w}, wg_[4] = {qg.x, qg.y, qg.z, qg.w}, w1_[4] = {q1.x, q1.y, q1.z, q1.w}, w2_[4] = {q2.x, q2.y, q2.z, q2.w};
        const float bon = BON[(size_t)row * 8 + hd] + BON[((size_t)MROWS + row) * 8 + hd];
        float y[8], s = 0.f;
#pragma unroll
        for (int j = 0; j < 8; ++j) { const int w = j >> 1; const bool up = j & 1; y[j] = (up ? bfhi(w1_[w]) : bflo(w1_[w])) + (up ? bfhi(w2_[w]) : bflo(w2_[w])); s += y[j]; }
        s = sum8(s);
        const float mean = s * (1.f / 64.f); float q = 0.f;
#pragma unroll
        for (int j = 0; j < 8; ++j) { y[j] -= mean; q += y[j] * y[j]; }
        q = sum8(q);
        const float rstd = 1.f / sqrtf(q * (1.f / 64.f) + GN_EPS);
        float o[8];
#pragma unroll
        for (int j = 0; j < 8; ++j) { const int w = j >> 1; const bool up = j & 1; const float v_ = up ? bfhi(wv_[w]) : bflo(wv_[w]), g_ = up ? bfhi(wg_[w]) : bflo(wg_[w]);
            o[j] = (y[j] * rstd * F.in[I_LNXG][c8 + j] + F.in[I_LNXB][c8 + j] + bon * v_) * g_; }
        *(v4u*)(A2 + (size_t)row * DM + c8) = (v4u){pk2(o[0], o[1]), pk2(o[2], o[3]), pk2(o[4], o[5]), pk2(o[6], o[7])};
        const v4u p0 = *(const v4u*)(ob0 + off), p1 = *(const v4u*)(ob1 + off);
        const unsigned u0[4] = {p0.x, p0.y, p0.z, p0.w}, u1[4] = {p1.x, p1.y, p1.z, p1.w};
        float z[8], ss = 0.f;
#pragma unroll
        for (int j = 0; j < 8; ++j) { const int w = j >> 1; const bool up = j & 1; z[j] = (up ? bfhi(u0[w]) : bflo(u0[w])) - lam * (up ? bfhi(u1[w]) : bflo(u1[w])); ss += z[j] * z[j]; }
        ss = sum16(ss);
        const float rr = 1.f / sqrtf(ss * (1.f / 128.f) + SUBLN_EPS) * (1.f - LAMBDA_INIT0);
#pragma unroll
        for (int j = 0; j < 8; ++j) z[j] = z[j] * rr * F.in[I_SUBG][(c8 + j) & 127];
        *(v4u*)(A2 + (size_t)row * DM + 512 + c8) = (v4u){pk2(z[0], z[1]), pk2(z[2], z[3]), pk2(z[4], z[5]), pk2(z[6], z[7])};
    }
}

__device__ __forceinline__ void p_qknorm1(Frame& F) {
    const int gw = F.bid * NWAVES + F.wave, NGW = F.G * NWAVES;
    bf16* QKV = (bf16*)(F.ws + WS_QKV1); const float* cosC = (const float*)(F.ws + WS_ROPE) + SEQ * 64; const float* sinC = cosC + SEQ * 64;
    const float qg1 = F.in[I_QNG][F.lane], qg2 = F.in[I_QNG][64 + F.lane], kg1 = F.in[I_KNG][F.lane], kg2 = F.in[I_KNG][64 + F.lane];
    for (int row = gw; row < MROWS; row += NGW) {
        const int b = row / TPB, tt = row - b * TPB; const bool lat = tt >= CTXL; const int t = tt - CTXL;
        float cs = 1.f, sn = 0.f; if (lat) { cs = cosC[t * 64 + F.lane]; sn = sinC[t * 64 + F.lane]; }
        bf16* p = QKV + (size_t)row * ODD_IN;
        for (int hd = 8; hd < 10; ++hd) {
            bf16* ph = p + hd * 128; const float x1 = bf2f(ph[F.lane]), x2 = bf2f(ph[64 + F.lane]);
            const float ss = wave_sum(x1 * x1 + x2 * x2); const float ri = 1.f / sqrtf(ss * (1.f / 128.f) + QKN_EPS);
            const float y1 = x1 * ri * (hd < 8 ? qg1 : kg1), y2 = x2 * ri * (hd < 8 ? qg2 : kg2);
            ph[F.lane] = (bf16)f2bf(y1 * cs - y2 * sn); ph[64 + F.lane] = (bf16)f2bf(y1 * sn + y2 * cs);
        }
    }
}
__device__ __forceinline__ void p_attn1(Frame& F) {
    const bf16* QKV = (const bf16*)(F.ws + WS_QKV1); bf16* OA = (bf16*)(F.ws + WS_OATT);
    for (int u = F.bid; u < 512; u += F.G) {
        const int qt = 1 + (u & 7), h = (u >> 3) & 7, b = u >> 6; const int kvh = h >> 2;
        const size_t row0 = (size_t)b * TPB;
        const bf16* Q = QKV + (row0 + (size_t)qt * 256) * ODD_IN + h * 128;
        const bf16* Kp = QKV + row0 * ODD_IN + 1024 + kvh * 128;
        const bf16* Vp = QKV + row0 * ODD_IN + 1280 + kvh * 128;
        bf16* O = OA + (row0 + (size_t)qt * 256) * DM + h * 128;
        att::attn_body<128, ODD_IN, ODD_IN, DM, true>(Q, Kp, Vp, O, TPB, (char*)g_lds + RING_OFF, F.wave, F.in[I_QNG], (const float*)(F.ws + WS_ROPE) + SEQ * 64, (const float*)(F.ws + WS_ROPE) + SEQ * 128, (qt - 1) * 256, QKN_EPS);
    }
}
namespace pg8 {
struct NoPre {};
struct EpiBf16 {
    static constexpr bool PERM = true; typedef NoPre Pre; __device__ __forceinline__ void prefetch(Pre&, const Unit&, int, int) const {}
    bf16_t* O; int ldc;
    __device__ __forceinline__ void operator()(const f32x4 (&acc)[2][2][4][2], const Unit& u, int wr, int wc, int fr, int fq, const Pre& pre) const {
        const int row0 = u.orow0 + wr * 64 + fr, col0 = u.pn * BM + wc * 32 + 8 * fq;
#pragma unroll
        for (int ai = 0; ai < 2; ++ai)
#pragma unroll
            for (int m = 0; m < 4; ++m) { bf16_t* rowp = O + (size_t)(row0 + ai * HALF + m * 16) * ldc + col0;
#pragma unroll
                for (int bj = 0; bj < 2; ++bj) { const f32x4 v0 = acc[ai][bj][m][0], v1 = acc[ai][bj][m][1];
                    u32x4 w; w.x = cvt_pk_bf16(v0[0], v0[1]); w.y = cvt_pk_bf16(v0[2], v0[3]); w.z = cvt_pk_bf16(v1[0], v1[1]); w.w = cvt_pk_bf16(v1[2], v1[3]);
                    *(u32x4*)(rowp + bj * HALF) = w; } }
    }
};
struct EpiIn0 {
    static constexpr bool PERM = true; typedef NoPre Pre; __device__ __forceinline__ void prefetch(Pre&, const Unit&, int, int) const {}
    bf16_t* PA; bf16_t* PB;
    __device__ __forceinline__ void operator()(const f32x4 (&acc)[2][2][4][2], const Unit& u, int wr, int wc, int fr, int fq, const Pre& pre) const {
        const int row0 = u.orow0 + wr * 64 + fr, col0 = u.pn * BM + wc * 32 + 8 * fq;
#pragma unroll
        for (int ai = 0; ai < 2; ++ai)
#pragma unroll
            for (int m = 0; m < 4; ++m) { const size_t row = (size_t)(row0 + ai * HALF + m * 16);
#pragma unroll
                for (int bj = 0; bj < 2; ++bj) { const f32x4 v0 = acc[ai][bj][m][0], v1 = acc[ai][bj][m][1]; const int col = col0 + bj * HALF;
                    u32x4 w; w.x = cvt_pk_bf16(v0[0], v0[1]); w.y = cvt_pk_bf16(v0[2], v0[3]); w.z = cvt_pk_bf16(v1[0], v1[1]); w.w = cvt_pk_bf16(v1[2], v1[3]);
                    if (col < 1920) *(u32x4*)(PA + row * 1920 + col) = w; else if (col < 3456) *(u32x4*)(PB + row * 1536 + (col - 1920)) = w; } }
    }
};
struct EpiMoe1 {
    static constexpr bool PERM = true; typedef NoPre Pre; __device__ __forceinline__ void prefetch(Pre&, const Unit&, int, int) const {}
    bf16_t* HID;
    __device__ __forceinline__ void operator()(const f32x4 (&acc)[2][2][4][2], const Unit& u, int wr, int wc, int fr, int fq, const Pre& pre) const {
        const int row0 = u.orow0 + wr * 64 + fr, col0 = u.pn * 128 + wc * 16 + 4 * fq;
#pragma unroll
        for (int ai = 0; ai < 2; ++ai)
#pragma unroll
            for (int m = 0; m < 4; ++m) { bf16_t* rowp = HID + (size_t)(row0 + ai * HALF + m * 16) * 512 + col0;
#pragma unroll
                for (int bj = 0; bj < 2; ++bj) { const f32x4 a = acc[ai][bj][m][0], b = acc[ai][bj][m][1]; float h[4];
#pragma unroll
                    for (int i = 0; i < 4; ++i) h[i] = a[i] / (1.f + __expf(-a[i])) * b[i];
                    u32x2 w; w.x = cvt_pk_bf16(h[0], h[1]); w.y = cvt_pk_bf16(h[2], h[3]);
                    *(u32x2*)(rowp + bj * 64) = w; } }
    }
};
struct EpiMoe2 {
    static constexpr bool PERM = true;
    struct Pre { float g[2][4]; };
    bf16_t* Y; const float* GATE;
    __device__ __forceinline__ void prefetch(Pre& p, const Unit& u, int wr, int fr) const {
#pragma unroll
        for (int ai = 0; ai < 2; ++ai)
#pragma unroll
            for (int m = 0; m < 4; ++m) { const int r = wr * 64 + fr + ai * HALF + m * 16; p.g[ai][m] = GATE[u.gbase + (r < u.nvalid ? r : 0)]; }
    }
    __device__ __forceinline__ void operator()(const f32x4 (&acc)[2][2][4][2], const Unit& u, int wr, int wc, int fr, int fq, const Pre& pre) const {
        const int r0 = wr * 64 + fr, col0 = u.pn * BM + wc * 32 + 8 * fq;
#pragma unroll
        for (int ai = 0; ai < 2; ++ai)
#pragma unroll
            for (int m = 0; m < 4; ++m) { const int r = r0 + ai * HALF + m * 16; if (r >= u.nvalid) continue;
                const float gt = pre.g[ai][m]; bf16_t* rowp = Y + (size_t)(u.orow0 + r) * 1024 + col0;
#pragma unroll
                for (int bj = 0; bj < 2; ++bj) { const f32x4 v0 = acc[ai][bj][m][0] * gt, v1 = acc[ai][bj][m][1] * gt;
                    u32x4 w; w.x = cvt_pk_bf16(v0[0], v0[1]); w.y = cvt_pk_bf16(v0[2], v0[3]); w.z = cvt_pk_bf16(v1[0], v1[1]); w.w = cvt_pk_bf16(v1[2], v1[3]);
                    *(u32x4*)(rowp + bj * HALF) = w; } }
    }
};
__device__ __forceinline__ void moe_build_table(const unsigned* cnt, PG8_LAS int* tab, int tid) {
    unsigned cn[16]; int total = 0;
#pragma unroll
    for (int e = 0; e < 16; ++e) { cn[e] = __hip_atomic_load(cnt + e, __ATOMIC_RELAXED, __HIP_MEMORY_SCOPE_AGENT); total += (int)((cn[e] + 255u) >> 8); }
    total *= 4;
    if (tid == 0) tab[0] = total;
    for (int L = tid; L < total; L += 512) {
        int base = 0, toff = 0, e = 0; bool found = false; unsigned ce = cn[0];
#pragma unroll
        for (int q = 0; q < 16; ++q) { const int nt = (int)((cn[q] + 255u) >> 8); if (!found) { if (L >= base + 4 * nt) { base += 4 * nt; toff += nt; e = q + 1; } else { found = true; ce = cn[q]; } } }
        const int nt_e = (int)((ce + 255u) >> 8); const int within = L - base, pn = within / nt_e, rt = within % nt_e;
        const int rem = (int)ce - rt * 256; const int nvalid = rem < 256 ? rem : 256;
        tab[4 + 2 * L] = e | (rt << 4) | (pn << 12) | (nvalid << 16); tab[4 + 2 * L + 1] = toff + rt;
    }
    __syncthreads();
}
template <bool GATHER_>
struct MoeOrder {
    static constexpr bool GATHER = GATHER_;
    const PG8_LAS int* tab; const int* perm; int G, c, K;
    __device__ __forceinline__ bool next(int i, Unit& u) const {
        const int total = __builtin_amdgcn_readfirstlane(tab[0]);
        const int L0 = i * G + c; if (L0 >= total) return false;
        const int L = xcd_remap(L0, total);
        const int w0 = __builtin_amdgcn_readfirstlane(tab[4 + 2 * L]), w1 = __builtin_amdgcn_readfirstlane(tab[4 + 2 * L + 1]);
        const int e = w0 & 15, rt = (w0 >> 4) & 255, pn = (w0 >> 12) & 3;
        u.pm = rt; u.pn = pn; u.e = e; u.gbase = e * 18432 + rt * 256; u.nvalid = (w0 >> 16) & 511; u.orow0 = w1 * 256;
        u.boff = ((size_t)e * 1024 + (size_t)pn * 256) * K * 2; u.aoff = (size_t)u.orow0 * K * 2; return true;
    }
    __device__ __forceinline__ int token(const Unit& u, int r) const { return perm[u.gbase + (r < u.nvalid ? r : 0)]; }
};
}

enum { PH_PROLOGUE = 0, PH_MOD0, PH_GEMM_IN0, PH_PREP, PH_CHUNK, PH_ATTN0, PH_READOUT, PH_GEMM_OUT0, PH_LNR0, PH_MOE1_0, PH_MOE2_0, PH_LN2_0,
       PH_GEMM_IN1, PH_QKN1, PH_ATTN1, PH_GEMM_OUT1, PH_LNR1, PH_MOE1_1, PH_MOE2_1, PH_FINAL, N_PHASES };

template <int LAYER> __device__ __forceinline__ void p_moe1(Frame& F) {
    pg8::Gemm g{(const pg8::bf16_t*)(F.ws + WS_H), (const pg8::bf16_t*)moe_w13(F, LAYER), DM};
    pg8::moe_build_table((const unsigned*)(F.ws + WS_CTL) + CW_CNT + LAYER * 64, (LAS int*)(F.lds + MOETAB_OFF), F.tid);
    pg8::MoeOrder<true> S{(const LAS int*)(F.lds + MOETAB_OFF), (const int*)(F.ws + WS_PERM_), F.G, F.bid, DM};
    pg8::EpiMoe1 E{(pg8::bf16_t*)(F.ws + WS_HID)};
    pg8::gemm_phase<pg8::EpiMoe1, pg8::MoeOrder<true>>(F.lds + RING_OFF, g, S, E, F.wave);
    if (LAYER == 0) convert_moe_filler(F, 1, ((const LAS int*)(F.lds + MOETAB_OFF))[0]);
}
template <int LAYER> __device__ __forceinline__ void p_moe2(Frame& F) {
    pg8::Gemm g{(const pg8::bf16_t*)(F.ws + WS_HID), (const pg8::bf16_t*)moe_w2(F, LAYER), EFF};
    pg8::moe_build_table((const unsigned*)(F.ws + WS_CTL) + CW_CNT + LAYER * 64, (LAS int*)(F.lds + MOETAB_OFF), F.tid);
    pg8::MoeOrder<false> S{(const LAS int*)(F.lds + MOETAB_OFF), (const int*)(F.ws + WS_PERM_), F.G, F.bid, EFF};
    pg8::EpiMoe2 E{(pg8::bf16_t*)(F.ws + WS_Y), (const float*)(F.ws + WS_GATE)};
    pg8::gemm_phase<pg8::EpiMoe2, pg8::MoeOrder<false>>(F.lds + RING_OFF, g, S, E, F.wave);
}
__device__ __forceinline__ void p_gemm_dense(Frame& F, size_t a_off, size_t w_off, int N, size_t o_off, int ldc, int skip9 = 0) {
    pg8::Gemm g{(const pg8::bf16_t*)(F.ws + a_off), (const pg8::bf16_t*)(F.ws + w_off), DM};
    pg8::DenseOrder S; S.init(MROWS, N, DM, F.G, F.bid, skip9);
    pg8::EpiBf16 E{(pg8::bf16_t*)(F.ws + o_off), ldc};
    pg8::gemm_phase<pg8::EpiBf16, pg8::DenseOrder>(F.lds + RING_OFF, g, S, E, F.wave);
}

template <int PH> __device__ __forceinline__ void run_phase(Frame& F) {
    if constexpr (PH == PH_PROLOGUE) p_mods(F);
    else if constexpr (PH == PH_MOD0) { p_prologue(F); p_mod0(F); }
    else if constexpr (PH == PH_GEMM_IN0) {
        pg8::Gemm g{(const pg8::bf16_t*)(F.ws + WS_H), (const pg8::bf16_t*)(F.ws + WS_WEVIN), DM};
        pg8::DenseOrder S; S.init(MROWS, EVEN_PAD, DM, F.G, F.bid);
        pg8::EpiIn0 E{(pg8::bf16_t*)(F.ws + WS_PA), (pg8::bf16_t*)(F.ws + WS_PB)};
        pg8::gemm_phase<pg8::EpiIn0, pg8::DenseOrder>(F.lds + RING_OFF, g, S, E, F.wave); }
    else if constexpr (PH == PH_PREP) { p_rope0(F); p_linact(F); }
    else if constexpr (PH == PH_CHUNK) p_chunk_pre(F);
    else if constexpr (PH == PH_ATTN0) { p_state(F); p_attn0(F); }
    else if constexpr (PH == PH_READOUT) p_readout(F);
    else if constexpr (PH == PH_GEMM_OUT0) { p_gemm_dense(F, WS_A2, WS_WEVOUT, DM, WS_MIX, DM); convert_moe_filler(F, 0, (MROWS / 256) * (DM / 256)); }
    else if constexpr (PH == PH_LNR0) p_ln_route<0>(F);
    else if constexpr (PH == PH_MOE1_0) p_moe1<0>(F);
    else if constexpr (PH == PH_MOE2_0) p_moe2<0>(F);
    else if constexpr (PH == PH_LN2_0) p_ln2<0>(F);
    else if constexpr (PH == PH_GEMM_IN1) p_gemm_dense(F, WS_H, WS_WODIN, ODD_IN, WS_QKV1, ODD_IN);
    else if constexpr (PH == PH_QKN1) p_qknorm1(F);
    else if constexpr (PH == PH_ATTN1) p_attn1(F);
    else if constexpr (PH == PH_GEMM_OUT1) p_gemm_dense(F, WS_OATT, WS_WODOUT, DM, WS_MIX, DM, 1);
    else if constexpr (PH == PH_LNR1) p_ln_route<1>(F);
    else if constexpr (PH == PH_MOE1_1) p_moe1<1>(F);
    else if constexpr (PH == PH_MOE2_1) p_moe2<1>(F);
    else if constexpr (PH == PH_FINAL) p_ln2<1>(F);
}
template <int PH, int HI> __device__ __forceinline__ void run_phases(Frame& F, const XcdBarrier& bar) {
    if constexpr (PH < HI) {
        {
            const float* const* inp = (const float* const*)__builtin_amdgcn_kernarg_segment_ptr(); asm volatile("" : "+s"(inp)); F.in = inp;
            asm volatile("" : "+s"(F.ws), "+s"(F.out), "+s"(F.G), "+s"(F.bid), "+s"(F.wave));
            const int l_ = lane_id_fresh(); F.lane = l_; F.tid = (F.wave << 6) | l_; }
        asm volatile("; PHASE_MARK %0" :: "i"(PH));
        run_phase<PH>(F);
        if constexpr (PH + 1 < HI) { xcd_barrier(bar, F.wave);
#ifdef XBAR_EXTRA
            if constexpr (PH == 5) { for (int q_ = 0; q_ < XBAR_EXTRA; ++q_) xcd_barrier(bar, F.wave); }
#endif
#ifdef TPROBE_A
            if (F.tid == 0) ((volatile LAS unsigned long long*)(F.lds + MISC_OFF + 128))[PH + 1] = __builtin_amdgcn_s_memrealtime();
#endif
            run_phases<PH + 1, HI>(F, bar); }
    }
}

template <int LO, int HI>
__global__ void __launch_bounds__(NTHR, 2) fwd_kernel(Args args) {
    Frame F;
    F.lds = (LAS unsigned char*)g_lds;
    F.tid = threadIdx.x; F.lane = F.tid & 63; F.wave = __builtin_amdgcn_readfirstlane(F.tid >> 6);
    F.G = gridDim.x; F.bid = blockIdx.x; F.in = args.in; F.out = args.out; F.ws = args.ws;
    volatile LAS unsigned* MISC = (volatile LAS unsigned*)(F.lds + MISC_OFF);
    for (int u = F.tid; u < (LDS_BYTES - LDSCTL_OFF) / 4; u += NTHR) ((LAS unsigned*)(F.lds + LDSCTL_OFF))[u] = 0u;
    __syncthreads();
    XcdBarrier bar; bar.bar = (unsigned*)(F.ws + WS_CTL) + CW_BAR; bar.x = 0; bar.st = nullptr;
    if constexpr (HI - LO > 1) bar = xcd_barrier_post((unsigned*)(F.ws + WS_CTL) + CW_BAR, MISC + 8);
#ifdef TPROBE_A
    if (threadIdx.x == 0) ((volatile LAS unsigned long long*)(F.lds + MISC_OFF + 128))[0] = __builtin_amdgcn_s_memrealtime();
#endif
    run_phases<LO, HI>(F, bar);
}

#ifndef N_LAUNCH_MODE
#define N_LAUNCH_MODE 0
#endif
template <int PH> static void launch_from(int grid, hipStream_t stream, const Args& a) {
    if constexpr (PH < N_PHASES) {
        (void)hipFuncSetAttribute((const void*)fwd_kernel<PH, PH + 1>, hipFuncAttributeMaxDynamicSharedMemorySize, LDS_BYTES);
        hipLaunchKernelGGL((fwd_kernel<PH, PH + 1>), dim3(grid), dim3(NTHR), LDS_BYTES, stream, a);
#ifdef PROBE_MASK
        if ((PROBE_MASK >> PH) & 1) hipLaunchKernelGGL((fwd_kernel<PH, PH + 1>), dim3(grid), dim3(NTHR), LDS_BYTES, stream, a);
#endif
        launch_from<PH + 1>(grid, stream, a);
    }
}
extern "C" void kernel_launch(void* const* d_in, const int* in_sizes, int n_in, void* d_out, int out_size, void* d_ws, size_t ws_size, hipStream_t stream) {
    static int grid = 0;
    if (grid == 0) {
        if (n_in != 34 || in_sizes[0] != NB * SEQ * DM || out_size != NB * SEQ * DM || ws_size < WS_TOTAL) {
            fprintf(stderr, "kernel_launch: unexpected shapes: n_in %d in0 %d out %d ws %zu (need %zu)\n", n_in, n_in > 0 ? in_sizes[0] : -1, out_size, ws_size, (size_t)WS_TOTAL); grid = -1; return; }
        int dev = 0, cus = 0;
        if (hipGetDevice(&dev) != hipSuccess || hipDeviceGetAttribute(&cus, hipDeviceAttributeMultiprocessorCount, dev) != hipSuccess) { grid = -1; return; }
#if N_LAUNCH_MODE == 0
        if (hipFuncSetAttribute((const void*)fwd_kernel<0, N_PHASES>, hipFuncAttributeMaxDynamicSharedMemorySize, LDS_BYTES) != hipSuccess) { fprintf(stderr, "kernel_launch: hipFuncSetAttribute failed\n"); grid = -1; return; }
#endif
        (void)hipGetLastError();
        grid = cus;
    }
    if (grid < 0) return;
    if (hipMemsetAsync((char*)d_ws + WS_CTL, 0, CTL_ZERO_BYTES, stream) != hipSuccess) return;
    Args a{};
    for (int i = 0; i < 34; ++i) a.in[i] = (const float*)d_in[i];
    a.out = (float*)d_out; a.ws = (unsigned char*)d_ws;
#if N_LAUNCH_MODE == 1
    launch_from<0>(grid, stream, a);
#else
    hipLaunchKernelGGL((fwd_kernel<0, N_PHASES>), dim3(grid), dim3(NTHR), LDS_BYTES, stream, a);
#endif
    const hipError_t le = hipPeekAtLastError();
    if (le != hipSuccess) fprintf(stderr, "kernel_launch: launch failed: %s\n", hipGetErrorName(le));
}
```

```cpp
#include <hip/hip_runtime.h>
#include <hip/hip_bf16.h>
#include <cstdio>
#include <cstdint>
#include <cmath>
namespace pg8 {
__device__ __forceinline__ int pg8_lane_fresh() { unsigned m = ~0u; asm volatile("" : "+s"(m)); return (int)__builtin_amdgcn_mbcnt_hi(m, __builtin_amdgcn_mbcnt_lo(m, 0u)); }
#define PG8_LAS __attribute__((address_space(3)))
typedef unsigned short bf16_t;
typedef short bf16x8 __attribute__((ext_vector_type(8)));
typedef float f32x4 __attribute__((ext_vector_type(4)));
typedef unsigned u32x4 __attribute__((ext_vector_type(4)));
typedef unsigned u32x2 __attribute__((ext_vector_type(2)));
constexpr int BM = 256, BK = 64, HALF = 128, HTB = HALF * BK * 2  , STAGE_BYTES = 8 * HTB, NXCD = 8, WGM = 8;

__host__ __device__ __forceinline__ int lds_byte(int r, int c) { const int st = (r >> 4) * 2 + (c >> 5), rr = r & 15, cc = c & 31, ob = rr * 64 + cc * 2; return st * 1024 + (ob ^ (((ob >> 9) & 1) << 5)); }
__host__ __device__ __forceinline__ void stage_rc(int b, int& R, int& C) { const int st = b / 1024, sb = b % 1024, swz = sb ^ (((sb >> 9) & 1) << 5); R = (st >> 1) * 16 + swz / 64; C = (st & 1) * 32 + (swz % 64) / 2; }
__host__ __device__ __forceinline__ int perm32(int rho) { const int n = rho >> 4, i = rho & 15; return 8 * (i >> 2) + 4 * n + (i & 3); }

struct Unit { int pm, pn; size_t aoff, boff; int gbase, nvalid, orow0, e; };
struct Gemm { const bf16_t* A; const bf16_t* Bt; int K; };

__device__ __forceinline__ int xcd_remap(int wgid, int nwg) { const int q = nwg / NXCD, r = nwg % NXCD, xcd = wgid % NXCD, off = wgid / NXCD; return (xcd < r ? xcd * (q + 1) : r * (q + 1) + (xcd - r) * q) + off; }

struct DenseOrder {
    int nM, nN, nwg, G, c, K, skip9;
    static constexpr bool GATHER = false;
    __device__ void init(int M, int N, int K_, int G_, int c_, int skip9_ = 0) { skip9 = skip9_; nM = skip9 ? (M / BM) * 8 / 9 : M / BM; nN = N / BM; nwg = nM * nN; G = G_; c = c_; K = K_; }
    __device__ bool next(int i, Unit& u) const {
        const long L = (long)i * G + c; if (L >= nwg) return false;
        const int wgid = xcd_remap((int)L, nwg);
        const int nig = WGM * nN, gid = wgid / nig, fm = gid * WGM, gsz = (nM - fm) < WGM ? (nM - fm) : WGM;
        u.pm = fm + ((wgid % nig) % gsz); u.pn = (wgid % nig) / gsz;
        if (skip9) u.pm = u.pm + u.pm / 8 + 1;
        u.aoff = (size_t)u.pm * BM * K * 2; u.boff = (size_t)u.pn * BM * K * 2; u.gbase = 0; u.nvalid = BM; u.orow0 = u.pm * BM; u.e = 0; return true;
    }
    __device__ __forceinline__ int token(const Unit&, int) const { return 0; }
};

__device__ __forceinline__ unsigned cvt_pk_bf16(float lo, float hi) { unsigned r; asm volatile("v_cvt_pk_bf16_f32 %0, %1, %2" : "=v"(r) : "v"(lo), "v"(hi)); return r; }

template <class Epi, class Sched>
__device__ __forceinline__ void gemm_phase(PG8_LAS unsigned char* lds, const Gemm g, const Sched& S, const Epi& E, int wave_id) {
    int tid = (wave_id << 6) | pg8_lane_fresh(); asm volatile("" : "+v"(tid));
    const int wid = __builtin_amdgcn_readfirstlane(tid >> 6), lane = tid & 63, wr = wid >> 2, wc = wid & 3, fr = lane & 15, fq = lane >> 4;
    const int K = g.K, nt = K / BK;
    int RA[2], CA[2];
    unsigned voffB[2], voffA[2][2], voffAn[2][2];
#pragma unroll
    for (int i = 0; i < 2; ++i) { int R, C; stage_rc(tid * 16 + i * 8192, R, C); RA[i] = R; CA[i] = C; const int Rb = Epi::PERM ? ((R & ~31) + perm32(R & 31)) : R;
        voffB[i] = (unsigned)(Rb * K + C) * 2u;
        voffA[0][i] = (unsigned)(R * K + C) * 2u; voffA[1][i] = (unsigned)((R + HALF) * K + C) * 2u; voffAn[0][i] = voffA[0][i]; voffAn[1][i] = voffA[1][i]; }
    const size_t kstep = (size_t)(BK * 2);
    const size_t hstep = (size_t)HALF * K * 2;
    const unsigned ldsw = (unsigned)wid * 1024u;
    const int aoff = lds_byte(wr * 64 + fr, fq * 8), boff = lds_byte(wc * 32 + fr, fq * 8);
#define PG8_SA(b, h) (((b) * 2 + (h)) * HTB)
#define PG8_SB(b, h) ((4 + (b) * 2 + (h)) * HTB)
#define PG8_STAGE(bufoff, gbase, voff) do { _Pragma("unroll") for (int _i = 0; _i < 2; ++_i) \
        __builtin_amdgcn_global_load_lds((const unsigned*)((const char*)(gbase) + (voff)[_i]), (PG8_LAS unsigned*)(lds + (bufoff) + ldsw + _i * 8192), 16, 0, 0); } while (0)
#define PG8_LDA(dst, b, h) do { _Pragma("unroll") for (int m = 0; m < 4; ++m) _Pragma("unroll") for (int k = 0; k < 2; ++k) dst[m][k] = *(const PG8_LAS bf16x8*)(lds + PG8_SA(b, h) + aoff + m * 2048 + k * 1024); } while (0)
#define PG8_LDB(dst, b, h) do { _Pragma("unroll") for (int n = 0; n < 2; ++n) _Pragma("unroll") for (int k = 0; k < 2; ++k) dst[n][k] = *(const PG8_LAS bf16x8*)(lds + PG8_SB(b, h) + boff + n * 2048 + k * 1024); } while (0)
#define PG8_MMA(ai, bj, At, Bt) do { __builtin_amdgcn_s_setprio(1); _Pragma("unroll") for (int m = 0; m < 4; ++m) _Pragma("unroll") for (int n = 0; n < 2; ++n) _Pragma("unroll") for (int k = 0; k < 2; ++k) \
        acc[ai][bj][m][n] = __builtin_amdgcn_mfma_f32_16x16x32_bf16(Bt[n][k], At[m][k], acc[ai][bj][m][n], 0, 0, 0); __builtin_amdgcn_s_setprio(0); } while (0)
#define PG8_WAIT_V(n) asm volatile("s_waitcnt vmcnt(" #n ")" ::: "memory")
#define PG8_WAIT_L(n) asm volatile("s_waitcnt lgkmcnt(" #n ")" ::: "memory")
#define PG8_BAR __builtin_amdgcn_s_barrier()
#define PG8_SCHED __builtin_amdgcn_sched_barrier(0)
#define PG8_GOFF(dst, U) do { if constexpr (Sched::GATHER) { _Pragma("unroll") for (int _h = 0; _h < 2; ++_h) _Pragma("unroll") for (int _i = 0; _i < 2; ++_i) \
        dst[_h][_i] = (unsigned)(S.token(U, _h * HALF + RA[_i]) * K + CA[_i]) * 2u; } } while (0)
    Unit cur, nxt; int ui = 0;
    if (!S.next(0, cur)) return;
    f32x4 acc[2][2][4][2];
#pragma unroll
    for (int a = 0; a < 2; ++a)
#pragma unroll
        for (int b = 0; b < 2; ++b)
#pragma unroll
            for (int m = 0; m < 4; ++m)
#pragma unroll
                for (int n = 0; n < 2; ++n) acc[a][b][m][n] = (f32x4){0.f, 0.f, 0.f, 0.f};
    bf16x8 At[4][2], B0[2][2], B1[2][2];
    typename Epi::Pre pre; E.prefetch(pre, cur, wr, fr);
    PG8_GOFF(voffA, cur);
    const char* cA = (const char*)g.A + (Sched::GATHER ? (size_t)0 : cur.aoff); const char* cB = (const char*)g.Bt + cur.boff;
    PG8_STAGE(PG8_SB(0, 0), cB, voffB); PG8_STAGE(PG8_SA(0, 0), cA, voffA[0]); PG8_STAGE(PG8_SB(0, 1), cB + hstep, voffB); PG8_STAGE(PG8_SA(0, 1), cA, voffA[1]);
    if (wr == 1) PG8_BAR;
    PG8_WAIT_V(4); PG8_BAR;
    PG8_STAGE(PG8_SB(1, 0), cB + kstep, voffB); PG8_STAGE(PG8_SA(1, 0), cA + kstep, voffA[0]); PG8_STAGE(PG8_SB(1, 1), cB + hstep + kstep, voffB);
    PG8_WAIT_V(6); PG8_BAR;
    for (;;) {
        const bool has_next = S.next(ui + 1, nxt);
        if (has_next) { PG8_GOFF(voffAn, nxt); if constexpr (Sched::GATHER) { asm volatile("" : "+v"(voffAn[0][0]), "+v"(voffAn[0][1]), "+v"(voffAn[1][0]), "+v"(voffAn[1][1])); } }
        const char* nA = has_next ? (const char*)g.A + (Sched::GATHER ? (size_t)0 : nxt.aoff) : cA; const char* nB = has_next ? (const char*)g.Bt + nxt.boff : cB;
        for (int t = 0; t < nt; t += 2) {
            const bool last = (t == nt - 2);
            const char* a1 = cA + (size_t)(t + 1) * kstep;
            const char* a2 = last ? nA : cA + (size_t)(t + 2) * kstep; const char* b2 = last ? nB : cB + (size_t)(t + 2) * kstep;
            const char* a3 = a2 + kstep; const char* b3 = b2 + kstep;
            unsigned va2[2][2];
#pragma unroll
            for (int h = 0; h < 2; ++h)
#pragma unroll
                for (int i = 0; i < 2; ++i) va2[h][i] = (Sched::GATHER && last && has_next) ? voffAn[h][i] : voffA[h][i];
            PG8_LDB(B0, 0, 0); PG8_SCHED; PG8_LDA(At, 0, 0); PG8_STAGE(PG8_SA(1, 1), a1, voffA[1]);
            PG8_WAIT_L(8); PG8_BAR; PG8_WAIT_L(0); PG8_MMA(0, 0, At, B0); PG8_BAR; PG8_SCHED;
            PG8_LDB(B1, 0, 1); PG8_STAGE(PG8_SB(0, 0), b2, voffB);
            PG8_BAR; PG8_WAIT_L(0); PG8_MMA(0, 1, At, B1); PG8_BAR;
            PG8_LDA(At, 0, 1); PG8_STAGE(PG8_SA(0, 0), a2, va2[0]);
            PG8_BAR; PG8_WAIT_L(0); PG8_MMA(1, 0, At, B0); PG8_BAR; PG8_SCHED;
            PG8_STAGE(PG8_SB(0, 1), b2 + hstep, voffB);
            PG8_WAIT_V(6); PG8_BAR; PG8_MMA(1, 1, At, B1); PG8_BAR;
            PG8_LDB(B0, 1, 0); PG8_SCHED; PG8_LDA(At, 1, 0); PG8_STAGE(PG8_SA(0, 1), a2, va2[1]);
            PG8_WAIT_L(8); PG8_BAR; PG8_WAIT_L(0); PG8_MMA(0, 0, At, B0); PG8_BAR; PG8_SCHED;
            PG8_LDB(B1, 1, 1); PG8_STAGE(PG8_SB(1, 0), b3, voffB);
            PG8_BAR; PG8_WAIT_L(0); PG8_MMA(0, 1, At, B1); PG8_BAR;
            PG8_LDA(At, 1, 1); PG8_STAGE(PG8_SA(1, 0), a3, va2[0]);
            PG8_BAR; PG8_WAIT_L(0); PG8_MMA(1, 0, At, B0); PG8_BAR; PG8_SCHED;
            PG8_STAGE(PG8_SB(1, 1), b3 + hstep, voffB);
            PG8_WAIT_V(6); PG8_BAR; PG8_MMA(1, 1, At, B1); PG8_BAR;
        }
        E(acc, cur, wr, wc, fr, fq, pre);
        if (!has_next) break;
#pragma unroll
        for (int a = 0; a < 2; ++a)
#pragma unroll
            for (int b = 0; b < 2; ++b)
#pragma unroll
                for (int m = 0; m < 4; ++m)
#pragma unroll
                    for (int n = 0; n < 2; ++n) acc[a][b][m][n] = (f32x4){0.f, 0.f, 0.f, 0.f};
        cur = nxt; cA = nA; cB = nB; ++ui;
        E.prefetch(pre, cur, wr, fr);
        if constexpr (Sched::GATHER) {
#pragma unroll
            for (int h = 0; h < 2; ++h)
#pragma unroll
                for (int i = 0; i < 2; ++i) voffA[h][i] = voffAn[h][i];
        }
    }
    PG8_WAIT_V(0);
    if (wr == 0) PG8_BAR;
    PG8_BAR;
#undef PG8_SA
#undef PG8_SB
#undef PG8_STAGE
#undef PG8_LDA
#undef PG8_LDB
#undef PG8_MMA
#undef PG8_WAIT_V
#undef PG8_WAIT_L
#undef PG8_BAR
#undef PG8_SCHED
#undef PG8_GOFF
}
}
namespace att {
using bf16x8 = __attribute__((ext_vector_type(8))) short;
using s16x4  = __attribute__((ext_vector_type(4))) short;
using f32x16 = __attribute__((ext_vector_type(16))) float;
using u32x4  = __attribute__((ext_vector_type(4))) unsigned;
typedef unsigned short bf16_t;
constexpr int NW = 8, QBLK = 32, KVBLK = 64;
constexpr float THR = 8.f;
constexpr size_t SHM_V = KVBLK * 128 * 2, SHM_K = KVBLK * 128 * 2, SHM_ATTN = 3 * SHM_V + 3 * SHM_K + NW * 64 * 4;
#define KSWZ(row, colB) ((row) * 256 + ((colB) ^ (((row) & 7) << 4)))
#define KSWZ64(row, colB) ((row) * 128 + ((colB) ^ ((((row) >> 1) & 7) << 4)))
#define SBAR() __builtin_amdgcn_sched_barrier(0)
__device__ __forceinline__ int crow(int r, int hi) { return (r & 3) + 8 * (r >> 2) + 4 * hi; }
__device__ __forceinline__ unsigned cvtpk(float lo, float hi) { unsigned r; asm volatile("v_cvt_pk_bf16_f32 %0, %1, %2" : "=v"(r) : "v"(lo), "v"(hi)); return r; }

template <int DQK> struct Sc { static constexpr float SCALE = (DQK == 64) ? 0.125f : 0.088388347648318440f; };

template <int DQK>
__device__ __forceinline__ void partialSM(f32x16& p0, f32x16& p1, float& m_reg, float& mn, float& alpha) {
  constexpr float SCALE = Sc<DQK>::SCALE;
  constexpr float C = SCALE * 1.4426950408889634f;
  float pmax = p0[0];
#pragma unroll
  for (int r = 1; r < 16; ++r) pmax = fmaxf(pmax, p0[r]);
#pragma unroll
  for (int r = 0; r < 16; ++r) pmax = fmaxf(pmax, p1[r]);
  { auto rr = __builtin_amdgcn_permlane32_swap(__float_as_uint(pmax), __float_as_uint(pmax), false, false);
    pmax = fmaxf(__uint_as_float(rr[0]), __uint_as_float(rr[1])); }
  if (__builtin_expect(__all(pmax - m_reg <= THR / SCALE), 1)) { mn = m_reg; alpha = 1.f; }
  else { mn = fmaxf(m_reg, pmax); alpha = __builtin_amdgcn_exp2f((m_reg - mn) * C); m_reg = mn; }
  float mnC = -mn * C;
#pragma unroll
  for (int r = 0; r < 16; ++r) p0[r] = fmaf(p0[r], C, mnC);
#pragma unroll
  for (int r = 0; r < 16; ++r) p1[r] = fmaf(p1[r], C, mnC);
#pragma unroll
  for (int r = 0; r < 16; ++r) p0[r] = __builtin_amdgcn_exp2f(p0[r]);
}
__device__ __forceinline__ void finishSM(f32x16& p0, f32x16& p1, float alpha, float& l_reg, bf16x8& pa0, bf16x8& pa1, bf16x8& pa2, bf16x8& pa3) {
#pragma unroll
  for (int r = 0; r < 16; ++r) p1[r] = __builtin_amdgcn_exp2f(p1[r]);
  float ps = 0;
#pragma unroll
  for (int r = 0; r < 16; ++r) ps += p0[r];
#pragma unroll
  for (int r = 0; r < 16; ++r) ps += p1[r];
  { auto rr = __builtin_amdgcn_permlane32_swap(__float_as_uint(ps), __float_as_uint(ps), false, false);
    ps = __uint_as_float(rr[0]) + __uint_as_float(rr[1]); }
  l_reg = l_reg * alpha + ps;
#define PK4(P, BASE, OUT) do { unsigned a0 = cvtpk(P[BASE + 0], P[BASE + 1]), a1 = cvtpk(P[BASE + 2], P[BASE + 3]);   \
    unsigned b0 = cvtpk(P[BASE + 4], P[BASE + 5]), b1 = cvtpk(P[BASE + 6], P[BASE + 7]);                              \
    auto r0 = __builtin_amdgcn_permlane32_swap(a0, b0, false, false); auto r1 = __builtin_amdgcn_permlane32_swap(a1, b1, false, false); \
    u32x4 w = {r0[0], r1[0], r0[1], r1[1]}; OUT = *reinterpret_cast<bf16x8*>(&w); } while (0)
  PK4(p0, 0, pa0); PK4(p0, 8, pa1); PK4(p1, 0, pa2); PK4(p1, 8, pa3);
#undef PK4
}
template <int DQK>
__device__ __forceinline__ void qkt(f32x16& p0, f32x16& p1, const char* Ks, const bf16x8* qr, int r32, int hi) {
#pragma unroll
  for (int r = 0; r < 16; ++r) { p0[r] = 0.f; p1[r] = 0.f; }
  asm volatile("" : "+v"(p0), "+v"(p1));
#pragma unroll
  for (int d0 = 0; d0 < DQK / 16; ++d0) { const int cb = (d0 * 16 + hi * 8) * 2;
    bf16x8 b0, b1;
    if constexpr (DQK == 128) { b0 = *reinterpret_cast<const bf16x8*>(Ks + KSWZ(r32, cb)); b1 = *reinterpret_cast<const bf16x8*>(Ks + KSWZ(32 + r32, cb)); }
    else { b0 = *reinterpret_cast<const bf16x8*>(Ks + KSWZ64(r32, cb)); b1 = *reinterpret_cast<const bf16x8*>(Ks + KSWZ64(32 + r32, cb)); }
    p0 = __builtin_amdgcn_mfma_f32_32x32x16_bf16(b0, qr[d0], p0, 0, 0, 0);
    p1 = __builtin_amdgcn_mfma_f32_32x32x16_bf16(b1, qr[d0], p1, 0, 0, 0); }
}
__device__ __forceinline__ int v_st(int k, int c) { const int kk = (k & ~0xC) | ((k & 4) << 1) | ((k & 8) >> 1); return ((kk >> 3) * 4 + (c >> 5)) * 512 + ((kk & 7) * 32 + (c & 31)) * 2; }
__device__ __forceinline__ int v_rd_base(int lane) { return ((lane & 3) << 3) | (((lane >> 2) & 3) << 6) | (((lane >> 4) & 1) << 5) | (((lane >> 5) & 1) << 8); }
constexpr int v_rd_off(int d0, int ks, int half) { return d0 * 512 + ks * 4096 + half * 2048; }
template <int OFF> __device__ __forceinline__ s16x4 tr_read(int vb) {
  s16x4 r; asm volatile("ds_read_b64_tr_b16 %0, %1 offset:%2" : "=&v"(r) : "v"(vb), "i"(OFF) : "memory"); return r;
}
template <int D0> __device__ __forceinline__ void pv_one(f32x16& od, int vb, bf16x8 pa0, bf16x8 pa1, bf16x8 pa2, bf16x8 pa3) {
  const s16x4 l0 = tr_read<v_rd_off(D0, 0, 0)>(vb), h0 = tr_read<v_rd_off(D0, 0, 1)>(vb), l1 = tr_read<v_rd_off(D0, 1, 0)>(vb), h1 = tr_read<v_rd_off(D0, 1, 1)>(vb);
  const s16x4 l2 = tr_read<v_rd_off(D0, 2, 0)>(vb), h2 = tr_read<v_rd_off(D0, 2, 1)>(vb), l3 = tr_read<v_rd_off(D0, 3, 0)>(vb), h3 = tr_read<v_rd_off(D0, 3, 1)>(vb);
  asm volatile("s_waitcnt lgkmcnt(0)" ::: "memory"); SBAR();
#define PK(L, H) (bf16x8){L[0], L[1], L[2], L[3], H[0], H[1], H[2], H[3]}
  od = __builtin_amdgcn_mfma_f32_32x32x16_bf16(pa0, PK(l0, h0), od, 0, 0, 0);
  od = __builtin_amdgcn_mfma_f32_32x32x16_bf16(pa1, PK(l1, h1), od, 0, 0, 0);
  od = __builtin_amdgcn_mfma_f32_32x32x16_bf16(pa2, PK(l2, h2), od, 0, 0, 0);
  od = __builtin_amdgcn_mfma_f32_32x32x16_bf16(pa3, PK(l3, h3), od, 0, 0, 0);
#undef PK
}
__device__ __forceinline__ void pv_d0(f32x16* o, int vb, bf16x8 pa0, bf16x8 pa1, bf16x8 pa2, bf16x8 pa3) {
  pv_one<0>(o[0], vb, pa0, pa1, pa2, pa3); pv_one<1>(o[1], vb, pa0, pa1, pa2, pa3); pv_one<2>(o[2], vb, pa0, pa1, pa2, pa3); pv_one<3>(o[3], vb, pa0, pa1, pa2, pa3);
}

template <int DQK, int LDQ, int LDK, int LDO, bool QN = false>
__device__ __forceinline__ void attn_body(const bf16_t* __restrict__ Qb, const bf16_t* __restrict__ Kh, const bf16_t* __restrict__ Vh, bf16_t* __restrict__ Ob, int seq, char* lds, int wave_id,
                                          const float* qg = nullptr, const float* cs = nullptr, const float* sn = nullptr, int qpos0 = 0, float qeps = 0.f) {
  unsigned lm_ = ~0u; asm volatile("" : "+s"(lm_)); int tid = (wave_id << 6) | (int)__builtin_amdgcn_mbcnt_hi(lm_, __builtin_amdgcn_mbcnt_lo(lm_, 0u)); asm volatile("" : "+v"(tid));
  const int wid = tid >> 6, lane = tid & 63, r32 = lane & 31, hi = lane >> 5;
  char* V_lds = lds; char* K_lds = lds + 3 * SHM_V;
  float* ws = (float*)(lds + 3 * SHM_V + 3 * SHM_K) + wid * 64; float* li_l = ws; float* al_l = ws + 32;
  float m_reg = -1e30f, l_reg = 0; f32x16 o[4] = {}; bf16x8 qr[DQK / 16];
  const bf16_t* Qw = Qb + (long)(wid * QBLK + r32) * LDQ + hi * 8;
#pragma unroll
  for (int d0 = 0; d0 < DQK / 16; ++d0) qr[d0] = *reinterpret_cast<const bf16x8*>(Qw + d0 * 16);
  if constexpr (QN) {
    static_assert(!QN || DQK == 128, "QN needs head dim 128");
    float qf[8][8]; float ss = 0.f;
#pragma unroll
    for (int d0 = 0; d0 < 8; ++d0)
#pragma unroll
      for (int j = 0; j < 8; ++j) { const float v = __builtin_bit_cast(float, (unsigned)(unsigned short)qr[d0][j] << 16); qf[d0][j] = v; ss += v * v; }
    { auto rr = __builtin_amdgcn_permlane32_swap(__float_as_uint(ss), __float_as_uint(ss), false, false); ss = __uint_as_float(rr[0]) + __uint_as_float(rr[1]); }
    const float ri = __builtin_amdgcn_rsqf(ss * (1.f / 128.f) + qeps);
    const int pos = qpos0 + wid * QBLK + r32;
#pragma unroll
    for (int d0 = 0; d0 < 4; ++d0) {
      const int i0 = 16 * d0 + 8 * hi;
#pragma unroll
      for (int j = 0; j < 8; ++j) { const float c = cs[pos * 64 + i0 + j], s = sn[pos * 64 + i0 + j];
        const float y1 = qf[d0][j] * ri * qg[i0 + j], y2 = qf[d0 + 4][j] * ri * qg[64 + i0 + j];
        qf[d0][j] = y1 * c - y2 * s; qf[d0 + 4][j] = y1 * s + y2 * c; }
    }
#pragma unroll
    for (int d0 = 0; d0 < 8; ++d0) { u32x4 w = {cvtpk(qf[d0][0], qf[d0][1]), cvtpk(qf[d0][2], qf[d0][3]), cvtpk(qf[d0][4], qf[d0][5]), cvtpk(qf[d0][6], qf[d0][7])}; qr[d0] = *reinterpret_cast<bf16x8*>(&w); }
  }
  const int sr = tid >> 4, sc = (tid & 15) * 8, vst0 = v_st(sr, sc), vst1 = v_st(32 + sr, sc);
  const int kr64 = tid >> 3, kc64 = (tid & 7) * 8;
  const int vb0 = (int)(uintptr_t)V_lds + v_rd_base(lane);
  struct { bf16x8 vs0, vs1, ks0, ks1; } sr_[2];
#define SLOAD(i, k0) do { sr_[i].vs0 = *reinterpret_cast<const bf16x8*>(&Vh[(long)((k0) + sr) * LDK + sc]); sr_[i].vs1 = *reinterpret_cast<const bf16x8*>(&Vh[(long)((k0) + 32 + sr) * LDK + sc]); \
    if constexpr (DQK == 128) { sr_[i].ks0 = *reinterpret_cast<const bf16x8*>(&Kh[(long)((k0) + sr) * LDK + sc]); sr_[i].ks1 = *reinterpret_cast<const bf16x8*>(&Kh[(long)((k0) + 32 + sr) * LDK + sc]); } \
    else { sr_[i].ks0 = *reinterpret_cast<const bf16x8*>(&Kh[(long)((k0) + kr64) * LDK + kc64]); } } while (0)
#define SWRITE(b, i) do { *(bf16x8*)(V_lds + (b) * SHM_V + vst0) = sr_[i].vs0;          \
    *(bf16x8*)(V_lds + (b) * SHM_V + vst1) = sr_[i].vs1;               \
    if constexpr (DQK == 128) { const int kc = sc * 2; *(bf16x8*)(K_lds + (b) * SHM_K + KSWZ(sr, kc)) = sr_[i].ks0; *(bf16x8*)(K_lds + (b) * SHM_K + KSWZ(32 + sr, kc)) = sr_[i].ks1; } \
    else { const int kc = kc64 * 2; *(bf16x8*)(K_lds + (b) * SHM_K + KSWZ64(kr64, kc)) = sr_[i].ks0; } } while (0)
#define SWAIT() do { if constexpr (DQK == 128) asm volatile("s_waitcnt vmcnt(4)" ::: "memory"); else asm volatile("s_waitcnt vmcnt(3)" ::: "memory"); } while (0)
#define RESC(a) do { if (__any((a) < 1.f)) { if (hi == 0) al_l[r32] = (a); asm volatile("s_waitcnt lgkmcnt(0)" ::: "memory"); \
    _Pragma("unroll") for (int d = 0; d < 4; ++d) _Pragma("unroll") for (int r = 0; r < 16; ++r) o[d][r] *= al_l[crow(r, hi)]; } } while (0)
  f32x16 pA0, pA1, pB0, pB1; float mnA, mnB, alA, alB; bf16x8 pa0, pa1, pa2, pa3; const int NT = seq / KVBLK;
  SLOAD(0, 0); asm volatile("s_waitcnt vmcnt(0)" ::: "memory"); SWRITE(0, 0);
  SLOAD(1, KVBLK);
  __syncthreads();
  SWRITE(1, 1);
  qkt<DQK>(pA0, pA1, K_lds, qr, r32, hi); if (2 < NT) SLOAD(0, 2 * KVBLK); partialSM<DQK>(pA0, pA1, m_reg, mnA, alA);
  __syncthreads();
  int s_prev = 0, s_cur = 1, s_next = 2;
#define ROT3() do { const int t_ = s_prev; s_prev = s_cur; s_cur = s_next; s_next = t_; } while (0)
  for (int j = 1; j + 1 < NT; j += 2) {
    SWRITE(s_next, 0);
    SBAR(); qkt<DQK>(pB0, pB1, K_lds + s_cur * SHM_K, qr, r32, hi);
    finishSM(pA0, pA1, alA, l_reg, pa0, pa1, pa2, pa3); SBAR();
    SLOAD(1, (j + 2) * KVBLK); SBAR();
    pv_d0(o, vb0 + s_prev * (int)SHM_V, pa0, pa1, pa2, pa3); partialSM<DQK>(pB0, pB1, m_reg, mnB, alB);
    RESC(alB); __syncthreads(); ROT3();
    SWRITE(s_next, 1);
    SBAR(); qkt<DQK>(pA0, pA1, K_lds + s_cur * SHM_K, qr, r32, hi);
    finishSM(pB0, pB1, alB, l_reg, pa0, pa1, pa2, pa3); SBAR();
    if (j + 3 < NT) SLOAD(0, (j + 3) * KVBLK); SBAR();
    pv_d0(o, vb0 + s_prev * (int)SHM_V, pa0, pa1, pa2, pa3); partialSM<DQK>(pA0, pA1, m_reg, mnA, alA);
    RESC(alA); __syncthreads(); ROT3();
  }
  SBAR(); qkt<DQK>(pB0, pB1, K_lds + s_cur * SHM_K, qr, r32, hi);
  finishSM(pA0, pA1, alA, l_reg, pa0, pa1, pa2, pa3); SBAR();
  pv_d0(o, vb0 + s_prev * (int)SHM_V, pa0, pa1, pa2, pa3); partialSM<DQK>(pB0, pB1, m_reg, mnB, alB);
  RESC(alB);
  finishSM(pB0, pB1, alB, l_reg, pa0, pa1, pa2, pa3); SBAR();
  pv_d0(o, vb0 + s_cur * (int)SHM_V, pa0, pa1, pa2, pa3);
#undef ROT3
  if (hi == 0) li_l[r32] = l_reg; asm volatile("s_waitcnt lgkmcnt(0)" ::: "memory");
  float rli[16];
#pragma unroll
  for (int r = 0; r < 16; ++r) rli[r] = __builtin_amdgcn_rcpf(li_l[crow(r, hi)]);
  bf16_t* Ow = Ob + (long)(wid * QBLK) * LDO;
#pragma unroll
  for (int r = 0; r < 16; ++r) { const int orow = crow(r, hi);
#pragma unroll
    for (int d0 = 0; d0 < 4; ++d0) { const float v = o[d0][r] * rli[r]; Ow[(long)orow * LDO + d0 * 32 + r32] = (bf16_t)(cvtpk(v, v) & 0xffffu); } }
  __syncthreads();
#undef SLOAD
#undef SWRITE
#undef SWAIT
#undef RESC
}
#undef SBAR
}
constexpr int NWAVES = 8, NTHR = 512;
constexpr int NB = 8, SEQ = 2048, CTXL = 256, TPB = CTXL + SEQ  , MROWS = NB * TPB  , DM = 1024;
constexpr int A_W = 512, A_IN = 1920, B_IN = 1536, EVEN_IN = 3456, EVEN_PAD = 3584, ODD_IN = 1536;
constexpr int NEXP = 16, EFF = 512, CAP = MROWS, MOE_ROWS = 40960;
constexpr float LN_EPS = 1e-5f, ALPHA = 1.4142135623730951f, GN_EPS = 64e-5f, SUBLN_EPS = 1e-5f, QKN_EPS = 1e-6f, LAMBDA_INIT0 = 0.2f;

constexpr size_t MiB = 1u << 20;
constexpr size_t WS_CTL = 0, CTL_ZERO_BYTES = 1 * MiB + 512 * 1024;
constexpr size_t WS_MOD = 1 * MiB;
constexpr size_t WS_ROPE = 2 * MiB;
constexpr size_t WS_WEVIN = 4 * MiB, WS_WEVOUT = 11 * MiB, WS_WODIN = 13 * MiB, WS_WODOUT = 16 * MiB;
constexpr size_t WS_WM13 = 18 * MiB, WS_WM2 = 50 * MiB;
constexpr size_t WS_H = 66 * MiB;
constexpr size_t WS_X = 102 * MiB;
constexpr size_t CH_BYTES = (size_t)4608 * 64 * 64 * 2;
constexpr size_t WS_CHG = 18 * MiB, WS_CHH = 54 * MiB, WS_CHRQ = 90 * MiB, WS_CHY = 126 * MiB;
constexpr size_t FEAT_BYTES = (size_t)MROWS * 512 * 2;
constexpr size_t WS_VOUT = 162 * MiB, WS_GOUT = 180 * MiB;
constexpr size_t WS_PA = 198 * MiB;
constexpr size_t WS_PB = 270 * MiB;
constexpr size_t WS_GL = 324 * MiB;
constexpr size_t WS_BON = WS_GL + (size_t)4608 * 64 * 4;
constexpr size_t WS_LORA = WS_BON + (size_t)2 * MROWS * 8 * 4;
constexpr size_t WS_OB0 = WS_PA, WS_OB1 = WS_PA + FEAT_BYTES;
constexpr size_t WS_A2 = WS_PA + 2 * FEAT_BYTES;
constexpr size_t WS_TAIL = 300 * MiB;
constexpr size_t WS_MIX = WS_TAIL;
constexpr size_t WS_HID = 174 * MiB;
constexpr size_t WS_Y = 214 * MiB;
constexpr size_t WS_QKV1 = 174 * MiB;
constexpr size_t WS_OATT = 228 * MiB;
static_assert(WS_CHY + CH_BYTES <= WS_VOUT && WS_GOUT + FEAT_BYTES <= WS_PA && WS_A2 + 2 * FEAT_BYTES <= WS_PB && WS_PB + (size_t)MROWS * 1536 * 2 <= WS_GL && WS_LORA + 393216 <= 328 * MiB
              && WS_Y + (size_t)MOE_ROWS * 1024 * 2 <= WS_TAIL && WS_OATT + 2 * FEAT_BYTES <= WS_TAIL && WS_MIX + 2 * FEAT_BYTES <= 336 * MiB && WS_A2 >= WS_HID + 40 * MiB - 40 * MiB, "ws map");
constexpr size_t DOUT_LINACT = (size_t)48 * MiB;
constexpr int CW_BAR = 4096;
constexpr int CW_CNT = 16384;
constexpr int CW_QCV = 20608;
constexpr int CW_Q0 = 20480;
constexpr size_t WS_ROUTE = 336 * MiB;
constexpr size_t WS_PERM_ = WS_ROUTE, WS_GATE = WS_ROUTE + (size_t)NEXP * CAP * 4, WS_TOK = WS_GATE + (size_t)NEXP * CAP * 4, WS_TOTAL = WS_TOK + (size_t)MROWS * 2 * 4;
static_assert(WS_TOTAL <= 339 * MiB, "ws total");

constexpr int RING_OFF = 0, RING_BYTES = 147456;
constexpr int LDSCTL_OFF = RING_BYTES, MISC_OFF = LDSCTL_OFF + 320;
constexpr int MOETAB_OFF = LDSCTL_OFF + 1024;
constexpr int LDS_BYTES = 163840;

#define GAS __attribute__((address_space(1)))
#define CAS __attribute__((address_space(4)))
#define LAS __attribute__((address_space(3)))
typedef unsigned short bf16;
typedef unsigned v4u __attribute__((ext_vector_type(4)));
typedef unsigned v2u __attribute__((ext_vector_type(2)));
typedef float f32x4 __attribute__((ext_vector_type(4)));
typedef short bf16x8 __attribute__((ext_vector_type(8)));
typedef GAS unsigned gu32;
#define RLX_AGENT __ATOMIC_RELAXED, __HIP_MEMORY_SCOPE_AGENT
#define LDS_WAIT() asm volatile("s_waitcnt lgkmcnt(0)" ::: "memory")
#define VM_WAIT() asm volatile("s_waitcnt vmcnt(0)" ::: "memory")
__device__ __forceinline__ unsigned pk2(float lo, float hi) { typedef float f32x2_t __attribute__((ext_vector_type(2))); typedef __bf16 bf16x2_t __attribute__((ext_vector_type(2)));
    f32x2_t v = {lo, hi}; bf16x2_t b = __builtin_convertvector(v, bf16x2_t); return __builtin_bit_cast(unsigned, b); }
__device__ __forceinline__ unsigned f2bf(float f) { return pk2(f, 0.f) & 0xffffu; }
__device__ __forceinline__ float bf2f(unsigned short b) { return __builtin_bit_cast(float, (unsigned)b << 16); }
__device__ __forceinline__ float bflo(unsigned w) { return __builtin_bit_cast(float, w << 16); }
__device__ __forceinline__ float bfhi(unsigned w) { return __builtin_bit_cast(float, w & 0xffff0000u); }
__device__ __forceinline__ float sigmoidf_(float x) { return 1.f / (1.f + __expf(-x)); }
__device__ __forceinline__ int lane_id_fresh() { unsigned m = ~0u; asm volatile("" : "+s"(m)); return (int)__builtin_amdgcn_mbcnt_hi(m, __builtin_amdgcn_mbcnt_lo(m, 0u)); }
template <int CTRL> __device__ __forceinline__ float dpp_f(float v) { return __builtin_bit_cast(float, __builtin_amdgcn_update_dpp(0, __builtin_bit_cast(int, v), CTRL, 0xF, 0xF, false)); }
__device__ __forceinline__ float sum4(float v) { v += dpp_f<0xB1>(v); v += dpp_f<0x4E>(v); return v; }
__device__ __forceinline__ float sum8(float v) { v = sum4(v); v += dpp_f<0x141>(v); return v; }
__device__ __forceinline__ float sum16(float v) { v = sum8(v); v += dpp_f<0x140>(v); return v; }
__device__ __forceinline__ float wave_sum(float v) {
    v = sum16(v);
    v += __builtin_bit_cast(float, __builtin_amdgcn_update_dpp(0, __builtin_bit_cast(int, v), 0x142, 0xA, 0xF, false));
    v += __builtin_bit_cast(float, __builtin_amdgcn_update_dpp(0, __builtin_bit_cast(int, v), 0x143, 0xC, 0xF, false));
    return __builtin_bit_cast(float, __builtin_amdgcn_readlane(__builtin_bit_cast(int, v), 63));
}

#define XB_TMO      128
#define XB_XCNT(j)  (256  + 64 * (j))
#define XB_XSUB(j)  (1280 + 64 * (j))
#define XB_XGEN(j)  (2304 + 64 * (j))
#define XB_TOP      3328
#define XB_TOPGEN   3392
#define XCD_BAR_WORDS 3456
#define XB_SPIN_CAP (1u << 22)
__device__ __forceinline__ unsigned xb_ld(unsigned* p)              { return __hip_atomic_load(p, __ATOMIC_RELAXED, __HIP_MEMORY_SCOPE_AGENT); }
__device__ __forceinline__ unsigned xb_add(unsigned* p, unsigned v) { return __hip_atomic_fetch_add(p, v, __ATOMIC_RELAXED, __HIP_MEMORY_SCOPE_AGENT); }
__device__ __forceinline__ unsigned xb_xcc_id() { return (unsigned)__builtin_amdgcn_s_getreg((3 << 11) | 20) & 0xFu; }
#define XB_SPIN(cond, bar) do { unsigned _sp = 0; while (cond) { __builtin_amdgcn_s_sleep(1); \
    if ((++_sp & 255u) == 0u) { if (xb_ld(&(bar)[XB_TMO])) break; if (_sp > XB_SPIN_CAP) { atomicAdd(&(bar)[XB_TMO], 1u); break; } } } } while (0)
struct XcdBarrier { unsigned* bar; unsigned x; volatile LAS unsigned* st; };
__device__ __forceinline__ XcdBarrier xcd_barrier_post(unsigned* bar, volatile LAS unsigned* st) {
    XcdBarrier b; b.bar = bar; b.x = xb_xcc_id(); b.st = st;
    if (threadIdx.x == 0) (void)xb_add(&bar[XB_XCNT(b.x)], 1u);
    return b;
}
__device__ __forceinline__ void xcd_barrier_complete(unsigned* bar, unsigned x, unsigned& nloc, unsigned& nx) {
    const unsigned G = gridDim.x * gridDim.y * gridDim.z;
    unsigned sum, cnt, mine, sp = 0u;
    for (;;) {
        sum = 0u; cnt = 0u; mine = 0u;
#pragma unroll
        for (unsigned j = 0; j < 16; ++j) { const unsigned c = xb_ld(&bar[XB_XCNT(j)]); sum += c; cnt += (c > 0u) ? 1u : 0u; mine = (j == x) ? c : mine; }
        if (sum == G) break;
        __builtin_amdgcn_s_sleep(1);
        if ((++sp & 255u) == 0u) { if (xb_ld(&bar[XB_TMO])) break; if (sp > XB_SPIN_CAP) { atomicAdd(&bar[XB_TMO], 1u); break; } }
    }
    nloc = mine > 0u ? mine : 1u; nx = cnt > 0u ? cnt : 1u;
}
__device__ __forceinline__ void xcd_barrier(const XcdBarrier& b, int wave_id) {
    asm volatile("s_waitcnt vmcnt(0)" ::: "memory");
    __syncthreads();
    if (wave_id == 0 && lane_id_fresh() == 0) {
        unsigned* bar = b.bar;
        __builtin_amdgcn_s_waitcnt(0);
        unsigned nloc = b.st[0], nx = b.st[1];
        if (nloc == 0u) { xcd_barrier_complete(bar, b.x, nloc, nx); b.st[0] = nloc; b.st[1] = nx; }
        const unsigned old = xb_add(&bar[XB_XSUB(b.x)], 1u);
        const unsigned gen = old / nloc;
        if (old + 1u == (gen + 1u) * nloc) {
            __builtin_amdgcn_fence(__ATOMIC_RELEASE, "agent");
            asm volatile("s_waitcnt vmcnt(0)" ::: "memory");
            const unsigned og = xb_add(&bar[XB_TOP], 1u);
            const unsigned tg = og / nx;
            if (og + 1u == (tg + 1u) * nx) xb_add(&bar[XB_TOPGEN], 1u);
            else XB_SPIN(xb_ld(&bar[XB_TOPGEN]) == tg, bar);
            __builtin_amdgcn_fence(__ATOMIC_ACQUIRE, "agent");
            xb_add(&bar[XB_XGEN(b.x)], 1u);
            asm volatile("s_waitcnt vmcnt(0)" ::: "memory");
        } else {
            XB_SPIN(xb_ld(&bar[XB_XGEN(b.x)]) == gen, bar);
            __builtin_amdgcn_fence(__ATOMIC_ACQUIRE, "agent");
            asm volatile("s_waitcnt vmcnt(0)" ::: "memory");
        }
    }
    __syncthreads();
}

struct Args { const float* in[34]; float* out; unsigned char* ws; };
extern __shared__ __attribute__((aligned(16))) unsigned char g_lds[];
struct Frame {
    LAS unsigned char* lds;
    int tid, lane, wave, G, bid;
    struct InTab { const CAS unsigned long long* t;
        __device__ __forceinline__ const float* operator[](int i) const { return (const float*)(const GAS float*)(uintptr_t)t[i]; } } in;
    GAS float* out; GAS unsigned char* ws;
};
enum { I_X = 0, I_C, I_CTX, I_CCTX, I_RW, I_RB, I_ADAW, I_ADAB, I_LN1G, I_LN1B, I_LN2G, I_LN2B, I_W1, I_W3, I_W2, I_EVWIN, I_EVWOUT, I_AMU, I_AW0, I_AW2, I_AA0, I_AA2,
       I_AG2, I_AKK, I_AKA, I_ARK, I_LNXG, I_LNXB, I_BLAM, I_SUBG, I_ODWIN, I_ODWOUT, I_QNG, I_KNG };

__device__ __forceinline__ const float* x0_row(const Frame& F, int row) {
    const int b = row / TPB, tt = row - b * TPB;
    return tt < CTXL ? F.in[I_CTX] + ((size_t)b * CTXL + tt) * DM : F.in[I_X] + ((size_t)b * SEQ + (tt - CTXL)) * DM;
}
__device__ __forceinline__ const float* mod_ptr(const Frame& F, int layer, int row, int idx) {
    const int b = row / TPB, tt = row - b * TPB; const int r = tt < CTXL ? 8 : b;
    return (const float*)(F.ws + WS_MOD) + ((size_t)(layer * 9 + r) * 6 + idx) * DM;
}
__device__ __forceinline__ void transpose_item(const float* W, int K, int N, bf16* WT, int mode, LAS float* scr, int item, int lane) {
    const int nblk = N / 64, kb = item / nblk, nb = item % nblk, k0 = 64 * kb, n0 = 64 * nb;
    float v[64];
#pragma unroll
    for (int i = 0; i < 64; ++i) v[i] = __builtin_nontemporal_load(W + (size_t)(k0 + i) * N + n0 + lane);
#pragma unroll
    for (int i = 0; i < 64; ++i) scr[i * 65 + lane] = v[i];
    LDS_WAIT(); asm volatile("" ::: "memory");
    const int c = lane & 7;
#pragma unroll
    for (int j = 0; j < 8; ++j) { const int n = (lane >> 3) + 8 * j; const LAS float* s = scr + (8 * c) * 65 + n;
        v4u o; o.x = pk2(s[0 * 65], s[1 * 65]); o.y = pk2(s[2 * 65], s[3 * 65]); o.z = pk2(s[4 * 65], s[5 * 65]); o.w = pk2(s[6 * 65], s[7 * 65]);
        const int ng = n0 + n; const int nd = mode == 0 ? ng : (8 * (ng >> 2) + 4 * (mode - 1) + (ng & 3));
        *(GAS v4u*)(WT + (size_t)nd * K + k0 + 8 * c) = o; }
    LDS_WAIT(); asm volatile("" ::: "memory");
}
__device__ __forceinline__ bf16* moe_w13(Frame& F, int layer) { return layer == 0 ? (bf16*)(F.ws + WS_WM13) : (bf16*)F.out; }
__device__ __forceinline__ bf16* moe_w2(Frame& F, int layer) { return layer == 0 ? (bf16*)(F.ws + WS_WM2) : (bf16*)F.out + (size_t)NEXP * 1024 * DM; }
__device__ __forceinline__ void convert_moe_weights(Frame& F, int layer, int part, int nparts) {
    LAS float* scr = (LAS float*)(F.lds + RING_OFF + F.wave * 16896);
    const int gw = part * NWAVES + F.wave, NGW = nparts * NWAVES;
    constexpr int I13 = (DM / 64) * (EFF / 64)  , I2 = (EFF / 64) * (DM / 64)  ;
    bf16* W13 = moe_w13(F, layer); bf16* W2 = moe_w2(F, layer);
    for (int it = gw; it < NEXP * (2 * I13 + I2); it += NGW) {
        const int e = it / (2 * I13 + I2); int r = it % (2 * I13 + I2);
        const size_t wofs = ((size_t)layer * NEXP + e) * DM * EFF;
        if (r < I13) { transpose_item(F.in[I_W1] + wofs, DM, EFF, W13 + (size_t)e * 1024 * DM, 1, scr, r, F.lane); continue; } r -= I13;
        if (r < I13) { transpose_item(F.in[I_W3] + wofs, DM, EFF, W13 + (size_t)e * 1024 * DM, 2, scr, r, F.lane); continue; } r -= I13;
        transpose_item(F.in[I_W2] + wofs, EFF, DM, W2 + (size_t)e * DM * EFF, 0, scr, r, F.lane);
    }
}
__device__ __forceinline__ void convert_moe_filler(Frame& F, int layer, int nunits) {
    const int rounds = (nunits + F.G - 1) / F.G; const int c0 = nunits - (rounds - 1) * F.G;
    if (c0 >= F.G) convert_moe_weights(F, layer, F.bid, F.G);
    else if (F.bid >= c0) convert_moe_weights(F, layer, F.bid - c0, F.G - c0);
}
__device__ __forceinline__ void p_mods(Frame& F) {
    LAS float* sv = (LAS float*)(F.lds + RING_OFF);
    LAS float* red = sv + 9 * 1024;
    for (int i = F.tid; i < 9 * 1024; i += NTHR) { const int r = i >> 10, k = i & 1023; const float c = r < 8 ? F.in[I_C][r * DM + k] : F.in[I_CCTX][k]; sv[i] = c * sigmoidf_(c); }
    __syncthreads();
    for (int it = F.bid; it < 384; it += F.G) {
        const int kh = it & 1, l = (it >> 1) / 96, cb = (it >> 1) % 96, col = cb * 64 + F.lane;
        const float* w = F.in[I_ADAW] + (size_t)l * DM * 6144 + col;
        float acc[9];
#pragma unroll
        for (int r = 0; r < 9; ++r) acc[r] = 0.f;
        const int k0 = kh * 512 + F.wave * 64;
        float wv[64];
#pragma unroll
        for (int k = 0; k < 64; ++k) wv[k] = __builtin_nontemporal_load(w + (size_t)(k0 + k) * 6144);
#pragma unroll
        for (int k4 = 0; k4 < 16; ++k4) {
#pragma unroll
            for (int r = 0; r < 9; ++r) { const f32x4 s4 = *(const LAS f32x4*)(sv + r * 1024 + k0 + 4 * k4); acc[r] += (s4.x * wv[4 * k4] + s4.y * wv[4 * k4 + 1]) + (s4.z * wv[4 * k4 + 2] + s4.w * wv[4 * k4 + 3]); } }
#pragma unroll
        for (int r = 0; r < 9; ++r) red[(F.wave * 9 + r) * 64 + F.lane] = acc[r];
        __syncthreads();
        for (int i = F.tid; i < 9 * 64; i += NTHR) { const int r = i >> 6, c = i & 63; float s = 0.f;
#pragma unroll
            for (int w8 = 0; w8 < 8; ++w8) s += red[(w8 * 9 + r) * 64 + c];
            const int cc = cb * 64 + c;
            atomicAdd((float*)(F.ws + WS_MOD) + (size_t)(l * 9 + r) * 6144 + cc, s + (kh == 0 ? F.in[I_ADAB][l * 6144 + cc] : 0.f)); }
        __syncthreads();
    }
}
__device__ __forceinline__ void p_prologue(Frame& F) {
    LAS float* scr = (LAS float*)(F.lds + RING_OFF + F.wave * 16896);
    const int gw = F.bid * NWAVES + F.wave, NGW = F.G * NWAVES;
    constexpr int I_A = (DM / 64) * (EVEN_IN / 64), I_B = (DM / 64) * (DM / 64), I_C_ = (DM / 64) * (ODD_IN / 64);
    for (int it = gw; it < I_A + 2 * I_B + I_C_; it += NGW) {
        int r = it;
        if (r < I_A) { transpose_item(F.in[I_EVWIN], DM, EVEN_IN, (bf16*)(F.ws + WS_WEVIN), 0, scr, r, F.lane); continue; } r -= I_A;
        if (r < I_B) { transpose_item(F.in[I_EVWOUT], DM, DM, (bf16*)(F.ws + WS_WEVOUT), 0, scr, r, F.lane); continue; } r -= I_B;
        if (r < I_C_) { transpose_item(F.in[I_ODWIN], DM, ODD_IN, (bf16*)(F.ws + WS_WODIN), 0, scr, r, F.lane); continue; } r -= I_C_;
        transpose_item(F.in[I_ODWOUT], DM, DM, (bf16*)(F.ws + WS_WODOUT), 0, scr, r, F.lane);
    }
    {
        v4u* z = (v4u*)((bf16*)(F.ws + WS_WEVIN) + (size_t)EVEN_IN * DM); const int n16 = (EVEN_PAD - EVEN_IN) * DM * 2 / 16;
        for (int i = F.bid * NTHR + F.tid; i < n16; i += F.G * NTHR) z[i] = (v4u){0u, 0u, 0u, 0u};
    }
    {
        bf16* W2T = (bf16*)(F.ws + WS_LORA); bf16* A2T = W2T + 2 * 512 * 64; bf16* G2T = A2T + 2 * 512 * 64;
        for (int i = F.bid * NTHR + F.tid; i < 3 * 65536; i += F.G * NTHR) {
            const int which = i >> 16, r = i & 65535;
            if (which < 2) { const int d = r >> 15, c = (r >> 6) & 511, l = r & 63; const float v = (which == 0 ? F.in[I_AW2] : F.in[I_AA2])[((size_t)d * 64 + l) * 512 + c]; (which == 0 ? W2T : A2T)[r] = (bf16)f2bf(v); }
            else { const int c = r >> 7, j = r & 127; G2T[r] = (bf16)f2bf(F.in[I_AG2][(size_t)j * 512 + c]); }
        }
    }
    {
        float* cosB = (float*)(F.ws + WS_ROPE); float* sinB = cosB + SEQ * 32; float* cosC = sinB + SEQ * 32; float* sinC = cosC + SEQ * 64;
        for (int i = F.bid * NTHR + F.tid; i < SEQ * 96; i += F.G * NTHR) {
            if (i < SEQ * 32) { const int t = i >> 5, j = i & 31; const float pos = (float)(j < 16 ? (t >> 6) : (t & 63)); const int f = j & 15;
                const float inv = powf(10000.f, -(float)(2 * f) / 32.f); const float ang = pos * inv; cosB[i] = cosf(ang); sinB[i] = sinf(ang); }
            else { const int ii = i - SEQ * 32; const int t = ii >> 6, j = ii & 63; const float pos = (float)(j < 32 ? (t >> 6) : (t & 63)); const int f = j & 31;
                const float inv = powf(10000.f, -(float)(2 * f) / 64.f); const float ang = pos * inv; cosC[ii] = cosf(ang); sinC[ii] = sinf(ang); }
        }
    }
    __syncthreads();
}

struct Row16 { f32x4 v[4]; };
__device__ __forceinline__ Row16 ld_row_f32(const float* p, int lane) { Row16 r; const f32x4* q = (const f32x4*)p + lane;
#pragma unroll
    for (int j = 0; j < 4; ++j) r.v[j] = q[64 * j]; return r; }
__device__ __forceinline__ Row16 ld_row_bf16(const bf16* p, int lane) { Row16 r; const v2u* q = (const v2u*)p + lane;
#pragma unroll
    for (int j = 0; j < 4; ++j) { const v2u w = q[64 * j]; r.v[j] = (f32x4){bflo(w.x), bfhi(w.x), bflo(w.y), bfhi(w.y)}; } return r; }
__device__ __forceinline__ void st_row_f32(float* p, int lane, const Row16& r) { f32x4* q = (f32x4*)p + lane;
#pragma unroll
    for (int j = 0; j < 4; ++j) q[64 * j] = r.v[j]; }
__device__ __forceinline__ void st_row_bf16(bf16* p, int lane, const Row16& r) { v2u* q = (v2u*)p + lane;
#pragma unroll
    for (int j = 0; j < 4; ++j) q[64 * j] = (v2u){pk2(r.v[j].x, r.v[j].y), pk2(r.v[j].z, r.v[j].w)}; }
__device__ __forceinline__ Row16 layer_norm(const Row16& x, const float* g, const float* b, int lane) {
    float s = 0.f;
#pragma unroll
    for (int j = 0; j < 4; ++j) s += (x.v[j].x + x.v[j].y) + (x.v[j].z + x.v[j].w);
    const float mean = wave_sum(s) * (1.f / DM); float s2 = 0.f; Row16 d;
#pragma unroll
    for (int j = 0; j < 4; ++j) { d.v[j] = x.v[j] - mean; s2 += (d.v[j].x * d.v[j].x + d.v[j].y * d.v[j].y) + (d.v[j].z * d.v[j].z + d.v[j].w * d.v[j].w); }
    const float rstd = 1.f / sqrtf(wave_sum(s2) * (1.f / DM) + LN_EPS);
    const Row16 gg = ld_row_f32(g, lane), bb = ld_row_f32(b, lane); Row16 o;
#pragma unroll
    for (int j = 0; j < 4; ++j) o.v[j] = d.v[j] * rstd * gg.v[j] + bb.v[j];
    return o;
}
__device__ __forceinline__ Row16 modulate(const Row16& x, const float* shift, const float* scale, int lane) {
    const Row16 sh = ld_row_f32(shift, lane), sc = ld_row_f32(scale, lane); Row16 o;
#pragma unroll
    for (int j = 0; j < 4; ++j) o.v[j] = x.v[j] * (1.f + sc.v[j]) + sh.v[j];
    return o;
}

__device__ __forceinline__ void p_mod0(Frame& F) {
    const int gw = F.bid * NWAVES + F.wave, NGW = F.G * NWAVES;
    bf16* H = (bf16*)(F.ws + WS_H);
    for (int row = gw; row < MROWS; row += 2 * NGW) {
        const int r1 = row + NGW; const bool has1 = r1 < MROWS; const int rb = has1 ? r1 : row;
        const Row16 xa = ld_row_f32(x0_row(F, row), F.lane), xb = ld_row_f32(x0_row(F, rb), F.lane);
        const Row16 ha = modulate(xa, mod_ptr(F, 0, row, 0), mod_ptr(F, 0, row, 1), F.lane), hb = modulate(xb, mod_ptr(F, 0, rb, 0), mod_ptr(F, 0, rb, 1), F.lane);
        st_row_bf16(H + (size_t)row * DM, F.lane, ha);
        if (has1) st_row_bf16(H + (size_t)r1 * DM, F.lane, hb);
    }
}

template <int LAYER>
__device__ __forceinline__ void p_ln_route(Frame& F) {
    LAS float* rwT = (LAS float*)(F.lds + RING_OFF);
    LAS int* lcnt = (LAS int*)(F.lds + RING_OFF + 65536);
    LAS int* rinfo = lcnt + 32;
    for (int i = F.tid; i < DM * NEXP; i += NTHR) { const int k = i >> 4, e = i & 15; rwT[e * DM + k] = F.in[I_RW][i]; }
    if (F.tid < 32) lcnt[F.tid] = 0;
    __syncthreads();
    const int rows_per = (MROWS + F.G - 1) / F.G, row_lo = F.bid * rows_per, row_hi = (row_lo + rows_per < MROWS) ? row_lo + rows_per : MROWS;
    bf16* X = (bf16*)(F.ws + WS_X); bf16* H = (bf16*)(F.ws + WS_H); const bf16* MIX = (const bf16*)(F.ws + WS_MIX);
    unsigned* cnt = (unsigned*)(F.ws + WS_CTL) + CW_CNT + LAYER * 64;
    int* PERM = (int*)(F.ws + WS_PERM_); float* GATE = (float*)(F.ws + WS_GATE); int* TOK = (int*)(F.ws + WS_TOK);
    LAS float* lgt = (LAS float*)(rinfo + 4 * 128);
    Row16 xin_n, mix_n;
    {   const int row = row_lo + F.wave; const int rr_ = row < row_hi ? row : row_lo;
        xin_n = LAYER == 0 ? ld_row_f32(x0_row(F, rr_), F.lane) : ld_row_bf16(X + (size_t)rr_ * DM, F.lane); mix_n = ld_row_bf16(MIX + (size_t)rr_ * DM, F.lane); }
    for (int row = row_lo + F.wave; row < row_hi; row += NWAVES) {
        const int b = row / TPB, tt = row - b * TPB; const int li = row - row_lo;
        const Row16 xin = xin_n, mix = mix_n;
        {   const int rn = row + NWAVES < row_hi ? row + NWAVES : row;
            xin_n = LAYER == 0 ? ld_row_f32(x0_row(F, rn), F.lane) : ld_row_bf16(X + (size_t)rn * DM, F.lane); mix_n = ld_row_bf16(MIX + (size_t)rn * DM, F.lane); }
        if (LAYER == 1 && tt < CTXL) { if (F.lane == 0) rinfo[li * 4] = -1; continue; }
        const Row16 gate = ld_row_f32(mod_ptr(F, LAYER, row, 2), F.lane);
        Row16 pre;
#pragma unroll
        for (int j = 0; j < 4; ++j) pre.v[j] = ALPHA * xin.v[j] + gate.v[j] * mix.v[j];
        const Row16 x1 = layer_norm(pre, F.in[I_LN1G] + LAYER * DM, F.in[I_LN1B] + LAYER * DM, F.lane);
        st_row_bf16(X + (size_t)row * DM, F.lane, x1);
        const Row16 h = modulate(x1, mod_ptr(F, LAYER, row, 3), mod_ptr(F, LAYER, row, 4), F.lane);
        st_row_bf16(H + (size_t)row * DM, F.lane, h);
        float mylg = 0.f;
#pragma unroll
        for (int e = 0; e < NEXP; ++e) { float s = 0.f;
#pragma unroll
            for (int j = 0; j < 4; ++j) { const f32x4 w = *((const LAS f32x4*)(rwT + e * DM) + F.lane + 64 * j); s += (h.v[j].x * w.x + h.v[j].y * w.y) + (h.v[j].z * w.z + h.v[j].w * w.w); }
            const float t = wave_sum(s); mylg = (F.lane == e) ? t : mylg; if ((e & 3) == 3) asm volatile("" ::: "memory"); }
        if (F.lane < NEXP) { lgt[li * 16 + F.lane] = mylg + F.in[I_RB][F.lane]; if (F.lane == 0) rinfo[li * 4] = 0; }
    }
    __syncthreads();
    if (row_lo + F.tid < row_hi && rinfo[F.tid * 4] >= 0) {
        const int li = F.tid; float lg[NEXP];
#pragma unroll
        for (int q = 0; q < 4; ++q) { const f32x4 t = *((const LAS f32x4*)(lgt + li * 16) + q); lg[4 * q] = t.x; lg[4 * q + 1] = t.y; lg[4 * q + 2] = t.z; lg[4 * q + 3] = t.w; }
        float mx = lg[0];
#pragma unroll
        for (int e = 1; e < NEXP; ++e) mx = fmaxf(mx, lg[e]);
        float p[NEXP];
#pragma unroll
        for (int e = 0; e < NEXP; ++e) p[e] = expf(lg[e] - mx);
        int best = 0; float bs = -1.f;
#pragma unroll
        for (int g = 0; g < 4; ++g) { float a = p[4 * g], c2 = -1.f;
#pragma unroll
            for (int i = 1; i < 4; ++i) { const float v = p[4 * g + i]; if (v > a) { c2 = a; a = v; } else if (v > c2) c2 = v; }
            const float sc = a + c2; if (sc > bs) { bs = sc; best = g; } }
        int i0 = 0; float p0 = -1.f;
#pragma unroll
        for (int i = 0; i < 4; ++i) { float v = 0.f;
#pragma unroll
            for (int g = 0; g < 4; ++g) v = (g == best) ? p[4 * g + i] : v;
            if (v > p0) { p0 = v; i0 = i; } }
        int i1 = 0; float p1 = -1.f;
#pragma unroll
        for (int i = 0; i < 4; ++i) { float v = 0.f;
#pragma unroll
            for (int g = 0; g < 4; ++g) v = (g == best) ? p[4 * g + i] : v;
            if (i != i0 && v > p1) { p1 = v; i1 = i; } }
        rinfo[li * 4 + 0] = best * 4 + i0; rinfo[li * 4 + 1] = best * 4 + i1;
        rinfo[li * 4 + 2] = __float_as_int(p0 / (p0 + p1)); rinfo[li * 4 + 3] = __float_as_int(p1 / (p0 + p1));
    }
    __syncthreads();
    int e0 = -1, e1 = -1, r0 = 0, r1 = 0; const int myrow = row_lo + F.tid;
    if (myrow < row_hi) { e0 = rinfo[F.tid * 4]; if (e0 >= 0) { e1 = rinfo[F.tid * 4 + 1]; r0 = __hip_atomic_fetch_add(lcnt + e0, 1, __ATOMIC_RELAXED, __HIP_MEMORY_SCOPE_WORKGROUP); r1 = __hip_atomic_fetch_add(lcnt + e1, 1, __ATOMIC_RELAXED, __HIP_MEMORY_SCOPE_WORKGROUP); } }
    __syncthreads();
    if (F.tid < 16) lcnt[16 + F.tid] = (int)atomicAdd(cnt + F.tid, (unsigned)lcnt[F.tid]);
    __syncthreads();
    if (e0 >= 0) {
        const int g0 = lcnt[16 + e0] + r0, g1 = lcnt[16 + e1] + r1;
        PERM[(size_t)e0 * CAP + g0] = myrow; GATE[(size_t)e0 * CAP + g0] = __int_as_float(rinfo[F.tid * 4 + 2]);
        PERM[(size_t)e1 * CAP + g1] = myrow; GATE[(size_t)e1 * CAP + g1] = __int_as_float(rinfo[F.tid * 4 + 3]);
        TOK[myrow * 2 + 0] = (e0 << 20) | g0; TOK[myrow * 2 + 1] = (e1 << 20) | g1;
    }
}

__device__ __forceinline__ void expert_tile_offsets(const unsigned* cnt, int (&toff)[NEXP + 1]) {
    toff[0] = 0;
#pragma unroll
    for (int e = 0; e < NEXP; ++e) toff[e + 1] = toff[e] + (int)((__hip_atomic_load(cnt + e, __ATOMIC_RELAXED, __HIP_MEMORY_SCOPE_AGENT) + 255u) >> 8);
}

template <int LAYER>
__device__ __forceinline__ void p_ln2(Frame& F) {
    const int gw = F.bid * NWAVES + F.wave, NGW = F.G * NWAVES;
    bf16* X = (bf16*)(F.ws + WS_X); bf16* H = (bf16*)(F.ws + WS_H); const bf16* Y = (const bf16*)(F.ws + WS_Y);
    const unsigned* cnt = (const unsigned*)(F.ws + WS_CTL) + CW_CNT + LAYER * 64; const int* TOK = (const int*)(F.ws + WS_TOK);
    int toff[NEXP + 1]; expert_tile_offsets(cnt, toff);
    constexpr int NR = LAYER == 0 ? MROWS : NB * SEQ;
    for (int q = gw; q < NR; q += 2 * NGW) {
        int rw[2]; bool ok[2]; rw[0] = q; rw[1] = q + NGW; ok[0] = true; ok[1] = rw[1] < NR; if (!ok[1]) rw[1] = rw[0];
        int row[2], bb[2], tt[2]; size_t y0[2], y1[2];
#pragma unroll
        for (int s = 0; s < 2; ++s) {
            if (LAYER == 0) { row[s] = rw[s]; bb[s] = row[s] / TPB; tt[s] = row[s] - bb[s] * TPB; } else { bb[s] = rw[s] / SEQ; tt[s] = CTXL + (rw[s] - bb[s] * SEQ); row[s] = bb[s] * TPB + tt[s]; }
            const int t0 = __hip_atomic_load(TOK + row[s] * 2, __ATOMIC_RELAXED, __HIP_MEMORY_SCOPE_AGENT), t1 = __hip_atomic_load(TOK + row[s] * 2 + 1, __ATOMIC_RELAXED, __HIP_MEMORY_SCOPE_AGENT); const int e0 = t0 >> 20, e1 = t1 >> 20;
            int o0 = 0, o1 = 0;
#pragma unroll
            for (int e = 0; e < NEXP; ++e) { o0 = (e == e0) ? toff[e] : o0; o1 = (e == e1) ? toff[e] : o1; }
            y0[s] = (size_t)o0 * 256 + (t0 & 0xfffff); y1[s] = (size_t)o1 * 256 + (t1 & 0xfffff);
        }
        Row16 xin[2], ya[2], yb[2], gate[2];
#pragma unroll
        for (int s = 0; s < 2; ++s) { xin[s] = ld_row_bf16(X + (size_t)row[s] * DM, F.lane); ya[s] = ld_row_bf16(Y + y0[s] * DM, F.lane); yb[s] = ld_row_bf16(Y + y1[s] * DM, F.lane); gate[s] = ld_row_f32(mod_ptr(F, LAYER, row[s], 5), F.lane); }
#pragma unroll
        for (int s = 0; s < 2; ++s) {
            Row16 pre;
#pragma unroll
            for (int j = 0; j < 4; ++j) pre.v[j] = ALPHA * xin[s].v[j] + gate[s].v[j] * (ya[s].v[j] + yb[s].v[j]);
            const Row16 x2 = layer_norm(pre, F.in[I_LN2G] + LAYER * DM, F.in[I_LN2B] + LAYER * DM, F.lane);
            if (!ok[s]) continue;
            if (LAYER == 0) {
                st_row_bf16(X + (size_t)row[s] * DM, F.lane, x2);
                const Row16 h = modulate(x2, mod_ptr(F, 1, row[s], 0), mod_ptr(F, 1, row[s], 1), F.lane);
                st_row_bf16(H + (size_t)row[s] * DM, F.lane, h);
            } else {
                st_row_f32((float*)(F.out + ((size_t)bb[s] * SEQ + (tt[s] - CTXL)) * DM), F.lane, x2);
#ifdef TPROBE_A
                if (row[s] == 2048 && F.lane == 0) { volatile LAS unsigned long long* ts = (volatile LAS unsigned long long*)(F.lds + MISC_OFF + 128);
                    const float span_us = (float)(ts[TPROBE_B] - ts[TPROBE_A]) * 0.01f; ((float*)F.out)[((size_t)bb[s] * SEQ + (tt[s] - CTXL)) * DM] = x2.v[0].x + span_us / (float)TPROBE_US; }
#endif
            }
        }
    }
}
namespace ck {
typedef short bf16x8 __attribute__((ext_vector_type(8)));
typedef float f32x16 __attribute__((ext_vector_type(16)));
typedef float f32x4 __attribute__((ext_vector_type(4)));
constexpr int NCH = 36;
__device__ __forceinline__ int crow(int r, int hi) { return (r & 3) + 8 * (r >> 2) + 4 * hi; }
__device__ __forceinline__ int swz(int row, int c16) { return row * 128 + ((c16 ^ ((row >> 1) & 7)) << 4); }
__device__ __forceinline__ int swz_el(int row, int col) { return swz(row, col >> 3) + (col & 7) * 2; }
__device__ __forceinline__ void mm_tile(f32x16& acc, const LAS unsigned char* A, int arow0, const LAS unsigned char* B, int brow0, int ks0, int nks, int r32, int hh) {
#pragma unroll
    for (int ks = 0; ks < 4; ++ks) if (ks >= ks0 && ks < ks0 + nks) {
        const bf16x8 a = *(const LAS bf16x8*)(A + swz(arow0 + r32, 2 * ks + hh));
        const bf16x8 b = *(const LAS bf16x8*)(B + swz(brow0 + r32, 2 * ks + hh));
        acc = __builtin_amdgcn_mfma_f32_32x32x16_bf16(a, b, acc, 0, 0, 0); }
}
__device__ __forceinline__ f32x16 zero16() { f32x16 z;
#pragma unroll
    for (int i = 0; i < 16; ++i) z[i] = 0.f; return z; }
__device__ __forceinline__ int chunk_index(int b, int h, int d, int c) { return ((b * 8 + h) * 2 + d) * NCH + c; }
}

constexpr int CK_LIN = 0;
constexpr int CK_E = 32768;
constexpr int CK_T = CK_E, CK_TT = CK_E + 8192, CK_PT = CK_E + 16384, CK_WT = CK_E + 24576;
constexpr int CK_OPS = 65536;
constexpr int CK_UT = 131072;
constexpr int CK_D = CK_UT + 8192;
constexpr int CK_ZT = CK_D + 4096;
constexpr int CK_WSUM = CK_ZT + 2048;
static_assert(CK_WSUM + 2048 <= RING_BYTES, "chunk LDS map");

__device__ __forceinline__ float fsig(float x) { return __builtin_amdgcn_rcpf(1.f + __builtin_amdgcn_exp2f(-1.4426950408889634f * x)); }
__device__ __forceinline__ float fexp(float x) { return __builtin_amdgcn_exp2f(1.4426950408889634f * x); }

__device__ __forceinline__ void p_chunk_pre(Frame& F) {
    using namespace ck;
    const LAS unsigned char* L0 = F.lds + RING_OFF;
    LAS unsigned char* lds = F.lds + RING_OFF;
    const bf16* PA = (const bf16*)(F.ws + WS_PA);
    const int wave = F.wave;
    bf16* CHG = (bf16*)(F.ws + WS_CHG); bf16* CHH = (bf16*)(F.ws + WS_CHH); bf16* CHRQ = (bf16*)(F.ws + WS_CHRQ); bf16* CHY = (bf16*)(F.ws + WS_CHY);
    float* GLp = (float*)(F.ws + WS_GL); float* BON = (float*)(F.ws + WS_BON);
    bf16* VOUT = (bf16*)(F.ws + WS_VOUT); bf16* GOUT = (bf16*)(F.ws + WS_GOUT);
    const bf16* W2T = (const bf16*)(F.ws + WS_LORA); const bf16* A2T = W2T + 2 * 512 * 64; const bf16* G2T = A2T + 2 * 512 * 64;
    const float* mu = F.in[I_AMU];
    const bf16* LINACT = (const bf16*)((const unsigned char*)F.out + DOUT_LINACT);
    v4u q_row[4]; float win[3][10];
#define CK_DECODE(it_, d_, tb_, h_, b_, isctx_, t0_, Ls_, rbase_) const int d_ = ((it_) & 1) ^ (((it_) / F.G) & 1 & (int)((F.G & 1) == 0)), tb_ = ((it_) >> 1) % 36, bh_##d_ = ((it_) >> 1) / 36, h_ = bh_##d_ & 7, b_ = bh_##d_ >> 3; \
        const bool isctx_ = tb_ < 4; const int t0_ = isctx_ ? tb_ * 64 : (tb_ - 4) * 64, Ls_ = isctx_ ? CTXL : SEQ; const int rbase_ = b_ * TPB + (isctx_ ? 0 : CTXL);
#define CK_LOAD(it_) do { CK_DECODE(it_, dL, tbL, hL, bL, icL, t0L, LsL, rbL) \
        const int ln_ = lane_id_fresh(), td_ = (wave << 6) | ln_; \
        { const int cc_ = (dL == 0 ? (td_ & 31) : (td_ & 15)) * 8, tf_ = dL == 0 ? 4 * (td_ >> 5) : 2 * (td_ >> 4); \
          const int col_ = cc_ < 64 ? 64 * dL + cc_ : cc_ < 128 ? 128 + 64 * dL + (cc_ - 64) : 256 + (cc_ - 128); \
          const bf16* pc_ = LINACT + (size_t)(rbL + t0L + tf_) * 384 + col_; \
          _Pragma("unroll") for (int n_ = 0; n_ < 4; ++n_) if (dL == 0 || n_ < 2) q_row[n_] = *(const v4u*)(pc_ + (size_t)n_ * 384); } \
        { const int tlo_ = dL == 0 ? 8 * wave : 63 - (8 * wave + 7); const bf16* pr_ = PA + (size_t)(rbL + t0L + tlo_) * A_IN + 64 * hL + ln_; \
          _Pragma("unroll") for (int j_ = 0; j_ < 10; ++j_) { const int tg2_ = t0L + tlo_ + j_ - 1; const bool ok_ = tg2_ >= 0 && tg2_ < LsL; \
            _Pragma("unroll") for (int s_ = 0; s_ < 3; ++s_) win[s_][j_] = ok_ ? bf2f(pr_[(ptrdiff_t)(j_ - 1) * A_IN + 512 * s_]) : 0.f; } } } while (0)
    if (F.bid < NB * 8 * 36 * 2) CK_LOAD(F.bid);
    for (int it = F.bid; it < NB * 8 * 36 * 2; it += F.G) {
        CK_DECODE(it, d, tb, h, b, isctx, t0, Ls, rbase)
        const int c = d == 0 ? tb : (isctx ? 3 - tb : 4 + (31 - (tb - 4)));
        const int ci = chunk_index(b, h, d, c);
        __syncthreads();
        int lane = lane_id_fresh(); asm volatile("" : "+v"(lane));
        const int tid = (wave << 6) | lane, r32 = lane & 31, hh = lane >> 5, k = lane, pg = wave;
        {
            const int cc = (d == 0 ? (tid & 31) : (tid & 15)) * 8, tf = d == 0 ? 4 * (tid >> 5) : 2 * (tid >> 4);
            const int mat = cc >> 6, l0 = cc & 63;
#pragma unroll
            for (int n = 0; n < 4; ++n) if (d == 0 || n < 2) *(LAS v4u*)(lds + CK_LIN + mat * 8192 + swz(tf + n, l0 >> 3)) = q_row[n];
        }
        float rr[8], kx[8], vv[8];
        {
            const float mr = mu[64 * h + k], mk = mu[512 + 64 * h + k], mv = mu[1024 + 64 * h + k];
#pragma unroll
            for (int i = 0; i < 8; ++i) { const int j = d == 0 ? i + 1 : 8 - i;
                rr[i] = win[0][j] + (0.5f * (win[0][j - 1] + win[0][j + 1]) - win[0][j]) * mr;
                kx[i] = win[1][j] + (0.5f * (win[1][j - 1] + win[1][j + 1]) - win[1][j]) * mk;
                vv[i] = win[2][j] + (0.5f * (win[2][j - 1] + win[2][j + 1]) - win[2][j]) * mv; }
        }
        __syncthreads();
        {
            const int tq = wave & 3, ti = tq >> 1, tj = tq & 1; const bool isW = wave < 4;
            f32x16 acc = zero16();
            const bf16* WT = (isW ? W2T : A2T) + ((size_t)d * 512 + 64 * h + 32 * tj + r32) * 64;
#pragma unroll
            for (int ks = 0; ks < 4; ++ks) {
                const bf16x8 a = *(const LAS bf16x8*)(L0 + CK_LIN + (isW ? 0 : 8192) + swz(32 * ti + r32, 2 * ks + hh));
                const bf16x8 bq = *(const bf16x8*)(WT + 16 * ks + 8 * hh);
                acc = __builtin_amdgcn_mfma_f32_32x32x16_bf16(a, bq, acc, 0, 0, 0); }
            const int ch = 32 * tj + r32; const float bias = isW ? F.in[I_AW0][d * 512 + 64 * h + ch] : F.in[I_AA0][d * 512 + 64 * h + ch];
#pragma unroll
            for (int r = 0; r < 16; ++r) { const int tl = 32 * ti + crow(r, hh); const int p = d == 0 ? tl : 63 - tl;
                const float sg = fsig(acc[r] + bias);
                *(LAS float*)(lds + CK_E + (isW ? 0 : 16384) + (p * 64 + ch) * 4) = isW ? sg * 0.6065306597126334f : sg; }
            if (d == 0 && !isW) {
                f32x16 g = zero16();
                const bf16* GT = G2T + (size_t)(64 * h + 32 * tj + r32) * 128;
#pragma unroll
                for (int ks = 0; ks < 8; ++ks) {
                    const bf16x8 a = *(const LAS bf16x8*)(L0 + CK_LIN + 16384 + (ks >> 2) * 8192 + swz(32 * ti + r32, 2 * (ks & 3) + hh));
                    const bf16x8 bq = *(const bf16x8*)(GT + 16 * ks + 8 * hh);
                    g = __builtin_amdgcn_mfma_f32_32x32x16_bf16(a, bq, g, 0, 0, 0); }
#pragma unroll
                for (int r = 0; r < 16; ++r) { const int tl = 32 * ti + crow(r, hh);
                    GOUT[(size_t)(rbase + t0 + tl) * 512 + 64 * h + ch] = (bf16)f2bf(g[r]); }
            }
        }
        __syncthreads();
        {
            float e[8], ai[8], cl[8];
#pragma unroll
            for (int i = 0; i < 8; ++i) { e[i] = *(const LAS float*)(L0 + CK_E + ((8 * pg + i) * 64 + k) * 4); ai[i] = *(const LAS float*)(L0 + CK_E + 16384 + ((8 * pg + i) * 64 + k) * 4); }
            float run = 0.f;
#pragma unroll
            for (int i = 0; i < 8; ++i) { run -= e[i]; cl[i] = run; }
            *(LAS float*)(lds + CK_WSUM + (pg * 64 + k) * 4) = run;
            __syncthreads();
            float off = 0.f, tot = 0.f;
#pragma unroll
            for (int q = 0; q < 8; ++q) { const float s = *(const LAS float*)(L0 + CK_WSUM + (q * 64 + k) * 4); tot += s; off += (q < pg) ? s : 0.f; }
            const float kkc = F.in[I_AKK][64 * h + k], kac = F.in[I_AKA][64 * h + k], rkc = F.in[I_ARK][64 * h + k];
            float bhv[8], khv[8], atv[8];
#pragma unroll
            for (int i = 0; i < 8; ++i) {
                const int p = 8 * pg + i; const float c_ = cl[i] + off;
                const float kr = kx[i] * kkc; const float ss = wave_sum(kr * kr); const float kk = kr * __builtin_amdgcn_rsqf(fmaxf(ss, 1e-24f));
                const float kd = kx[i] * (1.f + (ai[i] - 1.f) * kac), bb = kk * ai[i];
                const float bon = wave_sum(rr[i] * kd * rkc);
                const float ep = fexp(c_), em = __builtin_amdgcn_rcpf(ep), el = fexp(tot - c_);
                atv[i] = -kk * fexp(c_ + e[i]);
                *(LAS bf16*)(lds + CK_OPS + 0 * 8192 + swz_el(p, k)) = (bf16)f2bf(atv[i]);
                *(LAS bf16*)(lds + CK_OPS + 1 * 8192 + swz_el(p, k)) = (bf16)f2bf(bb * em);
                *(LAS bf16*)(lds + CK_OPS + 2 * 8192 + swz_el(p, k)) = (bf16)f2bf(kd * em);
                *(LAS bf16*)(lds + CK_OPS + 3 * 8192 + swz_el(p, k)) = (bf16)f2bf(rr[i] * ep);
                bhv[i] = bb * el; khv[i] = kd * el;
                const int tl = d == 0 ? p : 63 - p; const size_t row = (size_t)(rbase + t0 + tl);
                if (lane == 0) BON[((size_t)d * MROWS + row) * 8 + h] = bon;
                if (d == 0) VOUT[row * 512 + 64 * h + k] = (bf16)f2bf(vv[i]);
            }
            *(LAS v4u*)(lds + CK_OPS + 4 * 8192 + swz(k, pg)) = (v4u){pk2(bhv[0], bhv[1]), pk2(bhv[2], bhv[3]), pk2(bhv[4], bhv[5]), pk2(bhv[6], bhv[7])};
            *(LAS v4u*)(lds + CK_OPS + 5 * 8192 + swz(k, pg)) = (v4u){pk2(khv[0], khv[1]), pk2(khv[2], khv[3]), pk2(khv[4], khv[5]), pk2(khv[6], khv[7])};
            *(LAS v4u*)(lds + CK_OPS + 6 * 8192 + swz(k, pg)) = (v4u){pk2(vv[0], vv[1]), pk2(vv[2], vv[3]), pk2(vv[4], vv[5]), pk2(vv[6], vv[7])};
            *(LAS v4u*)(lds + CK_OPS + 7 * 8192 + swz(k, pg)) = (v4u){pk2(atv[0], atv[1]), pk2(atv[2], atv[3]), pk2(atv[4], atv[5]), pk2(atv[6], atv[7])};
            if (pg == 0) GLp[(size_t)ci * 64 + k] = fexp(tot);
            *(LAS v4u*)(lds + CK_T + tid * 16) = (v4u){0u, 0u, 0u, 0u}; *(LAS v4u*)(lds + CK_TT + tid * 16) = (v4u){0u, 0u, 0u, 0u};
        }
        __syncthreads();
        {
            const int prod = wave >> 2, tq = wave & 3, ti = tq >> 1, tj = tq & 1;
            f32x16 acc = zero16();
            if (!(ti == 0 && tj == 1)) mm_tile(acc, L0 + CK_OPS + 0 * 8192, 32 * ti, L0 + CK_OPS + (prod ? 2 : 1) * 8192, 32 * tj, 0, 4, r32, hh);
            const int s = 32 * tj + r32;
#pragma unroll
            for (int r = 0; r < 16; ++r) { const int p = 32 * ti + crow(r, hh); const float v = (s < p) ? acc[r] : 0.f;
                *(LAS bf16*)(lds + CK_LIN + prod * 8192 + swz_el(p, s)) = (bf16)f2bf(v);
                if (prod == 0 && (p >> 4) == (s >> 4)) *(LAS float*)(lds + CK_D + ((p >> 4) * 256 + (p & 15) * 16 + (s & 15)) * 4) = v; }
        }
        __syncthreads();
        if (wave == 0) {
            const int blk = lane >> 4, cc = lane & 15;
            float x[16];
#pragma unroll
            for (int p = 0; p < 16; ++p) x[p] = (p == cc) ? 1.f : 0.f;
#pragma unroll
            for (int s = 0; s < 15; ++s)
#pragma unroll
                for (int p = s + 1; p < 16; ++p) x[p] += *(const LAS float*)(L0 + CK_D + (blk * 256 + p * 16 + s) * 4) * x[s];
#pragma unroll
            for (int p = 0; p < 16; ++p) *(LAS bf16*)(lds + CK_T + swz_el(16 * blk + p, 16 * blk + cc)) = (bf16)f2bf(x[p]);
            *(LAS v4u*)(lds + CK_TT + swz(16 * blk + cc, 2 * blk)) = (v4u){pk2(x[0], x[1]), pk2(x[2], x[3]), pk2(x[4], x[5]), pk2(x[6], x[7])};
            *(LAS v4u*)(lds + CK_TT + swz(16 * blk + cc, 2 * blk + 1)) = (v4u){pk2(x[8], x[9]), pk2(x[10], x[11]), pk2(x[12], x[13]), pk2(x[14], x[15])};
            LDS_WAIT();
            typedef float f32x4_ __attribute__((ext_vector_type(4)));
            const int row = lane & 15, kg = lane >> 4;
            const bf16x8 zf = (bf16x8){0, 0, 0, 0, 0, 0, 0, 0};
#pragma unroll
            for (int pr_ = 0; pr_ < 2; ++pr_) {
                const int b0 = 2 * pr_, b1 = b0 + 1;
                bf16x8 a = *(const LAS bf16x8*)(L0 + CK_LIN + swz(16 * b1 + row, 2 * b0 + (kg & 1)));
                bf16x8 bq = *(const LAS bf16x8*)(L0 + CK_TT + swz(16 * b0 + row, 2 * b0 + (kg & 1)));
                if (kg >= 2) { a = zf; bq = zf; }
                f32x4_ z = __builtin_amdgcn_mfma_f32_16x16x32_bf16(a, bq, (f32x4_){0.f, 0.f, 0.f, 0.f}, 0, 0, 0);
                *(LAS v2u*)(lds + CK_ZT + (row * 16 + 4 * kg) * 2) = (v2u){pk2(z[0], z[1]), pk2(z[2], z[3])};
                LDS_WAIT();
                bf16x8 a2 = *(const LAS bf16x8*)(L0 + CK_T + swz(16 * b1 + row, 2 * b1 + (kg & 1)));
                bf16x8 b2 = *(const LAS bf16x8*)(L0 + CK_ZT + (row * 16 + 8 * (kg & 1)) * 2);
                if (kg >= 2) { a2 = zf; b2 = zf; }
                f32x4_ m = __builtin_amdgcn_mfma_f32_16x16x32_bf16(a2, b2, (f32x4_){0.f, 0.f, 0.f, 0.f}, 0, 0, 0);
#pragma unroll
                for (int i = 0; i < 4; ++i) *(LAS bf16*)(lds + CK_T + swz_el(16 * b1 + 4 * kg + i, 16 * b0 + row)) = (bf16)f2bf(m[i]);
                *(LAS v2u*)(lds + CK_TT + swz_el(16 * b0 + row, 16 * b1 + 4 * kg)) = (v2u){pk2(m[0], m[1]), pk2(m[2], m[3])};
                LDS_WAIT();
            }
            {
                f32x16 z2 = zero16();
#pragma unroll
                for (int ks = 0; ks < 2; ++ks) {
                    const bf16x8 a = *(const LAS bf16x8*)(L0 + CK_LIN + swz(32 + r32, 2 * ks + hh));
                    const bf16x8 bq = *(const LAS bf16x8*)(L0 + CK_TT + swz(r32, 2 * ks + hh));
                    z2 = __builtin_amdgcn_mfma_f32_32x32x16_bf16(a, bq, z2, 0, 0, 0); }
#pragma unroll
                for (int rq = 0; rq < 4; ++rq)
                    *(LAS v2u*)(lds + CK_ZT + (r32 * 32 + 8 * rq + 4 * hh) * 2) = (v2u){pk2(z2[4 * rq], z2[4 * rq + 1]), pk2(z2[4 * rq + 2], z2[4 * rq + 3])};
                LDS_WAIT();
                f32x16 m2 = zero16();
#pragma unroll
                for (int ks = 0; ks < 2; ++ks) {
                    const bf16x8 a = *(const LAS bf16x8*)(L0 + CK_T + swz(32 + r32, 4 + 2 * ks + hh));
                    const bf16x8 bq = *(const LAS bf16x8*)(L0 + CK_ZT + (r32 * 32 + 16 * ks + 8 * hh) * 2);
                    m2 = __builtin_amdgcn_mfma_f32_32x32x16_bf16(a, bq, m2, 0, 0, 0); }
#pragma unroll
                for (int r = 0; r < 16; ++r) *(LAS bf16*)(lds + CK_T + swz_el(32 + crow(r, hh), r32)) = (bf16)f2bf(m2[r]);
            }
        } else if (wave >= 5) {
            for (int job = wave - 5; job < 8; job += 3) {
                const int prod = 2 + (job >> 2), tq = job & 3, ti = tq >> 1, tj = tq & 1;
                f32x16 acc = zero16();
                if (!(ti == 0 && tj == 1)) mm_tile(acc, L0 + CK_OPS + 3 * 8192, 32 * ti, L0 + CK_OPS + ((prod & 1) ? 2 : 1) * 8192, 32 * tj, 0, 4, r32, hh);
                const int s = 32 * tj + r32;
#pragma unroll
                for (int r = 0; r < 16; ++r) { const int p = 32 * ti + crow(r, hh); const float v = (s <= p) ? acc[r] : 0.f;
                    *(LAS bf16*)(lds + CK_LIN + prod * 8192 + swz_el(p, s)) = (bf16)f2bf(v); }
            }
        } else {
            const int tq = wave - 1, ti = tq >> 1, tj = tq & 1; f32x16 acc = zero16();
            mm_tile(acc, L0 + CK_LIN + 1 * 8192, 32 * ti, L0 + CK_OPS + 6 * 8192, 32 * tj, 0, 4, r32, hh);
#pragma unroll
            for (int rq = 0; rq < 4; ++rq)
                *(LAS v2u*)(lds + CK_PT + swz_el(32 * tj + r32, 32 * ti + 8 * rq + 4 * hh)) = (v2u){pk2(acc[4 * rq], acc[4 * rq + 1]), pk2(acc[4 * rq + 2], acc[4 * rq + 3])};
        }
        __syncthreads();
        if (it + F.G < NB * 8 * 36 * 2) CK_LOAD(it + F.G);
        {
            const bool isW = wave < 4; const int tq = wave & 3, ti = tq >> 1, tj = tq & 1; f32x16 acc = zero16();
            mm_tile(acc, isW ? L0 + CK_OPS + 7 * 8192 : L0 + CK_PT, 32 * ti, L0 + CK_T, 32 * tj, 0, 4, r32, hh);
            LAS unsigned char* XT = isW ? lds + CK_WT : lds + CK_UT;
#pragma unroll
            for (int r = 0; r < 16; ++r) *(LAS bf16*)(XT + swz_el(32 * ti + crow(r, hh), 32 * tj + r32)) = (bf16)f2bf(acc[r]);
        }
        __syncthreads();
        {
            const LAS unsigned char* WT_ = L0 + CK_WT; const LAS unsigned char* UT_ = L0 + CK_UT;
            const LAS unsigned char* Arb = L0 + CK_LIN + 2 * 8192; const LAS unsigned char* Ark = L0 + CK_LIN + 3 * 8192;
            const LAS unsigned char* BhT = L0 + CK_OPS + 4 * 8192; const LAS unsigned char* KhT = L0 + CK_OPS + 5 * 8192; const LAS unsigned char* VT = L0 + CK_OPS + 6 * 8192;
            f32x16 acc2[2];
#pragma unroll
            for (int jj = 0; jj < 2; ++jj) { const int job = wave + 8 * jj, prod = job >> 2, tq = job & 3, ti = tq >> 1, tj = tq & 1;
                acc2[jj] = zero16();
                if (prod == 0) mm_tile(acc2[jj], Arb, 32 * ti, WT_, 32 * tj, 0, 4, r32, hh);
                else if (prod == 1) { mm_tile(acc2[jj], Arb, 32 * ti, UT_, 32 * tj, 0, 4, r32, hh); mm_tile(acc2[jj], Ark, 32 * ti, VT, 32 * tj, 0, 4, r32, hh); }
                else if (prod == 2) mm_tile(acc2[jj], WT_, 32 * ti, BhT, 32 * tj, 0, 4, r32, hh);
                else { mm_tile(acc2[jj], UT_, 32 * ti, BhT, 32 * tj, 0, 4, r32, hh); mm_tile(acc2[jj], VT, 32 * ti, KhT, 32 * tj, 0, 4, r32, hh); } }
#pragma unroll
            for (int jj = 0; jj < 2; ++jj) { const int job = wave + 8 * jj, prod = job >> 2, tq = job & 3, ti = tq >> 1, tj = tq & 1;
                const f32x16 acc = acc2[jj]; const int cc = 32 * tj + r32;
                if (prod == 0) {
#pragma unroll
                    for (int r = 0; r < 16; ++r) { const int p = 32 * ti + crow(r, hh); const float v = acc[r] + bf2f(*(const LAS bf16*)(L0 + CK_OPS + 3 * 8192 + swz_el(p, cc)));
                        CHRQ[(size_t)ci * 4096 + p * 64 + cc] = (bf16)f2bf(v); }
                } else if (prod == 1) {
#pragma unroll
                    for (int r = 0; r < 16; ++r) { const int p = 32 * ti + crow(r, hh); CHY[(size_t)ci * 4096 + p * 64 + cc] = (bf16)f2bf(acc[r]); }
                } else if (prod == 2) {
#pragma unroll
                    for (int rq = 0; rq < 4; ++rq) { const int k0 = 32 * ti + 8 * rq + 4 * hh;
                        *(v2u*)(CHG + (size_t)ci * 4096 + cc * 64 + k0) = (v2u){pk2(acc[4 * rq], acc[4 * rq + 1]), pk2(acc[4 * rq + 2], acc[4 * rq + 3])}; }
                } else {
#pragma unroll
                    for (int r = 0; r < 16; ++r) { const int v_ = 32 * ti + crow(r, hh); CHH[(size_t)ci * 4096 + v_ * 64 + cc] = (bf16)f2bf(acc[r]); }
                }
            }
        }
    }
#undef CK_LOAD
#undef CK_DECODE
}

__device__ __forceinline__ void p_state(Frame& F) {
    using namespace ck;
    const int lane = F.lane, wave = F.wave, r32 = lane & 31, hh = lane >> 5;
    const bf16* CHG = (const bf16*)(F.ws + WS_CHG); const bf16* CHH = (const bf16*)(F.ws + WS_CHH); const bf16* CHRQ = (const bf16*)(F.ws + WS_CHRQ); bf16* CHY = (bf16*)(F.ws + WS_CHY);
    const float* GLp = (const float*)(F.ws + WS_GL);
    LAS unsigned char* lds = F.lds + RING_OFF;
    for (int chain = F.bid; chain < NB * 8 * 2; chain += F.G) {
        const int d = chain & 1, h = (chain >> 1) & 7, b = chain >> 4;
        const int tq = wave & 3, ti = tq >> 1, tj = tq & 1; const bool isS = wave < 4;
        f32x16 S = zero16();
        __syncthreads();
        for (int i = F.tid; i < 8192 / 16; i += NTHR) *(LAS v4u*)(lds + i * 16) = (v4u){0u, 0u, 0u, 0u};
        bf16x8 frA[4], frB[4]; unsigned hvA[16], hvB[16]; float glA = 0.f, glB = 0.f;
#define ST_LOAD(fr, hv, gl, c_) do { const size_t cb_ = (size_t)chunk_index(b, h, d, (c_)) * 4096; \
            if (isS) { _Pragma("unroll") for (int ks = 0; ks < 4; ++ks) fr[ks] = *(const bf16x8*)(CHG + cb_ + (size_t)(32 * tj + r32) * 64 + 16 * ks + 8 * hh); \
                       _Pragma("unroll") for (int r = 0; r < 16; ++r) hv[r] = (unsigned)CHH[cb_ + (32 * ti + crow(r, hh)) * 64 + 32 * tj + r32]; \
                       gl = GLp[(size_t)chunk_index(b, h, d, (c_)) * 64 + 32 * tj + r32]; } \
            else { _Pragma("unroll") for (int ks = 0; ks < 4; ++ks) fr[ks] = *(const bf16x8*)(CHRQ + cb_ + (size_t)(32 * ti + r32) * 64 + 16 * ks + 8 * hh); \
                   _Pragma("unroll") for (int r = 0; r < 16; ++r) hv[r] = (unsigned)CHY[cb_ + (32 * ti + crow(r, hh)) * 64 + 32 * tj + r32]; } } while (0)
#define ST_STEP(fr, hv, gl, c_) do { const size_t cb = (size_t)chunk_index(b, h, d, (c_)) * 4096; \
            const LAS unsigned char* Sb = lds + ((c_) & 1) * 8192; LAS unsigned char* Sn = lds + (((c_) + 1) & 1) * 8192; \
            bf16x8 cf[4]; float cv[16]; const float cgl = gl; \
            _Pragma("unroll") for (int ks = 0; ks < 4; ++ks) cf[ks] = fr[ks]; \
            _Pragma("unroll") for (int r = 0; r < 16; ++r) cv[r] = __builtin_bit_cast(float, hv[r] << 16); \
            if ((c_) + 2 < NCH) ST_LOAD(fr, hv, gl, (c_) + 2);            \
            f32x16 acc = zero16(); \
            if (isS) { \
                _Pragma("unroll") for (int ks = 0; ks < 4; ++ks) { const bf16x8 a = *(const LAS bf16x8*)(Sb + swz(32 * ti + r32, 2 * ks + hh)); acc = __builtin_amdgcn_mfma_f32_32x32x16_bf16(a, cf[ks], acc, 0, 0, 0); } \
                _Pragma("unroll") for (int r = 0; r < 16; ++r) { const int v_ = 32 * ti + crow(r, hh); \
                    S[r] = S[r] * cgl + acc[r] + cv[r]; \
                    *(LAS bf16*)(Sn + swz_el(v_, 32 * tj + r32)) = (bf16)f2bf(S[r]); } \
            } else { \
                _Pragma("unroll") for (int ks = 0; ks < 4; ++ks) { const bf16x8 s = *(const LAS bf16x8*)(Sb + swz(32 * tj + r32, 2 * ks + hh)); acc = __builtin_amdgcn_mfma_f32_32x32x16_bf16(cf[ks], s, acc, 0, 0, 0); } \
                _Pragma("unroll") for (int r = 0; r < 16; ++r) { const int p = 32 * ti + crow(r, hh); CHY[cb + p * 64 + 32 * tj + r32] = (bf16)f2bf(acc[r] + cv[r]); } \
            } \
            __syncthreads(); } while (0)
        ST_LOAD(frA, hvA, glA, 0); ST_LOAD(frB, hvB, glB, 1);
        __syncthreads();
        for (int c = 0; c < NCH; c += 2) { ST_STEP(frA, hvA, glA, c); ST_STEP(frB, hvB, glB, c + 1); }
#undef ST_LOAD
#undef ST_STEP
    }
}

__device__ __forceinline__ void p_rope0(Frame& F) {
    const int gw = F.bid * NWAVES + F.wave, NGW = F.G * NWAVES;
    bf16* PB = (bf16*)(F.ws + WS_PB); const float* cosB = (const float*)(F.ws + WS_ROPE); const float* sinB = cosB + SEQ * 32;
    const int vec = F.lane >> 2, j8 = (F.lane & 3) * 8;
    for (int q = gw; q < NB * SEQ; q += 2 * NGW) {
        int qq[2]; qq[0] = q; qq[1] = q + NGW < NB * SEQ ? q + NGW : q; const bool ok1 = q + NGW < NB * SEQ;
        v4u a[2], b2[2]; f32x4 c0[2], c1[2], s0[2], s1[2]; bf16* pp[2];
#pragma unroll
        for (int s = 0; s < 2; ++s) { const int b = qq[s] / SEQ, t = qq[s] - b * SEQ; pp[s] = PB + (size_t)(b * TPB + CTXL + t) * B_IN + vec * 64 + j8;
            a[s] = *(const v4u*)pp[s]; b2[s] = *(const v4u*)(pp[s] + 32);
            c0[s] = *(const f32x4*)(cosB + t * 32 + j8); c1[s] = *(const f32x4*)(cosB + t * 32 + j8 + 4); s0[s] = *(const f32x4*)(sinB + t * 32 + j8); s1[s] = *(const f32x4*)(sinB + t * 32 + j8 + 4); }
#pragma unroll
        for (int s = 0; s < 2; ++s) {
            const unsigned aw[4] = {a[s].x, a[s].y, a[s].z, a[s].w}, bw[4] = {b2[s].x, b2[s].y, b2[s].z, b2[s].w};
            const float cs[8] = {c0[s].x, c0[s].y, c0[s].z, c0[s].w, c1[s].x, c1[s].y, c1[s].z, c1[s].w}, sn[8] = {s0[s].x, s0[s].y, s0[s].z, s0[s].w, s1[s].x, s1[s].y, s1[s].z, s1[s].w};
            float o1[8], o2[8];
#pragma unroll
            for (int i = 0; i < 8; ++i) { const int w = i >> 1; const bool up = i & 1; const float x1 = up ? bfhi(aw[w]) : bflo(aw[w]), x2 = up ? bfhi(bw[w]) : bflo(bw[w]);
                o1[i] = x1 * cs[i] - x2 * sn[i]; o2[i] = x1 * sn[i] + x2 * cs[i]; }
            if (s == 0 || ok1) { *(v4u*)pp[s] = (v4u){pk2(o1[0], o1[1]), pk2(o1[2], o1[3]), pk2(o1[4], o1[5]), pk2(o1[6], o1[7])};
                                 *(v4u*)(pp[s] + 32) = (v4u){pk2(o2[0], o2[1]), pk2(o2[2], o2[3]), pk2(o2[4], o2[5]), pk2(o2[6], o2[7])}; }
        }
    }
}

__device__ __forceinline__ void p_linact(Frame& F) {
    const int gw = F.bid * NWAVES + F.wave, NGW = F.G * NWAVES;
    const bf16* PA = (const bf16*)(F.ws + WS_PA); bf16* LA = (bf16*)((unsigned char*)F.out + DOUT_LINACT);
    const int cc = F.lane * 8; const bool act = F.lane < 48;
    const float* mu = F.in[I_AMU] + 1536 + (act ? cc : 0);
    const f32x4 m0 = *(const f32x4*)mu, m1 = *(const f32x4*)(mu + 4);
    const float mm[8] = {m0.x, m0.y, m0.z, m0.w, m1.x, m1.y, m1.z, m1.w};
    for (int row = gw; row < MROWS; row += NGW) {
        if (!act) continue;
        const int b = row / TPB, tt = row - b * TPB; const bool isctx = tt < CTXL; const int t = isctx ? tt : tt - CTXL, Ls = isctx ? CTXL : SEQ;
        const bf16* pc = PA + (size_t)row * A_IN + 1536 + cc;
        const v4u cur = *(const v4u*)pc; v4u prv = (v4u){0u, 0u, 0u, 0u}, nxt = (v4u){0u, 0u, 0u, 0u};
        if (t > 0) prv = *(const v4u*)(pc - A_IN);
        if (t + 1 < Ls) nxt = *(const v4u*)(pc + A_IN);
        const unsigned cw[4] = {cur.x, cur.y, cur.z, cur.w}, pw[4] = {prv.x, prv.y, prv.z, prv.w}, nw[4] = {nxt.x, nxt.y, nxt.z, nxt.w}; float u[8];
#pragma unroll
        for (int j = 0; j < 8; ++j) { const int w = j >> 1; const bool up = j & 1;
            const float cv = up ? bfhi(cw[w]) : bflo(cw[w]), pv = up ? bfhi(pw[w]) : bflo(pw[w]), nv = up ? bfhi(nw[w]) : bflo(nw[w]);
            float x = cv + (0.5f * (pv + nv) - cv) * mm[j];
            if (cc < 128) x = 1.f - 2.f * __builtin_amdgcn_rcpf(__builtin_amdgcn_exp2f(2.8853900817779268f * x) + 1.f); else if (cc >= 256) x = fsig(x);
            u[j] = x; }
        *(v4u*)(LA + (size_t)row * 384 + cc) = (v4u){pk2(u[0], u[1]), pk2(u[2], u[3]), pk2(u[4], u[5]), pk2(u[6], u[7])};
    }
}

__device__ __forceinline__ void p_attn0(Frame& F) {
    const bf16* PB = (const bf16*)(F.ws + WS_PB);
    unsigned* qctr = (unsigned*)(F.ws + WS_CTL) + CW_Q0;
    volatile LAS unsigned* slot = (volatile LAS unsigned*)(F.lds + MISC_OFF + 64);
    for (;;) {
        __syncthreads();
        if (F.tid == 0) slot[0] = atomicAdd(qctr, 1u);
        __syncthreads();
        const int u = (int)slot[0];
        if (u >= 576) break;
        int b, h, m, qt;
        if (u < 512) { qt = 1 + (u & 7); const int r = u >> 3; m = r & 1; h = (r >> 1) & 3; b = r >> 3; }
        else { const int r = u - 512; qt = 0; m = r & 1; h = (r >> 1) & 3; b = r >> 3; }
        const size_t row0 = (size_t)b * TPB;
        const bf16* Q = PB + (row0 + (size_t)qt * 256) * B_IN + h * 128 + m * 64;
        const bf16* Kp = PB + row0 * B_IN + 512 + h * 128 + m * 64;
        const bf16* Vp = PB + row0 * B_IN + 1024 + h * 128;
        bf16* O = (bf16*)(F.ws + (m == 0 ? WS_OB0 : WS_OB1)) + (row0 + (size_t)qt * 256) * 512 + h * 128;
        att::attn_body<64, B_IN, B_IN, 512>(Q, Kp, Vp, O, qt == 0 ? CTXL : TPB, (char*)g_lds + RING_OFF, F.wave);
    }
}

__device__ __forceinline__ void p_readout(Frame& F) {
    const int gw = F.bid * NWAVES + F.wave, NGW = F.G * NWAVES;
    const bf16* CHY = (const bf16*)(F.ws + WS_CHY); const bf16* fv = (const bf16*)(F.ws + WS_VOUT); const bf16* fg = (const bf16*)(F.ws + WS_GOUT); const float* BON = (const float*)(F.ws + WS_BON);
    const bf16* ob0 = (const bf16*)(F.ws + WS_OB0); const bf16* ob1 = (const bf16*)(F.ws + WS_OB1);
    bf16* A2 = (bf16*)(F.ws + WS_A2);
    float lam;
    { const float* lv = F.in[I_BLAM]; const float s1 = wave_sum(lv[F.lane] * lv[64 + F.lane]), s2 = wave_sum(lv[128 + F.lane] * lv[192 + F.lane]); lam = expf(s1) - expf(s2) + LAMBDA_INIT0; }
    const int c8 = F.lane * 8, hd = F.lane >> 3, v0 = (F.lane & 7) * 8;
    for (int row = gw; row < MROWS; row += NGW) {
        const size_t off = (size_t)row * 512 + c8;
        const int b = row / TPB, tt = row - b * TPB;
        const int ir = tt < CTXL ? (CTXL - 1 - tt) : CTXL + (TPB - 1 - tt);
        const size_t of = (size_t)ck::chunk_index(b, hd, 0, tt >> 6) * 4096 + (tt & 63) * 64 + v0, orv = (size_t)ck::chunk_index(b, hd, 1, ir >> 6) * 4096 + (ir & 63) * 64 + v0;
        const v4u qv = *(const v4u*)(fv + off), qg = *(const v4u*)(fg + off), q1 = *(const v4u*)(CHY + of), q2 = *(const v4u*)(CHY + orv);
        const unsigned wv_[4] = {qv.x, qv.y, qv.z, qv.w}, wg_[4] = {qg.x, qg.y, qg.z, qg.w}, w1_[4] = {q1.x, q1.y, q1.z, q1.w}, w2_[4] = {q2.x, q2.y, q2.z, q2.w};
        const float bon = BON[(size_t)row * 8 + hd] + BON[((size_t)MROWS + row) * 8 + hd];
        float y[8], s = 0.f;
#pragma unroll
        for (int j = 0; j < 8; ++j) { const int w = j >> 1; const bool up = j & 1; y[j] = (up ? bfhi(w1_[w]) : bflo(w1_[w])) + (up ? bfhi(w2_[w]) : bflo(w2_[w])); s += y[j]; }
        s = sum8(s);
        const float mean = s * (1.f / 64.f); float q = 0.f;
#pragma unroll
        for (int j = 0; j < 8; ++j) { y[j] -= mean; q += y[j] * y[j]; }
        q = sum8(q);
        const float rstd = 1.f / sqrtf(q * (1.f / 64.f) + GN_EPS);
        float o[8];
#pragma unroll
        for (int j = 0; j < 8; ++j) { const int w = j >> 1; const bool up = j & 1; const float v_ = up ? bfhi(wv_[w]) : bflo(wv_[w]), g_ = up ? bfhi(wg_[w]) : bflo(wg_[w]);
            o[j] = (y[j] * rstd * F.in[I_LNXG][c8 + j] + F.in[I_LNXB][c8 + j] + bon * v_) * g_; }
        *(v4u*)(A2 + (size_t)row * DM + c8) = (v4u){pk2(o[0], o[1]), pk2(o[2], o[3]), pk2(o[4], o[5]), pk2(o[6], o[7])};
        const v4u p0 = *(const v4u*)(ob0 + off), p1 = *(const v4u*)(ob1 + off);
        const unsigned u0[4] = {p0.x, p0.y, p0.z, p0.w}, u1[4] = {p1.x, p1.y, p1.z, p1.w};
        float z[8], ss = 0.f;
#pragma unroll
        for (int j = 0; j < 8; ++j) { const int w = j >> 1; const bool up = j & 1; z[j] = (up ? bfhi(u0[w]) : bflo(u0[w])) - lam * (up ? bfhi(u1[w]) : bflo(u1[w])); ss += z[j] * z[j]; }
        ss = sum16(ss);
        const float rr = 1.f / sqrtf(ss * (1.f / 128.f) + SUBLN_EPS) * (1.f - LAMBDA_INIT0);
#pragma unroll
        for (int j = 0; j < 8; ++j) z[j] = z[j] * rr * F.in[I_SUBG][(c8 + j) & 127];
        *(v4u*)(A2 + (size_t)row * DM + 512 + c8) = (v4u){pk2(z[0], z[1]), pk2(z[2], z[3]), pk2(z[4], z[5]), pk2(z[6], z[7])};
    }
}

__device__ __forceinline__ void p_qknorm1(Frame& F) {
    const int gw = F.bid * NWAVES + F.wave, NGW = F.G * NWAVES;
    bf16* QKV = (bf16*)(F.ws + WS_QKV1); const float* cosC = (const float*)(F.ws + WS_ROPE) + SEQ * 64; const float* sinC = cosC + SEQ * 64;
    const float qg1 = F.in[I_QNG][F.lane], qg2 = F.in[I_QNG][64 + F.lane], kg1 = F.in[I_KNG][F.lane], kg2 = F.in[I_KNG][64 + F.lane];
    for (int row = gw; row < MROWS; row += NGW) {
        const int b = row / TPB, tt = row - b * TPB; const bool lat = tt >= CTXL; const int t = tt - CTXL;
        float cs = 1.f, sn = 0.f; if (lat) { cs = cosC[t * 64 + F.lane]; sn = sinC[t * 64 + F.lane]; }
        bf16* p = QKV + (size_t)row * ODD_IN;
        for (int hd = 8; hd < 10; ++hd) {
            bf16* ph = p + hd * 128; const float x1 = bf2f(ph[F.lane]), x2 = bf2f(ph[64 + F.lane]);
            const float ss = wave_sum(x1 * x1 + x2 * x2); const float ri = 1.f / sqrtf(ss * (1.f / 128.f) + QKN_EPS);
            const float y1 = x1 * ri * (hd < 8 ? qg1 : kg1), y2 = x2 * ri * (hd < 8 ? qg2 : kg2);
            ph[F.lane] = (bf16)f2bf(y1 * cs - y2 * sn); ph[64 + F.lane] = (bf16)f2bf(y1 * sn + y2 * cs);
        }
    }
}
__device__ __forceinline__ void p_attn1(Frame& F) {
    const bf16* QKV = (const bf16*)(F.ws + WS_QKV1); bf16* OA = (bf16*)(F.ws + WS_OATT);
    for (int u = F.bid; u < 512; u += F.G) {
        const int qt = 1 + (u & 7), h = (u >> 3) & 7, b = u >> 6; const int kvh = h >> 2;
        const size_t row0 = (size_t)b * TPB;
        const bf16* Q = QKV + (row0 + (size_t)qt * 256) * ODD_IN + h * 128;
        const bf16* Kp = QKV + row0 * ODD_IN + 1024 + kvh * 128;
        const bf16* Vp = QKV + row0 * ODD_IN + 1280 + kvh * 128;
        bf16* O = OA + (row0 + (size_t)qt * 256) * DM + h * 128;
        att::attn_body<128, ODD_IN, ODD_IN, DM, true>(Q, Kp, Vp, O, TPB, (char*)g_lds + RING_OFF, F.wave, F.in[I_QNG], (const float*)(F.ws + WS_ROPE) + SEQ * 64, (const float*)(F.ws + WS_ROPE) + SEQ * 128, (qt - 1) * 256, QKN_EPS);
    }
}
namespace pg8 {
struct NoPre {};
struct EpiBf16 {
    static constexpr bool PERM = true; typedef NoPre Pre; __device__ __forceinline__ void prefetch(Pre&, const Unit&, int, int) const {}
    bf16_t* O; int ldc;
    __device__ __forceinline__ void operator()(const f32x4 (&acc)[2][2][4][2], const Unit& u, int wr, int wc, int fr, int fq, const Pre& pre) const {
        const int row0 = u.orow0 + wr * 64 + fr, col0 = u.pn * BM + wc * 32 + 8 * fq;
#pragma unroll
        for (int ai = 0; ai < 2; ++ai)
#pragma unroll
            for (int m = 0; m < 4; ++m) { bf16_t* rowp = O + (size_t)(row0 + ai * HALF + m * 16) * ldc + col0;
#pragma unroll
                for (int bj = 0; bj < 2; ++bj) { const f32x4 v0 = acc[ai][bj][m][0], v1 = acc[ai][bj][m][1];
                    u32x4 w; w.x = cvt_pk_bf16(v0[0], v0[1]); w.y = cvt_pk_bf16(v0[2], v0[3]); w.z = cvt_pk_bf16(v1[0], v1[1]); w.w = cvt_pk_bf16(v1[2], v1[3]);
                    *(u32x4*)(rowp + bj * HALF) = w; } }
    }
};
struct EpiIn0 {
    static constexpr bool PERM = true; typedef NoPre Pre; __device__ __forceinline__ void prefetch(Pre&, const Unit&, int, int) const {}
    bf16_t* PA; bf16_t* PB;
    __device__ __forceinline__ void operator()(const f32x4 (&acc)[2][2][4][2], const Unit& u, int wr, int wc, int fr, int fq, const Pre& pre) const {
        const int row0 = u.orow0 + wr * 64 + fr, col0 = u.pn * BM + wc * 32 + 8 * fq;
#pragma unroll
        for (int ai = 0; ai < 2; ++ai)
#pragma unroll
            for (int m = 0; m < 4; ++m) { const size_t row = (size_t)(row0 + ai * HALF + m * 16);
#pragma unroll
                for (int bj = 0; bj < 2; ++bj) { const f32x4 v0 = acc[ai][bj][m][0], v1 = acc[ai][bj][m][1]; const int col = col0 + bj * HALF;
                    u32x4 w; w.x = cvt_pk_bf16(v0[0], v0[1]); w.y = cvt_pk_bf16(v0[2], v0[3]); w.z = cvt_pk_bf16(v1[0], v1[1]); w.w = cvt_pk_bf16(v1[2], v1[3]);
                    if (col < 1920) *(u32x4*)(PA + row * 1920 + col) = w; else if (col < 3456) *(u32x4*)(PB + row * 1536 + (col - 1920)) = w; } }
    }
};
struct EpiMoe1 {
    static constexpr bool PERM = true; typedef NoPre Pre; __device__ __forceinline__ void prefetch(Pre&, const Unit&, int, int) const {}
    bf16_t* HID;
    __device__ __forceinline__ void operator()(const f32x4 (&acc)[2][2][4][2], const Unit& u, int wr, int wc, int fr, int fq, const Pre& pre) const {
        const int row0 = u.orow0 + wr * 64 + fr, col0 = u.pn * 128 + wc * 16 + 4 * fq;
#pragma unroll
        for (int ai = 0; ai < 2; ++ai)
#pragma unroll
            for (int m = 0; m < 4; ++m) { bf16_t* rowp = HID + (size_t)(row0 + ai * HALF + m * 16) * 512 + col0;
#pragma unroll
                for (int bj = 0; bj < 2; ++bj) { const f32x4 a = acc[ai][bj][m][0], b = acc[ai][bj][m][1]; float h[4];
#pragma unroll
                    for (int i = 0; i < 4; ++i) h[i] = a[i] / (1.f + __expf(-a[i])) * b[i];
                    u32x2 w; w.x = cvt_pk_bf16(h[0], h[1]); w.y = cvt_pk_bf16(h[2], h[3]);
                    *(u32x2*)(rowp + bj * 64) = w; } }
    }
};
struct EpiMoe2 {
    static constexpr bool PERM = true;
    struct Pre { float g[2][4]; };
    bf16_t* Y; const float* GATE;
    __device__ __forceinline__ void prefetch(Pre& p, const Unit& u, int wr, int fr) const {
#pragma unroll
        for (int ai = 0; ai < 2; ++ai)
#pragma unroll
            for (int m = 0; m < 4; ++m) { const int r = wr * 64 + fr + ai * HALF + m * 16; p.g[ai][m] = GATE[u.gbase + (r < u.nvalid ? r : 0)]; }
    }
    __device__ __forceinline__ void operator()(const f32x4 (&acc)[2][2][4][2], const Unit& u, int wr, int wc, int fr, int fq, const Pre& pre) const {
        const int r0 = wr * 64 + fr, col0 = u.pn * BM + wc * 32 + 8 * fq;
#pragma unroll
        for (int ai = 0; ai < 2; ++ai)
#pragma unroll
            for (int m = 0; m < 4; ++m) { const int r = r0 + ai * HALF + m * 16; if (r >= u.nvalid) continue;
                const float gt = pre.g[ai][m]; bf16_t* rowp = Y + (size_t)(u.orow0 + r) * 1024 + col0;
#pragma unroll
                for (int bj = 0; bj < 2; ++bj) { const f32x4 v0 = acc[ai][bj][m][0] * gt, v1 = acc[ai][bj][m][1] * gt;
                    u32x4 w; w.x = cvt_pk_bf16(v0[0], v0[1]); w.y = cvt_pk_bf16(v0[2], v0[3]); w.z = cvt_pk_bf16(v1[0], v1[1]); w.w = cvt_pk_bf16(v1[2], v1[3]);
                    *(u32x4*)(rowp + bj * HALF) = w; } }
    }
};
__device__ __forceinline__ void moe_build_table(const unsigned* cnt, PG8_LAS int* tab, int tid) {
    unsigned cn[16]; int total = 0;
#pragma unroll
    for (int e = 0; e < 16; ++e) { cn[e] = __hip_atomic_load(cnt + e, __ATOMIC_RELAXED, __HIP_MEMORY_SCOPE_AGENT); total += (int)((cn[e] + 255u) >> 8); }
    total *= 4;
    if (tid == 0) tab[0] = total;
    for (int L = tid; L < total; L += 512) {
        int base = 0, toff = 0, e = 0; bool found = false; unsigned ce = cn[0];
#pragma unroll
        for (int q = 0; q < 16; ++q) { const int nt = (int)((cn[q] + 255u) >> 8); if (!found) { if (L >= base + 4 * nt) { base += 4 * nt; toff += nt; e = q + 1; } else { found = true; ce = cn[q]; } } }
        const int nt_e = (int)((ce + 255u) >> 8); const int within = L - base, pn = within / nt_e, rt = within % nt_e;
        const int rem = (int)ce - rt * 256; const int nvalid = rem < 256 ? rem : 256;
        tab[4 + 2 * L] = e | (rt << 4) | (pn << 12) | (nvalid << 16); tab[4 + 2 * L + 1] = toff + rt;
    }
    __syncthreads();
}
template <bool GATHER_>
struct MoeOrder {
    static constexpr bool GATHER = GATHER_;
    const PG8_LAS int* tab; const int* perm; int G, c, K;
    __device__ __forceinline__ bool next(int i, Unit& u) const {
        const int total = __builtin_amdgcn_readfirstlane(tab[0]);
        const int L0 = i * G + c; if (L0 >= total) return false;
        const int L = xcd_remap(L0, total);
        const int w0 = __builtin_amdgcn_readfirstlane(tab[4 + 2 * L]), w1 = __builtin_amdgcn_readfirstlane(tab[4 + 2 * L + 1]);
        const int e = w0 & 15, rt = (w0 >> 4) & 255, pn = (w0 >> 12) & 3;
        u.pm = rt; u.pn = pn; u.e = e; u.gbase = e * 18432 + rt * 256; u.nvalid = (w0 >> 16) & 511; u.orow0 = w1 * 256;
        u.boff = ((size_t)e * 1024 + (size_t)pn * 256) * K * 2; u.aoff = (size_t)u.orow0 * K * 2; return true;
    }
    __device__ __forceinline__ int token(const Unit& u, int r) const { return perm[u.gbase + (r < u.nvalid ? r : 0)]; }
};
}

enum { PH_PROLOGUE = 0, PH_MOD0, PH_GEMM_IN0, PH_PREP, PH_CHUNK, PH_ATTN0, PH_READOUT, PH_GEMM_OUT0, PH_LNR0, PH_MOE1_0, PH_MOE2_0, PH_LN2_0,
       PH_GEMM_IN1, PH_QKN1, PH_ATTN1, PH_GEMM_OUT1, PH_LNR1, PH_MOE1_1, PH_MOE2_1, PH_FINAL, N_PHASES };

template <int LAYER> __device__ __forceinline__ void p_moe1(Frame& F) {
    pg8::Gemm g{(const pg8::bf16_t*)(F.ws + WS_H), (const pg8::bf16_t*)moe_w13(F, LAYER), DM};
    pg8::moe_build_table((const unsigned*)(F.ws + WS_CTL) + CW_CNT + LAYER * 64, (LAS int*)(F.lds + MOETAB_OFF), F.tid);
    pg8::MoeOrder<true> S{(const LAS int*)(F.lds + MOETAB_OFF), (const int*)(F.ws + WS_PERM_), F.G, F.bid, DM};
    pg8::EpiMoe1 E{(pg8::bf16_t*)(F.ws + WS_HID)};
    pg8::gemm_phase<pg8::EpiMoe1, pg8::MoeOrder<true>>(F.lds + RING_OFF, g, S, E, F.wave);
    if (LAYER == 0) convert_moe_filler(F, 1, ((const LAS int*)(F.lds + MOETAB_OFF))[0]);
}
template <int LAYER> __device__ __forceinline__ void p_moe2(Frame& F) {
    pg8::Gemm g{(const pg8::bf16_t*)(F.ws + WS_HID), (const pg8::bf16_t*)moe_w2(F, LAYER), EFF};
    pg8::moe_build_table((const unsigned*)(F.ws + WS_CTL) + CW_CNT + LAYER * 64, (LAS int*)(F.lds + MOETAB_OFF), F.tid);
    pg8::MoeOrder<false> S{(const LAS int*)(F.lds + MOETAB_OFF), (const int*)(F.ws + WS_PERM_), F.G, F.bid, EFF};
    pg8::EpiMoe2 E{(pg8::bf16_t*)(F.ws + WS_Y), (const float*)(F.ws + WS_GATE)};
    pg8::gemm_phase<pg8::EpiMoe2, pg8::MoeOrder<false>>(F.lds + RING_OFF, g, S, E, F.wave);
}
__device__ __forceinline__ void p_gemm_dense(Frame& F, size_t a_off, size_t w_off, int N, size_t o_off, int ldc, int skip9 = 0) {
    pg8::Gemm g{(const pg8::bf16_t*)(F.ws + a_off), (const pg8::bf16_t*)(F.ws + w_off), DM};
    pg8::DenseOrder S; S.init(MROWS, N, DM, F.G, F.bid, skip9);
    pg8::EpiBf16 E{(pg8::bf16_t*)(F.ws + o_off), ldc};
    pg8::gemm_phase<pg8::EpiBf16, pg8::DenseOrder>(F.lds + RING_OFF, g, S, E, F.wave);
}

template <int PH> __device__ __forceinline__ void run_phase(Frame& F) {
    if constexpr (PH == PH_PROLOGUE) p_mods(F);
    else if constexpr (PH == PH_MOD0) { p_prologue(F); p_mod0(F); }
    else if constexpr (PH == PH_GEMM_IN0) {
        pg8::Gemm g{(const pg8::bf16_t*)(F.ws + WS_H), (const pg8::bf16_t*)(F.ws + WS_WEVIN), DM};
        pg8::DenseOrder S; S.init(MROWS, EVEN_PAD, DM, F.G, F.bid);
        pg8::EpiIn0 E{(pg8::bf16_t*)(F.ws + WS_PA), (pg8::bf16_t*)(F.ws + WS_PB)};
        pg8::gemm_phase<pg8::EpiIn0, pg8::DenseOrder>(F.lds + RING_OFF, g, S, E, F.wave); }
    else if constexpr (PH == PH_PREP) { p_rope0(F); p_linact(F); }
    else if constexpr (PH == PH_CHUNK) p_chunk_pre(F);
    else if constexpr (PH == PH_ATTN0) { p_state(F); p_attn0(F); }
    else if constexpr (PH == PH_READOUT) p_readout(F);
    else if constexpr (PH == PH_GEMM_OUT0) { p_gemm_dense(F, WS_A2, WS_WEVOUT, DM, WS_MIX, DM); convert_moe_filler(F, 0, (MROWS / 256) * (DM / 256)); }
    else if constexpr (PH == PH_LNR0) p_ln_route<0>(F);
    else if constexpr (PH == PH_MOE1_0) p_moe1<0>(F);
    else if constexpr (PH == PH_MOE2_0) p_moe2<0>(F);
    else if constexpr (PH == PH_LN2_0) p_ln2<0>(F);
    else if constexpr (PH == PH_GEMM_IN1) p_gemm_dense(F, WS_H, WS_WODIN, ODD_IN, WS_QKV1, ODD_IN);
    else if constexpr (PH == PH_QKN1) p_qknorm1(F);
    else if constexpr (PH == PH_ATTN1) p_attn1(F);
    else if constexpr (PH == PH_GEMM_OUT1) p_gemm_dense(F, WS_OATT, WS_WODOUT, DM, WS_MIX, DM, 1);
    else if constexpr (PH == PH_LNR1) p_ln_route<1>(F);
    else if constexpr (PH == PH_MOE1_1) p_moe1<1>(F);
    else if constexpr (PH == PH_MOE2_1) p_moe2<1>(F);
    else if constexpr (PH == PH_FINAL) p_ln2<1>(F);
}
template <int PH, int HI> __device__ __forceinline__ void run_phases(Frame& F, const XcdBarrier& bar) {
    if constexpr (PH < HI) {
        {
            const CAS unsigned long long* inp = (const CAS unsigned long long*)__builtin_amdgcn_kernarg_segment_ptr(); asm volatile("" : "+s"(inp)); F.in.t = inp;
            asm volatile("" : "+s"(F.ws), "+s"(F.out), "+s"(F.G), "+s"(F.bid), "+s"(F.wave));
            const int l_ = lane_id_fresh(); F.lane = l_; F.tid = (F.wave << 6) | l_; }
        asm volatile("; PHASE_MARK %0" :: "i"(PH));
        run_phase<PH>(F);
        if constexpr (PH + 1 < HI) { xcd_barrier(bar, F.wave);
#ifdef XBAR_EXTRA
            if constexpr (PH == 5) { for (int q_ = 0; q_ < XBAR_EXTRA; ++q_) xcd_barrier(bar, F.wave); }
#endif
#ifdef TPROBE_A
            if (F.tid == 0) ((volatile LAS unsigned long long*)(F.lds + MISC_OFF + 128))[PH + 1] = __builtin_amdgcn_s_memrealtime();
#endif
            run_phases<PH + 1, HI>(F, bar); }
    }
}

template <int LO, int HI>
__global__ void __launch_bounds__(NTHR, 2) fwd_kernel(Args args) {
    Frame F;
    F.lds = (LAS unsigned char*)g_lds;
    F.tid = threadIdx.x; F.lane = F.tid & 63; F.wave = __builtin_amdgcn_readfirstlane(F.tid >> 6);
    F.G = gridDim.x; F.bid = blockIdx.x; F.in.t = (const CAS unsigned long long*)__builtin_amdgcn_kernarg_segment_ptr(); F.out = (GAS float*)args.out; F.ws = (GAS unsigned char*)args.ws;
    volatile LAS unsigned* MISC = (volatile LAS unsigned*)(F.lds + MISC_OFF);
    for (int u = F.tid; u < (LDS_BYTES - LDSCTL_OFF) / 4; u += NTHR) ((LAS unsigned*)(F.lds + LDSCTL_OFF))[u] = 0u;
    __syncthreads();
    XcdBarrier bar; bar.bar = (unsigned*)(F.ws + WS_CTL) + CW_BAR; bar.x = 0; bar.st = nullptr;
    if constexpr (HI - LO > 1) bar = xcd_barrier_post((unsigned*)(F.ws + WS_CTL) + CW_BAR, MISC + 8);
#ifdef TPROBE_A
    if (threadIdx.x == 0) ((volatile LAS unsigned long long*)(F.lds + MISC_OFF + 128))[0] = __builtin_amdgcn_s_memrealtime();
#endif
    run_phases<LO, HI>(F, bar);
}

#ifndef N_LAUNCH_MODE
#define N_LAUNCH_MODE 0
#endif
template <int PH> static void launch_from(int grid, hipStream_t stream, const Args& a) {
    if constexpr (PH < N_PHASES) {
        (void)hipFuncSetAttribute((const void*)fwd_kernel<PH, PH + 1>, hipFuncAttributeMaxDynamicSharedMemorySize, LDS_BYTES);
        hipLaunchKernelGGL((fwd_kernel<PH, PH + 1>), dim3(grid), dim3(NTHR), LDS_BYTES, stream, a);
#ifdef PROBE_MASK
        if ((PROBE_MASK >> PH) & 1) hipLaunchKernelGGL((fwd_kernel<PH, PH + 1>), dim3(grid), dim3(NTHR), LDS_BYTES, stream, a);
#endif
        launch_from<PH + 1>(grid, stream, a);
    }
}
extern "C" void kernel_launch(void* const* d_in, const int* in_sizes, int n_in, void* d_out, int out_size, void* d_ws, size_t ws_size, hipStream_t stream) {
    static int grid = 0;
    if (grid == 0) {
        if (n_in != 34 || in_sizes[0] != NB * SEQ * DM || out_size != NB * SEQ * DM || ws_size < WS_TOTAL) {
            fprintf(stderr, "kernel_launch: unexpected shapes: n_in %d in0 %d out %d ws %zu (need %zu)\n", n_in, n_in > 0 ? in_sizes[0] : -1, out_size, ws_size, (size_t)WS_TOTAL); grid = -1; return; }
        int dev = 0, cus = 0;
        if (hipGetDevice(&dev) != hipSuccess || hipDeviceGetAttribute(&cus, hipDeviceAttributeMultiprocessorCount, dev) != hipSuccess) { grid = -1; return; }
#if N_LAUNCH_MODE == 0
        if (hipFuncSetAttribute((const void*)fwd_kernel<0, N_PHASES>, hipFuncAttributeMaxDynamicSharedMemorySize, LDS_BYTES) != hipSuccess) { fprintf(stderr, "kernel_launch: hipFuncSetAttribute failed\n"); grid = -1; return; }
#endif
        (void)hipGetLastError();
        grid = cus;
    }
    if (grid < 0) return;
    if (hipMemsetAsync((char*)d_ws + WS_CTL, 0, CTL_ZERO_BYTES, stream) != hipSuccess) return;
    Args a{};
    for (int i = 0; i < 34; ++i) a.in[i] = (const float*)d_in[i];
    a.out = (float*)d_out; a.ws = (unsigned char*)d_ws;
#if N_LAUNCH_MODE == 1
    launch_from<0>(grid, stream, a);
#else
    hipLaunchKernelGGL((fwd_kernel<0, N_PHASES>), dim3(grid), dim3(NTHR), LDS_BYTES, stream, a);
#endif
    const hipError_t le = hipPeekAtLastError();
    if (le != hipSuccess) fprintf(stderr, "kernel_launch: launch failed: %s\n", hipGetErrorName(le));
}
```

```cpp
#include <hip/hip_runtime.h>
#include <hip/hip_bf16.h>
#include <cstdio>
#include <cstdint>
#include <cmath>
namespace pg8 {
__device__ __forceinline__ int pg8_lane_fresh() { unsigned m = ~0u; asm volatile("" : "+s"(m)); return (int)__builtin_amdgcn_mbcnt_hi(m, __builtin_amdgcn_mbcnt_lo(m, 0u)); }
#define PG8_LAS __attribute__((address_space(3)))
typedef unsigned short bf16_t;
typedef short bf16x8 __attribute__((ext_vector_type(8)));
typedef float f32x4 __attribute__((ext_vector_type(4)));
typedef unsigned u32x4 __attribute__((ext_vector_type(4)));
typedef unsigned u32x2 __attribute__((ext_vector_type(2)));
constexpr int BM = 256, BK = 64, HALF = 128, HTB = HALF * BK * 2  , STAGE_BYTES = 8 * HTB, NXCD = 8, WGM = 8;

__host__ __device__ __forceinline__ int lds_byte(int r, int c) { const int st = (r >> 4) * 2 + (c >> 5), rr = r & 15, cc = c & 31, ob = rr * 64 + cc * 2; return st * 1024 + (ob ^ (((ob >> 9) & 1) << 5)); }
__host__ __device__ __forceinline__ void stage_rc(int b, int& R, int& C) { const int st = b / 1024, sb = b % 1024, swz = sb ^ (((sb >> 9) & 1) << 5); R = (st >> 1) * 16 + swz / 64; C = (st & 1) * 32 + (swz % 64) / 2; }
__host__ __device__ __forceinline__ int perm32(int rho) { const int n = rho >> 4, i = rho & 15; return 8 * (i >> 2) + 4 * n + (i & 3); }

struct Unit { int pm, pn; size_t aoff, boff; int gbase, nvalid, orow0, e; };
struct Gemm { const bf16_t* A; const bf16_t* Bt; int K; };

__device__ __forceinline__ int xcd_remap(int wgid, int nwg) { const int q = nwg / NXCD, r = nwg % NXCD, xcd = wgid % NXCD, off = wgid / NXCD; return (xcd < r ? xcd * (q + 1) : r * (q + 1) + (xcd - r) * q) + off; }

struct DenseOrder {
    int nM, nN, nwg, G, c, K, skip9;
    static constexpr bool GATHER = false;
    __device__ void init(int M, int N, int K_, int G_, int c_, int skip9_ = 0) { skip9 = skip9_; nM = skip9 ? (M / BM) * 8 / 9 : M / BM; nN = N / BM; nwg = nM * nN; G = G_; c = c_; K = K_; }
    __device__ bool next(int i, Unit& u) const {
        const long L = (long)i * G + c; if (L >= nwg) return false;
        const int wgid = xcd_remap((int)L, nwg);
        const int nig = WGM * nN, gid = wgid / nig, fm = gid * WGM, gsz = (nM - fm) < WGM ? (nM - fm) : WGM;
        u.pm = fm + ((wgid % nig) % gsz); u.pn = (wgid % nig) / gsz;
        if (skip9) u.pm = u.pm + u.pm / 8 + 1;
        u.aoff = (size_t)u.pm * BM * K * 2; u.boff = (size_t)u.pn * BM * K * 2; u.gbase = 0; u.nvalid = BM; u.orow0 = u.pm * BM; u.e = 0; return true;
    }
    __device__ __forceinline__ int token(const Unit&, int) const { return 0; }
};

__device__ __forceinline__ unsigned cvt_pk_bf16(float lo, float hi) { unsigned r; asm volatile("v_cvt_pk_bf16_f32 %0, %1, %2" : "=v"(r) : "v"(lo), "v"(hi)); return r; }

template <class Epi, class Sched>
__device__ __forceinline__ void gemm_phase(PG8_LAS unsigned char* lds, const Gemm g, const Sched& S, const Epi& E, int wave_id) {
    int tid = (wave_id << 6) | pg8_lane_fresh(); asm volatile("" : "+v"(tid));
    const int wid = __builtin_amdgcn_readfirstlane(tid >> 6), lane = tid & 63, wr = wid >> 2, wc = wid & 3, fr = lane & 15, fq = lane >> 4;
    const int K = g.K, nt = K / BK;
    int RA[2], CA[2];
    unsigned voffB[2], voffA[2][2], voffAn[2][2];
#pragma unroll
    for (int i = 0; i < 2; ++i) { int R, C; stage_rc(tid * 16 + i * 8192, R, C); RA[i] = R; CA[i] = C; const int Rb = Epi::PERM ? ((R & ~31) + perm32(R & 31)) : R;
        voffB[i] = (unsigned)(Rb * K + C) * 2u;
        voffA[0][i] = (unsigned)(R * K + C) * 2u; voffA[1][i] = (unsigned)((R + HALF) * K + C) * 2u; voffAn[0][i] = voffA[0][i]; voffAn[1][i] = voffA[1][i]; }
    const size_t kstep = (size_t)(BK * 2);
    const size_t hstep = (size_t)HALF * K * 2;
    const unsigned ldsw = (unsigned)wid * 1024u;
    const int aoff = lds_byte(wr * 64 + fr, fq * 8), boff = lds_byte(wc * 32 + fr, fq * 8);
#define PG8_SA(b, h) (((b) * 2 + (h)) * HTB)
#define PG8_SB(b, h) ((4 + (b) * 2 + (h)) * HTB)
#define PG8_STAGE(bufoff, gbase, voff) do { _Pragma("unroll") for (int _i = 0; _i < 2; ++_i) \
        __builtin_amdgcn_global_load_lds((const unsigned*)((const char*)(gbase) + (voff)[_i]), (PG8_LAS unsigned*)(lds + (bufoff) + ldsw + _i * 8192), 16, 0, 0); } while (0)
#define PG8_LDA(dst, b, h) do { _Pragma("unroll") for (int m = 0; m < 4; ++m) _Pragma("unroll") for (int k = 0; k < 2; ++k) dst[m][k] = *(const PG8_LAS bf16x8*)(lds + PG8_SA(b, h) + aoff + m * 2048 + k * 1024); } while (0)
#define PG8_LDB(dst, b, h) do { _Pragma("unroll") for (int n = 0; n < 2; ++n) _Pragma("unroll") for (int k = 0; k < 2; ++k) dst[n][k] = *(const PG8_LAS bf16x8*)(lds + PG8_SB(b, h) + boff + n * 2048 + k * 1024); } while (0)
#define PG8_MMA(ai, bj, At, Bt) do { __builtin_amdgcn_s_setprio(1); _Pragma("unroll") for (int m = 0; m < 4; ++m) _Pragma("unroll") for (int n = 0; n < 2; ++n) _Pragma("unroll") for (int k = 0; k < 2; ++k) \
        acc[ai][bj][m][n] = __builtin_amdgcn_mfma_f32_16x16x32_bf16(Bt[n][k], At[m][k], acc[ai][bj][m][n], 0, 0, 0); __builtin_amdgcn_s_setprio(0); } while (0)
#define PG8_WAIT_V(n) asm volatile("s_waitcnt vmcnt(" #n ")" ::: "memory")
#define PG8_WAIT_L(n) asm volatile("s_waitcnt lgkmcnt(" #n ")" ::: "memory")
#define PG8_BAR __builtin_amdgcn_s_barrier()
#define PG8_SCHED __builtin_amdgcn_sched_barrier(0)
#define PG8_GOFF(dst, U) do { if constexpr (Sched::GATHER) { _Pragma("unroll") for (int _h = 0; _h < 2; ++_h) _Pragma("unroll") for (int _i = 0; _i < 2; ++_i) \
        dst[_h][_i] = (unsigned)(S.token(U, _h * HALF + RA[_i]) * K + CA[_i]) * 2u; } } while (0)
    Unit cur, nxt; int ui = 0;
    if (!S.next(0, cur)) return;
    f32x4 acc[2][2][4][2];
#pragma unroll
    for (int a = 0; a < 2; ++a)
#pragma unroll
        for (int b = 0; b < 2; ++b)
#pragma unroll
            for (int m = 0; m < 4; ++m)
#pragma unroll
                for (int n = 0; n < 2; ++n) acc[a][b][m][n] = (f32x4){0.f, 0.f, 0.f, 0.f};
    bf16x8 At[4][2], B0[2][2], B1[2][2];
    typename Epi::Pre pre; E.prefetch(pre, cur, wr, fr);
    PG8_GOFF(voffA, cur);
    const char* cA = (const char*)g.A + (Sched::GATHER ? (size_t)0 : cur.aoff); const char* cB = (const char*)g.Bt + cur.boff;
    PG8_STAGE(PG8_SB(0, 0), cB, voffB); PG8_STAGE(PG8_SA(0, 0), cA, voffA[0]); PG8_STAGE(PG8_SB(0, 1), cB + hstep, voffB); PG8_STAGE(PG8_SA(0, 1), cA, voffA[1]);
    if (wr == 1) PG8_BAR;
    PG8_WAIT_V(4); PG8_BAR;
    PG8_STAGE(PG8_SB(1, 0), cB + kstep, voffB); PG8_STAGE(PG8_SA(1, 0), cA + kstep, voffA[0]); PG8_STAGE(PG8_SB(1, 1), cB + hstep + kstep, voffB);
    PG8_WAIT_V(6); PG8_BAR;
    for (;;) {
        const bool has_next = S.next(ui + 1, nxt);
        if (has_next) { PG8_GOFF(voffAn, nxt); if constexpr (Sched::GATHER) { asm volatile("" : "+v"(voffAn[0][0]), "+v"(voffAn[0][1]), "+v"(voffAn[1][0]), "+v"(voffAn[1][1])); } }
        const char* nA = has_next ? (const char*)g.A + (Sched::GATHER ? (size_t)0 : nxt.aoff) : cA; const char* nB = has_next ? (const char*)g.Bt + nxt.boff : cB;
        for (int t = 0; t < nt; t += 2) {
            const bool last = (t == nt - 2);
            const char* a1 = cA + (size_t)(t + 1) * kstep;
            const char* a2 = last ? nA : cA + (size_t)(t + 2) * kstep; const char* b2 = last ? nB : cB + (size_t)(t + 2) * kstep;
            const char* a3 = a2 + kstep; const char* b3 = b2 + kstep;
            unsigned va2[2][2];
#pragma unroll
            for (int h = 0; h < 2; ++h)
#pragma unroll
                for (int i = 0; i < 2; ++i) va2[h][i] = (Sched::GATHER && last && has_next) ? voffAn[h][i] : voffA[h][i];
            PG8_LDB(B0, 0, 0); PG8_SCHED; PG8_LDA(At, 0, 0); PG8_STAGE(PG8_SA(1, 1), a1, voffA[1]);
            PG8_WAIT_L(8); PG8_BAR; PG8_WAIT_L(0); PG8_MMA(0, 0, At, B0); PG8_BAR; PG8_SCHED;
            PG8_LDB(B1, 0, 1); PG8_STAGE(PG8_SB(0, 0), b2, voffB);
            PG8_BAR; PG8_WAIT_L(0); PG8_MMA(0, 1, At, B1); PG8_BAR;
            PG8_LDA(At, 0, 1); PG8_STAGE(PG8_SA(0, 0), a2, va2[0]);
            PG8_BAR; PG8_WAIT_L(0); PG8_MMA(1, 0, At, B0); PG8_BAR; PG8_SCHED;
            PG8_STAGE(PG8_SB(0, 1), b2 + hstep, voffB);
            PG8_WAIT_V(6); PG8_BAR; PG8_MMA(1, 1, At, B1); PG8_BAR;
            PG8_LDB(B0, 1, 0); PG8_SCHED; PG8_LDA(At, 1, 0); PG8_STAGE(PG8_SA(0, 1), a2, va2[1]);
            PG8_WAIT_L(8); PG8_BAR; PG8_WAIT_L(0); PG8_MMA(0, 0, At, B0); PG8_BAR; PG8_SCHED;
            PG8_LDB(B1, 1, 1); PG8_STAGE(PG8_SB(1, 0), b3, voffB);
            PG8_BAR; PG8_WAIT_L(0); PG8_MMA(0, 1, At, B1); PG8_BAR;
            PG8_LDA(At, 1, 1); PG8_STAGE(PG8_SA(1, 0), a3, va2[0]);
            PG8_BAR; PG8_WAIT_L(0); PG8_MMA(1, 0, At, B0); PG8_BAR; PG8_SCHED;
            PG8_STAGE(PG8_SB(1, 1), b3 + hstep, voffB);
            PG8_WAIT_V(6); PG8_BAR; PG8_MMA(1, 1, At, B1); PG8_BAR;
        }
        if (wr == 0) PG8_BAR;
        E(acc, cur, wr, wc, fr, fq, pre);
        if (!has_next) break;
#pragma unroll
        for (int a = 0; a < 2; ++a)
#pragma unroll
            for (int b = 0; b < 2; ++b)
#pragma unroll
                for (int m = 0; m < 4; ++m)
#pragma unroll
                    for (int n = 0; n < 2; ++n) acc[a][b][m][n] = (f32x4){0.f, 0.f, 0.f, 0.f};
        cur = nxt; cA = nA; cB = nB; ++ui;
        E.prefetch(pre, cur, wr, fr);
        if (wr == 1) PG8_BAR;
        if constexpr (Sched::GATHER) {
#pragma unroll
            for (int h = 0; h < 2; ++h)
#pragma unroll
                for (int i = 0; i < 2; ++i) voffA[h][i] = voffAn[h][i];
        }
    }
    PG8_WAIT_V(0);
    PG8_BAR;
#undef PG8_SA
#undef PG8_SB
#undef PG8_STAGE
#undef PG8_LDA
#undef PG8_LDB
#undef PG8_MMA
#undef PG8_WAIT_V
#undef PG8_WAIT_L
#undef PG8_BAR
#undef PG8_SCHED
#undef PG8_GOFF
}
}
namespace att {
using bf16x8 = __attribute__((ext_vector_type(8))) short;
using s16x4  = __attribute__((ext_vector_type(4))) short;
using f32x16 = __attribute__((ext_vector_type(16))) float;
using u32x4  = __attribute__((ext_vector_type(4))) unsigned;
typedef unsigned short bf16_t;
constexpr int NW = 8, QBLK = 32, KVBLK = 64;
constexpr float THR = 8.f;
constexpr size_t SHM_V = KVBLK * 128 * 2, SHM_K = KVBLK * 128 * 2, SHM_ATTN = 3 * SHM_V + 3 * SHM_K + NW * 64 * 4;
#define KSWZ(row, colB) ((row) * 256 + ((colB) ^ (((row) & 7) << 4)))
#define KSWZ64(row, colB) ((row) * 128 + ((colB) ^ ((((row) >> 1) & 7) << 4)))
#define SBAR() __builtin_amdgcn_sched_barrier(0)
__device__ __forceinline__ int crow(int r, int hi) { return (r & 3) + 8 * (r >> 2) + 4 * hi; }
__device__ __forceinline__ unsigned cvtpk(float lo, float hi) { unsigned r; asm volatile("v_cvt_pk_bf16_f32 %0, %1, %2" : "=v"(r) : "v"(lo), "v"(hi)); return r; }

template <int DQK> struct Sc { static constexpr float SCALE = (DQK == 64) ? 0.125f : 0.088388347648318440f; };

template <int DQK>
__device__ __forceinline__ void partialSM(f32x16& p0, f32x16& p1, float& m_reg, float& mn, float& alpha) {
  constexpr float SCALE = Sc<DQK>::SCALE;
  constexpr float C = SCALE * 1.4426950408889634f;
  float pmax = p0[0];
#pragma unroll
  for (int r = 1; r < 16; ++r) pmax = fmaxf(pmax, p0[r]);
#pragma unroll
  for (int r = 0; r < 16; ++r) pmax = fmaxf(pmax, p1[r]);
  { auto rr = __builtin_amdgcn_permlane32_swap(__float_as_uint(pmax), __float_as_uint(pmax), false, false);
    pmax = fmaxf(__uint_as_float(rr[0]), __uint_as_float(rr[1])); }
  if (__builtin_expect(__all(pmax - m_reg <= THR / SCALE), 1)) { mn = m_reg; alpha = 1.f; }
  else { mn = fmaxf(m_reg, pmax); alpha = __builtin_amdgcn_exp2f((m_reg - mn) * C); m_reg = mn; }
  float mnC = -mn * C;
#pragma unroll
  for (int r = 0; r < 16; ++r) p0[r] = fmaf(p0[r], C, mnC);
#pragma unroll
  for (int r = 0; r < 16; ++r) p1[r] = fmaf(p1[r], C, mnC);
#pragma unroll
  for (int r = 0; r < 16; ++r) p0[r] = __builtin_amdgcn_exp2f(p0[r]);
}
__device__ __forceinline__ void finishSM(f32x16& p0, f32x16& p1, float alpha, float& l_reg, bf16x8& pa0, bf16x8& pa1, bf16x8& pa2, bf16x8& pa3) {
#pragma unroll
  for (int r = 0; r < 16; ++r) p1[r] = __builtin_amdgcn_exp2f(p1[r]);
  float ps = 0;
#pragma unroll
  for (int r = 0; r < 16; ++r) ps += p0[r];
#pragma unroll
  for (int r = 0; r < 16; ++r) ps += p1[r];
  { auto rr = __builtin_amdgcn_permlane32_swap(__float_as_uint(ps), __float_as_uint(ps), false, false);
    ps = __uint_as_float(rr[0]) + __uint_as_float(rr[1]); }
  l_reg = l_reg * alpha + ps;
#define PK4(P, BASE, OUT) do { unsigned a0 = cvtpk(P[BASE + 0], P[BASE + 1]), a1 = cvtpk(P[BASE + 2], P[BASE + 3]);   \
    unsigned b0 = cvtpk(P[BASE + 4], P[BASE + 5]), b1 = cvtpk(P[BASE + 6], P[BASE + 7]);                              \
    auto r0 = __builtin_amdgcn_permlane32_swap(a0, b0, false, false); auto r1 = __builtin_amdgcn_permlane32_swap(a1, b1, false, false); \
    u32x4 w = {r0[0], r1[0], r0[1], r1[1]}; OUT = *reinterpret_cast<bf16x8*>(&w); } while (0)
  PK4(p0, 0, pa0); PK4(p0, 8, pa1); PK4(p1, 0, pa2); PK4(p1, 8, pa3);
#undef PK4
}
template <int DQK>
__device__ __forceinline__ void qkt(f32x16& p0, f32x16& p1, const char* Ks, const bf16x8* qr, int r32, int hi) {
#pragma unroll
  for (int r = 0; r < 16; ++r) { p0[r] = 0.f; p1[r] = 0.f; }
  asm volatile("" : "+v"(p0), "+v"(p1));
#define QK_LD(d0_, x0_, x1_) do { const int cb_ = ((d0_) * 16 + hi * 8) * 2; \
    if constexpr (DQK == 128) { x0_ = *reinterpret_cast<const bf16x8*>(Ks + KSWZ(r32, cb_)); x1_ = *reinterpret_cast<const bf16x8*>(Ks + KSWZ(32 + r32, cb_)); } \
    else { x0_ = *reinterpret_cast<const bf16x8*>(Ks + KSWZ64(r32, cb_)); x1_ = *reinterpret_cast<const bf16x8*>(Ks + KSWZ64(32 + r32, cb_)); } } while (0)
  bf16x8 b0, b1, n0, n1;
  QK_LD(0, b0, b1);
#pragma unroll
  for (int d0 = 0; d0 < DQK / 16; ++d0) {
    if (d0 + 1 < DQK / 16) QK_LD(d0 + 1, n0, n1);
    p0 = __builtin_amdgcn_mfma_f32_32x32x16_bf16(b0, qr[d0], p0, 0, 0, 0);
    p1 = __builtin_amdgcn_mfma_f32_32x32x16_bf16(b1, qr[d0], p1, 0, 0, 0);
    b0 = n0; b1 = n1; }
#undef QK_LD
}
__device__ __forceinline__ int v_st(int k, int c) { const int kk = (k & ~0xC) | ((k & 4) << 1) | ((k & 8) >> 1); return ((kk >> 3) * 4 + (c >> 5)) * 512 + ((kk & 7) * 32 + (c & 31)) * 2; }
__device__ __forceinline__ int v_rd_base(int lane) { return ((lane & 3) << 3) | (((lane >> 2) & 3) << 6) | (((lane >> 4) & 1) << 5) | (((lane >> 5) & 1) << 8); }
constexpr int v_rd_off(int d0, int ks, int half) { return d0 * 512 + ks * 4096 + half * 2048; }
template <int OFF> __device__ __forceinline__ s16x4 tr_read(int vb) {
  s16x4 r; asm volatile("ds_read_b64_tr_b16 %0, %1 offset:%2" : "=&v"(r) : "v"(vb), "i"(OFF) : "memory"); return r;
}
template <int D0> __device__ __forceinline__ void pv_one(f32x16& od, int vb, bf16x8 pa0, bf16x8 pa1, bf16x8 pa2, bf16x8 pa3) {
  const s16x4 l0 = tr_read<v_rd_off(D0, 0, 0)>(vb), h0 = tr_read<v_rd_off(D0, 0, 1)>(vb), l1 = tr_read<v_rd_off(D0, 1, 0)>(vb), h1 = tr_read<v_rd_off(D0, 1, 1)>(vb);
  const s16x4 l2 = tr_read<v_rd_off(D0, 2, 0)>(vb), h2 = tr_read<v_rd_off(D0, 2, 1)>(vb), l3 = tr_read<v_rd_off(D0, 3, 0)>(vb), h3 = tr_read<v_rd_off(D0, 3, 1)>(vb);
  asm volatile("s_waitcnt lgkmcnt(0)" ::: "memory"); SBAR();
#define PK(L, H) (bf16x8){L[0], L[1], L[2], L[3], H[0], H[1], H[2], H[3]}
  od = __builtin_amdgcn_mfma_f32_32x32x16_bf16(pa0, PK(l0, h0), od, 0, 0, 0);
  od = __builtin_amdgcn_mfma_f32_32x32x16_bf16(pa1, PK(l1, h1), od, 0, 0, 0);
  od = __builtin_amdgcn_mfma_f32_32x32x16_bf16(pa2, PK(l2, h2), od, 0, 0, 0);
  od = __builtin_amdgcn_mfma_f32_32x32x16_bf16(pa3, PK(l3, h3), od, 0, 0, 0);
#undef PK
}
__device__ __forceinline__ void pv_d0(f32x16* o, int vb, bf16x8 pa0, bf16x8 pa1, bf16x8 pa2, bf16x8 pa3) {
  pv_one<0>(o[0], vb, pa0, pa1, pa2, pa3); pv_one<1>(o[1], vb, pa0, pa1, pa2, pa3); pv_one<2>(o[2], vb, pa0, pa1, pa2, pa3); pv_one<3>(o[3], vb, pa0, pa1, pa2, pa3);
}

template <int DQK, int LDQ, int LDK, int LDO, bool QN = false>
__device__ __forceinline__ void attn_body(const bf16_t* __restrict__ Qb, const bf16_t* __restrict__ Kh, const bf16_t* __restrict__ Vh, bf16_t* __restrict__ Ob, int seq, char* lds, int wave_id,
                                          const float* qg = nullptr, const float* cs = nullptr, const float* sn = nullptr, int qpos0 = 0, float qeps = 0.f) {
  unsigned lm_ = ~0u; asm volatile("" : "+s"(lm_)); int tid = (wave_id << 6) | (int)__builtin_amdgcn_mbcnt_hi(lm_, __builtin_amdgcn_mbcnt_lo(lm_, 0u)); asm volatile("" : "+v"(tid));
  const int wid = tid >> 6, lane = tid & 63, r32 = lane & 31, hi = lane >> 5;
  char* V_lds = lds; char* K_lds = lds + 3 * SHM_V;
  float* ws = (float*)(lds + 3 * SHM_V + 3 * SHM_K) + wid * 64; float* li_l = ws; float* al_l = ws + 32;
  float m_reg = -1e30f, l_reg = 0; f32x16 o[4] = {}; bf16x8 qr[DQK / 16];
  const bf16_t* Qw = Qb + (long)(wid * QBLK + r32) * LDQ + hi * 8;
#pragma unroll
  for (int d0 = 0; d0 < DQK / 16; ++d0) qr[d0] = *reinterpret_cast<const bf16x8*>(Qw + d0 * 16);
  if constexpr (QN) {
    static_assert(!QN || DQK == 128, "QN needs head dim 128");
    float qf[8][8]; float ss = 0.f;
#pragma unroll
    for (int d0 = 0; d0 < 8; ++d0)
#pragma unroll
      for (int j = 0; j < 8; ++j) { const float v = __builtin_bit_cast(float, (unsigned)(unsigned short)qr[d0][j] << 16); qf[d0][j] = v; ss += v * v; }
    { auto rr = __builtin_amdgcn_permlane32_swap(__float_as_uint(ss), __float_as_uint(ss), false, false); ss = __uint_as_float(rr[0]) + __uint_as_float(rr[1]); }
    const float ri = __builtin_amdgcn_rsqf(ss * (1.f / 128.f) + qeps);
    const int pos = qpos0 + wid * QBLK + r32;
#pragma unroll
    for (int d0 = 0; d0 < 4; ++d0) {
      const int i0 = 16 * d0 + 8 * hi;
#pragma unroll
      for (int j = 0; j < 8; ++j) { const float c = cs[pos * 64 + i0 + j], s = sn[pos * 64 + i0 + j];
        const float y1 = qf[d0][j] * ri * qg[i0 + j], y2 = qf[d0 + 4][j] * ri * qg[64 + i0 + j];
        qf[d0][j] = y1 * c - y2 * s; qf[d0 + 4][j] = y1 * s + y2 * c; }
    }
#pragma unroll
    for (int d0 = 0; d0 < 8; ++d0) { u32x4 w = {cvtpk(qf[d0][0], qf[d0][1]), cvtpk(qf[d0][2], qf[d0][3]), cvtpk(qf[d0][4], qf[d0][5]), cvtpk(qf[d0][6], qf[d0][7])}; qr[d0] = *reinterpret_cast<bf16x8*>(&w); }
  }
  const int sr = tid >> 4, sc = (tid & 15) * 8, vst0 = v_st(sr, sc), vst1 = v_st(32 + sr, sc);
  const int kr64 = tid >> 3, kc64 = (tid & 7) * 8;
  const int vb0 = (int)(uintptr_t)V_lds + v_rd_base(lane);
  struct { bf16x8 vs0, vs1, ks0, ks1; } sr_[2];
#define SLOAD(i, k0) do { sr_[i].vs0 = *reinterpret_cast<const bf16x8*>(&Vh[(long)((k0) + sr) * LDK + sc]); sr_[i].vs1 = *reinterpret_cast<const bf16x8*>(&Vh[(long)((k0) + 32 + sr) * LDK + sc]); \
    if constexpr (DQK == 128) { sr_[i].ks0 = *reinterpret_cast<const bf16x8*>(&Kh[(long)((k0) + sr) * LDK + sc]); sr_[i].ks1 = *reinterpret_cast<const bf16x8*>(&Kh[(long)((k0) + 32 + sr) * LDK + sc]); } \
    else { sr_[i].ks0 = *reinterpret_cast<const bf16x8*>(&Kh[(long)((k0) + kr64) * LDK + kc64]); } } while (0)
#define SWRITE(b, i) do { *(bf16x8*)(V_lds + (b) * SHM_V + vst0) = sr_[i].vs0;          \
    *(bf16x8*)(V_lds + (b) * SHM_V + vst1) = sr_[i].vs1;               \
    if constexpr (DQK == 128) { const int kc = sc * 2; *(bf16x8*)(K_lds + (b) * SHM_K + KSWZ(sr, kc)) = sr_[i].ks0; *(bf16x8*)(K_lds + (b) * SHM_K + KSWZ(32 + sr, kc)) = sr_[i].ks1; } \
    else { const int kc = kc64 * 2; *(bf16x8*)(K_lds + (b) * SHM_K + KSWZ64(kr64, kc)) = sr_[i].ks0; } } while (0)
#define SWAIT() do { if constexpr (DQK == 128) asm volatile("s_waitcnt vmcnt(4)" ::: "memory"); else asm volatile("s_waitcnt vmcnt(3)" ::: "memory"); } while (0)
#define RESC(a) do { if (__any((a) < 1.f)) { if (hi == 0) al_l[r32] = (a); asm volatile("s_waitcnt lgkmcnt(0)" ::: "memory"); \
    _Pragma("unroll") for (int d = 0; d < 4; ++d) _Pragma("unroll") for (int r = 0; r < 16; ++r) o[d][r] *= al_l[crow(r, hi)]; } } while (0)
  f32x16 pA0, pA1, pB0, pB1; float mnA, mnB, alA, alB; bf16x8 pa0, pa1, pa2, pa3; const int NT = seq / KVBLK;
  SLOAD(0, 0); asm volatile("s_waitcnt vmcnt(0)" ::: "memory"); SWRITE(0, 0);
  SLOAD(1, KVBLK);
  __syncthreads();
  SWRITE(1, 1);
  qkt<DQK>(pA0, pA1, K_lds, qr, r32, hi); if (2 < NT) SLOAD(0, 2 * KVBLK); partialSM<DQK>(pA0, pA1, m_reg, mnA, alA);
  __syncthreads();
#define IL_QK() do { __builtin_amdgcn_sched_group_barrier(0x100, 2, 0); _Pragma("unroll") for (int i_ = 0; i_ < DQK / 16; ++i_) { __builtin_amdgcn_sched_group_barrier(0x100, 2, 0); __builtin_amdgcn_sched_group_barrier(0x008, 1, 0); __builtin_amdgcn_sched_group_barrier(0x002, (DQK == 128 ? 6 : 12), 0); __builtin_amdgcn_sched_group_barrier(0x008, 1, 0); __builtin_amdgcn_sched_group_barrier(0x002, (DQK == 128 ? 6 : 12), 0); } } while (0)
  int s_prev = 0, s_cur = 1, s_next = 2;
#define ROT3() do { const int t_ = s_prev; s_prev = s_cur; s_cur = s_next; s_next = t_; } while (0)
  for (int j = 1; j + 1 < NT; j += 2) {
    SWRITE(s_next, 0);
    SBAR(); qkt<DQK>(pB0, pB1, K_lds + s_cur * SHM_K, qr, r32, hi);
    finishSM(pA0, pA1, alA, l_reg, pa0, pa1, pa2, pa3); SBAR();
    SLOAD(1, (j + 2) * KVBLK);
    pv_d0(o, vb0 + s_prev * (int)SHM_V, pa0, pa1, pa2, pa3); partialSM<DQK>(pB0, pB1, m_reg, mnB, alB);
    RESC(alB); __syncthreads(); ROT3();
    SWRITE(s_next, 1);
    SBAR(); qkt<DQK>(pA0, pA1, K_lds + s_cur * SHM_K, qr, r32, hi);
    finishSM(pB0, pB1, alB, l_reg, pa0, pa1, pa2, pa3); SBAR();
    if (j + 3 < NT) SLOAD(0, (j + 3) * KVBLK);
    pv_d0(o, vb0 + s_prev * (int)SHM_V, pa0, pa1, pa2, pa3); partialSM<DQK>(pA0, pA1, m_reg, mnA, alA);
    RESC(alA); __syncthreads(); ROT3();
  }
  SBAR(); qkt<DQK>(pB0, pB1, K_lds + s_cur * SHM_K, qr, r32, hi);
  finishSM(pA0, pA1, alA, l_reg, pa0, pa1, pa2, pa3); SBAR();
  pv_d0(o, vb0 + s_prev * (int)SHM_V, pa0, pa1, pa2, pa3); partialSM<DQK>(pB0, pB1, m_reg, mnB, alB);
  RESC(alB);
  finishSM(pB0, pB1, alB, l_reg, pa0, pa1, pa2, pa3); SBAR();
  pv_d0(o, vb0 + s_cur * (int)SHM_V, pa0, pa1, pa2, pa3);
#undef ROT3
#undef IL_QK
  if (hi == 0) li_l[r32] = l_reg; asm volatile("s_waitcnt lgkmcnt(0)" ::: "memory");
  float rli[16];
#pragma unroll
  for (int r = 0; r < 16; ++r) rli[r] = __builtin_amdgcn_rcpf(li_l[crow(r, hi)]);
  bf16_t* Ow = Ob + (long)(wid * QBLK) * LDO;
#pragma unroll
  for (int r = 0; r < 16; ++r) { const int orow = crow(r, hi);
#pragma unroll
    for (int d0 = 0; d0 < 4; ++d0) { const float v = o[d0][r] * rli[r]; Ow[(long)orow * LDO + d0 * 32 + r32] = (bf16_t)(cvtpk(v, v) & 0xffffu); } }
  __syncthreads();
#undef SLOAD
#undef SWRITE
#undef SWAIT
#undef RESC
}
#undef SBAR
}
constexpr int NWAVES = 8, NTHR = 512;
constexpr int NB = 8, SEQ = 2048, CTXL = 256, TPB = CTXL + SEQ  , MROWS = NB * TPB  , DM = 1024;
constexpr int A_W = 512, A_IN = 1920, B_IN = 1536, EVEN_IN = 3456, EVEN_PAD = 3584, ODD_IN = 1536;
constexpr int NEXP = 16, EFF = 512, CAP = MROWS, MOE_ROWS = 40960;
constexpr float LN_EPS = 1e-5f, ALPHA = 1.4142135623730951f, GN_EPS = 64e-5f, SUBLN_EPS = 1e-5f, QKN_EPS = 1e-6f, LAMBDA_INIT0 = 0.2f;

constexpr size_t MiB = 1u << 20;
constexpr size_t WS_CTL = 0, CTL_ZERO_BYTES = 1 * MiB + 512 * 1024;
constexpr size_t WS_MOD = 1 * MiB;
constexpr size_t WS_ROPE = 2 * MiB;
constexpr size_t WS_WEVIN = 4 * MiB, WS_WEVOUT = 11 * MiB, WS_WODIN = 13 * MiB, WS_WODOUT = 16 * MiB;
constexpr size_t WS_WM13 = 18 * MiB, WS_WM2 = 50 * MiB;
constexpr size_t WS_H = 66 * MiB;
constexpr size_t WS_X = 102 * MiB;
constexpr size_t CH_BYTES = (size_t)4608 * 64 * 64 * 2;
constexpr size_t WS_CHG = 18 * MiB, WS_CHH = 54 * MiB, WS_CHRQ = 90 * MiB, WS_CHY = 126 * MiB;
constexpr size_t FEAT_BYTES = (size_t)MROWS * 512 * 2;
constexpr size_t WS_VOUT = 162 * MiB, WS_GOUT = 180 * MiB;
constexpr size_t WS_PA = 198 * MiB;
constexpr size_t WS_PB = 270 * MiB;
constexpr size_t WS_GL = 324 * MiB;
constexpr size_t WS_BON = WS_GL + (size_t)4608 * 64 * 4;
constexpr size_t WS_LORA = WS_BON + (size_t)2 * MROWS * 8 * 4;
constexpr size_t WS_OB0 = WS_PA, WS_OB1 = WS_PA + FEAT_BYTES;
constexpr size_t WS_A2 = WS_PA + 2 * FEAT_BYTES;
constexpr size_t WS_TAIL = 300 * MiB;
constexpr size_t WS_MIX = WS_TAIL;
constexpr size_t WS_HID = 174 * MiB;
constexpr size_t WS_Y = 214 * MiB;
constexpr size_t WS_QKV1 = 174 * MiB;
constexpr size_t WS_OATT = 228 * MiB;
static_assert(WS_CHY + CH_BYTES <= WS_VOUT && WS_GOUT + FEAT_BYTES <= WS_PA && WS_A2 + 2 * FEAT_BYTES <= WS_PB && WS_PB + (size_t)MROWS * 1536 * 2 <= WS_GL && WS_LORA + 393216 <= 328 * MiB
              && WS_Y + (size_t)MOE_ROWS * 1024 * 2 <= WS_TAIL && WS_OATT + 2 * FEAT_BYTES <= WS_TAIL && WS_MIX + 2 * FEAT_BYTES <= 336 * MiB && WS_A2 >= WS_HID + 40 * MiB - 40 * MiB, "ws map");
constexpr size_t DOUT_LINACT = (size_t)48 * MiB;
constexpr int CW_BAR = 4096;
constexpr int CW_CNT = 16384;
constexpr int CW_QCV = 20608;
constexpr int CW_Q0 = 20480;
constexpr size_t WS_ROUTE = 336 * MiB;
constexpr size_t WS_PERM_ = WS_ROUTE, WS_GATE = WS_ROUTE + (size_t)NEXP * CAP * 4, WS_TOK = WS_GATE + (size_t)NEXP * CAP * 4, WS_TOTAL = WS_TOK + (size_t)MROWS * 2 * 4;
static_assert(WS_TOTAL <= 339 * MiB, "ws total");

constexpr int RING_OFF = 0, RING_BYTES = 147456;
constexpr int LDSCTL_OFF = RING_BYTES, MISC_OFF = LDSCTL_OFF + 320;
constexpr int MOETAB_OFF = LDSCTL_OFF + 1024;
constexpr int LDS_BYTES = 163840;

#define GAS __attribute__((address_space(1)))
#define CAS __attribute__((address_space(4)))
#define LAS __attribute__((address_space(3)))
typedef unsigned short bf16;
typedef unsigned v4u __attribute__((ext_vector_type(4)));
typedef unsigned v2u __attribute__((ext_vector_type(2)));
typedef float f32x4 __attribute__((ext_vector_type(4)));
typedef short bf16x8 __attribute__((ext_vector_type(8)));
typedef GAS unsigned gu32;
#define RLX_AGENT __ATOMIC_RELAXED, __HIP_MEMORY_SCOPE_AGENT
#define LDS_WAIT() asm volatile("s_waitcnt lgkmcnt(0)" ::: "memory")
#define VM_WAIT() asm volatile("s_waitcnt vmcnt(0)" ::: "memory")
__device__ __forceinline__ unsigned pk2(float lo, float hi) { typedef float f32x2_t __attribute__((ext_vector_type(2))); typedef __bf16 bf16x2_t __attribute__((ext_vector_type(2)));
    f32x2_t v = {lo, hi}; bf16x2_t b = __builtin_convertvector(v, bf16x2_t); return __builtin_bit_cast(unsigned, b); }
__device__ __forceinline__ unsigned f2bf(float f) { return pk2(f, 0.f) & 0xffffu; }
__device__ __forceinline__ float bf2f(unsigned short b) { return __builtin_bit_cast(float, (unsigned)b << 16); }
__device__ __forceinline__ float bflo(unsigned w) { return __builtin_bit_cast(float, w << 16); }
__device__ __forceinline__ float bfhi(unsigned w) { return __builtin_bit_cast(float, w & 0xffff0000u); }
__device__ __forceinline__ float sigmoidf_(float x) { return 1.f / (1.f + __expf(-x)); }
__device__ __forceinline__ int lane_id_fresh() { unsigned m = ~0u; asm volatile("" : "+s"(m)); return (int)__builtin_amdgcn_mbcnt_hi(m, __builtin_amdgcn_mbcnt_lo(m, 0u)); }
template <int CTRL> __device__ __forceinline__ float dpp_f(float v) { return __builtin_bit_cast(float, __builtin_amdgcn_update_dpp(0, __builtin_bit_cast(int, v), CTRL, 0xF, 0xF, false)); }
__device__ __forceinline__ float sum4(float v) { v += dpp_f<0xB1>(v); v += dpp_f<0x4E>(v); return v; }
__device__ __forceinline__ float sum8(float v) { v = sum4(v); v += dpp_f<0x141>(v); return v; }
__device__ __forceinline__ float sum16(float v) { v = sum8(v); v += dpp_f<0x140>(v); return v; }
__device__ __forceinline__ float wave_sum(float v) {
    v = sum16(v);
    v += __builtin_bit_cast(float, __builtin_amdgcn_update_dpp(0, __builtin_bit_cast(int, v), 0x142, 0xA, 0xF, false));
    v += __builtin_bit_cast(float, __builtin_amdgcn_update_dpp(0, __builtin_bit_cast(int, v), 0x143, 0xC, 0xF, false));
    return __builtin_bit_cast(float, __builtin_amdgcn_readlane(__builtin_bit_cast(int, v), 63));
}

#define XB_TMO      128
#define XB_XCNT(j)  (256  + 64 * (j))
#define XB_XSUB(j)  (1280 + 64 * (j))
#define XB_XGEN(j)  (2304 + 64 * (j))
#define XB_TOP      3328
#define XB_TOPGEN   3392
#define XCD_BAR_WORDS 3456
#define XB_SPIN_CAP (1u << 22)
__device__ __forceinline__ unsigned xb_ld(unsigned* p)              { return __hip_atomic_load(p, __ATOMIC_RELAXED, __HIP_MEMORY_SCOPE_AGENT); }
__device__ __forceinline__ unsigned xb_add(unsigned* p, unsigned v) { return __hip_atomic_fetch_add(p, v, __ATOMIC_RELAXED, __HIP_MEMORY_SCOPE_AGENT); }
__device__ __forceinline__ unsigned xb_xcc_id() { return (unsigned)__builtin_amdgcn_s_getreg((3 << 11) | 20) & 0xFu; }
#define XB_SPIN(cond, bar) do { unsigned _sp = 0; while (cond) { __builtin_amdgcn_s_sleep(1); \
    if ((++_sp & 255u) == 0u) { if (xb_ld(&(bar)[XB_TMO])) break; if (_sp > XB_SPIN_CAP) { atomicAdd(&(bar)[XB_TMO], 1u); break; } } } } while (0)
struct XcdBarrier { unsigned* bar; unsigned x; volatile LAS unsigned* st; };
__device__ __forceinline__ XcdBarrier xcd_barrier_post(unsigned* bar, volatile LAS unsigned* st) {
    XcdBarrier b; b.bar = bar; b.x = xb_xcc_id(); b.st = st;
    if (threadIdx.x == 0) (void)xb_add(&bar[XB_XCNT(b.x)], 1u);
    return b;
}
__device__ __forceinline__ void xcd_barrier_complete(unsigned* bar, unsigned x, unsigned& nloc, unsigned& nx) {
    const unsigned G = gridDim.x * gridDim.y * gridDim.z;
    unsigned sum, cnt, mine, sp = 0u;
    for (;;) {
        sum = 0u; cnt = 0u; mine = 0u;
#pragma unroll
        for (unsigned j = 0; j < 16; ++j) { const unsigned c = xb_ld(&bar[XB_XCNT(j)]); sum += c; cnt += (c > 0u) ? 1u : 0u; mine = (j == x) ? c : mine; }
        if (sum == G) break;
        __builtin_amdgcn_s_sleep(1);
        if ((++sp & 255u) == 0u) { if (xb_ld(&bar[XB_TMO])) break; if (sp > XB_SPIN_CAP) { atomicAdd(&bar[XB_TMO], 1u); break; } }
    }
    nloc = mine > 0u ? mine : 1u; nx = cnt > 0u ? cnt : 1u;
}
__device__ __forceinline__ void xcd_barrier(const XcdBarrier& b, int wave_id) {
    asm volatile("s_waitcnt vmcnt(0)" ::: "memory");
    __syncthreads();
    if (wave_id == 0 && lane_id_fresh() == 0) {
        unsigned* bar = b.bar;
        __builtin_amdgcn_s_waitcnt(0);
        unsigned nloc = b.st[0], nx = b.st[1];
        if (nloc == 0u) { xcd_barrier_complete(bar, b.x, nloc, nx); b.st[0] = nloc; b.st[1] = nx; }
        const unsigned old = xb_add(&bar[XB_XSUB(b.x)], 1u);
        const unsigned gen = old / nloc;
        if (old + 1u == (gen + 1u) * nloc) {
            __builtin_amdgcn_fence(__ATOMIC_RELEASE, "agent");
            asm volatile("s_waitcnt vmcnt(0)" ::: "memory");
            const unsigned og = xb_add(&bar[XB_TOP], 1u);
            const unsigned tg = og / nx;
            if (og + 1u == (tg + 1u) * nx) xb_add(&bar[XB_TOPGEN], 1u);
            else XB_SPIN(xb_ld(&bar[XB_TOPGEN]) == tg, bar);
            __builtin_amdgcn_fence(__ATOMIC_ACQUIRE, "agent");
            asm volatile("s_waitcnt vmcnt(0)" ::: "memory");
        } else {
            XB_SPIN(xb_ld(&bar[XB_TOPGEN]) == gen, bar);
            __builtin_amdgcn_fence(__ATOMIC_ACQUIRE, "agent");
            asm volatile("s_waitcnt vmcnt(0)" ::: "memory");
        }
    }
    __syncthreads();
}

struct Args { const float* in[34]; float* out; unsigned char* ws; };
extern __shared__ __attribute__((aligned(16))) unsigned char g_lds[];
struct Frame {
    LAS unsigned char* lds;
    int tid, lane, wave, G, bid;
    struct InTab { const CAS unsigned long long* t;
        __device__ __forceinline__ const float* operator[](int i) const { return (const float*)(const GAS float*)(uintptr_t)t[i]; } } in;
    GAS float* out; GAS unsigned char* ws;
};
enum { I_X = 0, I_C, I_CTX, I_CCTX, I_RW, I_RB, I_ADAW, I_ADAB, I_LN1G, I_LN1B, I_LN2G, I_LN2B, I_W1, I_W3, I_W2, I_EVWIN, I_EVWOUT, I_AMU, I_AW0, I_AW2, I_AA0, I_AA2,
       I_AG2, I_AKK, I_AKA, I_ARK, I_LNXG, I_LNXB, I_BLAM, I_SUBG, I_ODWIN, I_ODWOUT, I_QNG, I_KNG };

__device__ __forceinline__ const float* x0_row(const Frame& F, int row) {
    const int b = row / TPB, tt = row - b * TPB;
    return tt < CTXL ? F.in[I_CTX] + ((size_t)b * CTXL + tt) * DM : F.in[I_X] + ((size_t)b * SEQ + (tt - CTXL)) * DM;
}
__device__ __forceinline__ const float* mod_ptr(const Frame& F, int layer, int row, int idx) {
    const int b = row / TPB, tt = row - b * TPB; const int r = tt < CTXL ? 8 : b;
    return (const float*)(F.ws + WS_MOD) + ((size_t)(layer * 9 + r) * 6 + idx) * DM;
}
__device__ __forceinline__ void transpose_item(const float* W, int K, int N, bf16* WT, int mode, LAS float* scr, int item, int lane) {
    const int nblk = N / 64, kb = item / nblk, nb = item % nblk, k0 = 64 * kb, n0 = 64 * nb;
    float v[64];
#pragma unroll
    for (int i = 0; i < 64; ++i) v[i] = __builtin_nontemporal_load(W + (size_t)(k0 + i) * N + n0 + lane);
#pragma unroll
    for (int i = 0; i < 64; ++i) scr[i * 65 + lane] = v[i];
    LDS_WAIT(); asm volatile("" ::: "memory");
    const int c = lane & 7;
#pragma unroll
    for (int j = 0; j < 8; ++j) { const int n = (lane >> 3) + 8 * j; const LAS float* s = scr + (8 * c) * 65 + n;
        v4u o; o.x = pk2(s[0 * 65], s[1 * 65]); o.y = pk2(s[2 * 65], s[3 * 65]); o.z = pk2(s[4 * 65], s[5 * 65]); o.w = pk2(s[6 * 65], s[7 * 65]);
        const int ng = n0 + n; const int nd = mode == 0 ? ng : (8 * (ng >> 2) + 4 * (mode - 1) + (ng & 3));
        *(GAS v4u*)(WT + (size_t)nd * K + k0 + 8 * c) = o; }
    LDS_WAIT(); asm volatile("" ::: "memory");
}
__device__ __forceinline__ bf16* moe_w13(Frame& F, int layer) { return layer == 0 ? (bf16*)(F.ws + WS_WM13) : (bf16*)F.out; }
__device__ __forceinline__ bf16* moe_w2(Frame& F, int layer) { return layer == 0 ? (bf16*)(F.ws + WS_WM2) : (bf16*)F.out + (size_t)NEXP * 1024 * DM; }
constexpr int MOE_I13 = NEXP * 2 * (DM / 64) * (EFF / 64)  , MOE_IALL = MOE_I13 + NEXP * (EFF / 64) * (DM / 64)  ;
__device__ __forceinline__ void convert_moe_weights(Frame& F, int layer, int lo, int hi, int part, int nparts) {
    LAS float* scr = (LAS float*)(F.lds + RING_OFF + F.wave * 16896);
    const int gw = part * NWAVES + F.wave, NGW = nparts * NWAVES;
    constexpr int I13 = (DM / 64) * (EFF / 64)  , I2 = (EFF / 64) * (DM / 64)  ;
    bf16* W13 = moe_w13(F, layer); bf16* W2 = moe_w2(F, layer);
    for (int it = lo + gw; it < hi; it += NGW) {
        if (it < MOE_I13) { const int e = it / (2 * I13), r = it % (2 * I13); const size_t wofs = ((size_t)layer * NEXP + e) * DM * EFF;
            if (r < I13) transpose_item(F.in[I_W1] + wofs, DM, EFF, W13 + (size_t)e * 1024 * DM, 1, scr, r, F.lane);
            else transpose_item(F.in[I_W3] + wofs, DM, EFF, W13 + (size_t)e * 1024 * DM, 2, scr, r - I13, F.lane); }
        else { const int q = it - MOE_I13; const int e = q / I2, r = q % I2; const size_t wofs = ((size_t)layer * NEXP + e) * DM * EFF;
            transpose_item(F.in[I_W2] + wofs, EFF, DM, W2 + (size_t)e * DM * EFF, 0, scr, r, F.lane); }
    }
}
__device__ __forceinline__ void convert_moe_filler(Frame& F, int layer, int lo, int hi, int nunits) {
    const int rounds = (nunits + F.G - 1) / F.G; const int c0 = nunits - (rounds - 1) * F.G;
    if (c0 >= F.G) convert_moe_weights(F, layer, lo, hi, F.bid, F.G);
    else if (F.bid >= c0) convert_moe_weights(F, layer, lo, hi, F.bid - c0, F.G - c0);
}
__device__ __forceinline__ void p_mods(Frame& F) {
    LAS float* sv = (LAS float*)(F.lds + RING_OFF);
    LAS float* red = sv + 9 * 1024;
    {
        float cv[9 * 1024 / NTHR];
#pragma unroll
        for (int n = 0; n < 9 * 1024 / NTHR; ++n) { const int i = F.tid + n * NTHR; const int r = i >> 10, k = i & 1023; const float* p = r < 8 ? F.in[I_C] + r * DM + k : F.in[I_CCTX] + k; cv[n] = *p; }
#pragma unroll
        for (int n = 0; n < 9 * 1024 / NTHR; ++n) sv[F.tid + n * NTHR] = cv[n] * sigmoidf_(cv[n]);
    }
    __syncthreads();
    for (int it = F.bid; it < 384; it += F.G) {
        const int kh = it & 1, l = (it >> 1) / 96, cb = (it >> 1) % 96, col = cb * 64 + F.lane;
        const float* w = F.in[I_ADAW] + (size_t)l * DM * 6144 + col;
        float acc[9];
#pragma unroll
        for (int r = 0; r < 9; ++r) acc[r] = 0.f;
        const int k0 = kh * 512 + F.wave * 64;
        float wv[64];
#pragma unroll
        for (int k = 0; k < 64; ++k) wv[k] = __builtin_nontemporal_load(w + (size_t)(k0 + k) * 6144);
#pragma unroll
        for (int k4 = 0; k4 < 16; ++k4) {
#pragma unroll
            for (int r = 0; r < 9; ++r) { const f32x4 s4 = *(const LAS f32x4*)(sv + r * 1024 + k0 + 4 * k4); acc[r] += (s4.x * wv[4 * k4] + s4.y * wv[4 * k4 + 1]) + (s4.z * wv[4 * k4 + 2] + s4.w * wv[4 * k4 + 3]); } }
#pragma unroll
        for (int r = 0; r < 9; ++r) red[(F.wave * 9 + r) * 64 + F.lane] = acc[r];
        __syncthreads();
        for (int i = F.tid; i < 9 * 64; i += NTHR) { const int r = i >> 6, c = i & 63; float s = 0.f;
#pragma unroll
            for (int w8 = 0; w8 < 8; ++w8) s += red[(w8 * 9 + r) * 64 + c];
            const int cc = cb * 64 + c;
            atomicAdd((float*)(F.ws + WS_MOD) + (size_t)(l * 9 + r) * 6144 + cc, s + (kh == 0 ? F.in[I_ADAB][l * 6144 + cc] : 0.f)); }
        __syncthreads();
    }
}
__device__ __forceinline__ void convert_dense_l1(Frame& F, int part, int nparts) {
    LAS float* scr = (LAS float*)(F.lds + RING_OFF + F.wave * 16896);
    constexpr int I_C_ = (DM / 64) * (ODD_IN / 64), I_B = (DM / 64) * (DM / 64);
    for (int it = part * NWAVES + F.wave; it < I_C_ + I_B; it += nparts * NWAVES) {
        if (it < I_C_) transpose_item(F.in[I_ODWIN], DM, ODD_IN, (bf16*)(F.ws + WS_WODIN), 0, scr, it, F.lane);
        else transpose_item(F.in[I_ODWOUT], DM, DM, (bf16*)(F.ws + WS_WODOUT), 0, scr, it - I_C_, F.lane);
    }
}
__device__ __forceinline__ void p_prologue(Frame& F) {
    LAS float* scr = (LAS float*)(F.lds + RING_OFF + F.wave * 16896);
    const int gw = F.bid * NWAVES + F.wave, NGW = F.G * NWAVES;
    constexpr int I_A = (DM / 64) * (EVEN_IN / 64), I_B = (DM / 64) * (DM / 64), I_C_ = (DM / 64) * (ODD_IN / 64);
    for (int it = gw; it < I_A + I_B; it += NGW) {
        int r = it;
        if (r < I_A) { transpose_item(F.in[I_EVWIN], DM, EVEN_IN, (bf16*)(F.ws + WS_WEVIN), 0, scr, r, F.lane); continue; } r -= I_A;
        transpose_item(F.in[I_EVWOUT], DM, DM, (bf16*)(F.ws + WS_WEVOUT), 0, scr, r, F.lane);
    }
    {
        v4u* z = (v4u*)((bf16*)(F.ws + WS_WEVIN) + (size_t)EVEN_IN * DM); const int n16 = (EVEN_PAD - EVEN_IN) * DM * 2 / 16;
        for (int i = F.bid * NTHR + F.tid; i < n16; i += F.G * NTHR) z[i] = (v4u){0u, 0u, 0u, 0u};
    }
    {
        bf16* W2T = (bf16*)(F.ws + WS_LORA); bf16* A2T = W2T + 2 * 512 * 64; bf16* G2T = A2T + 2 * 512 * 64;
        for (int i = F.bid * NTHR + F.tid; i < 3 * 65536; i += F.G * NTHR) {
            const int which = i >> 16, r = i & 65535;
            if (which < 2) { const int d = r >> 15, c = (r >> 6) & 511, l = r & 63; const float v = (which == 0 ? F.in[I_AW2] : F.in[I_AA2])[((size_t)d * 64 + l) * 512 + c]; (which == 0 ? W2T : A2T)[r] = (bf16)f2bf(v); }
            else { const int c = r >> 7, j = r & 127; G2T[r] = (bf16)f2bf(F.in[I_AG2][(size_t)j * 512 + c]); }
        }
    }
    {
        float* cosB = (float*)(F.ws + WS_ROPE); float* sinB = cosB + SEQ * 32; float* cosC = sinB + SEQ * 32; float* sinC = cosC + SEQ * 64;
        for (int i = F.bid * NTHR + F.tid; i < SEQ * 96; i += F.G * NTHR) {
            if (i < SEQ * 32) { const int t = i >> 5, j = i & 31; const float pos = (float)(j < 16 ? (t >> 6) : (t & 63)); const int f = j & 15;
                const float inv = powf(10000.f, -(float)(2 * f) / 32.f); const float ang = pos * inv; cosB[i] = cosf(ang); sinB[i] = sinf(ang); }
            else { const int ii = i - SEQ * 32; const int t = ii >> 6, j = ii & 63; const float pos = (float)(j < 32 ? (t >> 6) : (t & 63)); const int f = j & 31;
                const float inv = powf(10000.f, -(float)(2 * f) / 64.f); const float ang = pos * inv; cosC[ii] = cosf(ang); sinC[ii] = sinf(ang); }
        }
    }
    __syncthreads();
}

struct Row16 { f32x4 v[4]; };
__device__ __forceinline__ Row16 ld_row_f32(const float* p, int lane) { Row16 r; const f32x4* q = (const f32x4*)p + lane;
#pragma unroll
    for (int j = 0; j < 4; ++j) r.v[j] = q[64 * j]; return r; }
__device__ __forceinline__ Row16 ld_row_bf16(const bf16* p, int lane) { Row16 r; const v2u* q = (const v2u*)p + lane;
#pragma unroll
    for (int j = 0; j < 4; ++j) { const v2u w = q[64 * j]; r.v[j] = (f32x4){bflo(w.x), bfhi(w.x), bflo(w.y), bfhi(w.y)}; } return r; }
__device__ __forceinline__ void st_row_f32(float* p, int lane, const Row16& r) { f32x4* q = (f32x4*)p + lane;
#pragma unroll
    for (int j = 0; j < 4; ++j) q[64 * j] = r.v[j]; }
__device__ __forceinline__ void st_row_bf16(bf16* p, int lane, const Row16& r) { v2u* q = (v2u*)p + lane;
#pragma unroll
    for (int j = 0; j < 4; ++j) q[64 * j] = (v2u){pk2(r.v[j].x, r.v[j].y), pk2(r.v[j].z, r.v[j].w)}; }
__device__ __forceinline__ Row16 layer_norm(const Row16& x, const float* g, const float* b, int lane) {
    float s = 0.f;
#pragma unroll
    for (int j = 0; j < 4; ++j) s += (x.v[j].x + x.v[j].y) + (x.v[j].z + x.v[j].w);
    const float mean = wave_sum(s) * (1.f / DM); float s2 = 0.f; Row16 d;
#pragma unroll
    for (int j = 0; j < 4; ++j) { d.v[j] = x.v[j] - mean; s2 += (d.v[j].x * d.v[j].x + d.v[j].y * d.v[j].y) + (d.v[j].z * d.v[j].z + d.v[j].w * d.v[j].w); }
    const float rstd = 1.f / sqrtf(wave_sum(s2) * (1.f / DM) + LN_EPS);
    const Row16 gg = ld_row_f32(g, lane), bb = ld_row_f32(b, lane); Row16 o;
#pragma unroll
    for (int j = 0; j < 4; ++j) o.v[j] = d.v[j] * rstd * gg.v[j] + bb.v[j];
    return o;
}
__device__ __forceinline__ Row16 modulate(const Row16& x, const float* shift, const float* scale, int lane) {
    const Row16 sh = ld_row_f32(shift, lane), sc = ld_row_f32(scale, lane); Row16 o;
#pragma unroll
    for (int j = 0; j < 4; ++j) o.v[j] = x.v[j] * (1.f + sc.v[j]) + sh.v[j];
    return o;
}

typedef float f32x2_t __attribute__((ext_vector_type(2)));
struct Raw8 { v2u w[4]; };
__device__ __forceinline__ Raw8 ld_raw_bf16(const bf16* p, int lane) { Raw8 r; const v2u* q = (const v2u*)p + lane;
#pragma unroll
    for (int j = 0; j < 4; ++j) r.w[j] = q[64 * j]; return r; }
__device__ __forceinline__ Row16 cvt_raw(Raw8 r) { Row16 o;
#pragma unroll
    for (int j = 0; j < 4; ++j) { asm volatile("" : "+v"(r.w[j])); o.v[j] = (f32x4){bflo(r.w[j].x), bfhi(r.w[j].x), bflo(r.w[j].y), bfhi(r.w[j].y)}; } return o; }
__device__ __forceinline__ Row16 ld_row_lds(const LAS float* p, int lane) { Row16 r; const LAS f32x4* q = (const LAS f32x4*)p + lane;
#pragma unroll
    for (int j = 0; j < 4; ++j) r.v[j] = q[64 * j]; return r; }
__device__ __forceinline__ Row16 layer_norm_l(const Row16& x, const LAS float* g, const LAS float* b, int lane) {
    float s = 0.f;
#pragma unroll
    for (int j = 0; j < 4; ++j) s += (x.v[j].x + x.v[j].y) + (x.v[j].z + x.v[j].w);
    const float mean = wave_sum(s) * (1.f / DM); float s2 = 0.f; Row16 d;
#pragma unroll
    for (int j = 0; j < 4; ++j) { d.v[j] = x.v[j] - mean; s2 += (d.v[j].x * d.v[j].x + d.v[j].y * d.v[j].y) + (d.v[j].z * d.v[j].z + d.v[j].w * d.v[j].w); }
    const float rstd = 1.f / sqrtf(wave_sum(s2) * (1.f / DM) + LN_EPS);
    const Row16 gg = ld_row_lds(g, lane), bb = ld_row_lds(b, lane); Row16 o;
#pragma unroll
    for (int j = 0; j < 4; ++j) o.v[j] = d.v[j] * rstd * gg.v[j] + bb.v[j];
    return o;
}
__device__ __forceinline__ Row16 modulate_l(const Row16& x, const LAS float* shift, const LAS float* scale, int lane) {
    const Row16 sh = ld_row_lds(shift, lane), sc = ld_row_lds(scale, lane); Row16 o;
#pragma unroll
    for (int j = 0; j < 4; ++j) o.v[j] = x.v[j] * (1.f + sc.v[j]) + sh.v[j];
    return o;
}

__device__ __forceinline__ void p_mod0(Frame& F) {
    const int gw = F.bid * NWAVES + F.wave, NGW = F.G * NWAVES;
    bf16* H = (bf16*)(F.ws + WS_H);
    for (int row = gw; row < MROWS; row += 2 * NGW) {
        const int r1 = row + NGW; const bool has1 = r1 < MROWS; const int rb = has1 ? r1 : row;
        const Row16 xa = ld_row_f32(x0_row(F, row), F.lane), xb = ld_row_f32(x0_row(F, rb), F.lane);
        const Row16 ha = modulate(xa, mod_ptr(F, 0, row, 0), mod_ptr(F, 0, row, 1), F.lane), hb = modulate(xb, mod_ptr(F, 0, rb, 0), mod_ptr(F, 0, rb, 1), F.lane);
        st_row_bf16(H + (size_t)row * DM, F.lane, ha);
        if (has1) st_row_bf16(H + (size_t)r1 * DM, F.lane, hb);
    }
}

template <int LAYER>
__device__ __forceinline__ void p_ln_route(Frame& F) {
    LAS float* rwT = (LAS float*)(F.lds + RING_OFF);
    constexpr int RWS = DM + 4;
    LAS int* lcnt = (LAS int*)(F.lds + RING_OFF + 66048);
    LAS int* rinfo = lcnt + 32;
    {   const float* rwp = F.in[I_RW] + F.tid;
        float rv[DM * NEXP / NTHR];
#pragma unroll
        for (int n = 0; n < DM * NEXP / NTHR; ++n) rv[n] = rwp[n * NTHR];
#pragma unroll
        for (int n = 0; n < DM * NEXP / NTHR; ++n) { const int i = F.tid + n * NTHR; rwT[(i & 15) * RWS + (i >> 4)] = rv[n]; } }
    if (F.tid < 32) lcnt[F.tid] = 0;
    const int rows_per = (MROWS + F.G - 1) / F.G, row_lo = F.bid * rows_per, row_hi = (row_lo + rows_per < MROWS) ? row_lo + rows_per : MROWS;
    LAS float* par = (LAS float*)(F.lds + RING_OFF + 73728);
    const bool par_ok = (TPB % rows_per) == 0 && row_lo < MROWS;
    if (par_ok) { const int bq = row_lo / TPB; const float* mL = mod_ptr(F, LAYER, bq * TPB + CTXL, 0); const float* mC = mod_ptr(F, LAYER, bq * TPB, 0);
        for (int i = F.tid; i < DM; i += NTHR) { par[i] = mL[2 * DM + i]; par[DM + i] = mL[3 * DM + i]; par[2 * DM + i] = mL[4 * DM + i];
            par[3 * DM + i] = F.in[I_LN1G][LAYER * DM + i]; par[4 * DM + i] = F.in[I_LN1B][LAYER * DM + i];
            par[5 * DM + i] = mC[2 * DM + i]; par[6 * DM + i] = mC[3 * DM + i]; par[7 * DM + i] = mC[4 * DM + i]; } }
    __syncthreads();
    bf16* X = (bf16*)(F.ws + WS_X); bf16* H = (bf16*)(F.ws + WS_H); const bf16* MIX = (const bf16*)(F.ws + WS_MIX);
    unsigned* cnt = (unsigned*)(F.ws + WS_CTL) + CW_CNT + LAYER * 64;
    int* PERM = (int*)(F.ws + WS_PERM_); float* GATE = (float*)(F.ws + WS_GATE); int* TOK = (int*)(F.ws + WS_TOK);
    LAS float* lgt = (LAS float*)(rinfo + 4 * 128);
    constexpr int NWREG = 6;
    f32x4 wreg[NWREG][4];
#pragma unroll
    for (int e = 0; e < NWREG; ++e)
#pragma unroll
        for (int j = 0; j < 4; ++j) wreg[e][j] = *((const LAS f32x4*)(rwT + e * RWS) + F.lane + 64 * j);
    Row16 xin_n; Raw8 xr_n, mix_n;
    {   const int row = row_lo + F.wave; const int rr_ = (row < row_hi ? row : row_lo) < MROWS ? (row < row_hi ? row : row_lo) : 0;
        if (LAYER == 0) xin_n = ld_row_f32(x0_row(F, rr_), F.lane); else xr_n = ld_raw_bf16(X + (size_t)rr_ * DM, F.lane);
        mix_n = ld_raw_bf16(MIX + (size_t)rr_ * DM, F.lane); }
    for (int row = row_lo + F.wave; row < row_hi; row += NWAVES) {
        const int b = row / TPB, tt = row - b * TPB; const int li = row - row_lo;
        Row16 xin; if (LAYER == 0) xin = xin_n; else xin = cvt_raw(xr_n);
        const Row16 mix = cvt_raw(mix_n);
        {   const int rn = row + NWAVES < row_hi ? row + NWAVES : row;
            if (LAYER == 0) xin_n = ld_row_f32(x0_row(F, rn), F.lane); else xr_n = ld_raw_bf16(X + (size_t)rn * DM, F.lane);
            mix_n = ld_raw_bf16(MIX + (size_t)rn * DM, F.lane); }
        if (LAYER == 1 && tt < CTXL) { if (F.lane == 0) rinfo[li * 4] = -1; continue; }
        const LAS float* pm = tt < CTXL ? par + 5 * DM : par;
        const Row16 gate = par_ok ? ld_row_lds(pm, F.lane) : ld_row_f32(mod_ptr(F, LAYER, row, 2), F.lane);
        Row16 pre;
#pragma unroll
        for (int j = 0; j < 4; ++j) pre.v[j] = ALPHA * xin.v[j] + gate.v[j] * mix.v[j];
        const Row16 x1 = par_ok ? layer_norm_l(pre, par + 3 * DM, par + 4 * DM, F.lane) : layer_norm(pre, F.in[I_LN1G] + LAYER * DM, F.in[I_LN1B] + LAYER * DM, F.lane);
        st_row_bf16(X + (size_t)row * DM, F.lane, x1);
        const Row16 h = par_ok ? modulate_l(x1, pm + DM, pm + 2 * DM, F.lane) : modulate(x1, mod_ptr(F, LAYER, row, 3), mod_ptr(F, LAYER, row, 4), F.lane);
        st_row_bf16(H + (size_t)row * DM, F.lane, h);
        LAS float* tr = (LAS float*)(F.lds + RING_OFF + 106496) + F.wave * (64 * 17);
#pragma unroll
        for (int e = 0; e < NEXP; ++e) { f32x2_t a = {0.f, 0.f};
#pragma unroll
            for (int j = 0; j < 4; ++j) { const f32x4 w = e < NWREG ? wreg[e < NWREG ? e : 0][j] : *((const LAS f32x4*)(rwT + e * RWS) + F.lane + 64 * j);
                a += (f32x2_t){h.v[j].x, h.v[j].y} * (f32x2_t){w.x, w.y}; a += (f32x2_t){h.v[j].z, h.v[j].w} * (f32x2_t){w.z, w.w}; }
            tr[F.lane * 17 + e] = a.x + a.y; if ((e & 3) == 3) asm volatile("" ::: "memory"); }
        float t = 0.f;
#pragma unroll
        for (int i = 0; i < 16; ++i) t += tr[((F.lane & 48) + i) * 17 + (F.lane & 15)];
        t += __shfl_xor(t, 16); t += __shfl_xor(t, 32);
        if (F.lane < NEXP) { lgt[li * 16 + F.lane] = t + F.in[I_RB][F.lane]; if (F.lane == 0) rinfo[li * 4] = 0; }
    }
    __syncthreads();
    if (row_lo + F.tid < row_hi && rinfo[F.tid * 4] >= 0) {
        const int li = F.tid; float lg[NEXP];
#pragma unroll
        for (int q = 0; q < 4; ++q) { const f32x4 t = *((const LAS f32x4*)(lgt + li * 16) + q); lg[4 * q] = t.x; lg[4 * q + 1] = t.y; lg[4 * q + 2] = t.z; lg[4 * q + 3] = t.w; }
        float mx = lg[0];
#pragma unroll
        for (int e = 1; e < NEXP; ++e) mx = fmaxf(mx, lg[e]);
        float p[NEXP];
#pragma unroll
        for (int e = 0; e < NEXP; ++e) p[e] = expf(lg[e] - mx);
        int best = 0; float bs = -1.f;
#pragma unroll
        for (int g = 0; g < 4; ++g) { float a = p[4 * g], c2 = -1.f;
#pragma unroll
            for (int i = 1; i < 4; ++i) { const float v = p[4 * g + i]; if (v > a) { c2 = a; a = v; } else if (v > c2) c2 = v; }
            const float sc = a + c2; if (sc > bs) { bs = sc; best = g; } }
        int i0 = 0; float p0 = -1.f;
#pragma unroll
        for (int i = 0; i < 4; ++i) { float v = 0.f;
#pragma unroll
            for (int g = 0; g < 4; ++g) v = (g == best) ? p[4 * g + i] : v;
            if (v > p0) { p0 = v; i0 = i; } }
        int i1 = 0; float p1 = -1.f;
#pragma unroll
        for (int i = 0; i < 4; ++i) { float v = 0.f;
#pragma unroll
            for (int g = 0; g < 4; ++g) v = (g == best) ? p[4 * g + i] : v;
            if (i != i0 && v > p1) { p1 = v; i1 = i; } }
        rinfo[li * 4 + 0] = best * 4 + i0; rinfo[li * 4 + 1] = best * 4 + i1;
        rinfo[li * 4 + 2] = __float_as_int(p0 / (p0 + p1)); rinfo[li * 4 + 3] = __float_as_int(p1 / (p0 + p1));
    }
    __syncthreads();
    int e0 = -1, e1 = -1, r0 = 0, r1 = 0; const int myrow = row_lo + F.tid;
    if (myrow < row_hi) { e0 = rinfo[F.tid * 4]; if (e0 >= 0) { e1 = rinfo[F.tid * 4 + 1]; r0 = __hip_atomic_fetch_add(lcnt + e0, 1, __ATOMIC_RELAXED, __HIP_MEMORY_SCOPE_WORKGROUP); r1 = __hip_atomic_fetch_add(lcnt + e1, 1, __ATOMIC_RELAXED, __HIP_MEMORY_SCOPE_WORKGROUP); } }
    __syncthreads();
    if (F.tid < 16) lcnt[16 + F.tid] = (int)atomicAdd(cnt + F.tid, (unsigned)lcnt[F.tid]);
    __syncthreads();
    if (e0 >= 0) {
        const int g0 = lcnt[16 + e0] + r0, g1 = lcnt[16 + e1] + r1;
        PERM[(size_t)e0 * CAP + g0] = myrow; GATE[(size_t)e0 * CAP + g0] = __int_as_float(rinfo[F.tid * 4 + 2]);
        PERM[(size_t)e1 * CAP + g1] = myrow; GATE[(size_t)e1 * CAP + g1] = __int_as_float(rinfo[F.tid * 4 + 3]);
        TOK[myrow * 2 + 0] = (e0 << 20) | g0; TOK[myrow * 2 + 1] = (e1 << 20) | g1;
    }
}

__device__ __forceinline__ void expert_tile_offsets(const unsigned* cnt, int (&toff)[NEXP + 1]) {
    toff[0] = 0;
#pragma unroll
    for (int e = 0; e < NEXP; ++e) toff[e + 1] = toff[e] + (int)((__hip_atomic_load(cnt + e, __ATOMIC_RELAXED, __HIP_MEMORY_SCOPE_AGENT) + 255u) >> 8);
}

template <int LAYER>
__device__ __forceinline__ void p_ln2(Frame& F) {
    {
        constexpr int NRq = LAYER == 0 ? MROWS : NB * SEQ, PERB = LAYER == 0 ? TPB : SEQ;
        const int rows_per = (NRq + F.G - 1) / F.G;
        if (PERB % rows_per == 0) {
            const int q_lo = F.bid * rows_per, q_hi = (q_lo + rows_per < NRq) ? q_lo + rows_per : NRq;
            if (q_lo >= NRq) return;
            bf16* X = (bf16*)(F.ws + WS_X); bf16* H = (bf16*)(F.ws + WS_H); const bf16* Y = (const bf16*)(F.ws + WS_Y);
            const unsigned* cnt = (const unsigned*)(F.ws + WS_CTL) + CW_CNT + LAYER * 64; const int* TOK = (const int*)(F.ws + WS_TOK);
            int toff[NEXP + 1]; toff[0] = 0;
#pragma unroll
            for (int e = 0; e < NEXP; ++e) toff[e + 1] = toff[e] + (int)(((unsigned)((const LAS int*)(F.lds + MOETAB_OFF))[1284 + e] + 255u) >> 8);
            const int bq = q_lo / PERB;
            LAS float* par = (LAS float*)(F.lds + RING_OFF);
            {   const float* mL = mod_ptr(F, LAYER, bq * TPB + CTXL, 0); const float* mC = mod_ptr(F, LAYER, bq * TPB, 0);
                const float* nL = mod_ptr(F, 1, bq * TPB + CTXL, 0); const float* nC = mod_ptr(F, 1, bq * TPB, 0);
                for (int i = F.tid; i < DM; i += NTHR) { par[i] = mL[5 * DM + i]; par[DM + i] = nL[i]; par[2 * DM + i] = nL[DM + i];
                    par[3 * DM + i] = F.in[I_LN2G][LAYER * DM + i]; par[4 * DM + i] = F.in[I_LN2B][LAYER * DM + i];
                    par[5 * DM + i] = mC[5 * DM + i]; par[6 * DM + i] = nC[i]; par[7 * DM + i] = nC[DM + i]; } }
            __syncthreads();
#define LN2_ROW(q_) (LAYER == 0 ? (q_) : ((q_) / SEQ) * TPB + CTXL + ((q_) % SEQ))
#define LN2_TOK(q_, t0_, t1_) do { const int r_ = LN2_ROW(q_); t0_ = __hip_atomic_load(TOK + r_ * 2, __ATOMIC_RELAXED, __HIP_MEMORY_SCOPE_AGENT); t1_ = __hip_atomic_load(TOK + r_ * 2 + 1, __ATOMIC_RELAXED, __HIP_MEMORY_SCOPE_AGENT); } while (0)
#define LN2_DATA(q_, t0_, t1_) do { const int r_ = LN2_ROW(q_); const int e0_ = (t0_) >> 20, e1_ = (t1_) >> 20; int o0_ = 0, o1_ = 0; \
                _Pragma("unroll") for (int e = 0; e < NEXP; ++e) { o0_ = (e == e0_) ? toff[e] : o0_; o1_ = (e == e1_) ? toff[e] : o1_; } \
                xr_n = ld_raw_bf16(X + (size_t)r_ * DM, F.lane); ya_n = ld_raw_bf16(Y + ((size_t)o0_ * 256 + ((t0_) & 0xfffff)) * DM, F.lane); yb_n = ld_raw_bf16(Y + ((size_t)o1_ * 256 + ((t1_) & 0xfffff)) * DM, F.lane); } while (0)
            Raw8 xr_n, ya_n, yb_n; int tk0, tk1;
            const int q0 = q_lo + F.wave;
            if (q0 < q_hi) { LN2_TOK(q0, tk0, tk1); LN2_DATA(q0, tk0, tk1); const int q1 = q0 + NWAVES < q_hi ? q0 + NWAVES : q0; LN2_TOK(q1, tk0, tk1); }
            for (int q = q0; q < q_hi; q += NWAVES) {
                const int row = LN2_ROW(q); const int b = row / TPB, tt = row - b * TPB;
                const Row16 xin = cvt_raw(xr_n), ya = cvt_raw(ya_n), yb = cvt_raw(yb_n);
                {   const int q1 = q + NWAVES < q_hi ? q + NWAVES : q, q2 = q1 + NWAVES < q_hi ? q1 + NWAVES : q1;
                    LN2_DATA(q1, tk0, tk1); LN2_TOK(q2, tk0, tk1); }
                const LAS float* pm = tt < CTXL ? par + 5 * DM : par;
                const Row16 gate = ld_row_lds(pm, F.lane);
                Row16 pre;
#pragma unroll
                for (int j = 0; j < 4; ++j) pre.v[j] = ALPHA * xin.v[j] + gate.v[j] * (ya.v[j] + yb.v[j]);
                const Row16 x2 = layer_norm_l(pre, par + 3 * DM, par + 4 * DM, F.lane);
                if (LAYER == 0) {
                    st_row_bf16(X + (size_t)row * DM, F.lane, x2);
                    const Row16 h = modulate_l(x2, pm + DM, pm + 2 * DM, F.lane);
                    st_row_bf16(H + (size_t)row * DM, F.lane, h);
                } else {
                    st_row_f32((float*)(F.out + ((size_t)b * SEQ + (tt - CTXL)) * DM), F.lane, x2);
#ifdef TPROBE_A
                    if (row == 2048 && F.lane == 0) { volatile LAS unsigned long long* ts = (volatile LAS unsigned long long*)(F.lds + MISC_OFF + 128);
                        const float span_us = (float)(ts[TPROBE_B] - ts[TPROBE_A]) * 0.01f; ((float*)F.out)[((size_t)b * SEQ + (tt - CTXL)) * DM] = x2.v[0].x + span_us / (float)TPROBE_US; }
#endif
                }
            }
#undef LN2_ROW
#undef LN2_TOK
#undef LN2_DATA
            return;
        }
    }
    const int gw = F.bid * NWAVES + F.wave, NGW = F.G * NWAVES;
    bf16* X = (bf16*)(F.ws + WS_X); bf16* H = (bf16*)(F.ws + WS_H); const bf16* Y = (const bf16*)(F.ws + WS_Y);
    const unsigned* cnt = (const unsigned*)(F.ws + WS_CTL) + CW_CNT + LAYER * 64; const int* TOK = (const int*)(F.ws + WS_TOK);
    int toff[NEXP + 1]; expert_tile_offsets(cnt, toff);
    constexpr int NR = LAYER == 0 ? MROWS : NB * SEQ;
    for (int q = gw; q < NR; q += 2 * NGW) {
        int rw[2]; bool ok[2]; rw[0] = q; rw[1] = q + NGW; ok[0] = true; ok[1] = rw[1] < NR; if (!ok[1]) rw[1] = rw[0];
        int row[2], bb[2], tt[2]; size_t y0[2], y1[2];
#pragma unroll
        for (int s = 0; s < 2; ++s) {
            if (LAYER == 0) { row[s] = rw[s]; bb[s] = row[s] / TPB; tt[s] = row[s] - bb[s] * TPB; } else { bb[s] = rw[s] / SEQ; tt[s] = CTXL + (rw[s] - bb[s] * SEQ); row[s] = bb[s] * TPB + tt[s]; }
            const int t0 = __hip_atomic_load(TOK + row[s] * 2, __ATOMIC_RELAXED, __HIP_MEMORY_SCOPE_AGENT), t1 = __hip_atomic_load(TOK + row[s] * 2 + 1, __ATOMIC_RELAXED, __HIP_MEMORY_SCOPE_AGENT); const int e0 = t0 >> 20, e1 = t1 >> 20;
            int o0 = 0, o1 = 0;
#pragma unroll
            for (int e = 0; e < NEXP; ++e) { o0 = (e == e0) ? toff[e] : o0; o1 = (e == e1) ? toff[e] : o1; }
            y0[s] = (size_t)o0 * 256 + (t0 & 0xfffff); y1[s] = (size_t)o1 * 256 + (t1 & 0xfffff);
        }
        Row16 xin[2], ya[2], yb[2], gate[2];
#pragma unroll
        for (int s = 0; s < 2; ++s) { xin[s] = ld_row_bf16(X + (size_t)row[s] * DM, F.lane); ya[s] = ld_row_bf16(Y + y0[s] * DM, F.lane); yb[s] = ld_row_bf16(Y + y1[s] * DM, F.lane); gate[s] = ld_row_f32(mod_ptr(F, LAYER, row[s], 5), F.lane); }
#pragma unroll
        for (int s = 0; s < 2; ++s) {
            Row16 pre;
#pragma unroll
            for (int j = 0; j < 4; ++j) pre.v[j] = ALPHA * xin[s].v[j] + gate[s].v[j] * (ya[s].v[j] + yb[s].v[j]);
            const Row16 x2 = layer_norm(pre, F.in[I_LN2G] + LAYER * DM, F.in[I_LN2B] + LAYER * DM, F.lane);
            if (!ok[s]) continue;
            if (LAYER == 0) {
                st_row_bf16(X + (size_t)row[s] * DM, F.lane, x2);
                const Row16 h = modulate(x2, mod_ptr(F, 1, row[s], 0), mod_ptr(F, 1, row[s], 1), F.lane);
                st_row_bf16(H + (size_t)row[s] * DM, F.lane, h);
            } else {
                st_row_f32((float*)(F.out + ((size_t)bb[s] * SEQ + (tt[s] - CTXL)) * DM), F.lane, x2);
#ifdef TPROBE_A
                if (row[s] == 2048 && F.lane == 0) { volatile LAS unsigned long long* ts = (volatile LAS unsigned long long*)(F.lds + MISC_OFF + 128);
                    const float span_us = (float)(ts[TPROBE_B] - ts[TPROBE_A]) * 0.01f; ((float*)F.out)[((size_t)bb[s] * SEQ + (tt[s] - CTXL)) * DM] = x2.v[0].x + span_us / (float)TPROBE_US; }
#endif
            }
        }
    }
}
namespace ck {
typedef short bf16x8 __attribute__((ext_vector_type(8)));
typedef float f32x16 __attribute__((ext_vector_type(16)));
typedef float f32x4 __attribute__((ext_vector_type(4)));
constexpr int NCH = 36;
__device__ __forceinline__ int crow(int r, int hi) { return (r & 3) + 8 * (r >> 2) + 4 * hi; }
__device__ __forceinline__ int swz(int row, int c16) { return row * 128 + ((c16 ^ ((row >> 1) & 7)) << 4); }
__device__ __forceinline__ int swz_el(int row, int col) { return swz(row, col >> 3) + (col & 7) * 2; }
__device__ __forceinline__ void mm_tile(f32x16& acc, const LAS unsigned char* A, int arow0, const LAS unsigned char* B, int brow0, int ks0, int nks, int r32, int hh) {
#pragma unroll
    for (int ks = 0; ks < 4; ++ks) if (ks >= ks0 && ks < ks0 + nks) {
        const bf16x8 a = *(const LAS bf16x8*)(A + swz(arow0 + r32, 2 * ks + hh));
        const bf16x8 b = *(const LAS bf16x8*)(B + swz(brow0 + r32, 2 * ks + hh));
        acc = __builtin_amdgcn_mfma_f32_32x32x16_bf16(a, b, acc, 0, 0, 0); }
}
__device__ __forceinline__ f32x16 zero16() { f32x16 z;
#pragma unroll
    for (int i = 0; i < 16; ++i) z[i] = 0.f; return z; }
__device__ __forceinline__ int fro(int r, int c) { return ((((r >> 5) * 8 + (c >> 3)) * 32 + (r & 31)) << 3) + (c & 7); }
__device__ __forceinline__ int chunk_index(int b, int h, int d, int c) { return ((b * 8 + h) * 2 + d) * NCH + c; }
}

constexpr int CK_LIN = 0;
constexpr int CK_E = 32768;
constexpr int CK_T = CK_E, CK_TT = CK_E + 8192, CK_PT = CK_E + 16384, CK_WT = CK_E + 24576;
constexpr int CK_OPS = 65536;
constexpr int CK_UT = 131072;
constexpr int CK_D = CK_UT + 8192;
constexpr int CK_ZT = CK_D + 4096;
constexpr int CK_WSUM = CK_ZT + 2048;
static_assert(CK_WSUM + 2048 <= RING_BYTES, "chunk LDS map");

__device__ __forceinline__ float fsig(float x) { return __builtin_amdgcn_rcpf(1.f + __builtin_amdgcn_exp2f(-1.4426950408889634f * x)); }
__device__ __forceinline__ float fexp(float x) { return __builtin_amdgcn_exp2f(1.4426950408889634f * x); }

__device__ __forceinline__ void p_chunk_pre(Frame& F) {
    using namespace ck;
    const LAS unsigned char* L0 = F.lds + RING_OFF;
    LAS unsigned char* lds = F.lds + RING_OFF;
    const bf16* PA = (const bf16*)(F.ws + WS_PA);
    const int wave = F.wave;
    bf16* CHG = (bf16*)(F.ws + WS_CHG); bf16* CHH = (bf16*)(F.ws + WS_CHH); bf16* CHRQ = (bf16*)(F.ws + WS_CHRQ); bf16* CHY = (bf16*)(F.ws + WS_CHY);
    float* GLp = (float*)(F.ws + WS_GL); float* BON = (float*)(F.ws + WS_BON);
    bf16* VOUT = (bf16*)(F.ws + WS_VOUT); bf16* GOUT = (bf16*)(F.ws + WS_GOUT);
    const bf16* W2T = (const bf16*)(F.ws + WS_LORA); const bf16* A2T = W2T + 2 * 512 * 64; const bf16* G2T = A2T + 2 * 512 * 64;
    const float* mu = F.in[I_AMU];
    const bf16* LINACT = (const bf16*)((const unsigned char*)F.out + DOUT_LINACT);
    v4u q_row[4]; unsigned winr[3][10]; float pfm[3], pfc[3], pfb;
#define CK_DECODE(it_, d_, tb_, h_, b_, isctx_, t0_, Ls_, rbase_) const int d_ = ((it_) & 1) ^ (((it_) / F.G) & 1 & (int)((F.G & 1) == 0)), tb_ = ((it_) >> 1) % 36, bh_##d_ = ((it_) >> 1) / 36, h_ = bh_##d_ & 7, b_ = bh_##d_ >> 3; \
        const bool isctx_ = tb_ < 4; const int t0_ = isctx_ ? tb_ * 64 : (tb_ - 4) * 64, Ls_ = isctx_ ? CTXL : SEQ; const int rbase_ = b_ * TPB + (isctx_ ? 0 : CTXL);
#define CK_LOAD(it_) do { CK_DECODE(it_, dL, tbL, hL, bL, icL, t0L, LsL, rbL) \
        const int ln_ = lane_id_fresh(), td_ = (wave << 6) | ln_; \
        { const int cc_ = (dL == 0 ? (td_ & 31) : (td_ & 15)) * 8, tf_ = dL == 0 ? 4 * (td_ >> 5) : 2 * (td_ >> 4); \
          const int col_ = cc_ < 64 ? 64 * dL + cc_ : cc_ < 128 ? 128 + 64 * dL + (cc_ - 64) : 256 + (cc_ - 128); \
          const bf16* pc_ = LINACT + (size_t)(rbL + t0L + tf_) * 384 + col_; \
          _Pragma("unroll") for (int n_ = 0; n_ < 4; ++n_) if (dL == 0 || n_ < 2) q_row[n_] = *(const v4u*)(pc_ + (size_t)n_ * 384); } \
        { const int tlo_ = dL == 0 ? 8 * wave : 63 - (8 * wave + 7); const bf16* pr_ = PA + (size_t)rbL * A_IN + 64 * hL + (ln_ & ~1);     \
          _Pragma("unroll") for (int j_ = 0; j_ < 10; ++j_) { int tg2_ = t0L + tlo_ + j_ - 1; tg2_ = tg2_ < 0 ? 0 : tg2_ >= LsL ? LsL - 1 : tg2_;     \
            _Pragma("unroll") for (int s_ = 0; s_ < 3; ++s_) winr[s_][j_] = *(const unsigned*)(pr_ + (size_t)tg2_ * A_IN + 512 * s_); } } \
        { const int c_ = 64 * hL + ln_; pfm[0] = mu[c_]; pfm[1] = mu[512 + c_]; pfm[2] = mu[1024 + c_]; pfc[0] = F.in[I_AKK][c_]; pfc[1] = F.in[I_AKA][c_]; pfc[2] = F.in[I_ARK][c_]; \
          const int ch_ = 64 * hL + 32 * (wave & 1) + (ln_ & 31); const bool isW_ = wave < 4; \
          pfb = (isW_ ? F.in[I_AW0] : F.in[I_AA0])[dL * 512 + ch_]; \
          } } while (0)
    if (F.bid < NB * 8 * 36 * 2) CK_LOAD(F.bid);
    for (int it = F.bid; it < NB * 8 * 36 * 2; it += F.G) {
        CK_DECODE(it, d, tb, h, b, isctx, t0, Ls, rbase)
        const int c = d == 0 ? tb : (isctx ? 3 - tb : 4 + (31 - (tb - 4)));
        const int ci = chunk_index(b, h, d, c);
        __syncthreads();
        int lane = lane_id_fresh(); asm volatile("" : "+v"(lane));
        const int tid = (wave << 6) | lane, r32 = lane & 31, hh = lane >> 5, k = lane, pg = wave;
        bf16x8 pfw[4];
        { const bf16* WT = (wave < 4 ? W2T : A2T) + ((size_t)d * 512 + 64 * h + 32 * (wave & 1) + r32) * 64 + 8 * hh;
#pragma unroll
          for (int ks = 0; ks < 4; ++ks) pfw[ks] = *(const bf16x8*)(WT + 16 * ks); }
        {
            const int cc = (d == 0 ? (tid & 31) : (tid & 15)) * 8, tf = d == 0 ? 4 * (tid >> 5) : 2 * (tid >> 4);
            const int mat = cc >> 6, l0 = cc & 63;
#pragma unroll
            for (int n = 0; n < 4; ++n) if (d == 0 || n < 2) *(LAS v4u*)(lds + CK_LIN + mat * 8192 + swz(tf + n, l0 >> 3)) = q_row[n];
        }
        float rr[8], kx[8], vv[8];
        {
            float win[3][10];
            { const int tlo = d == 0 ? 8 * wave : 63 - (8 * wave + 7);
#pragma unroll
              for (int j = 0; j < 10; ++j) { const int tg2 = t0 + tlo + j - 1; const bool ok = tg2 >= 0 && tg2 < Ls;
#pragma unroll
                for (int s_ = 0; s_ < 3; ++s_) { unsigned w_ = winr[s_][j]; asm volatile("" : "+v"(w_)); win[s_][j] = ok ? __uint_as_float((w_ >> ((lane & 1) * 16)) << 16) : 0.f; } } }
            const float mr = pfm[0], mk = pfm[1], mv = pfm[2];
#pragma unroll
            for (int i = 0; i < 8; ++i) {
                const bool f = d == 0;
                const float c0 = f ? win[0][i + 1] : win[0][8 - i], n0 = f ? win[0][i] + win[0][i + 2] : win[0][7 - i] + win[0][9 - i];
                const float c1 = f ? win[1][i + 1] : win[1][8 - i], n1 = f ? win[1][i] + win[1][i + 2] : win[1][7 - i] + win[1][9 - i];
                const float c2 = f ? win[2][i + 1] : win[2][8 - i], n2 = f ? win[2][i] + win[2][i + 2] : win[2][7 - i] + win[2][9 - i];
                rr[i] = c0 + (0.5f * n0 - c0) * mr; kx[i] = c1 + (0.5f * n1 - c1) * mk; vv[i] = c2 + (0.5f * n2 - c2) * mv; }
        }
        __syncthreads();
        {
            const int tq = wave & 3, ti = tq >> 1, tj = tq & 1; const bool isW = wave < 4;
            f32x16 acc = zero16();
#pragma unroll
            for (int ks = 0; ks < 4; ++ks) {
                const bf16x8 a = *(const LAS bf16x8*)(L0 + CK_LIN + (isW ? 0 : 8192) + swz(32 * ti + r32, 2 * ks + hh));
                const bf16x8 bq = pfw[ks];
                acc = __builtin_amdgcn_mfma_f32_32x32x16_bf16(a, bq, acc, 0, 0, 0); }
            const int ch = 32 * tj + r32; const float bias = pfb;
#pragma unroll
            for (int r = 0; r < 16; ++r) { const int tl = 32 * ti + crow(r, hh); const int p = d == 0 ? tl : 63 - tl;
                const float sg = fsig(acc[r] + bias);
                *(LAS float*)(lds + CK_E + (isW ? 0 : 16384) + (p * 64 + ch) * 4) = isW ? sg * 0.6065306597126334f : sg; }
            if (d == 0 && !isW) {
                f32x16 g = zero16();
                bf16x8 gq[8];
                { const bf16* GT = G2T + (size_t)(64 * h + 32 * tj + r32) * 128 + 8 * hh;
#pragma unroll
                  for (int ks = 0; ks < 8; ++ks) gq[ks] = *(const bf16x8*)(GT + 16 * ks); }
                asm volatile("" : "+v"(gq[0]), "+v"(gq[1]), "+v"(gq[2]), "+v"(gq[3]), "+v"(gq[4]), "+v"(gq[5]), "+v"(gq[6]), "+v"(gq[7]));
#pragma unroll
                for (int ks = 0; ks < 8; ++ks) {
                    const bf16x8 a = *(const LAS bf16x8*)(L0 + CK_LIN + 16384 + (ks >> 2) * 8192 + swz(32 * ti + r32, 2 * (ks & 3) + hh));
                    const bf16x8 bq = gq[ks];
                    g = __builtin_amdgcn_mfma_f32_32x32x16_bf16(a, bq, g, 0, 0, 0); }
#pragma unroll
                for (int r = 0; r < 16; ++r) { const int tl = 32 * ti + crow(r, hh);
                    GOUT[(size_t)(rbase + t0 + tl) * 512 + 64 * h + ch] = (bf16)f2bf(g[r]); }
            }
        }
        __syncthreads();
        {
            float e[8], ai[8], cl[8];
#pragma unroll
            for (int i = 0; i < 8; ++i) { e[i] = *(const LAS float*)(L0 + CK_E + ((8 * pg + i) * 64 + k) * 4); ai[i] = *(const LAS float*)(L0 + CK_E + 16384 + ((8 * pg + i) * 64 + k) * 4); }
            float run = 0.f;
#pragma unroll
            for (int i = 0; i < 8; ++i) { run -= e[i]; cl[i] = run; }
            *(LAS float*)(lds + CK_WSUM + (pg * 64 + k) * 4) = run;
            __syncthreads();
            float off = 0.f, tot = 0.f;
#pragma unroll
            for (int q = 0; q < 8; ++q) { const float s = *(const LAS float*)(L0 + CK_WSUM + (q * 64 + k) * 4); tot += s; off += (q < pg) ? s : 0.f; }
            const float kkc = pfc[0], kac = pfc[1], rkc = pfc[2];
            float bhv[8], khv[8], atv[8];
            float red[16];
            {
                LAS float* tr = (LAS float*)(lds + CK_LIN) + wave * 1024;
#pragma unroll
                for (int i = 0; i < 8; ++i) { const float kr = kx[i] * kkc, kd = kx[i] * (1.f + (ai[i] - 1.f) * kac);
                    tr[lane * 16 + ((2 * i) ^ (lane & 15))] = kr * kr; tr[lane * 16 + ((2 * i + 1) ^ (lane & 15))] = rr[i] * kd * rkc; }
                float t = 0.f;
#pragma unroll
                for (int i = 0; i < 16; ++i) t += tr[((lane & 48) + i) * 16 + ((lane & 15) ^ i)];
                t += __shfl_xor(t, 16); t += __shfl_xor(t, 32);
                if (lane < 16) tr[lane] = t;
#pragma unroll
                for (int q = 0; q < 4; ++q) { const f32x4 u = *((const LAS f32x4*)tr + q); red[4 * q] = u.x; red[4 * q + 1] = u.y; red[4 * q + 2] = u.z; red[4 * q + 3] = u.w; }
            }
            const float etot = fexp(tot); float gprev = fexp(cl[0] + off + e[0]);
#pragma unroll
            for (int i = 0; i < 8; ++i) {
                const int p = 8 * pg + i; const float c_ = cl[i] + off;
                const float kr = kx[i] * kkc; const float ss = red[2 * i]; const float kk = kr * __builtin_amdgcn_rsqf(fmaxf(ss, 1e-24f));
                const float kd = kx[i] * (1.f + (ai[i] - 1.f) * kac), bb = kk * ai[i];
                const float bon = red[2 * i + 1];
                const float ep = fexp(c_), em = __builtin_amdgcn_rcpf(ep), el = etot * em;
                atv[i] = -kk * gprev; gprev = ep;
                *(LAS bf16*)(lds + CK_OPS + 0 * 8192 + swz_el(p, k)) = (bf16)f2bf(atv[i]);
                *(LAS bf16*)(lds + CK_OPS + 1 * 8192 + swz_el(p, k)) = (bf16)f2bf(bb * em);
                *(LAS bf16*)(lds + CK_OPS + 2 * 8192 + swz_el(p, k)) = (bf16)f2bf(kd * em);
                *(LAS bf16*)(lds + CK_OPS + 3 * 8192 + swz_el(p, k)) = (bf16)f2bf(rr[i] * ep);
                bhv[i] = bb * el; khv[i] = kd * el;
                const int tl = d == 0 ? p : 63 - p; const size_t row = (size_t)(rbase + t0 + tl);
                if (lane == 0) BON[((size_t)d * MROWS + row) * 8 + h] = bon;
                if (d == 0) VOUT[row * 512 + 64 * h + k] = (bf16)f2bf(vv[i]);
            }
            *(LAS v4u*)(lds + CK_OPS + 4 * 8192 + swz(k, pg)) = (v4u){pk2(bhv[0], bhv[1]), pk2(bhv[2], bhv[3]), pk2(bhv[4], bhv[5]), pk2(bhv[6], bhv[7])};
            *(LAS v4u*)(lds + CK_OPS + 5 * 8192 + swz(k, pg)) = (v4u){pk2(khv[0], khv[1]), pk2(khv[2], khv[3]), pk2(khv[4], khv[5]), pk2(khv[6], khv[7])};
            *(LAS v4u*)(lds + CK_OPS + 6 * 8192 + swz(k, pg)) = (v4u){pk2(vv[0], vv[1]), pk2(vv[2], vv[3]), pk2(vv[4], vv[5]), pk2(vv[6], vv[7])};
            *(LAS v4u*)(lds + CK_OPS + 7 * 8192 + swz(k, pg)) = (v4u){pk2(atv[0], atv[1]), pk2(atv[2], atv[3]), pk2(atv[4], atv[5]), pk2(atv[6], atv[7])};
            if (pg == 0) GLp[(size_t)ci * 64 + k] = etot;
            *(LAS v4u*)(lds + CK_T + tid * 16) = (v4u){0u, 0u, 0u, 0u}; *(LAS v4u*)(lds + CK_TT + tid * 16) = (v4u){0u, 0u, 0u, 0u};
        }
        __syncthreads();
        {
            const int prod = wave >> 2, tq = wave & 3, ti = tq >> 1, tj = tq & 1;
            f32x16 acc = zero16();
            if (!(ti == 0 && tj == 1)) mm_tile(acc, L0 + CK_OPS + 0 * 8192, 32 * ti, L0 + CK_OPS + (prod ? 2 : 1) * 8192, 32 * tj, 0, 4, r32, hh);
            const int s = 32 * tj + r32;
#pragma unroll
            for (int r = 0; r < 16; ++r) { const int p = 32 * ti + crow(r, hh); const float v = (s < p) ? acc[r] : 0.f;
                *(LAS bf16*)(lds + CK_LIN + prod * 8192 + swz_el(p, s)) = (bf16)f2bf(v);
                if (prod == 0 && (p >> 4) == (s >> 4)) *(LAS float*)(lds + CK_D + ((p >> 4) * 256 + (p & 15) * 16 + (s & 15)) * 4) = v; }
        }
        __syncthreads();
        if (wave == 0) {
            const int blk = lane >> 4, cc = lane & 15;
            float x[16];
#pragma unroll
            for (int p = 0; p < 16; ++p) x[p] = (p == cc) ? 1.f : 0.f;
#pragma unroll
            for (int s = 0; s < 15; ++s)
#pragma unroll
                for (int p = s + 1; p < 16; ++p) x[p] += *(const LAS float*)(L0 + CK_D + (blk * 256 + p * 16 + s) * 4) * x[s];
#pragma unroll
            for (int p = 0; p < 16; ++p) *(LAS bf16*)(lds + CK_T + swz_el(16 * blk + p, 16 * blk + cc)) = (bf16)f2bf(x[p]);
            *(LAS v4u*)(lds + CK_TT + swz(16 * blk + cc, 2 * blk)) = (v4u){pk2(x[0], x[1]), pk2(x[2], x[3]), pk2(x[4], x[5]), pk2(x[6], x[7])};
            *(LAS v4u*)(lds + CK_TT + swz(16 * blk + cc, 2 * blk + 1)) = (v4u){pk2(x[8], x[9]), pk2(x[10], x[11]), pk2(x[12], x[13]), pk2(x[14], x[15])};
            LDS_WAIT();
            typedef float f32x4_ __attribute__((ext_vector_type(4)));
            const int row = lane & 15, kg = lane >> 4;
            const bf16x8 zf = (bf16x8){0, 0, 0, 0, 0, 0, 0, 0};
#pragma unroll
            for (int pr_ = 0; pr_ < 2; ++pr_) {
                const int b0 = 2 * pr_, b1 = b0 + 1;
                bf16x8 a = *(const LAS bf16x8*)(L0 + CK_LIN + swz(16 * b1 + row, 2 * b0 + (kg & 1)));
                bf16x8 bq = *(const LAS bf16x8*)(L0 + CK_TT + swz(16 * b0 + row, 2 * b0 + (kg & 1)));
                if (kg >= 2) { a = zf; bq = zf; }
                f32x4_ z = __builtin_amdgcn_mfma_f32_16x16x32_bf16(a, bq, (f32x4_){0.f, 0.f, 0.f, 0.f}, 0, 0, 0);
                *(LAS v2u*)(lds + CK_ZT + (row * 16 + 4 * kg) * 2) = (v2u){pk2(z[0], z[1]), pk2(z[2], z[3])};
                LDS_WAIT();
                bf16x8 a2 = *(const LAS bf16x8*)(L0 + CK_T + swz(16 * b1 + row, 2 * b1 + (kg & 1)));
                bf16x8 b2 = *(const LAS bf16x8*)(L0 + CK_ZT + (row * 16 + 8 * (kg & 1)) * 2);
                if (kg >= 2) { a2 = zf; b2 = zf; }
                f32x4_ m = __builtin_amdgcn_mfma_f32_16x16x32_bf16(a2, b2, (f32x4_){0.f, 0.f, 0.f, 0.f}, 0, 0, 0);
#pragma unroll
                for (int i = 0; i < 4; ++i) *(LAS bf16*)(lds + CK_T + swz_el(16 * b1 + 4 * kg + i, 16 * b0 + row)) = (bf16)f2bf(m[i]);
                *(LAS v2u*)(lds + CK_TT + swz_el(16 * b0 + row, 16 * b1 + 4 * kg)) = (v2u){pk2(m[0], m[1]), pk2(m[2], m[3])};
                LDS_WAIT();
            }
            {
                f32x16 z2 = zero16();
#pragma unroll
                for (int ks = 0; ks < 2; ++ks) {
                    const bf16x8 a = *(const LAS bf16x8*)(L0 + CK_LIN + swz(32 + r32, 2 * ks + hh));
                    const bf16x8 bq = *(const LAS bf16x8*)(L0 + CK_TT + swz(r32, 2 * ks + hh));
                    z2 = __builtin_amdgcn_mfma_f32_32x32x16_bf16(a, bq, z2, 0, 0, 0); }
#pragma unroll
                for (int rq = 0; rq < 4; ++rq)
                    *(LAS v2u*)(lds + CK_ZT + (r32 * 32 + 8 * rq + 4 * hh) * 2) = (v2u){pk2(z2[4 * rq], z2[4 * rq + 1]), pk2(z2[4 * rq + 2], z2[4 * rq + 3])};
                LDS_WAIT();
                f32x16 m2 = zero16();
#pragma unroll
                for (int ks = 0; ks < 2; ++ks) {
                    const bf16x8 a = *(const LAS bf16x8*)(L0 + CK_T + swz(32 + r32, 4 + 2 * ks + hh));
                    const bf16x8 bq = *(const LAS bf16x8*)(L0 + CK_ZT + (r32 * 32 + 16 * ks + 8 * hh) * 2);
                    m2 = __builtin_amdgcn_mfma_f32_32x32x16_bf16(a, bq, m2, 0, 0, 0); }
#pragma unroll
                for (int r = 0; r < 16; ++r) *(LAS bf16*)(lds + CK_T + swz_el(32 + crow(r, hh), r32)) = (bf16)f2bf(m2[r]);
            }
        } else if (wave >= 5) {
            for (int job = wave - 5; job < 8; job += 3) {
                const int prod = 2 + (job >> 2), tq = job & 3, ti = tq >> 1, tj = tq & 1;
                f32x16 acc = zero16();
                if (!(ti == 0 && tj == 1)) mm_tile(acc, L0 + CK_OPS + 3 * 8192, 32 * ti, L0 + CK_OPS + ((prod & 1) ? 2 : 1) * 8192, 32 * tj, 0, 4, r32, hh);
                const int s = 32 * tj + r32;
#pragma unroll
                for (int r = 0; r < 16; ++r) { const int p = 32 * ti + crow(r, hh); const float v = (s <= p) ? acc[r] : 0.f;
                    *(LAS bf16*)(lds + CK_LIN + prod * 8192 + swz_el(p, s)) = (bf16)f2bf(v); }
            }
        } else {
            const int tq = wave - 1, ti = tq >> 1, tj = tq & 1; f32x16 acc = zero16();
            mm_tile(acc, L0 + CK_LIN + 1 * 8192, 32 * ti, L0 + CK_OPS + 6 * 8192, 32 * tj, 0, 4, r32, hh);
#pragma unroll
            for (int rq = 0; rq < 4; ++rq)
                *(LAS v2u*)(lds + CK_PT + swz_el(32 * tj + r32, 32 * ti + 8 * rq + 4 * hh)) = (v2u){pk2(acc[4 * rq], acc[4 * rq + 1]), pk2(acc[4 * rq + 2], acc[4 * rq + 3])};
        }
        __syncthreads();
        if (it + F.G < NB * 8 * 36 * 2) CK_LOAD(it + F.G);
        {
            const bool isW = wave < 4; const int tq = wave & 3, ti = tq >> 1, tj = tq & 1; f32x16 acc = zero16();
            mm_tile(acc, isW ? L0 + CK_OPS + 7 * 8192 : L0 + CK_PT, 32 * ti, L0 + CK_T, 32 * tj, 0, 4, r32, hh);
            LAS unsigned char* XT = isW ? lds + CK_WT : lds + CK_UT;
#pragma unroll
            for (int r = 0; r < 16; ++r) *(LAS bf16*)(XT + swz_el(32 * ti + crow(r, hh), 32 * tj + r32)) = (bf16)f2bf(acc[r]);
        }
        __syncthreads();
        {
            const LAS unsigned char* WT_ = L0 + CK_WT; const LAS unsigned char* UT_ = L0 + CK_UT;
            const LAS unsigned char* Arb = L0 + CK_LIN + 2 * 8192; const LAS unsigned char* Ark = L0 + CK_LIN + 3 * 8192;
            const LAS unsigned char* BhT = L0 + CK_OPS + 4 * 8192; const LAS unsigned char* KhT = L0 + CK_OPS + 5 * 8192; const LAS unsigned char* VT = L0 + CK_OPS + 6 * 8192;
            f32x16 acc2[2];
#pragma unroll
            for (int jj = 0; jj < 2; ++jj) { const int job = wave + 8 * jj, prod = job >> 2, tq = job & 3, ti = tq >> 1, tj = tq & 1;
                acc2[jj] = zero16();
                if (prod == 0) mm_tile(acc2[jj], WT_, 32 * ti, Arb, 32 * tj, 0, 4, r32, hh);
                else if (prod == 1) { mm_tile(acc2[jj], UT_, 32 * ti, Arb, 32 * tj, 0, 4, r32, hh); mm_tile(acc2[jj], VT, 32 * ti, Ark, 32 * tj, 0, 4, r32, hh); }
                else if (prod == 2) mm_tile(acc2[jj], WT_, 32 * ti, BhT, 32 * tj, 0, 4, r32, hh);
                else { mm_tile(acc2[jj], UT_, 32 * ti, BhT, 32 * tj, 0, 4, r32, hh); mm_tile(acc2[jj], VT, 32 * ti, KhT, 32 * tj, 0, 4, r32, hh); } }
#pragma unroll
            for (int jj = 0; jj < 2; ++jj) { const int job = wave + 8 * jj, prod = job >> 2, tq = job & 3, ti = tq >> 1, tj = tq & 1;
                const f32x16 acc = acc2[jj]; const int cc = 32 * tj + r32;
#pragma unroll
                for (int rq = 0; rq < 4; ++rq) { const int r0 = 32 * ti + 8 * rq + 4 * hh;
                    float v0 = acc[4 * rq], v1 = acc[4 * rq + 1], v2 = acc[4 * rq + 2], v3 = acc[4 * rq + 3];
                    if (prod == 0) { const v2u rt = *(const LAS v2u*)(L0 + CK_OPS + 3 * 8192 + swz_el(cc, r0)); v0 += bflo(rt.x); v1 += bfhi(rt.x); v2 += bflo(rt.y); v3 += bfhi(rt.y); }
                    bf16* dst = prod == 0 ? CHRQ : prod == 1 ? CHY : prod == 2 ? CHG : CHH;
                    *(v2u*)(dst + (size_t)ci * 4096 + fro(cc, r0)) = (v2u){pk2(v0, v1), pk2(v2, v3)}; }
            }
        }
    }
#undef CK_LOAD
#undef CK_DECODE
}

__device__ __forceinline__ void p_state(Frame& F) {
    using namespace ck;
    const int wave = F.wave;
    const bf16* CHG = (const bf16*)(F.ws + WS_CHG); const bf16* CHH = (const bf16*)(F.ws + WS_CHH); const bf16* CHRQ = (const bf16*)(F.ws + WS_CHRQ); bf16* CHY = (bf16*)(F.ws + WS_CHY);
    const float* GLp = (const float*)(F.ws + WS_GL);
    for (int pair = F.bid; pair < NB * 8; pair += F.G) {
        const int chain = 2 * pair + (wave >> 2);
        const int d = chain & 1, h = (chain >> 1) & 7, b = chain >> 4;
        const int tq = wave & 3, ti = tq >> 1, tj = tq & 1;
        LAS unsigned char* lds = F.lds + RING_OFF + (wave >> 2) * 16384;
        f32x16 S = zero16();
        __syncthreads();
        for (int i = F.tid; i < 32768 / 16; i += NTHR) *(LAS v4u*)(F.lds + RING_OFF + i * 16) = (v4u){0u, 0u, 0u, 0u};
        struct Ops { bf16x8 g[4], q[4]; v2u h[4], y[4]; float gl; } A, B;
#define ST_LOAD(O, c_) do { const size_t cb_ = (size_t)chunk_index(b, h, d, (c_)) * 4096; int l_ = lane_id_fresh(); asm volatile("" : "+v"(l_)); const int r32 = l_ & 31, hh = l_ >> 5; \
            _Pragma("unroll") for (int ks = 0; ks < 4; ++ks) { O.g[ks] = *(const bf16x8*)(CHG + cb_ + fro(32 * tj + r32, 16 * ks + 8 * hh)); O.q[ks] = *(const bf16x8*)(CHRQ + cb_ + fro(32 * tj + r32, 16 * ks + 8 * hh)); } \
            _Pragma("unroll") for (int rq = 0; rq < 4; ++rq) { const size_t o_ = cb_ + fro(32 * tj + r32, 32 * ti + 8 * rq + 4 * hh); O.h[rq] = *(const v2u*)(CHH + o_); O.y[rq] = *(const v2u*)(CHY + o_); } \
            O.gl = GLp[(size_t)chunk_index(b, h, d, (c_)) * 64 + 32 * tj + r32]; } while (0)
#define ST_STEP(O, c_, SB, SN) do { const size_t cb = (size_t)chunk_index(b, h, d, (c_)) * 4096; \
            int lane = lane_id_fresh(); asm volatile("" : "+v"(lane)); const int r32 = lane & 31, hh = lane >> 5; \
            const LAS unsigned char* Sb = lds + (SB) * 8192; LAS unsigned char* Sn = lds + (SN) * 8192; \
            asm volatile("" : "+v"(O.g[0]), "+v"(O.g[1]), "+v"(O.g[2]), "+v"(O.g[3]), "+v"(O.q[0]), "+v"(O.q[1]), "+v"(O.q[2]), "+v"(O.q[3])); \
            asm volatile("" : "+v"(O.h[0]), "+v"(O.h[1]), "+v"(O.h[2]), "+v"(O.h[3]), "+v"(O.y[0]), "+v"(O.y[1]), "+v"(O.y[2]), "+v"(O.y[3]), "+v"(O.gl)); \
            f32x16 accS = zero16(), accY = zero16(); \
            _Pragma("unroll") for (int ks = 0; ks < 4; ++ks) { \
                const bf16x8 a = *(const LAS bf16x8*)(Sb + swz(32 * ti + r32, 2 * ks + hh)); \
                accS = __builtin_amdgcn_mfma_f32_32x32x16_bf16(a, O.g[ks], accS, 0, 0, 0); \
                accY = __builtin_amdgcn_mfma_f32_32x32x16_bf16(a, O.q[ks], accY, 0, 0, 0); } \
            _Pragma("unroll") for (int rq = 0; rq < 4; ++rq) { \
                const float hv[4] = {bflo(O.h[rq].x), bfhi(O.h[rq].x), bflo(O.h[rq].y), bfhi(O.h[rq].y)}, yv[4] = {bflo(O.y[rq].x), bfhi(O.y[rq].x), bflo(O.y[rq].y), bfhi(O.y[rq].y)}; \
                float yo[4]; \
                _Pragma("unroll") for (int i = 0; i < 4; ++i) { const int r = 4 * rq + i; const int v_ = 32 * ti + crow(r, hh); \
                    S[r] = S[r] * O.gl + accS[r] + hv[i]; \
                    *(LAS bf16*)(Sn + swz_el(v_, 32 * tj + r32)) = (bf16)f2bf(S[r]); \
                    yo[i] = accY[r] + yv[i]; } \
                *(v2u*)(CHY + cb + fro(32 * tj + r32, 32 * ti + 8 * rq + 4 * hh)) = (v2u){pk2(yo[0], yo[1]), pk2(yo[2], yo[3])}; } } while (0)
        ST_LOAD(A, 0); ST_LOAD(B, 1);
        __syncthreads();
        for (int c = 0; c < NCH; c += 2) {
            ST_STEP(A, c, 0, 1);
            __builtin_amdgcn_sched_barrier(0);
            ST_LOAD(A, (c + 2 < NCH ? c + 2 : NCH - 1));
            __builtin_amdgcn_sched_barrier(0);
            __syncthreads();
            ST_STEP(B, c + 1, 1, 0);
            __builtin_amdgcn_sched_barrier(0);
            ST_LOAD(B, (c + 3 < NCH ? c + 3 : NCH - 1));
            __builtin_amdgcn_sched_barrier(0);
            __syncthreads();
        }
#undef ST_STEP
#undef ST_LOAD
    }
}

__device__ __forceinline__ void p_rope0(Frame& F) {
    const int gw = F.bid * NWAVES + F.wave, NGW = F.G * NWAVES;
    bf16* PB = (bf16*)(F.ws + WS_PB); const float* cosB = (const float*)(F.ws + WS_ROPE); const float* sinB = cosB + SEQ * 32;
    const int vec = F.lane >> 2, j8 = (F.lane & 3) * 8;
    for (int q = gw; q < NB * SEQ; q += 2 * NGW) {
        int qq[2]; qq[0] = q; qq[1] = q + NGW < NB * SEQ ? q + NGW : q; const bool ok1 = q + NGW < NB * SEQ;
        v4u a[2], b2[2]; f32x4 c0[2], c1[2], s0[2], s1[2]; bf16* pp[2];
#pragma unroll
        for (int s = 0; s < 2; ++s) { const int b = qq[s] / SEQ, t = qq[s] - b * SEQ; pp[s] = PB + (size_t)(b * TPB + CTXL + t) * B_IN + vec * 64 + j8;
            a[s] = *(const v4u*)pp[s]; b2[s] = *(const v4u*)(pp[s] + 32);
            c0[s] = *(const f32x4*)(cosB + t * 32 + j8); c1[s] = *(const f32x4*)(cosB + t * 32 + j8 + 4); s0[s] = *(const f32x4*)(sinB + t * 32 + j8); s1[s] = *(const f32x4*)(sinB + t * 32 + j8 + 4); }
#pragma unroll
        for (int s = 0; s < 2; ++s) {
            const unsigned aw[4] = {a[s].x, a[s].y, a[s].z, a[s].w}, bw[4] = {b2[s].x, b2[s].y, b2[s].z, b2[s].w};
            const float cs[8] = {c0[s].x, c0[s].y, c0[s].z, c0[s].w, c1[s].x, c1[s].y, c1[s].z, c1[s].w}, sn[8] = {s0[s].x, s0[s].y, s0[s].z, s0[s].w, s1[s].x, s1[s].y, s1[s].z, s1[s].w};
            float o1[8], o2[8];
#pragma unroll
            for (int i = 0; i < 8; ++i) { const int w = i >> 1; const bool up = i & 1; const float x1 = up ? bfhi(aw[w]) : bflo(aw[w]), x2 = up ? bfhi(bw[w]) : bflo(bw[w]);
                o1[i] = x1 * cs[i] - x2 * sn[i]; o2[i] = x1 * sn[i] + x2 * cs[i]; }
            if (s == 0 || ok1) { *(v4u*)pp[s] = (v4u){pk2(o1[0], o1[1]), pk2(o1[2], o1[3]), pk2(o1[4], o1[5]), pk2(o1[6], o1[7])};
                                 *(v4u*)(pp[s] + 32) = (v4u){pk2(o2[0], o2[1]), pk2(o2[2], o2[3]), pk2(o2[4], o2[5]), pk2(o2[6], o2[7])}; }
        }
    }
}

__device__ __forceinline__ void p_linact(Frame& F) {
    const int gw = F.bid * NWAVES + F.wave, NGW = F.G * NWAVES;
    const bf16* PA = (const bf16*)(F.ws + WS_PA); bf16* LA = (bf16*)((unsigned char*)F.out + DOUT_LINACT);
    const int cc = F.lane * 8; const bool act = F.lane < 48;
    const float* mu = F.in[I_AMU] + 1536 + (act ? cc : 0);
    const f32x4 m0 = *(const f32x4*)mu, m1 = *(const f32x4*)(mu + 4);
    const float mm[8] = {m0.x, m0.y, m0.z, m0.w, m1.x, m1.y, m1.z, m1.w};
    if (!act) return;
    for (int row0 = gw; row0 < MROWS; row0 += 2 * NGW) {
        int rws[2]; rws[0] = row0; rws[1] = row0 + NGW < MROWS ? row0 + NGW : row0; const bool ok1 = row0 + NGW < MROWS;
        v4u cur[2], prv[2], nxt[2];
#pragma unroll
        for (int s = 0; s < 2; ++s) { const int row = rws[s]; const int b = row / TPB, tt = row - b * TPB; const bool isctx = tt < CTXL; const int t = isctx ? tt : tt - CTXL, Ls = isctx ? CTXL : SEQ;
            const bf16* pc = PA + (size_t)row * A_IN + 1536 + cc;
            cur[s] = *(const v4u*)pc; const v4u pv_ = *(const v4u*)(pc - (t > 0 ? A_IN : 0)), nv_ = *(const v4u*)(pc + (t + 1 < Ls ? A_IN : 0));
            prv[s] = t > 0 ? pv_ : (v4u){0u, 0u, 0u, 0u}; nxt[s] = t + 1 < Ls ? nv_ : (v4u){0u, 0u, 0u, 0u}; }
#pragma unroll
        for (int s = 0; s < 2; ++s) {
            if (s == 1 && !ok1) break;
            const unsigned cw[4] = {cur[s].x, cur[s].y, cur[s].z, cur[s].w}, pw[4] = {prv[s].x, prv[s].y, prv[s].z, prv[s].w}, nw[4] = {nxt[s].x, nxt[s].y, nxt[s].z, nxt[s].w}; float u[8];
#pragma unroll
            for (int j = 0; j < 8; ++j) { const int w = j >> 1; const bool up = j & 1;
                const float cv = up ? bfhi(cw[w]) : bflo(cw[w]), pv = up ? bfhi(pw[w]) : bflo(pw[w]), nv = up ? bfhi(nw[w]) : bflo(nw[w]);
                float x = cv + (0.5f * (pv + nv) - cv) * mm[j];
                if (cc < 128) x = 1.f - 2.f * __builtin_amdgcn_rcpf(__builtin_amdgcn_exp2f(2.8853900817779268f * x) + 1.f); else if (cc >= 256) x = fsig(x);
                u[j] = x; }
            *(v4u*)(LA + (size_t)rws[s] * 384 + cc) = (v4u){pk2(u[0], u[1]), pk2(u[2], u[3]), pk2(u[4], u[5]), pk2(u[6], u[7])};
        }
    }
}

__device__ __forceinline__ void p_attn0(Frame& F) {
    const bf16* PB = (const bf16*)(F.ws + WS_PB);
    unsigned* qctr = (unsigned*)(F.ws + WS_CTL) + CW_Q0;
    volatile LAS unsigned* slot = (volatile LAS unsigned*)(F.lds + MISC_OFF + 64);
    for (;;) {
        __syncthreads();
        if (F.tid == 0) slot[0] = atomicAdd(qctr, 1u);
        __syncthreads();
        const int u = (int)slot[0];
        if (u >= 576) break;
        int b, h, m, qt;
        if (u < 512) { qt = 1 + (u & 7); const int r = u >> 3; m = r & 1; h = (r >> 1) & 3; b = r >> 3; }
        else { const int r = u - 512; qt = 0; m = r & 1; h = (r >> 1) & 3; b = r >> 3; }
        const size_t row0 = (size_t)b * TPB;
        const bf16* Q = PB + (row0 + (size_t)qt * 256) * B_IN + h * 128 + m * 64;
        const bf16* Kp = PB + row0 * B_IN + 512 + h * 128 + m * 64;
        const bf16* Vp = PB + row0 * B_IN + 1024 + h * 128;
        bf16* O = (bf16*)(F.ws + (m == 0 ? WS_OB0 : WS_OB1)) + (row0 + (size_t)qt * 256) * 512 + h * 128;
        att::attn_body<64, B_IN, B_IN, 512>(Q, Kp, Vp, O, qt == 0 ? CTXL : TPB, (char*)g_lds + RING_OFF, F.wave);
    }
}

__device__ __forceinline__ void p_readout(Frame& F) {
    const int gw = F.bid * NWAVES + F.wave, NGW = F.G * NWAVES;
    const bf16* CHY = (const bf16*)(F.ws + WS_CHY); const bf16* fv = (const bf16*)(F.ws + WS_VOUT); const bf16* fg = (const bf16*)(F.ws + WS_GOUT); const float* BON = (const float*)(F.ws + WS_BON);
    const bf16* ob0 = (const bf16*)(F.ws + WS_OB0); const bf16* ob1 = (const bf16*)(F.ws + WS_OB1);
    bf16* A2 = (bf16*)(F.ws + WS_A2);
    float lam;
    { const float* lv = F.in[I_BLAM]; const float s1 = wave_sum(lv[F.lane] * lv[64 + F.lane]), s2 = wave_sum(lv[128 + F.lane] * lv[192 + F.lane]); lam = expf(s1) - expf(s2) + LAMBDA_INIT0; }
    const int pl = F.lane >> 4, c16 = F.lane & 15;
    for (int it = gw; it < MROWS; it += NGW) {
        const int row = (it >> 2) * 4 + pl, c8 = (it & 3) * 128 + c16 * 8, hd = c8 >> 6, v0 = c8 & 63;
        const size_t off = (size_t)row * 512 + c8;
        const int b = row / TPB, tt = row - b * TPB;
        const int ir = tt < CTXL ? (CTXL - 1 - tt) : CTXL + (TPB - 1 - tt);
        const size_t of = (size_t)ck::chunk_index(b, hd, 0, tt >> 6) * 4096 + ck::fro(tt & 63, v0), orv = (size_t)ck::chunk_index(b, hd, 1, ir >> 6) * 4096 + ck::fro(ir & 63, v0);
        const v4u qv = *(const v4u*)(fv + off), qg = *(const v4u*)(fg + off), q1 = *(const v4u*)(CHY + of), q2 = *(const v4u*)(CHY + orv);
        const unsigned wv_[4] = {qv.x, qv.y, qv.z, qv.w}, wg_[4] = {qg.x, qg.y, qg.z, qg.w}, w1_[4] = {q1.x, q1.y, q1.z, q1.w}, w2_[4] = {q2.x, q2.y, q2.z, q2.w};
        const float bon = BON[(size_t)row * 8 + hd] + BON[((size_t)MROWS + row) * 8 + hd];
        float y[8], s = 0.f;
#pragma unroll
        for (int j = 0; j < 8; ++j) { const int w = j >> 1; const bool up = j & 1; y[j] = (up ? bfhi(w1_[w]) : bflo(w1_[w])) + (up ? bfhi(w2_[w]) : bflo(w2_[w])); s += y[j]; }
        s = sum8(s);
        const float mean = s * (1.f / 64.f); float q = 0.f;
#pragma unroll
        for (int j = 0; j < 8; ++j) { y[j] -= mean; q += y[j] * y[j]; }
        q = sum8(q);
        const float rstd = 1.f / sqrtf(q * (1.f / 64.f) + GN_EPS);
        float o[8];
#pragma unroll
        for (int j = 0; j < 8; ++j) { const int w = j >> 1; const bool up = j & 1; const float v_ = up ? bfhi(wv_[w]) : bflo(wv_[w]), g_ = up ? bfhi(wg_[w]) : bflo(wg_[w]);
            o[j] = (y[j] * rstd * F.in[I_LNXG][c8 + j] + F.in[I_LNXB][c8 + j] + bon * v_) * g_; }
        *(v4u*)(A2 + (size_t)row * DM + c8) = (v4u){pk2(o[0], o[1]), pk2(o[2], o[3]), pk2(o[4], o[5]), pk2(o[6], o[7])};
        const v4u p0 = *(const v4u*)(ob0 + off), p1 = *(const v4u*)(ob1 + off);
        const unsigned u0[4] = {p0.x, p0.y, p0.z, p0.w}, u1[4] = {p1.x, p1.y, p1.z, p1.w};
        float z[8], ss = 0.f;
#pragma unroll
        for (int j = 0; j < 8; ++j) { const int w = j >> 1; const bool up = j & 1; z[j] = (up ? bfhi(u0[w]) : bflo(u0[w])) - lam * (up ? bfhi(u1[w]) : bflo(u1[w])); ss += z[j] * z[j]; }
        ss = sum16(ss);
        const float rr = 1.f / sqrtf(ss * (1.f / 128.f) + SUBLN_EPS) * (1.f - LAMBDA_INIT0);
#pragma unroll
        for (int j = 0; j < 8; ++j) z[j] = z[j] * rr * F.in[I_SUBG][(c8 + j) & 127];
        *(v4u*)(A2 + (size_t)row * DM + 512 + c8) = (v4u){pk2(z[0], z[1]), pk2(z[2], z[3]), pk2(z[4], z[5]), pk2(z[6], z[7])};
    }
}

__device__ __forceinline__ void p_qknorm1(Frame& F) {
    const int gw = F.bid * NWAVES + F.wave, NGW = F.G * NWAVES;
    bf16* QKV = (bf16*)(F.ws + WS_QKV1); const float* cosC = (const float*)(F.ws + WS_ROPE) + SEQ * 64; const float* sinC = cosC + SEQ * 64;
    const float qg1 = F.in[I_QNG][F.lane], qg2 = F.in[I_QNG][64 + F.lane], kg1 = F.in[I_KNG][F.lane], kg2 = F.in[I_KNG][64 + F.lane];
    for (int row0 = gw; row0 < MROWS; row0 += 2 * NGW) {
        int rws[2]; rws[0] = row0; rws[1] = row0 + NGW < MROWS ? row0 + NGW : row0; const bool ok1 = row0 + NGW < MROWS;
        unsigned short xr[2][2][2]; float cs[2], sn[2];
#pragma unroll
        for (int s = 0; s < 2; ++s) { const int row = rws[s]; const int b = row / TPB, tt = row - b * TPB; const bool lat = tt >= CTXL; const int t = lat ? tt - CTXL : 0;
            const bf16* p = QKV + (size_t)row * ODD_IN + 8 * 128;
#pragma unroll
            for (int hd = 0; hd < 2; ++hd) { xr[s][hd][0] = p[hd * 128 + F.lane]; xr[s][hd][1] = p[hd * 128 + 64 + F.lane]; }
            const float c_ = cosC[t * 64 + F.lane], s_ = sinC[t * 64 + F.lane]; cs[s] = lat ? c_ : 1.f; sn[s] = lat ? s_ : 0.f; }
#pragma unroll
        for (int s = 0; s < 2; ++s) {
            if (s == 1 && !ok1) break;
            bf16* p = QKV + (size_t)rws[s] * ODD_IN + 8 * 128;
#pragma unroll
            for (int hd = 0; hd < 2; ++hd) {
                const float x1 = bf2f(xr[s][hd][0]), x2 = bf2f(xr[s][hd][1]);
                const float ss = wave_sum(x1 * x1 + x2 * x2); const float ri = 1.f / sqrtf(ss * (1.f / 128.f) + QKN_EPS);
                const float y1 = x1 * ri * kg1, y2 = x2 * ri * kg2;
                p[hd * 128 + F.lane] = (bf16)f2bf(y1 * cs[s] - y2 * sn[s]); p[hd * 128 + 64 + F.lane] = (bf16)f2bf(y1 * sn[s] + y2 * cs[s]);
            }
        }
    }
}
__device__ __forceinline__ void p_attn1(Frame& F) {
    const bf16* QKV = (const bf16*)(F.ws + WS_QKV1); bf16* OA = (bf16*)(F.ws + WS_OATT);
    for (int u = F.bid; u < 512; u += F.G) {
        const int qt = 1 + (u & 7), h = (u >> 3) & 7, b = u >> 6; const int kvh = h >> 2;
        const size_t row0 = (size_t)b * TPB;
        const bf16* Q = QKV + (row0 + (size_t)qt * 256) * ODD_IN + h * 128;
        const bf16* Kp = QKV + row0 * ODD_IN + 1024 + kvh * 128;
        const bf16* Vp = QKV + row0 * ODD_IN + 1280 + kvh * 128;
        bf16* O = OA + (row0 + (size_t)qt * 256) * DM + h * 128;
        att::attn_body<128, ODD_IN, ODD_IN, DM, true>(Q, Kp, Vp, O, TPB, (char*)g_lds + RING_OFF, F.wave, F.in[I_QNG], (const float*)(F.ws + WS_ROPE) + SEQ * 64, (const float*)(F.ws + WS_ROPE) + SEQ * 128, (qt - 1) * 256, QKN_EPS);
    }
}
namespace pg8 {
struct NoPre {};
struct EpiBf16 {
    static constexpr bool PERM = true; typedef NoPre Pre; __device__ __forceinline__ void prefetch(Pre&, const Unit&, int, int) const {}
    bf16_t* O; int ldc;
    __device__ __forceinline__ void operator()(const f32x4 (&acc)[2][2][4][2], const Unit& u, int wr, int wc, int fr, int fq, const Pre& pre) const {
        const int row0 = u.orow0 + wr * 64 + fr, col0 = u.pn * BM + wc * 32 + 8 * fq;
#pragma unroll
        for (int ai = 0; ai < 2; ++ai)
#pragma unroll
            for (int m = 0; m < 4; ++m) { bf16_t* rowp = O + (size_t)(row0 + ai * HALF + m * 16) * ldc + col0;
#pragma unroll
                for (int bj = 0; bj < 2; ++bj) { const f32x4 v0 = acc[ai][bj][m][0], v1 = acc[ai][bj][m][1];
                    u32x4 w; w.x = cvt_pk_bf16(v0[0], v0[1]); w.y = cvt_pk_bf16(v0[2], v0[3]); w.z = cvt_pk_bf16(v1[0], v1[1]); w.w = cvt_pk_bf16(v1[2], v1[3]);
                    *(u32x4*)(rowp + bj * HALF) = w; } }
    }
};
struct EpiIn0 {
    static constexpr bool PERM = true; typedef NoPre Pre; __device__ __forceinline__ void prefetch(Pre&, const Unit&, int, int) const {}
    bf16_t* PA; bf16_t* PB;
    __device__ __forceinline__ void operator()(const f32x4 (&acc)[2][2][4][2], const Unit& u, int wr, int wc, int fr, int fq, const Pre& pre) const {
        const int row0 = u.orow0 + wr * 64 + fr, col0 = u.pn * BM + wc * 32 + 8 * fq;
#pragma unroll
        for (int ai = 0; ai < 2; ++ai)
#pragma unroll
            for (int m = 0; m < 4; ++m) { const size_t row = (size_t)(row0 + ai * HALF + m * 16);
#pragma unroll
                for (int bj = 0; bj < 2; ++bj) { const f32x4 v0 = acc[ai][bj][m][0], v1 = acc[ai][bj][m][1]; const int col = col0 + bj * HALF;
                    u32x4 w; w.x = cvt_pk_bf16(v0[0], v0[1]); w.y = cvt_pk_bf16(v0[2], v0[3]); w.z = cvt_pk_bf16(v1[0], v1[1]); w.w = cvt_pk_bf16(v1[2], v1[3]);
                    if (col < 1920) *(u32x4*)(PA + row * 1920 + col) = w; else if (col < 3456) *(u32x4*)(PB + row * 1536 + (col - 1920)) = w; } }
    }
};
struct EpiMoe1 {
    static constexpr bool PERM = true; typedef NoPre Pre; __device__ __forceinline__ void prefetch(Pre&, const Unit&, int, int) const {}
    bf16_t* HID;
    __device__ __forceinline__ void operator()(const f32x4 (&acc)[2][2][4][2], const Unit& u, int wr, int wc, int fr, int fq, const Pre& pre) const {
        const int row0 = u.orow0 + wr * 64 + fr, col0 = u.pn * 128 + wc * 16 + 4 * fq;
#pragma unroll
        for (int ai = 0; ai < 2; ++ai)
#pragma unroll
            for (int m = 0; m < 4; ++m) { bf16_t* rowp = HID + (size_t)(row0 + ai * HALF + m * 16) * 512 + col0;
#pragma unroll
                for (int bj = 0; bj < 2; ++bj) { const f32x4 a = acc[ai][bj][m][0], b = acc[ai][bj][m][1]; float h[4];
#pragma unroll
                    for (int i = 0; i < 4; ++i) h[i] = a[i] * __builtin_amdgcn_rcpf(1.f + __builtin_amdgcn_exp2f(-1.4426950408889634f * a[i])) * b[i];
                    u32x2 w; w.x = cvt_pk_bf16(h[0], h[1]); w.y = cvt_pk_bf16(h[2], h[3]);
                    *(u32x2*)(rowp + bj * 64) = w; } }
    }
};
struct EpiMoe2 {
    static constexpr bool PERM = true;
    struct Pre { float g[2][4]; };
    bf16_t* Y; const float* GATE;
    __device__ __forceinline__ void prefetch(Pre& p, const Unit& u, int wr, int fr) const {
#pragma unroll
        for (int ai = 0; ai < 2; ++ai)
#pragma unroll
            for (int m = 0; m < 4; ++m) { const int r = wr * 64 + fr + ai * HALF + m * 16; p.g[ai][m] = GATE[u.gbase + (r < u.nvalid ? r : 0)]; }
    }
    __device__ __forceinline__ void operator()(const f32x4 (&acc)[2][2][4][2], const Unit& u, int wr, int wc, int fr, int fq, const Pre& pre) const {
        const int r0 = wr * 64 + fr, col0 = u.pn * BM + wc * 32 + 8 * fq;
#pragma unroll
        for (int ai = 0; ai < 2; ++ai)
#pragma unroll
            for (int m = 0; m < 4; ++m) { const int r = r0 + ai * HALF + m * 16; if (r >= u.nvalid) continue;
                const float gt = pre.g[ai][m]; bf16_t* rowp = Y + (size_t)(u.orow0 + r) * 1024 + col0;
#pragma unroll
                for (int bj = 0; bj < 2; ++bj) { const f32x4 v0 = acc[ai][bj][m][0] * gt, v1 = acc[ai][bj][m][1] * gt;
                    u32x4 w; w.x = cvt_pk_bf16(v0[0], v0[1]); w.y = cvt_pk_bf16(v0[2], v0[3]); w.z = cvt_pk_bf16(v1[0], v1[1]); w.w = cvt_pk_bf16(v1[2], v1[3]);
                    *(u32x4*)(rowp + bj * HALF) = w; } }
    }
};
__device__ __forceinline__ void moe_build_table(const unsigned* cnt, PG8_LAS int* tab, int tid) {
    unsigned cn[16]; int total = 0;
#pragma unroll
    for (int e = 0; e < 16; ++e) { cn[e] = __hip_atomic_load(cnt + e, __ATOMIC_RELAXED, __HIP_MEMORY_SCOPE_AGENT); total += (int)((cn[e] + 255u) >> 8); }
    total *= 4;
    if (tid == 0) tab[0] = total;
    if (tid == 0) {
#pragma unroll
        for (int e = 0; e < 16; ++e) tab[1284 + e] = (int)cn[e]; }
    for (int L = tid; L < total; L += 512) {
        int base = 0, toff = 0, e = 0; bool found = false; unsigned ce = cn[0];
#pragma unroll
        for (int q = 0; q < 16; ++q) { const int nt = (int)((cn[q] + 255u) >> 8); if (!found) { if (L >= base + 4 * nt) { base += 4 * nt; toff += nt; e = q + 1; } else { found = true; ce = cn[q]; } } }
        const int nt_e = (int)((ce + 255u) >> 8); const int within = L - base, pn = within / nt_e, rt = within % nt_e;
        const int rem = (int)ce - rt * 256; const int nvalid = rem < 256 ? rem : 256;
        tab[4 + 2 * L] = e | (rt << 4) | (pn << 12) | (nvalid << 16); tab[4 + 2 * L + 1] = toff + rt;
    }
    __syncthreads();
}
template <bool GATHER_>
struct MoeOrder {
    static constexpr bool GATHER = GATHER_;
    const PG8_LAS int* tab; const int* perm; int G, c, K;
    __device__ __forceinline__ bool next(int i, Unit& u) const {
        const int total = __builtin_amdgcn_readfirstlane(tab[0]);
        const int L0 = i * G + c; if (L0 >= total) return false;
        const int L = xcd_remap(L0, total);
        const int w0 = __builtin_amdgcn_readfirstlane(tab[4 + 2 * L]), w1 = __builtin_amdgcn_readfirstlane(tab[4 + 2 * L + 1]);
        const int e = w0 & 15, rt = (w0 >> 4) & 255, pn = (w0 >> 12) & 3;
        u.pm = rt; u.pn = pn; u.e = e; u.gbase = e * 18432 + rt * 256; u.nvalid = (w0 >> 16) & 511; u.orow0 = w1 * 256;
        u.boff = ((size_t)e * 1024 + (size_t)pn * 256) * K * 2; u.aoff = (size_t)u.orow0 * K * 2; return true;
    }
    __device__ __forceinline__ int token(const Unit& u, int r) const { return perm[u.gbase + (r < u.nvalid ? r : 0)]; }
};
}

enum { PH_PROLOGUE = 0, PH_MOD0, PH_GEMM_IN0, PH_PREP, PH_CHUNK, PH_ATTN0, PH_READOUT, PH_GEMM_OUT0, PH_LNR0, PH_MOE1_0, PH_MOE2_0, PH_LN2_0,
       PH_GEMM_IN1, PH_QKN1, PH_ATTN1, PH_GEMM_OUT1, PH_LNR1, PH_MOE1_1, PH_MOE2_1, PH_FINAL, N_PHASES };

template <int LAYER> __device__ __forceinline__ void p_moe1(Frame& F) {
    pg8::Gemm g{(const pg8::bf16_t*)(F.ws + WS_H), (const pg8::bf16_t*)moe_w13(F, LAYER), DM};
    pg8::moe_build_table((const unsigned*)(F.ws + WS_CTL) + CW_CNT + LAYER * 64, (LAS int*)(F.lds + MOETAB_OFF), F.tid);
    const int total = ((const LAS int*)(F.lds + MOETAB_OFF))[0];
    constexpr int NCV = 32, MOE_DED2 = 512;
    const int Gg = (LAYER == 0 && F.G > 4 * NCV && (total + F.G - NCV - 1) / (F.G - NCV) == (total + F.G - 1) / F.G) ? F.G - NCV : F.G;
    if (F.bid < Gg) {
        pg8::MoeOrder<true> S{(const LAS int*)(F.lds + MOETAB_OFF), (const int*)(F.ws + WS_PERM_), Gg, F.bid, DM};
        pg8::EpiMoe1 E{(pg8::bf16_t*)(F.ws + WS_HID)};
        pg8::gemm_phase<pg8::EpiMoe1, pg8::MoeOrder<true>>(F.lds + RING_OFF, g, S, E, F.wave);
        const int lo2 = Gg == F.G ? MOE_I13 : MOE_I13 + MOE_DED2;
        const int rounds = (total + Gg - 1) / Gg, c0 = total - (rounds - 1) * Gg;
        if (c0 >= Gg) convert_moe_weights(F, LAYER, lo2, MOE_IALL, F.bid, Gg);
        else if (F.bid >= c0) convert_moe_weights(F, LAYER, lo2, MOE_IALL, F.bid - c0, Gg - c0);
    } else { convert_moe_weights(F, 0, MOE_I13, MOE_I13 + MOE_DED2, F.bid - Gg, F.G - Gg);
             convert_moe_weights(F, 1, 0, MOE_I13 / 2, F.bid - Gg, F.G - Gg); }
    if (LAYER == 0 && Gg == F.G) convert_moe_filler(F, 1, 0, MOE_I13 / 2, total);
}
template <int LAYER> __device__ __forceinline__ void p_moe2(Frame& F) {
    pg8::Gemm g{(const pg8::bf16_t*)(F.ws + WS_HID), (const pg8::bf16_t*)moe_w2(F, LAYER), EFF};
    pg8::MoeOrder<false> S{(const LAS int*)(F.lds + MOETAB_OFF), (const int*)(F.ws + WS_PERM_), F.G, F.bid, EFF};
    pg8::EpiMoe2 E{(pg8::bf16_t*)(F.ws + WS_Y), (const float*)(F.ws + WS_GATE)};
    pg8::gemm_phase<pg8::EpiMoe2, pg8::MoeOrder<false>>(F.lds + RING_OFF, g, S, E, F.wave);
    if (LAYER == 0) { const int nunits = ((const LAS int*)(F.lds + MOETAB_OFF))[0]; const int rounds = (nunits + F.G - 1) / F.G, c0 = nunits - (rounds - 1) * F.G;
        if (c0 >= F.G) convert_dense_l1(F, F.bid, F.G); else if (F.bid >= c0) convert_dense_l1(F, F.bid - c0, F.G - c0); }
}
__device__ __forceinline__ void p_gemm_dense(Frame& F, size_t a_off, size_t w_off, int N, size_t o_off, int ldc, int skip9 = 0, int Geff = 0) {
    pg8::Gemm g{(const pg8::bf16_t*)(F.ws + a_off), (const pg8::bf16_t*)(F.ws + w_off), DM};
    pg8::DenseOrder S; S.init(MROWS, N, DM, Geff > 0 ? Geff : F.G, F.bid, skip9);
    pg8::EpiBf16 E{(pg8::bf16_t*)(F.ws + o_off), ldc};
    pg8::gemm_phase<pg8::EpiBf16, pg8::DenseOrder>(F.lds + RING_OFF, g, S, E, F.wave);
}

template <int PH> __device__ __forceinline__ void run_phase(Frame& F) {
    if constexpr (PH == PH_PROLOGUE) p_mods(F);
    else if constexpr (PH == PH_MOD0) { p_prologue(F); p_mod0(F); }
    else if constexpr (PH == PH_GEMM_IN0) {
        pg8::Gemm g{(const pg8::bf16_t*)(F.ws + WS_H), (const pg8::bf16_t*)(F.ws + WS_WEVIN), DM};
        pg8::DenseOrder S; S.init(MROWS, EVEN_PAD, DM, F.G, F.bid);
        pg8::EpiIn0 E{(pg8::bf16_t*)(F.ws + WS_PA), (pg8::bf16_t*)(F.ws + WS_PB)};
        pg8::gemm_phase<pg8::EpiIn0, pg8::DenseOrder>(F.lds + RING_OFF, g, S, E, F.wave); }
    else if constexpr (PH == PH_PREP) { p_rope0(F); p_linact(F); }
    else if constexpr (PH == PH_CHUNK) p_chunk_pre(F);
    else if constexpr (PH == PH_ATTN0) { p_state(F); p_attn0(F); }
    else if constexpr (PH == PH_READOUT) p_readout(F);
    else if constexpr (PH == PH_GEMM_OUT0) {
        constexpr int NUNITS = (MROWS / 256) * (DM / 256), NCV = 64, XSPLIT = 2304;
        const int Gg = F.G - NCV;
        if (Gg >= NUNITS / 2 && Gg < NUNITS && F.G > 2 * NCV) {
            if (F.bid < Gg) { p_gemm_dense(F, WS_A2, WS_WEVOUT, DM, WS_MIX, DM, 0, Gg);
                const int c0 = NUNITS - Gg;
                if (F.bid >= c0) convert_moe_weights(F, 0, XSPLIT, MOE_I13, F.bid - c0, Gg - c0); }
            else convert_moe_weights(F, 0, 0, XSPLIT, F.bid - Gg, NCV);
        } else { p_gemm_dense(F, WS_A2, WS_WEVOUT, DM, WS_MIX, DM); convert_moe_filler(F, 0, 0, MOE_I13, NUNITS); }
    }
    else if constexpr (PH == PH_LNR0) p_ln_route<0>(F);
    else if constexpr (PH == PH_MOE1_0) p_moe1<0>(F);
    else if constexpr (PH == PH_MOE2_0) p_moe2<0>(F);
    else if constexpr (PH == PH_LN2_0) p_ln2<0>(F);
    else if constexpr (PH == PH_GEMM_IN1) { p_gemm_dense(F, WS_H, WS_WODIN, ODD_IN, WS_QKV1, ODD_IN); convert_moe_filler(F, 1, MOE_I13 / 2, MOE_I13, (MROWS / 256) * (ODD_IN / 256)); }
    else if constexpr (PH == PH_QKN1) p_qknorm1(F);
    else if constexpr (PH == PH_ATTN1) p_attn1(F);
    else if constexpr (PH == PH_GEMM_OUT1) p_gemm_dense(F, WS_OATT, WS_WODOUT, DM, WS_MIX, DM, 1);
    else if constexpr (PH == PH_LNR1) p_ln_route<1>(F);
    else if constexpr (PH == PH_MOE1_1) p_moe1<1>(F);
    else if constexpr (PH == PH_MOE2_1) p_moe2<1>(F);
    else if constexpr (PH == PH_FINAL) p_ln2<1>(F);
}
template <int PH, int HI> __device__ __forceinline__ void run_phases(Frame& F, const XcdBarrier& bar) {
    if constexpr (PH < HI) {
        {
            const CAS unsigned long long* inp = (const CAS unsigned long long*)__builtin_amdgcn_kernarg_segment_ptr(); asm volatile("" : "+s"(inp)); F.in.t = inp;
            asm volatile("" : "+s"(F.ws), "+s"(F.out), "+s"(F.G), "+s"(F.bid), "+s"(F.wave));
            const int l_ = lane_id_fresh(); F.lane = l_; F.tid = (F.wave << 6) | l_; }
        asm volatile("; PHASE_MARK %0" :: "i"(PH));
        run_phase<PH>(F);
        if constexpr (PH + 1 < HI) { xcd_barrier(bar, F.wave);
#ifdef XBAR_EXTRA
            if constexpr (PH == 5) { for (int q_ = 0; q_ < XBAR_EXTRA; ++q_) xcd_barrier(bar, F.wave); }
#endif
#ifdef TPROBE_A
            if (F.tid == 0) ((volatile LAS unsigned long long*)(F.lds + MISC_OFF + 128))[PH + 1] = __builtin_amdgcn_s_memrealtime();
#endif
            run_phases<PH + 1, HI>(F, bar); }
    }
}

template <int LO, int HI>
__global__ void __launch_bounds__(NTHR, 2) fwd_kernel(Args args) {
    Frame F;
    F.lds = (LAS unsigned char*)g_lds;
    F.tid = threadIdx.x; F.lane = F.tid & 63; F.wave = __builtin_amdgcn_readfirstlane(F.tid >> 6);
    F.G = gridDim.x; F.bid = blockIdx.x; F.in.t = (const CAS unsigned long long*)__builtin_amdgcn_kernarg_segment_ptr(); F.out = (GAS float*)args.out; F.ws = (GAS unsigned char*)args.ws;
    volatile LAS unsigned* MISC = (volatile LAS unsigned*)(F.lds + MISC_OFF);
    for (int u = F.tid; u < (LDS_BYTES - LDSCTL_OFF) / 4; u += NTHR) ((LAS unsigned*)(F.lds + LDSCTL_OFF))[u] = 0u;
    __syncthreads();
    XcdBarrier bar; bar.bar = (unsigned*)(F.ws + WS_CTL) + CW_BAR; bar.x = 0; bar.st = nullptr;
    if constexpr (HI - LO > 1) bar = xcd_barrier_post((unsigned*)(F.ws + WS_CTL) + CW_BAR, MISC + 8);
#ifdef TPROBE_A
    if (threadIdx.x == 0) ((volatile LAS unsigned long long*)(F.lds + MISC_OFF + 128))[0] = __builtin_amdgcn_s_memrealtime();
#endif
    run_phases<LO, HI>(F, bar);
}

#ifndef N_LAUNCH_MODE
#define N_LAUNCH_MODE 0
#endif
template <int PH> static void launch_from(int grid, hipStream_t stream, const Args& a) {
    if constexpr (PH < N_PHASES) {
        (void)hipFuncSetAttribute((const void*)fwd_kernel<PH, PH + 1>, hipFuncAttributeMaxDynamicSharedMemorySize, LDS_BYTES);
        hipLaunchKernelGGL((fwd_kernel<PH, PH + 1>), dim3(grid), dim3(NTHR), LDS_BYTES, stream, a);
#ifdef PROBE_MASK
        if ((PROBE_MASK >> PH) & 1) hipLaunchKernelGGL((fwd_kernel<PH, PH + 1>), dim3(grid), dim3(NTHR), LDS_BYTES, stream, a);
#endif
        launch_from<PH + 1>(grid, stream, a);
    }
}
extern "C" void kernel_launch(void* const* d_in, const int* in_sizes, int n_in, void* d_out, int out_size, void* d_ws, size_t ws_size, hipStream_t stream) {
    static int grid = 0;
    if (grid == 0) {
        if (n_in != 34 || in_sizes[0] != NB * SEQ * DM || out_size != NB * SEQ * DM || ws_size < WS_TOTAL) {
            fprintf(stderr, "kernel_launch: unexpected shapes: n_in %d in0 %d out %d ws %zu (need %zu)\n", n_in, n_in > 0 ? in_sizes[0] : -1, out_size, ws_size, (size_t)WS_TOTAL); grid = -1; return; }
        int dev = 0, cus = 0;
        if (hipGetDevice(&dev) != hipSuccess || hipDeviceGetAttribute(&cus, hipDeviceAttributeMultiprocessorCount, dev) != hipSuccess) { grid = -1; return; }
#if N_LAUNCH_MODE == 0
        if (hipFuncSetAttribute((const void*)fwd_kernel<0, N_PHASES>, hipFuncAttributeMaxDynamicSharedMemorySize, LDS_BYTES) != hipSuccess) { fprintf(stderr, "kernel_launch: hipFuncSetAttribute failed\n"); grid = -1; return; }
#endif
        (void)hipGetLastError();
        grid = cus;
    }
    if (grid < 0) return;
    if (hipMemsetAsync((char*)d_ws + WS_CTL, 0, CTL_ZERO_BYTES, stream) != hipSuccess) return;
    Args a{};
    for (int i = 0; i < 34; ++i) a.in[i] = (const float*)d_in[i];
    a.out = (float*)d_out; a.ws = (unsigned char*)d_ws;
#if N_LAUNCH_MODE == 1
    launch_from<0>(grid, stream, a);
#else
    hipLaunchKernelGGL((fwd_kernel<0, N_PHASES>), dim3(grid), dim3(NTHR), LDS_BYTES, stream, a);
#endif
    const hipError_t le = hipPeekAtLastError();
    if (le != hipSuccess) fprintf(stderr, "kernel_launch: launch failed: %s\n", hipGetErrorName(le));
}
```
